# Optimizing an MI355X kernel written in HIP

```python
import jax, jax.numpy as jnp
from jax import lax
import numpy as np

D_MODEL = 2048
BATCH = 4
SEQ = 8192
DEPTH = 2

EPS = 1e-6
N_BRANCH = 3
BRANCH_WIDTH = D_MODEL // 4
SGU_GROUPS = 8
SGU_GROUP_DIM = BRANCH_WIDTH // SGU_GROUPS
SGU_CHUNK = 128
MOBA_HEADS = 8
MOBA_HEAD_DIM = BRANCH_WIDTH // MOBA_HEADS
MOBA_BLOCK = 256
MOBA_TOPK = 3
MOBA_QBLOCK = 64
POOL_WINDOWS = (2, 4, 8, 16)
POOL_GROUPS = 4
POOL_GROUP_DIM = BRANCH_WIDTH // POOL_GROUPS
IN_SPLIT_POINTS = tuple(BRANCH_WIDTH * i for i in range(1, 7))
IN_WIDTH = 6 * BRANCH_WIDTH + N_BRANCH * D_MODEL
D_FF = 11 * D_MODEL // 4
CONV_WIDTH = 3
N_MOD = 6

kernel_name = "hybrid_sgu_moba_pool_block"


def rms_norm(x, g):
    xf = x.astype(jnp.float32)
    y = xf * lax.rsqrt(jnp.mean(xf * xf, axis=-1, keepdims=True) + EPS)
    return (y * g.astype(jnp.float32)).astype(x.dtype)


def alibi_slopes(n_heads):
    return jnp.exp2(-(8.0 / n_heads) * jnp.arange(1, n_heads + 1, dtype=jnp.float32))


def spatial_gating(u, v, norm_g, w_s, b_s):
    Bsz, S, _ = u.shape
    vf = v.astype(jnp.float32)
    mu = jnp.mean(vf, axis=-1, keepdims=True)
    var = jnp.mean(jnp.square(vf - mu), axis=-1, keepdims=True)
    vn = (vf - mu) * lax.rsqrt(var + EPS) * norm_g.astype(jnp.float32)
    vc = vn.reshape(Bsz, S // SGU_CHUNK, SGU_CHUNK, SGU_GROUPS, SGU_GROUP_DIM)
    mask = jnp.tril(jnp.ones((SGU_CHUNK, SGU_CHUNK), jnp.float32))
    w = w_s.astype(jnp.float32) * mask
    mixed = jnp.einsum('gts,bcsgd->bctgd', w, vc) + b_s.astype(jnp.float32).T[None, None, :, :, None]
    return u * mixed.reshape(Bsz, S, BRANCH_WIDTH).astype(u.dtype)


def moba_attention(q, k, v):
    Bsz, S, _ = q.shape
    H, Dh, BLK, QB = MOBA_HEADS, MOBA_HEAD_DIM, MOBA_BLOCK, MOBA_QBLOCK
    nb = -(-S // BLK)
    pad = nb * BLK - S

    def heads(t):
        return t.reshape(Bsz, S, H, Dh).transpose(0, 2, 1, 3)

    qh = heads(q)
    kb = jnp.pad(heads(k), ((0, 0), (0, 0), (0, pad), (0, 0))).reshape(Bsz, H, nb, BLK, Dh)
    vb = jnp.pad(heads(v), ((0, 0), (0, 0), (0, pad), (0, 0))).reshape(Bsz, H, nb, BLK, Dh)
    kmean = jnp.mean(kb.astype(jnp.float32), axis=3)
    slopes = alibi_slopes(H)[None, :, None, None]
    k_sel = min(MOBA_TOPK, nb)
    scale = Dh ** -0.5
    bi = jnp.arange(Bsz)[:, None, None, None]
    hi = jnp.arange(H)[None, :, None, None]
    key_off = jnp.arange(BLK)
    n_q = S // QB
    q_chunks = qh.reshape(Bsz, H, n_q, QB, Dh).transpose(2, 0, 1, 3, 4)

    def attend(args):
        qc, ci = args
        t = ci * QB + jnp.arange(QB)
        own = (ci * QB) // BLK
        blk_scores = jnp.einsum('bhqd,bhnd->bhqn', qc.astype(jnp.float32), kmean)
        blk_scores = jnp.where(jnp.arange(nb) < own, blk_scores, -jnp.inf)
        _, idx = lax.top_k(blk_scores, k_sel)
        ksel = kb[bi, hi, idx]
        vsel = vb[bi, hi, idx]
        s_past = jnp.einsum('bhqd,bhqjsd->bhqjs', qc, ksel,
                            preferred_element_type=jnp.float32) * scale
        pos_past = idx[..., None] * BLK + key_off
        dist_past = (t[None, None, :, None, None] - pos_past).astype(jnp.float32)
        s_past = s_past - slopes[..., None] * dist_past
        valid = (jnp.arange(k_sel) < own)[:, None]
        s_past = jnp.where(valid, s_past, -jnp.inf).reshape(Bsz, H, QB, k_sel * BLK)
        k_own = lax.dynamic_index_in_dim(kb, own, axis=2, keepdims=False)
        v_own = lax.dynamic_index_in_dim(vb, own, axis=2, keepdims=False)
        dist_own = t[:, None] - (own * BLK + key_off)[None, :]
        s_own = jnp.einsum('bhqd,bhsd->bhqs', qc, k_own,
                           preferred_element_type=jnp.float32) * scale
        s_own = s_own - slopes * dist_own.astype(jnp.float32)
        s_own = jnp.where(dist_own >= 0, s_own, -jnp.inf)
        p = jax.nn.softmax(jnp.concatenate([s_past, s_own], axis=-1), axis=-1)
        p_past = p[..., :k_sel * BLK].reshape(Bsz, H, QB, k_sel, BLK).astype(v.dtype)
        p_own = p[..., k_sel * BLK:].astype(v.dtype)
        o = (jnp.einsum('bhqjs,bhqjsd->bhqd', p_past, vsel, preferred_element_type=jnp.float32)
             + jnp.einsum('bhqs,bhsd->bhqd', p_own, v_own, preferred_element_type=jnp.float32))
        return o.astype(v.dtype)

    out = lax.map(attend, (q_chunks, jnp.arange(n_q)))
    return out.transpose(1, 0, 3, 2, 4).reshape(Bsz, S, H * Dh)


def multiscale_pool(z, pool_w, pool_scale):
    Bsz, S, _ = z.shape
    zf = z.astype(jnp.float32).reshape(Bsz, S, POOL_GROUPS, POOL_GROUP_DIM)
    cs = jnp.pad(jnp.cumsum(zf, axis=1), ((0, 0), (1, 0), (0, 0), (0, 0)))
    t = jnp.arange(S)
    means = []
    for gi, w in enumerate(POOL_WINDOWS):
        lo = jnp.maximum(t + 1 - w, 0)
        win_sum = cs[:, 1:, gi] - jnp.take(cs[:, :, gi], lo, axis=1)
        count = jnp.minimum(t + 1, w).astype(jnp.float32)
        means.append(win_sum / count[None, :, None])
    pooled = jnp.stack(means, axis=2) - zf
    y = jnp.einsum('bsgc,gcd->bsgd', pooled, pool_w.astype(jnp.float32))
    return (y.reshape(Bsz, S, BRANCH_WIDTH) * pool_scale.astype(jnp.float32)).astype(z.dtype)


def token_mixing(h, w_in, b_in, sgu_norm_g, sgu_w, sgu_b, pool_w, pool_scale,
                 w_sgu_out, w_moba_out, w_pool_out, w_out):
    p = h @ w_in + b_in
    u, v, q, k, v_att, z_pool, gates = jnp.split(p, IN_SPLIT_POINTS, axis=-1)
    y_sgu = spatial_gating(jax.nn.gelu(u), jax.nn.gelu(v), sgu_norm_g, sgu_w, sgu_b)
    y_moba = moba_attention(q, k, v_att)
    y_pool = multiscale_pool(z_pool, pool_w, pool_scale)
    g_sgu, g_moba, g_pool = jnp.split(jax.nn.sigmoid(gates), N_BRANCH, axis=-1)
    merged = (g_sgu * (y_sgu @ w_sgu_out) + g_moba * (y_moba @ w_moba_out)
              + g_pool * (y_pool @ w_pool_out))
    return merged @ w_out


def conv_ffn(h, w_up, w_conv, b_conv, w_down):
    z = h @ w_up
    z1 = jnp.pad(z[:, :-1], ((0, 0), (1, 0), (0, 0)))
    z2 = jnp.pad(z[:, :-2], ((0, 0), (2, 0), (0, 0)))
    z = w_conv[0] * z2 + w_conv[1] * z1 + w_conv[2] * z + b_conv
    gate, val = jnp.split(z, 2, axis=-1)
    return (jax.nn.gelu(gate) * val) @ w_down


def setup_inputs(seed: int = 0) -> dict:
    key = jax.random.key(seed)
    ks = jax.random.split(key, 24)
    f32 = jnp.float32
    L, D = DEPTH, D_MODEL

    def nrm(k, shape, s):
        return jax.random.normal(k, shape, f32) * s

    return {
        "x": nrm(ks[0], (BATCH, SEQ, D), 1.0),
        "c": nrm(ks[1], (BATCH, D), 1.0),
        "g_pre_mix": 1.0 + nrm(ks[2], (L, D), 0.02),
        "g_post_mix": 1.0 + nrm(ks[3], (L, D), 0.02),
        "g_pre_ffn": 1.0 + nrm(ks[4], (L, D), 0.02),
        "g_post_ffn": 1.0 + nrm(ks[5], (L, D), 0.02),
        "w_ada": nrm(ks[6], (L, D, N_MOD * D), D ** -0.5),
        "b_ada": nrm(ks[7], (L, N_MOD * D), 0.01),
        "w_in": nrm(ks[8], (L, D, IN_WIDTH), D ** -0.5),
        "b_in": nrm(ks[9], (L, IN_WIDTH), 0.01),
        "sgu_norm_g": 1.0 + nrm(ks[10], (L, BRANCH_WIDTH), 0.02),
        "sgu_w": nrm(ks[11], (L, SGU_GROUPS, SGU_CHUNK, SGU_CHUNK), SGU_CHUNK ** -0.5),
        "sgu_b": 1.0 + nrm(ks[12], (L, SGU_GROUPS, SGU_CHUNK), 0.02),
        "pool_w": nrm(ks[13], (L, POOL_GROUPS, POOL_GROUP_DIM, POOL_GROUP_DIM), POOL_GROUP_DIM ** -0.5),
        "pool_scale": 1.0 + nrm(ks[14], (L, BRANCH_WIDTH), 0.02),
        "w_sgu_out": nrm(ks[15], (L, BRANCH_WIDTH, D), BRANCH_WIDTH ** -0.5),
        "w_moba_out": nrm(ks[16], (L, BRANCH_WIDTH, D), BRANCH_WIDTH ** -0.5),
        "w_pool_out": nrm(ks[17], (L, BRANCH_WIDTH, D), BRANCH_WIDTH ** -0.5),
        "w_out": nrm(ks[18], (L, D, D), D ** -0.5),
        "w_up": nrm(ks[19], (L, D, 2 * D_FF), D ** -0.5),
        "w_conv": nrm(ks[20], (L, CONV_WIDTH, 2 * D_FF), CONV_WIDTH ** -0.5),
        "b_conv": nrm(ks[21], (L, 2 * D_FF), 0.01),
        "w_down": nrm(ks[22], (L, D_FF, D), D_FF ** -0.5),
    }


def reference(x, c, g_pre_mix, g_post_mix, g_pre_ffn, g_post_ffn, w_ada, b_ada,
              w_in, b_in, sgu_norm_g, sgu_w, sgu_b, pool_w, pool_scale,
              w_sgu_out, w_moba_out, w_pool_out, w_out, w_up, w_conv, b_conv, w_down):
    cond = jax.nn.silu(c)
    for l in range(DEPTH):
        mod = cond @ w_ada[l] + b_ada[l]
        sh1, sc1, gt1, sh2, sc2, gt2 = [m[:, None, :] for m in jnp.split(mod, N_MOD, axis=-1)]
        h = rms_norm(x, g_pre_mix[l]) * (1.0 + sc1) + sh1
        y = token_mixing(h, w_in[l], b_in[l], sgu_norm_g[l], sgu_w[l], sgu_b[l],
                         pool_w[l], pool_scale[l], w_sgu_out[l], w_moba_out[l],
                         w_pool_out[l], w_out[l])
        x = x + gt1 * rms_norm(y, g_post_mix[l])
        h = rms_norm(x, g_pre_ffn[l]) * (1.0 + sc2) + sh2
        y = conv_ffn(h, w_up[l], w_conv[l], b_conv[l], w_down[l])
        x = x + gt2 * rms_norm(y, g_post_ffn[l])
    return x
```

```cpp
#include <hip/hip_runtime.h>
#include <cstdio>
#include <cstdint>
namespace pg8 {
#define PG8_LAS __attribute__((address_space(3)))
typedef unsigned short bf16_t;
typedef short bf16x8 __attribute__((ext_vector_type(8)));
typedef float f32x4 __attribute__((ext_vector_type(4)));
typedef unsigned u32x4 __attribute__((ext_vector_type(4)));
constexpr int BM = 256, BK = 64, HALF = 128, HTB = HALF * BK * 2  , STAGE_BYTES = 8 * HTB, NXCD = 8, WGM = 8;

__host__ __device__ __forceinline__ int lds_byte(int r, int c) { const int st = (r >> 4) * 2 + (c >> 5), rr = r & 15, cc = c & 31, ob = rr * 64 + cc * 2; return st * 1024 + (ob ^ (((ob >> 9) & 1) << 5)); }
__host__ __device__ __forceinline__ void stage_rc(int b, int& R, int& C) { const int st = b / 1024, sb = b % 1024, swz = sb ^ (((sb >> 9) & 1) << 5); R = (st >> 1) * 16 + swz / 64; C = (st & 1) * 32 + (swz % 64) / 2; }
__host__ __device__ __forceinline__ int perm32(int rho) { const int n = rho >> 4, i = rho & 15; return 8 * (i >> 2) + 4 * n + (i & 3); }

struct Unit { int pm, pn; };
struct Gemm { const bf16_t* A; const bf16_t* Bt; int M, N, K; };

struct StaticOrder {
    int nM, nN, nwg, G, c;
    __host__ __device__ void init(int M, int N, int G_, int c_) { nM = M / BM; nN = N / BM; nwg = nM * nN; G = G_; c = c_; }
    __host__ __device__ bool next(int i, Unit& u) const {
        const long L = (long)i * G + c; if (L >= nwg) return false;
        int wgid = (int)L; { const int q = nwg / NXCD, r = nwg % NXCD, xcd = wgid % NXCD, off = wgid / NXCD; wgid = (xcd < r ? xcd * (q + 1) : r * (q + 1) + (xcd - r) * q) + off; }
        const int nig = WGM * nN, gid = wgid / nig, fm = gid * WGM, gsz = (nM - fm) < WGM ? (nM - fm) : WGM;
        u.pm = fm + ((wgid % nig) % gsz); u.pn = (wgid % nig) / gsz; return true;
    }
    __device__ __forceinline__ void a_ready(const Unit&) const {}
    __device__ __forceinline__ void done(const Unit&) const {}
};

__device__ __forceinline__ unsigned cvt_pk_bf16(float lo, float hi) { unsigned r; asm volatile("v_cvt_pk_bf16_f32 %0, %1, %2" : "=v"(r) : "v"(lo), "v"(hi)); return r; }
typedef float f32x2 __attribute__((ext_vector_type(2)));
template <class Epi, class Sched, bool ALIGN_EPI = false, bool SP2 = false>
__device__ __forceinline__ void gemm_phase(PG8_LAS unsigned char* lds, const Gemm g, const Sched& S, const Epi& E) {
    int tid_l = threadIdx.x; asm volatile("" : "+v"(tid_l));
    const int tid = tid_l, wid = __builtin_amdgcn_readfirstlane(tid >> 6), lane = tid & 63, wr = wid >> 2, wc = wid & 3, fr = lane & 15, fq = lane >> 4;
    const int K = g.K, nt = K / BK;
    unsigned voffA[2], voffB[2];
#pragma unroll
    for (int i = 0; i < 2; ++i) { int R, C; stage_rc(tid * 16 + i * 8192, R, C); const int Rb = Epi::PERM ? ((R & ~31) + perm32(R & 31)) : R;
        voffA[i] = (unsigned)(R * K + C) * 2u; voffB[i] = (unsigned)(Rb * K + C) * 2u; }
    const size_t kstep = (size_t)(BK * 2);
    const size_t hstep = (size_t)HALF * K * 2;
    const size_t tstep = 2 * hstep;
    const unsigned ldsw = (unsigned)wid * 1024u;
    const int aoff = lds_byte(wr * 64 + fr, fq * 8), boff = lds_byte(wc * 32 + fr, fq * 8);
#define PG8_SA(b, h) (((b) * 2 + (h)) * HTB)
#define PG8_SB(b, h) ((4 + (b) * 2 + (h)) * HTB)
#define PG8_STAGE(bufoff, gbase, voff) do { _Pragma("unroll") for (int _i = 0; _i < 2; ++_i) \
        __builtin_amdgcn_global_load_lds((const unsigned*)((const char*)(gbase) + (voff)[_i]), (PG8_LAS unsigned*)(lds + (bufoff) + ldsw + _i * 8192), 16, 0, 0); } while (0)
#define PG8_LDA(dst, b, h) do { _Pragma("unroll") for (int m = 0; m < 4; ++m) _Pragma("unroll") for (int k = 0; k < 2; ++k) dst[m][k] = *(const PG8_LAS bf16x8*)(lds + PG8_SA(b, h) + aoff + m * 2048 + k * 1024); } while (0)
#define PG8_LDB(dst, b, h) do { _Pragma("unroll") for (int n = 0; n < 2; ++n) _Pragma("unroll") for (int k = 0; k < 2; ++k) dst[n][k] = *(const PG8_LAS bf16x8*)(lds + PG8_SB(b, h) + boff + n * 2048 + k * 1024); } while (0)
#define PG8_MMA(ai, bj, At, Bt) do { __builtin_amdgcn_s_setprio(1); _Pragma("unroll") for (int m = 0; m < 4; ++m) _Pragma("unroll") for (int n = 0; n < 2; ++n) _Pragma("unroll") for (int k = 0; k < 2; ++k) \
        acc[ai][bj][m][n] = __builtin_amdgcn_mfma_f32_16x16x32_bf16(Bt[n][k], At[m][k], acc[ai][bj][m][n], 0, 0, 0); __builtin_amdgcn_s_setprio(0); } while (0)
#define PG8_WAIT_V(n) asm volatile("s_waitcnt vmcnt(" #n ")" ::: "memory")
#define PG8_WAIT_L(n) asm volatile("s_waitcnt lgkmcnt(" #n ")" ::: "memory")
#define PG8_BAR __builtin_amdgcn_s_barrier()
#define PG8_SCHED __builtin_amdgcn_sched_barrier(0)
    Unit cur, nxt; int ui = 0;
    if (!S.next(0, cur)) return;
    f32x4 acc[2][2][4][2];
#pragma unroll
    for (int a = 0; a < 2; ++a)
#pragma unroll
        for (int b = 0; b < 2; ++b)
#pragma unroll
            for (int m = 0; m < 4; ++m)
#pragma unroll
                for (int n = 0; n < 2; ++n) acc[a][b][m][n] = (f32x4){0.f, 0.f, 0.f, 0.f};
    bf16x8 At[4][2], B0[2][2], B1[2][2];
    const char* cA = (const char*)g.A + (size_t)cur.pm * tstep; const char* cB = (const char*)g.Bt + (size_t)cur.pn * tstep;
    S.a_ready(cur);
    if constexpr (SP2) {
        PG8_STAGE(PG8_SB(0, 0), cB, voffB); PG8_STAGE(PG8_SB(0, 1), cB + hstep, voffB); PG8_STAGE(PG8_SA(0, 0), cA, voffA); PG8_STAGE(PG8_SA(0, 1), cA + hstep, voffA);
        if (wr == 1) PG8_BAR;
        PG8_WAIT_V(2); PG8_BAR;
        PG8_STAGE(PG8_SB(1, 0), cB + kstep, voffB); PG8_STAGE(PG8_SA(1, 0), cA + kstep, voffA); PG8_STAGE(PG8_SB(1, 1), cB + hstep + kstep, voffB);
        PG8_WAIT_V(6); PG8_BAR;
    } else {
        PG8_STAGE(PG8_SB(0, 0), cB, voffB); PG8_STAGE(PG8_SA(0, 0), cA, voffA); PG8_STAGE(PG8_SB(0, 1), cB + hstep, voffB); PG8_STAGE(PG8_SA(0, 1), cA + hstep, voffA);
        if (wr == 1) PG8_BAR;
        PG8_WAIT_V(4); PG8_BAR;
        PG8_STAGE(PG8_SB(1, 0), cB + kstep, voffB); PG8_STAGE(PG8_SA(1, 0), cA + kstep, voffA); PG8_STAGE(PG8_SB(1, 1), cB + hstep + kstep, voffB);
        PG8_WAIT_V(6); PG8_BAR;
    }
    for (;;) {
        const bool has_next = S.next(ui + 1, nxt);
        const char* nA = has_next ? (const char*)g.A + (size_t)nxt.pm * tstep : cA; const char* nB = has_next ? (const char*)g.Bt + (size_t)nxt.pn * tstep : cB;
        for (int t = 0; t < nt; t += 2) {
            const bool last = (t == nt - 2);
            const char* a1 = cA + (size_t)(t + 1) * kstep;
            const char* a2 = last ? nA : cA + (size_t)(t + 2) * kstep; const char* b2 = last ? nB : cB + (size_t)(t + 2) * kstep;
            const char* a3 = a2 + kstep; const char* b3 = b2 + kstep;
            if (last && has_next) S.a_ready(nxt);
            if constexpr (SP2) {
            PG8_LDB(B0, 0, 0); PG8_LDB(B1, 0, 1); PG8_SCHED; PG8_LDA(At, 0, 0); PG8_STAGE(PG8_SA(1, 1), a1 + hstep, voffA);
            PG8_WAIT_V(8); PG8_WAIT_L(0); PG8_BAR; PG8_MMA(0, 0, At, B0); PG8_MMA(0, 1, At, B1); PG8_BAR; PG8_SCHED;
            PG8_LDA(At, 0, 1); PG8_STAGE(PG8_SB(0, 0), b2, voffB); PG8_STAGE(PG8_SB(0, 1), b2 + hstep, voffB); PG8_STAGE(PG8_SA(0, 0), a2, voffA);
            PG8_WAIT_V(8); PG8_WAIT_L(0); PG8_BAR; PG8_MMA(1, 0, At, B0); PG8_MMA(1, 1, At, B1); PG8_BAR; PG8_SCHED;
            PG8_LDB(B0, 1, 0); PG8_LDB(B1, 1, 1); PG8_SCHED; PG8_LDA(At, 1, 0); PG8_STAGE(PG8_SA(0, 1), a2 + hstep, voffA);
            PG8_WAIT_V(8); PG8_WAIT_L(0); PG8_BAR; PG8_MMA(0, 0, At, B0); PG8_MMA(0, 1, At, B1); PG8_BAR; PG8_SCHED;
            PG8_LDA(At, 1, 1); PG8_STAGE(PG8_SB(1, 0), b3, voffB); PG8_STAGE(PG8_SB(1, 1), b3 + hstep, voffB); PG8_STAGE(PG8_SA(1, 0), a3, voffA);
            PG8_WAIT_V(8); PG8_WAIT_L(0); PG8_BAR; PG8_MMA(1, 0, At, B0); PG8_MMA(1, 1, At, B1); PG8_BAR; PG8_SCHED;
            } else {
            PG8_LDB(B0, 0, 0); PG8_SCHED; PG8_LDA(At, 0, 0); PG8_STAGE(PG8_SA(1, 1), a1 + hstep, voffA);
            PG8_WAIT_L(8); PG8_BAR; PG8_WAIT_L(0); PG8_MMA(0, 0, At, B0); PG8_BAR; PG8_SCHED;
            PG8_LDB(B1, 0, 1); PG8_STAGE(PG8_SB(0, 0), b2, voffB);
            PG8_BAR; PG8_WAIT_L(0); PG8_MMA(0, 1, At, B1); PG8_BAR;
            PG8_LDA(At, 0, 1); PG8_STAGE(PG8_SA(0, 0), a2, voffA);
            PG8_BAR; PG8_WAIT_L(0); PG8_MMA(1, 0, At, B0); PG8_BAR; PG8_SCHED;
            PG8_STAGE(PG8_SB(0, 1), b2 + hstep, voffB);
            PG8_WAIT_V(6); PG8_BAR; PG8_MMA(1, 1, At, B1); PG8_BAR;
            PG8_LDB(B0, 1, 0); PG8_SCHED; PG8_LDA(At, 1, 0); PG8_STAGE(PG8_SA(0, 1), a2 + hstep, voffA);
            PG8_WAIT_L(8); PG8_BAR; PG8_WAIT_L(0); PG8_MMA(0, 0, At, B0); PG8_BAR; PG8_SCHED;
            PG8_LDB(B1, 1, 1); PG8_STAGE(PG8_SB(1, 0), b3, voffB);
            PG8_BAR; PG8_WAIT_L(0); PG8_MMA(0, 1, At, B1); PG8_BAR;
            PG8_LDA(At, 1, 1); PG8_STAGE(PG8_SA(1, 0), a3, voffA);
            PG8_BAR; PG8_WAIT_L(0); PG8_MMA(1, 0, At, B0); PG8_BAR; PG8_SCHED;
            PG8_STAGE(PG8_SB(1, 1), b3 + hstep, voffB);
            PG8_WAIT_V(6); PG8_BAR; PG8_MMA(1, 1, At, B1); PG8_BAR;
            }
        }
        if constexpr (ALIGN_EPI) { if (wr == 0) PG8_BAR; }
        if constexpr (!Epi::AFTER_DRAIN) { E(acc, cur, wr, wc, fr, fq); S.done(cur); }
        if (!has_next) break;
#pragma unroll
        for (int a = 0; a < 2; ++a)
#pragma unroll
            for (int b = 0; b < 2; ++b)
#pragma unroll
                for (int m = 0; m < 4; ++m)
#pragma unroll
                    for (int n = 0; n < 2; ++n) acc[a][b][m][n] = (f32x4){0.f, 0.f, 0.f, 0.f};
        cur = nxt; cA = nA; cB = nB; ++ui;
        if constexpr (ALIGN_EPI) { if (wr == 1) PG8_BAR; }
    }
    PG8_WAIT_V(0);
    if constexpr (!ALIGN_EPI) { if (wr == 0) PG8_BAR; }
    PG8_BAR;
    if constexpr (Epi::AFTER_DRAIN) { E.fused(acc, cur, wr, wc, fr, fq, lds, wid, lane); S.done(cur); }
#undef PG8_SA
#undef PG8_SB
#undef PG8_STAGE
#undef PG8_LDA
#undef PG8_LDB
#undef PG8_MMA
#undef PG8_WAIT_V
#undef PG8_WAIT_L
#undef PG8_BAR
#undef PG8_SCHED
}
}
#define GAS __attribute__((address_space(1)))
#define LAS __attribute__((address_space(3)))
typedef unsigned short bf16;
typedef unsigned v4u __attribute__((ext_vector_type(4)));
typedef float f32x4 __attribute__((ext_vector_type(4)));
typedef short bf16x8 __attribute__((ext_vector_type(8)));
typedef GAS unsigned gu32;
typedef GAS unsigned long long gu64;
#define RLX_AGENT __ATOMIC_RELAXED, __HIP_MEMORY_SCOPE_AGENT
#define LDS_WAIT() asm volatile("s_waitcnt lgkmcnt(0)" ::: "memory")
#define VM_WAIT() asm volatile("s_waitcnt vmcnt(0)" ::: "memory")
__device__ __forceinline__ unsigned long long rt() { return __builtin_amdgcn_s_memrealtime(); }
__device__ __forceinline__ unsigned f2bf(float f) { unsigned u = __builtin_bit_cast(unsigned, f); return (u + 0x7fffu + ((u >> 16) & 1u)) >> 16; }
__device__ __forceinline__ unsigned pk2(float lo, float hi) { return f2bf(lo) | (f2bf(hi) << 16); }
#define XB_TMO      128
#define XB_XCNT(j)  (256  + 64 * (j))
#define XB_XSUB(j)  (1280 + 64 * (j))
#define XB_XGEN(j)  (2304 + 64 * (j))
#define XB_TOP      3328
#define XB_TOPGEN   3392
#define XCD_BAR_WORDS 3456
#define XB_SPIN_CAP (1u << 18)

__device__ __forceinline__ unsigned xb_ld(unsigned* p)              { return __hip_atomic_load(p, __ATOMIC_RELAXED, __HIP_MEMORY_SCOPE_AGENT); }
__device__ __forceinline__ unsigned xb_add(unsigned* p, unsigned v) { return __hip_atomic_fetch_add(p, v, __ATOMIC_RELAXED, __HIP_MEMORY_SCOPE_AGENT); }
__device__ __forceinline__ unsigned xb_xcc_id() { return (unsigned)__builtin_amdgcn_s_getreg((3 << 11) | 20) & 0xFu; }
#define XB_SPIN(cond, bar) do { unsigned _sp = 0; while (cond) { __builtin_amdgcn_s_sleep(1); \
    if ((++_sp & 255u) == 0u) { if (xb_ld(&(bar)[XB_TMO])) break; if (_sp > XB_SPIN_CAP) { atomicAdd(&(bar)[XB_TMO], 1u); break; } } } } while (0)

struct XcdBarrier {
    unsigned* bar; unsigned x;
    volatile LAS unsigned* st;
};

__device__ __forceinline__ XcdBarrier xcd_barrier_post(unsigned* bar, volatile LAS unsigned* st) {
    XcdBarrier b; b.bar = bar; b.x = xb_xcc_id(); b.st = st;
    if (threadIdx.x == 0) (void)xb_add(&bar[XB_XCNT(b.x)], 1u);
    return b;
}
__device__ __forceinline__ void xcd_barrier_complete(unsigned* bar, unsigned x, unsigned& nloc, unsigned& nx) {
    const unsigned G = gridDim.x * gridDim.y * gridDim.z;
    unsigned sum, cnt, mine, sp = 0u;
    for (;;) {
        sum = 0u; cnt = 0u; mine = 0u;
#pragma unroll
        for (unsigned j = 0; j < 16; ++j) { const unsigned c = xb_ld(&bar[XB_XCNT(j)]); sum += c; cnt += (c > 0u) ? 1u : 0u; mine = (j == x) ? c : mine; }
        if (sum == G) break;
        __builtin_amdgcn_s_sleep(1);
        if ((++sp & 255u) == 0u) { if (xb_ld(&bar[XB_TMO])) break; if (sp > XB_SPIN_CAP) { atomicAdd(&bar[XB_TMO], 1u); break; } }
    }
    nloc = mine > 0u ? mine : 1u; nx = cnt > 0u ? cnt : 1u;
}

__device__ __forceinline__ void xcd_barrier(const XcdBarrier& b) {
    asm volatile("s_waitcnt vmcnt(0)" ::: "memory");
    __syncthreads();
    if (threadIdx.x == 0) {
        unsigned* bar = b.bar;
        __builtin_amdgcn_s_waitcnt(0);
        unsigned nloc = b.st[0], nx = b.st[1];
        if (nloc == 0u) { xcd_barrier_complete(bar, b.x, nloc, nx); b.st[0] = nloc; b.st[1] = nx; }
        const unsigned old = xb_add(&bar[XB_XSUB(b.x)], 1u);
        const unsigned gen = old / nloc;
        if (old + 1u == (gen + 1u) * nloc) {
            __builtin_amdgcn_fence(__ATOMIC_RELEASE, "agent");
            asm volatile("s_waitcnt vmcnt(0)" ::: "memory");
            const unsigned og = xb_add(&bar[XB_TOP], 1u);
            const unsigned tg = og / nx;
            if (og + 1u == (tg + 1u) * nx) xb_add(&bar[XB_TOPGEN], 1u);
            else XB_SPIN(xb_ld(&bar[XB_TOPGEN]) == tg, bar);
            __builtin_amdgcn_fence(__ATOMIC_ACQUIRE, "agent");
            xb_add(&bar[XB_XGEN(b.x)], 1u);
            asm volatile("s_waitcnt vmcnt(0)" ::: "memory");
        } else {
            XB_SPIN(xb_ld(&bar[XB_XGEN(b.x)]) == gen, bar);
            __builtin_amdgcn_fence(__ATOMIC_ACQUIRE, "agent");
            asm volatile("s_waitcnt vmcnt(0)" ::: "memory");
        }
    }
    __syncthreads();
}
constexpr int BATCH = 4, SEQ = 8192, DM = 2048, M = BATCH * SEQ, BW = 512, INW = 9216, DFF = 5632, NUP = 2 * DFF, DEPTH = 2;
constexpr int NWAVES = 8;
constexpr float EPS = 1e-6f;
constexpr float LOG2E = 1.4426950408889634f;
constexpr float QSCALE = 0.125f * LOG2E;

__device__ __forceinline__ float bf_lo(unsigned w) { return __builtin_bit_cast(float, w << 16); }
__device__ __forceinline__ float bf_hi(unsigned w) { return __builtin_bit_cast(float, w & 0xffff0000u); }
__device__ __forceinline__ float bf2f(unsigned short h) { return __builtin_bit_cast(float, ((unsigned)h) << 16); }
__device__ __forceinline__ float sigmoid_f(float v) { return __builtin_amdgcn_rcpf(1.0f + __builtin_amdgcn_exp2f(-LOG2E * v)); }
__device__ __forceinline__ float gelu_tanh(float v) {
    const float y2 = 1.5957691216057308f * (v + 0.044715f * v * v * v);
    return v * __builtin_amdgcn_rcpf(1.0f + __builtin_amdgcn_exp2f(-LOG2E * y2));
}

struct EpiPlain {
    static constexpr bool PERM = true, AFTER_DRAIN = false;
    pg8::bf16_t* O; int ldc;
    __device__ __forceinline__ void operator()(const pg8::f32x4 (&acc)[2][2][4][2], const pg8::Unit& u, int wr, int wc, int fr, int fq) const {
        const int row0 = u.pm * 256 + wr * 64 + fr, col0 = u.pn * 256 + wc * 32 + 8 * fq;
#pragma unroll
        for (int ai = 0; ai < 2; ++ai)
#pragma unroll
            for (int m = 0; m < 4; ++m) { pg8::bf16_t* rowp = O + (size_t)(row0 + ai * 128 + m * 16) * ldc + col0;
#pragma unroll
                for (int bj = 0; bj < 2; ++bj) { const pg8::f32x4 v0 = acc[ai][bj][m][0], v1 = acc[ai][bj][m][1];
                    pg8::u32x4 w; w.x = pg8::cvt_pk_bf16(v0[0], v0[1]); w.y = pg8::cvt_pk_bf16(v0[2], v0[3]); w.z = pg8::cvt_pk_bf16(v1[0], v1[1]); w.w = pg8::cvt_pk_bf16(v1[2], v1[3]);
                    *(pg8::u32x4*)(rowp + bj * 128) = w; } }
    }
};
struct EpiInProj {
    static constexpr bool PERM = true, AFTER_DRAIN = false;
    const float* bias; pg8::bf16_t* T6; pg8::bf16_t* G3;
    __device__ __forceinline__ void operator()(const pg8::f32x4 (&acc)[2][2][4][2], const pg8::Unit& u, int wr, int wc, int fr, int fq) const {
        const int pn = u.pn; int mode, ldc, colt; pg8::bf16_t* base;
        if (pn < 12) { const int t = pn >> 1; base = T6 + (size_t)t * M * BW; ldc = BW; colt = (pn & 1) * 256; mode = t < 2 ? 1 : (t == 2 ? 2 : 0); }
        else { const int gi = (pn - 12) >> 3; base = G3 + (size_t)gi * M * DM; ldc = DM; colt = ((pn - 12) & 7) * 256; mode = 3; }
        const int row0 = u.pm * 256 + wr * 64 + fr, col0 = colt + wc * 32 + 8 * fq, bcol0 = pn * 256 + wc * 32 + 8 * fq;
        pg8::f32x4 bv[2][2];
#pragma unroll
        for (int bj = 0; bj < 2; ++bj)
#pragma unroll
            for (int n = 0; n < 2; ++n) bv[bj][n] = *(const pg8::f32x4*)(bias + bcol0 + bj * 128 + 4 * n);
#pragma unroll
        for (int ai = 0; ai < 2; ++ai)
#pragma unroll
            for (int m = 0; m < 4; ++m) { pg8::bf16_t* rowp = base + (size_t)(row0 + ai * 128 + m * 16) * ldc + col0;
#pragma unroll
                for (int bj = 0; bj < 2; ++bj) { pg8::f32x4 v0 = acc[ai][bj][m][0] + bv[bj][0], v1 = acc[ai][bj][m][1] + bv[bj][1];
                    if (mode == 1) {
#pragma unroll
                        for (int j = 0; j < 4; ++j) { v0[j] = gelu_tanh(v0[j]); v1[j] = gelu_tanh(v1[j]); } }
                    else if (mode == 2) { v0 = v0 * QSCALE; v1 = v1 * QSCALE; }
                    else if (mode == 3) {
#pragma unroll
                        for (int j = 0; j < 4; ++j) { v0[j] = sigmoid_f(v0[j]); v1[j] = sigmoid_f(v1[j]); } }
                    pg8::u32x4 w; w.x = pg8::cvt_pk_bf16(v0[0], v0[1]); w.y = pg8::cvt_pk_bf16(v0[2], v0[3]); w.z = pg8::cvt_pk_bf16(v1[0], v1[1]); w.w = pg8::cvt_pk_bf16(v1[2], v1[3]);
                    *(pg8::u32x4*)(rowp + bj * 128) = w; } }
    }
};
struct EpiGate {
    static constexpr bool PERM = true, AFTER_DRAIN = false;
    const pg8::bf16_t* G; pg8::bf16_t* Mb; int first;
    __device__ __forceinline__ void operator()(const pg8::f32x4 (&acc)[2][2][4][2], const pg8::Unit& u, int wr, int wc, int fr, int fq) const {
        const int row0 = u.pm * 256 + wr * 64 + fr, col0 = u.pn * 256 + wc * 32 + 8 * fq;
#pragma unroll
        for (int ai = 0; ai < 2; ++ai)
#pragma unroll
            for (int m = 0; m < 4; ++m) { const size_t ro = (size_t)(row0 + ai * 128 + m * 16) * DM + col0;
#pragma unroll
                for (int bj = 0; bj < 2; ++bj) { const size_t off = ro + bj * 128;
                    const pg8::u32x4 gv = *(const pg8::u32x4*)(G + off);
                    pg8::u32x4 pv = (pg8::u32x4){0u, 0u, 0u, 0u}; if (!first) pv = *(const pg8::u32x4*)(Mb + off);
                    const pg8::f32x4 a0 = acc[ai][bj][m][0], a1 = acc[ai][bj][m][1];
                    const float o0 = bf_lo(pv.x) + bf_lo(gv.x) * a0[0], o1 = bf_hi(pv.x) + bf_hi(gv.x) * a0[1], o2 = bf_lo(pv.y) + bf_lo(gv.y) * a0[2], o3 = bf_hi(pv.y) + bf_hi(gv.y) * a0[3];
                    const float o4 = bf_lo(pv.z) + bf_lo(gv.z) * a1[0], o5 = bf_hi(pv.z) + bf_hi(gv.z) * a1[1], o6 = bf_lo(pv.w) + bf_lo(gv.w) * a1[2], o7 = bf_hi(pv.w) + bf_hi(gv.w) * a1[3];
                    pg8::u32x4 w; w.x = pg8::cvt_pk_bf16(o0, o1); w.y = pg8::cvt_pk_bf16(o2, o3); w.z = pg8::cvt_pk_bf16(o4, o5); w.w = pg8::cvt_pk_bf16(o6, o7);
                    *(pg8::u32x4*)(Mb + off) = w; } }
    }
};
constexpr size_t MiB = (size_t)1 << 20;
constexpr size_t WS_CTL = 0, CTL_ZERO_BYTES = 1 * MiB;
constexpr size_t WS_W0 = 2 * MiB, W_LAYER = 116 * MiB;
constexpr size_t WO_IN = 0, WO_SGU = 36 * MiB, WO_MOBA = 38 * MiB, WO_POOL = 40 * MiB, WO_OUT = 42 * MiB, WO_UP = 50 * MiB, WO_DOWN = 94 * MiB;
constexpr size_t WS_SMALL = 234 * MiB;
constexpr size_t WS_MOD = WS_SMALL + 768 * 1024;
constexpr size_t WS_KMEAN = WS_SMALL + 1152 * 1024;
constexpr size_t WS_MODP = 236 * MiB;
constexpr size_t WS_H = 264 * MiB;
constexpr size_t WS_T6 = 392 * MiB;
constexpr size_t WS_G3 = 584 * MiB;
constexpr size_t WS_YP = 968 * MiB;
constexpr size_t WS_Y = 392 * MiB;
constexpr size_t WS_A2 = 584 * MiB;
constexpr size_t WS_RAWZ = 392 * MiB;
constexpr size_t WS_END = 1000 * MiB;
constexpr int CW_TMO = 0, CW_CODE = 1, CW_BAR = 4096;
constexpr int RING_BYTES = 131072, LDSCTL_OFF = RING_BYTES, MISC_OFF = LDSCTL_OFF + 320, LDS_BYTES = 147456;

__device__ __forceinline__ float wave_sum(float v) {
#pragma unroll
    for (int o = 1; o < 64; o <<= 1) v += __shfl_xor(v, o);
    return v;
}
__device__ __forceinline__ float wave_max(float v) {
#pragma unroll
    for (int o = 1; o < 64; o <<= 1) v = fmaxf(v, __shfl_xor(v, o));
    return v;
}
__device__ __forceinline__ void transpose_item(const float* W, int K, int N, bf16* WT, bool upperm, LAS float* scr, int item, int lane) {
    const int nblk = N / 32, kb = item / nblk, nb = item % nblk, k0 = 64 * kb, n0 = 32 * nb;
    int drow0 = n0;
    if (upperm) drow0 = (n0 < DFF) ? (n0 >> 7) * 256 + (n0 & 127) : ((n0 - DFF) >> 7) * 256 + 128 + ((n0 - DFF) & 127);
#pragma unroll 8
    for (int i = 0; i < 32; ++i) { const int kk = 2 * i + (lane >> 5); scr[kk * 33 + (lane & 31)] = W[(size_t)(k0 + kk) * N + n0 + (lane & 31)]; }
    LDS_WAIT(); asm volatile("" ::: "memory");
    const int c = lane & 7;
#pragma unroll
    for (int j = 0; j < 4; ++j) { const int n = (lane >> 3) + 8 * j; const LAS float* s = scr + (8 * c) * 33 + n;
        v4u o; o.x = pk2(s[0 * 33], s[1 * 33]); o.y = pk2(s[2 * 33], s[3 * 33]); o.z = pk2(s[4 * 33], s[5 * 33]); o.w = pk2(s[6 * 33], s[7 * 33]);
        *(GAS v4u*)(WT + (size_t)(drow0 + n) * K + k0 + 8 * c) = o; }
    LDS_WAIT(); asm volatile("" ::: "memory");
}

template <int MODE>
__device__ __forceinline__ void thin_phase(LAS unsigned char* lds, int tid, int lane, int wave, int bx, int G,
        const float* xin, const bf16* yin, float* xout, bf16* hout,
        const float* modA, const float* gA, const float* modS, const float* modT, const float* gS) {
    LAS float* vA = (LAS float*)lds; LAS float* vS = vA + 2048; LAS float* vT = vS + 2048;
    for (int rb = bx; rb < M / 128; rb += G) {
        const int b = rb >> 6;
        __syncthreads();
        for (int c = tid; c < DM; c += 512) {
            if (MODE != 0) vA[c] = modA[(size_t)b * 12288 + c] * gA[c];
            if (MODE != 2) { vS[c] = gS[c] * (1.0f + modS[(size_t)b * 12288 + c]); vT[c] = modT[(size_t)b * 12288 + c]; }
        }
        __syncthreads();
        for (int i = 0; i < 16; ++i) {
            const int row = rb * 128 + wave * 16 + i;
            const size_t ro = (size_t)row * DM + 4 * lane;
            f32x4 x[8];
#pragma unroll
            for (int j = 0; j < 8; ++j) x[j] = *(const f32x4*)(xin + ro + 256 * j);
            if (MODE != 0) {
                f32x4 y[8]; float ss = 0.f;
#pragma unroll
                for (int j = 0; j < 8; ++j) { const uint2 w = *(const uint2*)(yin + ro + 256 * j); y[j] = (f32x4){bf_lo(w.x), bf_hi(w.x), bf_lo(w.y), bf_hi(w.y)};
                    ss += (y[j][0] * y[j][0] + y[j][1] * y[j][1]) + (y[j][2] * y[j][2] + y[j][3] * y[j][3]); }
                const float rstd = 1.0f / __builtin_sqrtf(wave_sum(ss) * (1.0f / DM) + EPS);
#pragma unroll
                for (int j = 0; j < 8; ++j) { const f32x4 a = *(const LAS f32x4*)(vA + 4 * lane + 256 * j); x[j] = x[j] + a * (y[j] * rstd); *(f32x4*)(xout + ro + 256 * j) = x[j]; }
            }
            if (MODE != 2) {
                float ss = 0.f;
#pragma unroll
                for (int j = 0; j < 8; ++j) ss += (x[j][0] * x[j][0] + x[j][1] * x[j][1]) + (x[j][2] * x[j][2] + x[j][3] * x[j][3]);
                const float rstd = 1.0f / __builtin_sqrtf(wave_sum(ss) * (1.0f / DM) + EPS);
#pragma unroll
                for (int j = 0; j < 8; ++j) { const f32x4 s = *(const LAS f32x4*)(vS + 4 * lane + 256 * j), t = *(const LAS f32x4*)(vT + 4 * lane + 256 * j);
                    const f32x4 h = x[j] * rstd * s + t; uint2 w; w.x = pk2(h[0], h[1]); w.y = pk2(h[2], h[3]); *(uint2*)(hout + ro + 256 * j) = w; }
            }
        }
    }
    __syncthreads();
}

__device__ __forceinline__ void attn_naive_item(int b, int h, int tq, bf16* Q, const bf16* Kt, const bf16* Vt, const float* KM, LAS float* ps, int lane) {
    LAS float* qs = ps + 1024;
    const int own = tq >> 8;
    const size_t rowq = (size_t)(b * SEQ + tq) * BW + h * 64;
    qs[lane] = bf2f(Q[rowq + lane]);
    LDS_WAIT(); asm volatile("" ::: "memory");
    float sc = -INFINITY;
    if (lane < own) { const float* km = KM + ((size_t)(b * 8 + h) * 32 + lane) * 64; float s = 0.f;
        for (int d = 0; d < 64; ++d) s += qs[d] * km[d];
        sc = s; }
    int blk[4]; const int nsel = own < 3 ? own : 3;
#pragma unroll
    for (int r = 0; r < 3; ++r) { float bv = sc; int bj = lane;
#pragma unroll
        for (int o = 32; o >= 1; o >>= 1) { const float ov = __shfl_xor(bv, o); const int oj = __shfl_xor(bj, o); if (ov > bv || (ov == bv && oj < bj)) { bv = ov; bj = oj; } }
        blk[r] = __builtin_amdgcn_readfirstlane(bj); if (lane == blk[r]) sc = -INFINITY; }
    blk[3] = own;
    const float sl2 = LOG2E * __builtin_amdgcn_exp2f(-(float)(h + 1));
    float s16[16];
#pragma unroll
    for (int slot = 0; slot < 4; ++slot) { const bool act = (slot == 3) || (slot < nsel); const int jb = blk[slot];
#pragma unroll
        for (int ch = 0; ch < 4; ++ch) { float s = -INFINITY;
            if (act) { const int key = jb * 256 + ch * 64 + lane;
                if (key <= tq) { const uint4* kp = (const uint4*)(Kt + (size_t)(b * SEQ + key) * BW + h * 64); float dot = 0.f;
#pragma unroll
                    for (int i = 0; i < 8; ++i) { const uint4 kv = kp[i];
                        dot += qs[8 * i + 0] * bf_lo(kv.x) + qs[8 * i + 1] * bf_hi(kv.x) + qs[8 * i + 2] * bf_lo(kv.y) + qs[8 * i + 3] * bf_hi(kv.y)
                             + qs[8 * i + 4] * bf_lo(kv.z) + qs[8 * i + 5] * bf_hi(kv.z) + qs[8 * i + 6] * bf_lo(kv.w) + qs[8 * i + 7] * bf_hi(kv.w); }
                    s = dot - sl2 * (float)(tq - key); } }
            s16[slot * 4 + ch] = s; } }
    float mx = s16[0];
#pragma unroll
    for (int i = 1; i < 16; ++i) mx = fmaxf(mx, s16[i]);
    mx = wave_max(mx);
    float lsum = 0.f;
#pragma unroll
    for (int i = 0; i < 16; ++i) { const float p = __builtin_amdgcn_exp2f(s16[i] - mx); lsum += p; ps[i * 64 + lane] = p; }
    lsum = wave_sum(lsum);
    LDS_WAIT(); asm volatile("" ::: "memory");
    float o = 0.f;
#pragma unroll
    for (int slot = 0; slot < 4; ++slot) { const bool act = (slot == 3) || (slot < nsel);
        if (act) { const int jb = blk[slot]; const int nk = (slot == 3) ? (tq - own * 256 + 1) : 256;
            const bf16* vp = Vt + (size_t)(b * SEQ + jb * 256) * BW + h * 64 + lane;
#pragma unroll 8
            for (int i = 0; i < nk; ++i) o += ps[slot * 256 + i] * bf2f(vp[(size_t)i * BW]); } }
    Q[rowq + lane] = (bf16)f2bf(o / lsum);
    LDS_WAIT(); asm volatile("" ::: "memory");
}

__device__ __forceinline__ void sgu_naive_chunk(LAS unsigned char* lds, int chunk, const bf16* Vt, bf16* Ut, const float* norm_g, const float* sgu_w, const float* sgu_b, int tid, int lane, int wave) {
    LAS unsigned short* vn = (LAS unsigned short*)lds;
    const int t0 = chunk * 128;
    float g8[8];
#pragma unroll
    for (int e = 0; e < 8; ++e) g8[e] = norm_g[8 * lane + e];
    for (int i = 0; i < 16; ++i) { const int s = wave * 16 + i;
        const uint4 raw = *(const uint4*)(Vt + (size_t)(t0 + s) * BW + 8 * lane);
        float v[8] = {bf_lo(raw.x), bf_hi(raw.x), bf_lo(raw.y), bf_hi(raw.y), bf_lo(raw.z), bf_hi(raw.z), bf_lo(raw.w), bf_hi(raw.w)};
        float sum = 0.f;
#pragma unroll
        for (int e = 0; e < 8; ++e) sum += v[e];
        const float mu = wave_sum(sum) * (1.0f / BW); float q = 0.f;
#pragma unroll
        for (int e = 0; e < 8; ++e) { v[e] -= mu; q += v[e] * v[e]; }
        const float rstd = 1.0f / __builtin_sqrtf(wave_sum(q) * (1.0f / BW) + EPS);
        v4u o; o.x = pk2(v[0] * rstd * g8[0], v[1] * rstd * g8[1]); o.y = pk2(v[2] * rstd * g8[2], v[3] * rstd * g8[3]); o.z = pk2(v[4] * rstd * g8[4], v[5] * rstd * g8[5]); o.w = pk2(v[6] * rstd * g8[6], v[7] * rstd * g8[7]);
        *(LAS v4u*)(vn + s * BW + 8 * lane) = o; }
    __syncthreads();
    const int c = tid; const float* W = sgu_w + (size_t)wave * 16384; const float* Bs = sgu_b + wave * 128;
    for (int tb = 0; tb < 16; ++tb) { float acc[8];
#pragma unroll
        for (int tt = 0; tt < 8; ++tt) acc[tt] = 0.f;
        const int tend = tb * 8 + 7;
        for (int s = 0; s <= tend; ++s) { const float v = bf2f(vn[s * BW + c]);
#pragma unroll
            for (int tt = 0; tt < 8; ++tt) { const int t = tb * 8 + tt; const float w = (s <= t) ? W[t * 128 + s] : 0.f; acc[tt] += w * v; } }
#pragma unroll
        for (int tt = 0; tt < 8; ++tt) { const int t = tb * 8 + tt; const size_t o = (size_t)(t0 + t) * BW + c; const float u = bf2f(Ut[o]); Ut[o] = (bf16)f2bf(u * (acc[tt] + Bs[t])); } }
    __syncthreads();
}

__device__ __forceinline__ void pool_naive_tile(LAS unsigned char* lds, int tile, const bf16* ZP, bf16* YP, const float* pool_w, const float* pool_scale, int tid) {
    LAS float* pl = (LAS float*)lds;
    const int t0 = tile * 64, c = tid, g = c >> 7, w = 2 << g;
    for (int tl = 0; tl < 64; ++tl) { const int t = t0 + tl, pos = t & (SEQ - 1); const int cnt = (pos + 1 < w) ? pos + 1 : w; float s = 0.f;
        for (int i = 0; i < cnt; ++i) s += bf2f(ZP[(size_t)(t - i) * BW + c]);
        const float z = bf2f(ZP[(size_t)t * BW + c]); pl[tl * BW + c] = s / (float)cnt - z; }
    __syncthreads();
    const int d = c & 127; const float* pw = pool_w + (size_t)g * 16384; const float sc = pool_scale[c];
    for (int tb = 0; tb < 8; ++tb) { float acc[8];
#pragma unroll
        for (int tt = 0; tt < 8; ++tt) acc[tt] = 0.f;
        for (int cc = 0; cc < 128; ++cc) { const float wv = pw[cc * 128 + d];
#pragma unroll
            for (int tt = 0; tt < 8; ++tt) acc[tt] += pl[(tb * 8 + tt) * BW + g * 128 + cc] * wv; }
#pragma unroll
        for (int tt = 0; tt < 8; ++tt) YP[(size_t)(t0 + tb * 8 + tt) * BW + c] = (bf16)f2bf(acc[tt] * sc); }
    __syncthreads();
}

#define PHASE_IDS() int tid_o = threadIdx.x; asm volatile("" : "+v"(tid_o)); const int tid = tid_o, lane = tid & 63, wave = __builtin_amdgcn_readfirstlane(tid >> 6), gw = bx * NWAVES + wave, NGW = G * NWAVES; (void)lane; (void)gw; (void)NGW; (void)wave
struct Args { const float* in[23]; float* out; unsigned char* ws; };
__global__ void __launch_bounds__(NWAVES * 64, 2) fwd_kernel(Args args) {
    extern __shared__ __attribute__((aligned(16))) unsigned char lds_raw[];
    LAS unsigned char* lds = (LAS unsigned char*)lds_raw;
    const int G = gridDim.x, bx = blockIdx.x;
    gu32* ctl = (gu32*)(args.ws + WS_CTL);
    for (int u = threadIdx.x; u < (LDS_BYTES - LDSCTL_OFF) / 4; u += NWAVES * 64) ((LAS unsigned*)(lds + LDSCTL_OFF))[u] = 0u;
    __syncthreads();
    volatile LAS unsigned* MISC = (volatile LAS unsigned*)(lds + MISC_OFF);
    XcdBarrier bar = xcd_barrier_post((unsigned*)(ctl + CW_BAR), MISC + 8);
#define GRID_BAR() xcd_barrier(bar)
    const volatile __attribute__((address_space(4))) unsigned long long* kargs = (const volatile __attribute__((address_space(4))) unsigned long long*)__builtin_amdgcn_kernarg_segment_ptr();
#define INP(i) ((const float*)kargs[(i)])
#define OUTP ((float*)kargs[23])
#define WSB ((unsigned char*)kargs[24])
#define in_x INP(0)
#define in_c INP(1)
#define g_pre_mix INP(2)
#define g_post_mix INP(3)
#define g_pre_ffn INP(4)
#define g_post_ffn INP(5)
#define w_ada INP(6)
#define b_ada INP(7)
#define w_in INP(8)
#define b_in INP(9)
#define sgu_norm_g INP(10)
#define sgu_w INP(11)
#define sgu_b INP(12)
#define pool_w INP(13)
#define pool_scale INP(14)
#define w_sgu_out INP(15)
#define w_moba_out INP(16)
#define w_pool_out INP(17)
#define w_out INP(18)
#define w_up INP(19)
#define w_conv INP(20)
#define b_conv INP(21)
#define w_down INP(22)
#define out OUTP
#define MOD ((float*)(WSB + WS_MOD))
#define MODP ((float*)(WSB + WS_MODP))
#define KMEAN ((float*)(WSB + WS_KMEAN))
#define H ((bf16*)(WSB + WS_H))
#define T6 ((bf16*)(WSB + WS_T6))
#define G3 ((bf16*)(WSB + WS_G3))
#define YP ((bf16*)(WSB + WS_YP))
#define Yb ((bf16*)(WSB + WS_Y))
#define A2 ((bf16*)(WSB + WS_A2))
#define RAWZ ((bf16*)(WSB + WS_RAWZ))
#define Ut T6
#define Vt (T6 + (size_t)1 * M * BW)
#define Qt (T6 + (size_t)2 * M * BW)
#define Kt (T6 + (size_t)3 * M * BW)
#define VAt (T6 + (size_t)4 * M * BW)
#define ZPt (T6 + (size_t)5 * M * BW)

    {   PHASE_IDS();
        LAS float* cond = (LAS float*)(lds + 69632);
        for (int i = tid; i < BATCH * DM; i += NWAVES * 64) { const float c = in_c[i]; cond[i] = c * sigmoid_f(c); }
        __syncthreads();
        for (int wt = gw; wt < 1536; wt += NGW) {
            const int ks = wt / 96, cb = wt % 96, l = cb / 48, n0 = (cb % 48) * 256 + 4 * lane;
            const float* wp = w_ada + ((size_t)l * DM + ks * 128) * 12288 + n0;
            f32x4 a0 = {0.f, 0.f, 0.f, 0.f}, a1 = a0, a2 = a0, a3 = a0;
#pragma unroll 8
            for (int k = 0; k < 128; ++k) { const f32x4 w = *(const f32x4*)(wp + (size_t)k * 12288); const int kk = ks * 128 + k;
                a0 += cond[kk] * w; a1 += cond[DM + kk] * w; a2 += cond[2 * DM + kk] * w; a3 += cond[3 * DM + kk] * w; }
            float* pp = MODP + (size_t)(ks * 8 + l * 4) * 12288 + n0;
            *(f32x4*)(pp) = a0; *(f32x4*)(pp + 12288) = a1; *(f32x4*)(pp + 2 * 12288) = a2; *(f32x4*)(pp + 3 * 12288) = a3;
        }
        LAS float* scr = (LAS float*)(lds + wave * 8448);
        for (int it = gw; it < 2 * 29696; it += NGW) {
            const int l = it / 29696; int r = it % 29696;
            bf16* Wl = (bf16*)(WSB + WS_W0 + (size_t)l * W_LAYER);
            if (r < 9216) { transpose_item(w_in + (size_t)l * DM * INW, DM, INW, (bf16*)((unsigned char*)Wl + WO_IN), false, scr, r, lane); continue; } r -= 9216;
            if (r < 512) { transpose_item(w_sgu_out + (size_t)l * BW * DM, BW, DM, (bf16*)((unsigned char*)Wl + WO_SGU), false, scr, r, lane); continue; } r -= 512;
            if (r < 512) { transpose_item(w_moba_out + (size_t)l * BW * DM, BW, DM, (bf16*)((unsigned char*)Wl + WO_MOBA), false, scr, r, lane); continue; } r -= 512;
            if (r < 512) { transpose_item(w_pool_out + (size_t)l * BW * DM, BW, DM, (bf16*)((unsigned char*)Wl + WO_POOL), false, scr, r, lane); continue; } r -= 512;
            if (r < 2048) { transpose_item(w_out + (size_t)l * DM * DM, DM, DM, (bf16*)((unsigned char*)Wl + WO_OUT), false, scr, r, lane); continue; } r -= 2048;
            if (r < 11264) { transpose_item(w_up + (size_t)l * DM * NUP, DM, NUP, (bf16*)((unsigned char*)Wl + WO_UP), true, scr, r, lane); continue; } r -= 11264;
            transpose_item(w_down + (size_t)l * DFF * DM, DFF, DM, (bf16*)((unsigned char*)Wl + WO_DOWN), false, scr, r, lane);
        }
        GRID_BAR();
    }
    {   PHASE_IDS();
        for (int v = bx * NWAVES * 64 + tid; v < 2 * BATCH * 12288; v += G * NWAVES * 64) {
            const int lb = v / 12288, n = v % 12288; float s = b_ada[(size_t)(lb >> 2) * 12288 + n];
            for (int ks = 0; ks < 16; ++ks) s += MODP[(size_t)(ks * 8 + lb) * 12288 + n];
            MOD[v] = s; }
        GRID_BAR();
    }
    { PHASE_IDS(); thin_phase<0>(lds, tid, lane, wave, bx, G, in_x, nullptr, nullptr, H, nullptr, nullptr, MOD + 2048, MOD + 0, g_pre_mix); }
    GRID_BAR();

    for (int l = 0; l < DEPTH; ++l) {
        #define Wl (WSB + WS_W0 + (size_t)l * W_LAYER)
#define modl (MOD + (size_t)l * BATCH * 12288)
        { pg8::Gemm g{H, (const bf16*)(Wl + WO_IN), M, INW, DM}; pg8::StaticOrder S; S.init(M, INW, G, bx);
          EpiInProj E{b_in + (size_t)l * INW, T6, G3};
          pg8::gemm_phase<EpiInProj, pg8::StaticOrder, true, true>(lds, g, S, E);
          GRID_BAR(); }
        { PHASE_IDS(); for (int v = bx * NWAVES * 64 + tid; v < BATCH * 32 * BW; v += G * NWAVES * 64) {
              const int b = v / (32 * BW), j = (v / BW) % 32, col = v % BW; const bf16* kp = Kt + (size_t)(b * SEQ + j * 256) * BW + col; float s = 0.f;
              for (int r = 0; r < 256; ++r) s += bf2f(kp[(size_t)r * BW]);
              KMEAN[((size_t)(b * 8 + (col >> 6)) * 32 + j) * 64 + (col & 63)] = s * (1.0f / 256.0f); }
          GRID_BAR(); }
        { PHASE_IDS(); LAS float* ps = (LAS float*)(lds + wave * 8192);
          for (int w2 = gw; w2 < BATCH * 8 * 64; w2 += NGW) { const int bh = w2 >> 6, ch = w2 & 63;
              for (int i = 0; i < 128; ++i) attn_naive_item(bh >> 3, bh & 7, ch * 128 + i, Qt, Kt, VAt, KMEAN, ps, lane); }
          __syncthreads();
          for (int chunk = bx; chunk < M / 128; chunk += G) sgu_naive_chunk(lds, chunk, Vt, Ut, sgu_norm_g + (size_t)l * BW, sgu_w + (size_t)l * 8 * 16384, sgu_b + (size_t)l * 8 * 128, tid, lane, wave);
          for (int tile = bx; tile < M / 64; tile += G) pool_naive_tile(lds, tile, ZPt, YP, pool_w + (size_t)l * 4 * 16384, pool_scale + (size_t)l * BW, tid);
          GRID_BAR(); }
        for (int p = 0; p < 3; ++p) {
            const bf16* Ab = (p == 0) ? Ut : (p == 1) ? Qt : YP;
            const bf16* Bb = (const bf16*)(Wl + (p == 0 ? WO_SGU : p == 1 ? WO_MOBA : WO_POOL));
            pg8::Gemm g{Ab, Bb, M, DM, BW}; pg8::StaticOrder S; S.init(M, DM, G, bx);
            EpiGate E{G3 + (size_t)p * M * DM, H, p == 0 ? 1 : 0};
            pg8::gemm_phase<EpiGate, pg8::StaticOrder, true, true>(lds, g, S, E);
            GRID_BAR();
        }
        { pg8::Gemm g{H, (const bf16*)(Wl + WO_OUT), M, DM, DM}; pg8::StaticOrder S; S.init(M, DM, G, bx);
          EpiPlain E{Yb, DM};
          pg8::gemm_phase<EpiPlain, pg8::StaticOrder, true, true>(lds, g, S, E);
          GRID_BAR(); }
        { PHASE_IDS(); thin_phase<1>(lds, tid, lane, wave, bx, G, l == 0 ? in_x : out, Yb, out, H, modl + 4096, g_post_mix + (size_t)l * DM, modl + 8192, modl + 6144, g_pre_ffn + (size_t)l * DM); }
        GRID_BAR();
        for (int q = 0; q < 4; ++q) {
            { pg8::Gemm g{H, (const bf16*)(Wl + WO_UP) + (size_t)q * 2816 * DM, M, 2816, DM}; pg8::StaticOrder S; S.init(M, 2816, G, bx);
              EpiPlain E{RAWZ, 2816};
              pg8::gemm_phase<EpiPlain, pg8::StaticOrder, true, true>(lds, g, S, E);
              GRID_BAR(); }
            { PHASE_IDS(); const float* wc = w_conv + (size_t)l * 3 * NUP; const float* bc = b_conv + (size_t)l * NUP;
              for (size_t it = (size_t)bx * NWAVES * 64 + tid; it < (size_t)M * 176; it += (size_t)G * NWAVES * 64) {
                  const int t = (int)(it / 176), j8 = (int)(it % 176), jj = j8 >> 4, i0 = (j8 & 15) * 8, ncol = (q * 11 + jj) * 128 + i0, pos = t & (SEQ - 1);
                  const bf16* zr = RAWZ + (size_t)t * 2816 + jj * 256 + i0;
                  float zg[3][8], zv[3][8];
#pragma unroll
                  for (int k = 0; k < 3; ++k) {
                      uint4 a = make_uint4(0u, 0u, 0u, 0u), c = a;
                      if (pos >= 2 - k) { a = *(const uint4*)(zr - (size_t)(2 - k) * 2816); c = *(const uint4*)(zr - (size_t)(2 - k) * 2816 + 128); }
                      zg[k][0] = bf_lo(a.x); zg[k][1] = bf_hi(a.x); zg[k][2] = bf_lo(a.y); zg[k][3] = bf_hi(a.y); zg[k][4] = bf_lo(a.z); zg[k][5] = bf_hi(a.z); zg[k][6] = bf_lo(a.w); zg[k][7] = bf_hi(a.w);
                      zv[k][0] = bf_lo(c.x); zv[k][1] = bf_hi(c.x); zv[k][2] = bf_lo(c.y); zv[k][3] = bf_hi(c.y); zv[k][4] = bf_lo(c.z); zv[k][5] = bf_hi(c.z); zv[k][6] = bf_lo(c.w); zv[k][7] = bf_hi(c.w); }
                  float o[8];
#pragma unroll
                  for (int e = 0; e < 8; ++e) { const int n = ncol + e;
                      const float cg = wc[n] * zg[0][e] + wc[NUP + n] * zg[1][e] + wc[2 * NUP + n] * zg[2][e] + bc[n];
                      const float cv = wc[DFF + n] * zv[0][e] + wc[NUP + DFF + n] * zv[1][e] + wc[2 * NUP + DFF + n] * zv[2][e] + bc[DFF + n];
                      o[e] = gelu_tanh(cg) * cv; }
                  v4u w; w.x = pk2(o[0], o[1]); w.y = pk2(o[2], o[3]); w.z = pk2(o[4], o[5]); w.w = pk2(o[6], o[7]);
                  *(v4u*)(A2 + (size_t)t * DFF + ncol) = w; }
              GRID_BAR(); }
        }
        { pg8::Gemm g{A2, (const bf16*)(Wl + WO_DOWN), M, DM, DFF}; pg8::StaticOrder S; S.init(M, DM, G, bx);
          EpiPlain E{Yb, DM};
          pg8::gemm_phase<EpiPlain, pg8::StaticOrder, true, true>(lds, g, S, E);
          GRID_BAR(); }
        if (l == 0) { PHASE_IDS(); thin_phase<1>(lds, tid, lane, wave, bx, G, out, Yb, out, H, modl + 10240, g_post_ffn, MOD + (size_t)BATCH * 12288 + 2048, MOD + (size_t)BATCH * 12288, g_pre_mix + DM); GRID_BAR(); }
        else { PHASE_IDS(); thin_phase<2>(lds, tid, lane, wave, bx, G, out, Yb, out, nullptr, modl + 10240, g_post_ffn + (size_t)l * DM, nullptr, nullptr, nullptr); }
    }
#undef GRID_BAR
}
#undef INP
#undef OUTP
#undef WSB
#undef in_x
#undef in_c
#undef g_pre_mix
#undef g_post_mix
#undef g_pre_ffn
#undef g_post_ffn
#undef w_ada
#undef b_ada
#undef w_in
#undef b_in
#undef sgu_norm_g
#undef sgu_w
#undef sgu_b
#undef pool_w
#undef pool_scale
#undef w_sgu_out
#undef w_moba_out
#undef w_pool_out
#undef w_out
#undef w_up
#undef w_conv
#undef b_conv
#undef w_down
#undef out
#undef MOD
#undef MODP
#undef KMEAN
#undef H
#undef T6
#undef G3
#undef YP
#undef Yb
#undef A2
#undef RAWZ
#undef Ut
#undef Vt
#undef Qt
#undef Kt
#undef VAt
#undef ZPt
#undef Wl
#undef modl

extern "C" void kernel_launch(void* const* d_in, const int* in_sizes, int n_in, void* d_out, int out_size, void* d_ws, size_t ws_size, hipStream_t stream) {
    static int grid = 0;
    if (grid == 0) {
        if (n_in != 23 || in_sizes[0] != M * DM || out_size != M * DM || ws_size < WS_END) { fprintf(stderr, "kernel_launch: unexpected shapes (n_in %d, in0 %d, out %d, ws %zu); nothing launched\n", n_in, n_in > 0 ? in_sizes[0] : -1, out_size, ws_size); grid = -1; return; }
        int dev = 0, cus = 0;
        if (hipGetDevice(&dev) != hipSuccess || hipDeviceGetAttribute(&cus, hipDeviceAttributeMultiprocessorCount, dev) != hipSuccess) { grid = -1; return; }
        if (hipFuncSetAttribute((const void*)fwd_kernel, hipFuncAttributeMaxDynamicSharedMemorySize, LDS_BYTES) != hipSuccess) { fprintf(stderr, "kernel_launch: hipFuncSetAttribute failed\n"); grid = -1; return; }
        int per_cu = 0;
        if (hipOccupancyMaxActiveBlocksPerMultiprocessor(&per_cu, (const void*)fwd_kernel, NWAVES * 64, LDS_BYTES) != hipSuccess || per_cu < 1) fprintf(stderr, "kernel_launch: occupancy query says %d\n", per_cu);
        (void)hipGetLastError();
        grid = cus;
    }
    if (grid < 0) return;
    if (hipMemsetAsync((char*)d_ws + WS_CTL, 0, CTL_ZERO_BYTES, stream) != hipSuccess) return;
    Args a{};
    for (int i = 0; i < 23; ++i) a.in[i] = (const float*)d_in[i];
    a.out = (float*)d_out; a.ws = (unsigned char*)d_ws;
    hipLaunchKernelGGL(fwd_kernel, dim3(grid), dim3(NWAVES * 64), LDS_BYTES, stream, a);
}
```

```cpp
#include <hip/hip_runtime.h>
#include <cstdio>
#include <cstdint>
namespace pg8 {
#define PG8_LAS __attribute__((address_space(3)))
typedef unsigned short bf16_t;
typedef short bf16x8 __attribute__((ext_vector_type(8)));
typedef float f32x4 __attribute__((ext_vector_type(4)));
typedef unsigned u32x4 __attribute__((ext_vector_type(4)));
__device__ __forceinline__ int lane_now() { int l; asm volatile("v_mbcnt_lo_u32_b32 %0, -1, 0\n\tv_mbcnt_hi_u32_b32 %0, -1, %0" : "=v"(l)); return l; }
typedef int i32x4 __attribute__((ext_vector_type(4)));
typedef int i32x8 __attribute__((ext_vector_type(8)));
constexpr int BM = 256, BK = 64, HALF = 128, HTB = HALF * BK * 2  , STAGE_BYTES = 8 * HTB, NXCD = 8, WGM = 8;

__host__ __device__ __forceinline__ int lds_byte(int r, int c) { const int st = (r >> 4) * 2 + (c >> 5), rr = r & 15, cc = c & 31, ob = rr * 64 + cc * 2; return st * 1024 + (ob ^ (((ob >> 9) & 1) << 5)); }
__host__ __device__ __forceinline__ void stage_rc(int b, int& R, int& C) { const int st = b / 1024, sb = b % 1024, swz = sb ^ (((sb >> 9) & 1) << 5); R = (st >> 1) * 16 + swz / 64; C = (st & 1) * 32 + (swz % 64) / 2; }
__host__ __device__ __forceinline__ int perm32(int rho) { const int n = rho >> 4, i = rho & 15; return 8 * (i >> 2) + 4 * n + (i & 3); }

struct Unit { int pm, pn; };
struct Gemm { const bf16_t* A; const bf16_t* Bt; int M, N, K; int nseg; size_t segA, segB; };

struct StaticOrder {
    int nM, nN, nwg, G, c, wgm;
    __host__ __device__ void init(int M, int N, int G_, int c_, int wgm_ = WGM) { nM = M / BM; nN = N / BM; nwg = nM * nN; G = G_; c = c_; wgm = wgm_; }
    __host__ __device__ bool next(int i, Unit& u) const {
        const long L = (long)i * G + c; if (L >= nwg) return false;
        int wgid = (int)L; { const int q = nwg / NXCD, r = nwg % NXCD, xcd = wgid % NXCD, off = wgid / NXCD; wgid = (xcd < r ? xcd * (q + 1) : r * (q + 1) + (xcd - r) * q) + off; }
        const int nig = wgm * nN, gid = wgid / nig, fm = gid * wgm, gsz = (nM - fm) < wgm ? (nM - fm) : wgm;
        u.pm = fm + ((wgid % nig) % gsz); u.pn = (wgid % nig) / gsz; return true;
    }
    __device__ __forceinline__ void a_ready(const Unit&) const {}
    __device__ __forceinline__ void done(const Unit&) const {}
};

__device__ __forceinline__ unsigned cvt_pk_bf16(float lo, float hi) { unsigned r; asm volatile("v_cvt_pk_bf16_f32 %0, %1, %2" : "=v"(r) : "v"(lo), "v"(hi)); return r; }
typedef float f32x2 __attribute__((ext_vector_type(2)));
template <class Epi, class Sched, bool ALIGN_EPI = false, bool SP2 = false, bool FP8 = false, bool I8 = false>
__device__ __forceinline__ void gemm_phase(PG8_LAS unsigned char* lds, const Gemm g, const Sched& S, const Epi& E, int wave_s) {
    int tid_l = wave_s * 64 + lane_now(); asm volatile("" : "+v"(tid_l));
    const int tid = tid_l, wid = __builtin_amdgcn_readfirstlane(tid >> 6), lane = tid & 63, wr = wid >> 2, wc = wid & 3, fr = lane & 15, fq = lane >> 4;
    const int K = g.K, nt = (K / BK) * (Epi::SEGMENTED ? g.nseg : 1);
    unsigned voffA[2], voffB[2];
#pragma unroll
    for (int i = 0; i < 2; ++i) { int R, C; stage_rc(tid * 16 + i * 8192, R, C); const int Rb = Epi::PERM ? ((R & ~31) + perm32(R & 31)) : R;
        voffA[i] = (unsigned)(R * K + C) * 2u; voffB[i] = (unsigned)(Rb * K + C) * 2u; }
    const size_t kstep = (size_t)(BK * 2);
    const size_t hstep = (size_t)HALF * K * 2;
    const size_t tstep = 2 * hstep;
    const unsigned ldsw = (unsigned)wid * 1024u;
    const int aoff = lds_byte(wr * 64 + fr, fq * 8), boff = lds_byte(wc * 32 + fr, fq * 8);
#define PG8_SA(b, h) (((b) * 2 + (h)) * HTB)
#define PG8_SB(b, h) ((4 + (b) * 2 + (h)) * HTB)
#define PG8_STAGE(bufoff, gbase, voff) do { _Pragma("unroll") for (int _i = 0; _i < 2; ++_i) { unsigned vo_ = (voff)[_i]; if constexpr (FP8 || I8) asm volatile("" : "+v"(vo_));     \
        __builtin_amdgcn_global_load_lds((const unsigned*)((const char*)(gbase) + vo_), (PG8_LAS unsigned*)(lds + (bufoff) + ldsw + _i * 8192), 16, 0, 0); } } while (0)
#define PG8_LDA(dst, b, h) do { _Pragma("unroll") for (int m = 0; m < 4; ++m) _Pragma("unroll") for (int k = 0; k < 2; ++k) dst[m][k] = *(const PG8_LAS bf16x8*)(lds + PG8_SA(b, h) + aoff + m * 2048 + k * 1024); } while (0)
#define PG8_LDB(dst, b, h) do { _Pragma("unroll") for (int n = 0; n < 2; ++n) _Pragma("unroll") for (int k = 0; k < 2; ++k) dst[n][k] = *(const PG8_LAS bf16x8*)(lds + PG8_SB(b, h) + boff + n * 2048 + k * 1024); } while (0)
#define PG8_CAT8(v) __builtin_shufflevector(__builtin_bit_cast(i32x4, (v)[0]), __builtin_bit_cast(i32x4, (v)[1]), 0, 1, 2, 3, 4, 5, 6, 7)
#define PG8_MMA(ai, bj, At, Bt) do { __builtin_amdgcn_s_setprio(1); _Pragma("unroll") for (int m = 0; m < 4; ++m) _Pragma("unroll") for (int n = 0; n < 2; ++n) { \
        if constexpr (FP8) acc[ai][bj][m][n] = __builtin_amdgcn_mfma_scale_f32_16x16x128_f8f6f4(PG8_CAT8(Bt[n]), PG8_CAT8(At[m]), acc[ai][bj][m][n], 0, 0, 0, 0, 0, 0);     \
        else if constexpr (I8) { _Pragma("unroll") for (int k = 0; k < 2; ++k) acc[ai][bj][m][n] = __builtin_bit_cast(f32x4, __builtin_amdgcn_mfma_i32_16x16x64_i8(__builtin_bit_cast(i32x4, Bt[n][k]), __builtin_bit_cast(i32x4, At[m][k]), __builtin_bit_cast(i32x4, acc[ai][bj][m][n]), 0, 0, 0)); } \
        else { _Pragma("unroll") for (int k = 0; k < 2; ++k) acc[ai][bj][m][n] = __builtin_amdgcn_mfma_f32_16x16x32_bf16(Bt[n][k], At[m][k], acc[ai][bj][m][n], 0, 0, 0); } } __builtin_amdgcn_s_setprio(0); } while (0)
#define PG8_WAIT_V(n) asm volatile("s_waitcnt vmcnt(" #n ")" ::: "memory")
#define PG8_WAIT_L(n) asm volatile("s_waitcnt lgkmcnt(" #n ")" ::: "memory")
#define PG8_BAR __builtin_amdgcn_s_barrier()
#define PG8_SCHED __builtin_amdgcn_sched_barrier(0)
    Unit cur, nxt; int ui = 0;
    if (!S.next(0, cur)) return;
    f32x4 acc[2][2][4][2];
#pragma unroll
    for (int a = 0; a < 2; ++a)
#pragma unroll
        for (int b = 0; b < 2; ++b)
#pragma unroll
            for (int m = 0; m < 4; ++m)
#pragma unroll
                for (int n = 0; n < 2; ++n) acc[a][b][m][n] = (f32x4){0.f, 0.f, 0.f, 0.f};
    bf16x8 At[4][2], B0[2][2], B1[2][2];
    const char* cA = (const char*)g.A + (size_t)cur.pm * tstep; const char* cB = (const char*)g.Bt + (size_t)cur.pn * tstep;
    S.a_ready(cur);
    if constexpr (SP2) {
        PG8_STAGE(PG8_SB(0, 0), cB, voffB); PG8_STAGE(PG8_SB(0, 1), cB + hstep, voffB); PG8_STAGE(PG8_SA(0, 0), cA, voffA); PG8_STAGE(PG8_SA(0, 1), cA + hstep, voffA);
        if (wr == 1) PG8_BAR;
        PG8_WAIT_V(2); PG8_BAR;
        PG8_STAGE(PG8_SB(1, 0), cB + kstep, voffB); PG8_STAGE(PG8_SA(1, 0), cA + kstep, voffA); PG8_STAGE(PG8_SB(1, 1), cB + hstep + kstep, voffB);
        PG8_WAIT_V(6); PG8_BAR;
    } else {
        PG8_STAGE(PG8_SB(0, 0), cB, voffB); PG8_STAGE(PG8_SA(0, 0), cA, voffA); PG8_STAGE(PG8_SB(0, 1), cB + hstep, voffB); PG8_STAGE(PG8_SA(0, 1), cA + hstep, voffA);
        if (wr == 1) PG8_BAR;
        PG8_WAIT_V(4); PG8_BAR;
        PG8_STAGE(PG8_SB(1, 0), cB + kstep, voffB); PG8_STAGE(PG8_SA(1, 0), cA + kstep, voffA); PG8_STAGE(PG8_SB(1, 1), cB + hstep + kstep, voffB);
        PG8_WAIT_V(6); PG8_BAR;
    }
    for (;;) {
        const bool has_next = S.next(ui + 1, nxt);
        const char* nA = has_next ? (const char*)g.A + (size_t)nxt.pm * tstep : cA; const char* nB = has_next ? (const char*)g.Bt + (size_t)nxt.pn * tstep : cB;
        for (int t = 0; t < nt; t += 2) {
            const bool last = (t == nt - 2);
            const char* a1; const char* a2; const char* b2;
            if constexpr (Epi::SEGMENTED) {
                constexpr int SH = Epi::SEG_SHIFT, SM = (1 << SH) - 1;
                a1 = cA + (size_t)((t + 1) >> SH) * g.segA + (size_t)((t + 1) & SM) * kstep;
                a2 = last ? nA : cA + (size_t)((t + 2) >> SH) * g.segA + (size_t)((t + 2) & SM) * kstep; b2 = last ? nB : cB + (size_t)((t + 2) >> SH) * g.segB + (size_t)((t + 2) & SM) * kstep;
                if (t != 0 && (t & SM) == 0) E.seg_hook(acc, cur, t >> SH, wr, wc, fr, fq);
            } else {
                a1 = cA + (size_t)(t + 1) * kstep;
                a2 = last ? nA : cA + (size_t)(t + 2) * kstep; b2 = last ? nB : cB + (size_t)(t + 2) * kstep;
            }
            const char* a3 = a2 + kstep; const char* b3 = b2 + kstep;
            if (last && has_next) S.a_ready(nxt);
            if constexpr (SP2) {
            PG8_LDB(B0, 0, 0); PG8_LDB(B1, 0, 1); PG8_SCHED; PG8_LDA(At, 0, 0); PG8_STAGE(PG8_SA(1, 1), a1 + hstep, voffA);
            PG8_WAIT_V(8); PG8_WAIT_L(0); PG8_BAR; PG8_MMA(0, 0, At, B0); PG8_MMA(0, 1, At, B1); PG8_BAR; PG8_SCHED;
            PG8_LDA(At, 0, 1); PG8_STAGE(PG8_SB(0, 0), b2, voffB); PG8_STAGE(PG8_SB(0, 1), b2 + hstep, voffB); PG8_STAGE(PG8_SA(0, 0), a2, voffA);
            PG8_WAIT_V(8); PG8_WAIT_L(0); PG8_BAR; PG8_MMA(1, 0, At, B0); PG8_MMA(1, 1, At, B1); PG8_BAR; PG8_SCHED;
            PG8_LDB(B0, 1, 0); PG8_LDB(B1, 1, 1); PG8_SCHED; PG8_LDA(At, 1, 0); PG8_STAGE(PG8_SA(0, 1), a2 + hstep, voffA);
            PG8_WAIT_V(8); PG8_WAIT_L(0); PG8_BAR; PG8_MMA(0, 0, At, B0); PG8_MMA(0, 1, At, B1); PG8_BAR; PG8_SCHED;
            PG8_LDA(At, 1, 1); PG8_STAGE(PG8_SB(1, 0), b3, voffB); PG8_STAGE(PG8_SB(1, 1), b3 + hstep, voffB); PG8_STAGE(PG8_SA(1, 0), a3, voffA);
            PG8_WAIT_V(8); PG8_WAIT_L(0); PG8_BAR; PG8_MMA(1, 0, At, B0); PG8_MMA(1, 1, At, B1); PG8_BAR; PG8_SCHED;
            } else {
            PG8_LDB(B0, 0, 0); PG8_SCHED; PG8_LDA(At, 0, 0); PG8_STAGE(PG8_SA(1, 1), a1 + hstep, voffA);
            PG8_WAIT_L(8); PG8_BAR; PG8_WAIT_L(0); PG8_MMA(0, 0, At, B0); PG8_BAR; PG8_SCHED;
            PG8_LDB(B1, 0, 1); PG8_STAGE(PG8_SB(0, 0), b2, voffB);
            PG8_BAR; PG8_WAIT_L(0); PG8_MMA(0, 1, At, B1); PG8_BAR;
            PG8_LDA(At, 0, 1); PG8_STAGE(PG8_SA(0, 0), a2, voffA);
            PG8_BAR; PG8_WAIT_L(0); PG8_MMA(1, 0, At, B0); PG8_BAR; PG8_SCHED;
            PG8_STAGE(PG8_SB(0, 1), b2 + hstep, voffB);
            PG8_WAIT_V(6); PG8_BAR; PG8_MMA(1, 1, At, B1); PG8_BAR;
            PG8_LDB(B0, 1, 0); PG8_SCHED; PG8_LDA(At, 1, 0); PG8_STAGE(PG8_SA(0, 1), a2 + hstep, voffA);
            PG8_WAIT_L(8); PG8_BAR; PG8_WAIT_L(0); PG8_MMA(0, 0, At, B0); PG8_BAR; PG8_SCHED;
            PG8_LDB(B1, 1, 1); PG8_STAGE(PG8_SB(1, 0), b3, voffB);
            PG8_BAR; PG8_WAIT_L(0); PG8_MMA(0, 1, At, B1); PG8_BAR;
            PG8_LDA(At, 1, 1); PG8_STAGE(PG8_SA(1, 0), a3, voffA);
            PG8_BAR; PG8_WAIT_L(0); PG8_MMA(1, 0, At, B0); PG8_BAR; PG8_SCHED;
            PG8_STAGE(PG8_SB(1, 1), b3 + hstep, voffB);
            PG8_WAIT_V(6); PG8_BAR; PG8_MMA(1, 1, At, B1); PG8_BAR;
            }
        }
        if constexpr (ALIGN_EPI) { if (wr == 0) PG8_BAR; }
        if constexpr (!Epi::AFTER_DRAIN) { E(acc, cur, wr, wc, fr, fq); S.done(cur); }
        if (!has_next) break;
#pragma unroll
        for (int a = 0; a < 2; ++a)
#pragma unroll
            for (int b = 0; b < 2; ++b)
#pragma unroll
                for (int m = 0; m < 4; ++m)
#pragma unroll
                    for (int n = 0; n < 2; ++n) acc[a][b][m][n] = (f32x4){0.f, 0.f, 0.f, 0.f};
        cur = nxt; cA = nA; cB = nB; ++ui;
        if constexpr (ALIGN_EPI) { if (wr == 1) PG8_BAR; }
    }
    PG8_WAIT_V(0);
    if constexpr (!ALIGN_EPI) { if (wr == 0) PG8_BAR; }
    PG8_BAR;
    if constexpr (Epi::AFTER_DRAIN) { E.fused(acc, cur, wr, wc, fr, fq, lds, wid, lane); S.done(cur); }
#undef PG8_SA
#undef PG8_SB
#undef PG8_STAGE
#undef PG8_LDA
#undef PG8_LDB
#undef PG8_MMA
#undef PG8_CAT8
#undef PG8_WAIT_V
#undef PG8_WAIT_L
#undef PG8_BAR
#undef PG8_SCHED
}
}
#define GAS __attribute__((address_space(1)))
#define LAS __attribute__((address_space(3)))
typedef unsigned short bf16;
typedef unsigned v4u __attribute__((ext_vector_type(4)));
typedef float f32x4 __attribute__((ext_vector_type(4)));
typedef short bf16x8 __attribute__((ext_vector_type(8)));
typedef GAS unsigned gu32;
typedef GAS unsigned long long gu64;
#define RLX_AGENT __ATOMIC_RELAXED, __HIP_MEMORY_SCOPE_AGENT
#define LDS_WAIT() asm volatile("s_waitcnt lgkmcnt(0)" ::: "memory")
#define VM_WAIT() asm volatile("s_waitcnt vmcnt(0)" ::: "memory")
__device__ __forceinline__ unsigned long long rt() { return __builtin_amdgcn_s_memrealtime(); }
__device__ __forceinline__ unsigned f2bf(float f) { unsigned u = __builtin_bit_cast(unsigned, f); return (u + 0x7fffu + ((u >> 16) & 1u)) >> 16; }
__device__ __forceinline__ unsigned pk2(float lo, float hi) { return f2bf(lo) | (f2bf(hi) << 16); }
#define XB_TMO      128
#define XB_XCNT(j)  (256  + 64 * (j))
#define XB_XSUB(j)  (1280 + 64 * (j))
#define XB_XGEN(j)  (2304 + 64 * (j))
#define XB_TOP      3328
#define XB_TOPGEN   3392
#define XCD_BAR_WORDS 3456
#define XB_SPIN_CAP (1u << 18)

__device__ __forceinline__ unsigned xb_ld(unsigned* p)              { return __hip_atomic_load(p, __ATOMIC_RELAXED, __HIP_MEMORY_SCOPE_AGENT); }
__device__ __forceinline__ unsigned xb_add(unsigned* p, unsigned v) { return __hip_atomic_fetch_add(p, v, __ATOMIC_RELAXED, __HIP_MEMORY_SCOPE_AGENT); }
__device__ __forceinline__ unsigned xb_xcc_id() { return (unsigned)__builtin_amdgcn_s_getreg((3 << 11) | 20) & 0xFu; }
#define XB_SPIN(cond, bar) do { unsigned _sp = 0; while (cond) { __builtin_amdgcn_s_sleep(1); \
    if ((++_sp & 255u) == 0u) { if (xb_ld(&(bar)[XB_TMO])) break; if (_sp > XB_SPIN_CAP) { atomicAdd(&(bar)[XB_TMO], 1u); break; } } } } while (0)

struct XcdBarrier {
    unsigned* bar; unsigned x; int wv;
    volatile LAS unsigned* st;
};

__device__ __forceinline__ XcdBarrier xcd_barrier_post(unsigned* bar, volatile LAS unsigned* st) {
    XcdBarrier b; b.bar = bar; b.x = xb_xcc_id(); b.st = st; b.wv = __builtin_amdgcn_readfirstlane((int)(threadIdx.x >> 6));
    if (threadIdx.x == 0) (void)xb_add(&bar[XB_XCNT(b.x)], 1u);
    return b;
}
__device__ __forceinline__ void xcd_barrier_complete(unsigned* bar, unsigned x, unsigned& nloc, unsigned& nx) {
    const unsigned G = gridDim.x * gridDim.y * gridDim.z;
    unsigned sum, cnt, mine, sp = 0u;
    for (;;) {
        sum = 0u; cnt = 0u; mine = 0u;
#pragma unroll
        for (unsigned j = 0; j < 16; ++j) { const unsigned c = xb_ld(&bar[XB_XCNT(j)]); sum += c; cnt += (c > 0u) ? 1u : 0u; mine = (j == x) ? c : mine; }
        if (sum == G) break;
        __builtin_amdgcn_s_sleep(1);
        if ((++sp & 255u) == 0u) { if (xb_ld(&bar[XB_TMO])) break; if (sp > XB_SPIN_CAP) { atomicAdd(&bar[XB_TMO], 1u); break; } }
    }
    nloc = mine > 0u ? mine : 1u; nx = cnt > 0u ? cnt : 1u;
}

__device__ __forceinline__ void xcd_barrier(const XcdBarrier& b) {
    asm volatile("s_waitcnt vmcnt(0)" ::: "memory");
    __syncthreads();
    if (b.wv == 0 && pg8::lane_now() == 0) {
        unsigned* bar = b.bar;
        __builtin_amdgcn_s_waitcnt(0);
        unsigned nloc = b.st[0], nx = b.st[1];
        if (nloc == 0u) { xcd_barrier_complete(bar, b.x, nloc, nx); b.st[0] = nloc; b.st[1] = nx; }
        const unsigned old = xb_add(&bar[XB_XSUB(b.x)], 1u);
        const unsigned gen = old / nloc;
        if (old + 1u == (gen + 1u) * nloc) {
            __builtin_amdgcn_fence(__ATOMIC_RELEASE, "agent");
            asm volatile("s_waitcnt vmcnt(0)" ::: "memory");
            const unsigned og = xb_add(&bar[XB_TOP], 1u);
            const unsigned tg = og / nx;
            if (og + 1u == (tg + 1u) * nx) xb_add(&bar[XB_TOPGEN], 1u);
            else XB_SPIN(xb_ld(&bar[XB_TOPGEN]) == tg, bar);
            __builtin_amdgcn_fence(__ATOMIC_ACQUIRE, "agent");
            xb_add(&bar[XB_XGEN(b.x)], 1u);
            asm volatile("s_waitcnt vmcnt(0)" ::: "memory");
        } else {
            XB_SPIN(xb_ld(&bar[XB_XGEN(b.x)]) == gen, bar);
            __builtin_amdgcn_fence(__ATOMIC_ACQUIRE, "agent");
            asm volatile("s_waitcnt vmcnt(0)" ::: "memory");
        }
    }
    __syncthreads();
}
constexpr int BATCH = 4, SEQ = 8192, DM = 2048, M = BATCH * SEQ, BW = 512, INW = 9216, DFF = 5632, NUP = 2 * DFF, DEPTH = 2;
constexpr int NWAVES = 8;
constexpr float EPS = 1e-6f;
constexpr float LOG2E = 1.4426950408889634f;
constexpr float QSCALE = 0.125f * LOG2E;

__device__ __forceinline__ float bf_lo(unsigned w) { return __builtin_bit_cast(float, w << 16); }
__device__ __forceinline__ float bf_hi(unsigned w) { return __builtin_bit_cast(float, w & 0xffff0000u); }
__device__ __forceinline__ float bf2f(unsigned short h) { return __builtin_bit_cast(float, ((unsigned)h) << 16); }
constexpr float W8_SCALE = 32.0f, W8_INV = 1.0f / 32.0f;
__device__ __forceinline__ float sigmoid_f(float v) { return __builtin_amdgcn_rcpf(1.0f + __builtin_amdgcn_exp2f(-LOG2E * v)); }
__device__ __forceinline__ unsigned gate_q4(const pg8::f32x4 x) {
    float t[4];
#pragma unroll
    for (int j = 0; j < 4; ++j) t[j] = fmaxf(__builtin_fmaf(sigmoid_f(x[j]), 255.0f, 12582912.0f), 12582913.0f);
    return __builtin_amdgcn_perm(__builtin_bit_cast(unsigned, t[1]), __builtin_bit_cast(unsigned, t[0]), 0x0c0c0400u) | __builtin_amdgcn_perm(__builtin_bit_cast(unsigned, t[3]), __builtin_bit_cast(unsigned, t[2]), 0x04000c0cu);
}
__device__ __forceinline__ unsigned q8x4(float a, float b, float c, float d, float inv) {
    const float t0 = __builtin_fmaf(a, inv, 12582912.0f), t1 = __builtin_fmaf(b, inv, 12582912.0f), t2 = __builtin_fmaf(c, inv, 12582912.0f), t3 = __builtin_fmaf(d, inv, 12582912.0f);
    return __builtin_amdgcn_perm(__builtin_bit_cast(unsigned, t1), __builtin_bit_cast(unsigned, t0), 0x0c0c0400u) | __builtin_amdgcn_perm(__builtin_bit_cast(unsigned, t3), __builtin_bit_cast(unsigned, t2), 0x04000c0cu);
}
__device__ __forceinline__ float ub0(unsigned q) { float r; asm("v_cvt_f32_ubyte0 %0, %1" : "=v"(r) : "v"(q)); return r; }
__device__ __forceinline__ float ub1(unsigned q) { float r; asm("v_cvt_f32_ubyte1 %0, %1" : "=v"(r) : "v"(q)); return r; }
__device__ __forceinline__ float ub2(unsigned q) { float r; asm("v_cvt_f32_ubyte2 %0, %1" : "=v"(r) : "v"(q)); return r; }
__device__ __forceinline__ float ub3(unsigned q) { float r; asm("v_cvt_f32_ubyte3 %0, %1" : "=v"(r) : "v"(q)); return r; }
__device__ __forceinline__ pg8::f32x4 gate_ratio4(unsigned a, unsigned b) { pg8::f32x4 r; r[0] = ub0(a) * __builtin_amdgcn_rcpf(ub0(b)); r[1] = ub1(a) * __builtin_amdgcn_rcpf(ub1(b)); r[2] = ub2(a) * __builtin_amdgcn_rcpf(ub2(b)); r[3] = ub3(a) * __builtin_amdgcn_rcpf(ub3(b)); return r; }
__device__ __forceinline__ pg8::f32x4 gate_val4(unsigned a) { pg8::f32x4 r; r[0] = ub0(a); r[1] = ub1(a); r[2] = ub2(a); r[3] = ub3(a); return r * (1.0f / 255.0f); }
__device__ __forceinline__ float gelu_tanh(float v) {
    const float u = __builtin_fmaf(v * v, -0.10294324f, -2.3022082f);
    return v * __builtin_amdgcn_rcpf(1.0f + __builtin_amdgcn_exp2f(v * u));
}

#ifndef UPCONV_DPP
#define UPCONV_DPP 1
#endif
#define EPI_ST(p, v) (*(pg8::u32x4*)(p) = (v))
#define EPI_DRY_DECL
#define EPI_DRY_MEMBER
struct EpiPlain {
    static constexpr bool PERM = true, AFTER_DRAIN = false, SEGMENTED = false;
    pg8::bf16_t* O; int ldc; EPI_DRY_MEMBER
    __device__ __forceinline__ void operator()(const pg8::f32x4 (&acc)[2][2][4][2], const pg8::Unit& u, int wr, int wc, int fr, int fq) const {
        EPI_DRY_DECL
        const int row0 = u.pm * 256 + wr * 64 + fr, col0 = u.pn * 256 + wc * 32 + 8 * fq;
#pragma unroll
        for (int ai = 0; ai < 2; ++ai)
#pragma unroll
            for (int m = 0; m < 4; ++m) { pg8::bf16_t* rowp = O + (size_t)(row0 + ai * 128 + m * 16) * ldc + col0;
#pragma unroll
                for (int bj = 0; bj < 2; ++bj) { const pg8::f32x4 v0 = acc[ai][bj][m][0], v1 = acc[ai][bj][m][1];
                    pg8::u32x4 w; w.x = pg8::cvt_pk_bf16(v0[0], v0[1]); w.y = pg8::cvt_pk_bf16(v0[2], v0[3]); w.z = pg8::cvt_pk_bf16(v1[0], v1[1]); w.w = pg8::cvt_pk_bf16(v1[2], v1[3]);
                    EPI_ST(rowp + bj * 128, w); } }
    }
};
struct EpiInProj {
    static constexpr bool PERM = true, AFTER_DRAIN = false, SEGMENTED = false;
    const float* bias; pg8::bf16_t* T6; float* kmean; unsigned* kabs; const float* rs; const unsigned* cm; EPI_DRY_MEMBER
    __device__ __forceinline__ void operator()(pg8::f32x4 (&acc)[2][2][4][2], const pg8::Unit& u, int wr, int wc, int fr, int fq) const {
        EPI_DRY_DECL
        const int pn = u.pn; int mode, ldc, colt; pg8::bf16_t* base;
        {
            pg8::f32x4 cv[2][2];
#pragma unroll
            for (int bj = 0; bj < 2; ++bj)
#pragma unroll
                for (int n = 0; n < 2; ++n) { const pg8::u32x4 cmv = *(const pg8::u32x4*)(cm + pn * 256 + wc * 32 + 8 * fq + bj * 128 + 4 * n); const unsigned c0 = cmv.x, c1 = cmv.y, c2 = cmv.z, c3 = cmv.w;
                    pg8::f32x4 t; t[0] = __builtin_bit_cast(float, c0); t[1] = __builtin_bit_cast(float, c1); t[2] = __builtin_bit_cast(float, c2); t[3] = __builtin_bit_cast(float, c3); cv[bj][n] = t * (1.0f / 127.0f); }
#pragma unroll
            for (int ai = 0; ai < 2; ++ai)
#pragma unroll
                for (int m = 0; m < 4; ++m) { const float rsv = rs[u.pm * 256 + ai * 128 + wr * 64 + m * 16 + fr];
#pragma unroll
                    for (int bj = 0; bj < 2; ++bj)
#pragma unroll
                        for (int n = 0; n < 2; ++n) { pg8::f32x4 t;
#pragma unroll
                            for (int j = 0; j < 4; ++j) { const float af = acc[ai][bj][m][n][j]; t[j] = (float)__builtin_bit_cast(int, af); }
                            acc[ai][bj][m][n] = (t * rsv) * cv[bj][n]; } }
        }
        if (pn < 12) { const int t = pn >> 1, slot = (t == 0) ? 0 : (t == 1) ? 3 : (t == 2) ? 1 : t + 1;
            base = T6 + (size_t)slot * M * BW; ldc = BW; colt = (pn & 1) * 256; mode = t < 2 ? 1 : (t == 2 ? 2 : 0); }
        else { base = T6; ldc = DM; colt = 0; mode = 0; }
        const int row0 = u.pm * 256 + wr * 64 + fr, col0 = colt + wc * 32 + 8 * fq, bcol0 = pn * 256 + wc * 32 + 8 * fq;
        pg8::f32x4 bv[2][2];
#pragma unroll
        for (int bj = 0; bj < 2; ++bj)
#pragma unroll
            for (int n = 0; n < 2; ++n) bv[bj][n] = *(const pg8::f32x4*)(bias + bcol0 + bj * 128 + 4 * n);
        if (pn == 6 || pn == 7) {
            const int lane = fq * 16 + fr; const int b = u.pm >> 5, jblk = u.pm & 31;
#pragma unroll
            for (int bj = 0; bj < 2; ++bj)
#pragma unroll
                for (int n = 0; n < 2; ++n) { pg8::f32x4 s = bv[bj][n] * 8.0f;
#pragma unroll
                    for (int ai = 0; ai < 2; ++ai)
#pragma unroll
                        for (int m = 0; m < 4; ++m) s = s + acc[ai][bj][m][n];
                    pg8::f32x4 mx = {0.f, 0.f, 0.f, 0.f};
#pragma unroll
                    for (int ai = 0; ai < 2; ++ai)
#pragma unroll
                        for (int m = 0; m < 4; ++m) { const pg8::f32x4 kv = acc[ai][bj][m][n] + bv[bj][n];
#pragma unroll
                            for (int j = 0; j < 4; ++j) mx[j] = fmaxf(mx[j], __builtin_fabsf(kv[j])); }
#pragma unroll
                    for (int j = 0; j < 4; ++j) { float v = s[j]; float a = mx[j];
#pragma unroll
                        for (int o = 1; o < 16; o <<= 1) { v += __builtin_bit_cast(float, __builtin_amdgcn_ds_bpermute((lane ^ o) << 2, __builtin_bit_cast(int, v)));
                            a = fmaxf(a, __builtin_bit_cast(float, __builtin_amdgcn_ds_bpermute((lane ^ o) << 2, __builtin_bit_cast(int, a)))); }
                        if (fr == 0) { const int col = (pn & 1) * 256 + bj * 128 + wc * 32 + 8 * fq + 4 * n + j; const size_t ki = ((size_t)(b * 8 + (col >> 6)) * 32 + jblk) * 64 + (col & 63);
                            atomicAdd(kmean + ki, v * (1.0f / 256.0f)); atomicMax(kabs + ki, __builtin_bit_cast(unsigned, a)); } } }
        }
#pragma unroll
        for (int ai = 0; ai < 2; ++ai)
#pragma unroll
            for (int m = 0; m < 4; ++m) { pg8::bf16_t* rowp = base + (size_t)(row0 + ai * 128 + m * 16) * ldc + col0;
#pragma unroll
                for (int bj = 0; bj < 2; ++bj) { pg8::f32x4 v0 = acc[ai][bj][m][0] + bv[bj][0], v1 = acc[ai][bj][m][1] + bv[bj][1];
                    if (mode == 1) {
#pragma unroll
                        for (int j = 0; j < 4; ++j) { v0[j] = gelu_tanh(v0[j]); v1[j] = gelu_tanh(v1[j]); } }
                    else if (mode == 2) { v0 = v0 * QSCALE; v1 = v1 * QSCALE; }
                    pg8::u32x4 w; w.x = pg8::cvt_pk_bf16(v0[0], v0[1]); w.y = pg8::cvt_pk_bf16(v0[2], v0[3]); w.z = pg8::cvt_pk_bf16(v1[0], v1[1]); w.w = pg8::cvt_pk_bf16(v1[2], v1[3]);
                    EPI_ST(rowp + bj * 128, w); } }
    }
};
struct EpiGate8 {
    static constexpr bool PERM = true, AFTER_DRAIN = false, SEGMENTED = false;
    const float* bias; unsigned char* G8; const float* rs; const unsigned* cm; EPI_DRY_MEMBER
    __device__ __forceinline__ void operator()(const pg8::f32x4 (&acc)[2][2][4][2], const pg8::Unit& u, int wr, int wc, int fr_in, int fq_in) const {
        EPI_DRY_DECL
        int fr = fr_in, fq = fq_in; asm volatile("" : "+v"(fr), "+v"(fq));
        const int pn = u.pn, bcol0 = pn * 256 + wc * 32 + 8 * fq;
        pg8::f32x4 bv[2][2];
#pragma unroll
        for (int bj = 0; bj < 2; ++bj)
#pragma unroll
            for (int n = 0; n < 2; ++n) bv[bj][n] = *(const pg8::f32x4*)(bias + bcol0 + bj * 128 + 4 * n);
        pg8::f32x4 cv[2][2];
#pragma unroll
        for (int bj = 0; bj < 2; ++bj)
#pragma unroll
            for (int n = 0; n < 2; ++n) { const pg8::u32x4 cmv = *(const pg8::u32x4*)(cm + bcol0 + bj * 128 + 4 * n); const unsigned c0 = cmv.x, c1 = cmv.y, c2 = cmv.z, c3 = cmv.w;
                pg8::f32x4 t; t[0] = __builtin_bit_cast(float, c0); t[1] = __builtin_bit_cast(float, c1); t[2] = __builtin_bit_cast(float, c2); t[3] = __builtin_bit_cast(float, c3); cv[bj][n] = t * (1.0f / 127.0f); }
        unsigned char* tp = G8 + ((size_t)((pn >> 3) * (M / 256) + u.pm) * 8 + (pn & 7)) * 65536 + (size_t)((((wr * 4 + wc) * 64) + fq * 16 + fr) * 16);
#pragma unroll
        for (int ai = 0; ai < 2; ++ai)
#pragma unroll
            for (int m = 0; m < 4; ++m) { pg8::u32x4 w; const float rsv = rs[u.pm * 256 + ai * 128 + wr * 64 + m * 16 + fr];
                pg8::f32x4 z[2][2];
#pragma unroll
                for (int bj = 0; bj < 2; ++bj)
#pragma unroll
                    for (int n = 0; n < 2; ++n) { pg8::f32x4 t;
#pragma unroll
                        for (int j = 0; j < 4; ++j) { const float af = acc[ai][bj][m][n][j]; t[j] = (float)__builtin_bit_cast(int, af); }
                        z[bj][n] = (t * rsv) * cv[bj][n] + bv[bj][n]; }
                w.x = gate_q4(z[0][0]); w.y = gate_q4(z[0][1]); w.z = gate_q4(z[1][0]); w.w = gate_q4(z[1][1]);
                EPI_ST(tp + (ai * 4 + m) * 8192, w); }
    }
};
struct EpiUpConv {
    static constexpr bool PERM = true, AFTER_DRAIN = false, SEGMENTED = false;
    pg8::bf16_t* A2; const float* wconv; const float* bconv; float* topz; float* botz; PG8_LAS float* xb; const float* rs; const unsigned* cm; EPI_DRY_MEMBER
    __device__ __forceinline__ void operator()(pg8::f32x4 (&acc)[2][2][4][2], const pg8::Unit& u, int wr, int wc, int fr_in, int fq_in) const {
        EPI_DRY_DECL
        int fr = fr_in, fq = fq_in; asm volatile("" : "+v"(fr), "+v"(fq));
        const int lane = fq * 16 + fr, wv = wr * 4 + wc, pm = u.pm, pn = u.pn;
#pragma unroll
        for (int ai = 0; ai < 2; ++ai)
#pragma unroll
            for (int m = 0; m < 4; ++m) { const float rsv = rs[pm * 256 + ai * 128 + wr * 64 + m * 16 + fr];
#pragma unroll
                for (int bj = 0; bj < 2; ++bj)
#pragma unroll
                    for (int n = 0; n < 2; ++n) { pg8::f32x4 t;
#pragma unroll
                        for (int j = 0; j < 4; ++j) { const float af = acc[ai][bj][m][n][j]; t[j] = (float)__builtin_bit_cast(int, af); }
                        acc[ai][bj][m][n] = t * rsv; } }
        if (fr >= 14) {
#pragma unroll
            for (int ai = 0; ai < 2; ++ai)
#pragma unroll
                for (int bj = 0; bj < 2; ++bj) { PG8_LAS pg8::f32x4* p = (PG8_LAS pg8::f32x4*)(xb + ((((wv * 2 + ai) * 2 + (fr - 14)) * 4 + fq) * 2 + bj) * 8); p[0] = acc[ai][bj][3][0]; p[1] = acc[ai][bj][3][1]; }
        }
        const int ecol = pn * 256 + wc * 32 + 8 * fq;
        if (wr == 0 && fr < 2) { float* t = topz + ((size_t)pm * 2 + fr) * NUP + ecol;
#pragma unroll
            for (int bj = 0; bj < 2; ++bj)
#pragma unroll
                for (int n = 0; n < 2; ++n) *(pg8::f32x4*)(t + bj * 128 + 4 * n) = acc[0][bj][0][n]; }
        if (wr == 1 && fr >= 14) { float* t = botz + ((size_t)pm * 2 + (fr - 14)) * NUP + ecol;
#pragma unroll
            for (int bj = 0; bj < 2; ++bj)
#pragma unroll
                for (int n = 0; n < 2; ++n) *(pg8::f32x4*)(t + bj * 128 + 4 * n) = acc[1][bj][3][n]; }
        asm volatile("s_waitcnt lgkmcnt(0)" ::: "memory"); __builtin_amdgcn_s_barrier(); asm volatile("" ::: "memory");
        pg8::f32x4 bnd[2][2][2];
#pragma unroll
        for (int ai = 0; ai < 2; ++ai) { const int sw = (wr == 1) ? wc : 4 + wc, sai = (wr == 1) ? ai : 0; const bool have = (wr == 1) || (ai == 1);
#pragma unroll
            for (int bj = 0; bj < 2; ++bj) { pg8::f32x4 a = {0.f, 0.f, 0.f, 0.f}, b = a;
                if (have && fr >= 14) { const PG8_LAS pg8::f32x4* p = (const PG8_LAS pg8::f32x4*)(xb + ((((sw * 2 + sai) * 2 + (fr - 14)) * 4 + fq) * 2 + bj) * 8); a = p[0]; b = p[1]; }
                bnd[ai][bj][0] = a; bnd[ai][bj][1] = b; } }
        const int s1 = (fr >= 1 ? lane - 1 : lane + 15) << 2, s2 = (fr >= 2 ? lane - 2 : lane + 14) << 2;
#pragma unroll
        for (int bj = 0; bj < 2; ++bj)
#pragma unroll
            for (int n = 0; n < 2; ++n) { const int col = (bj ? DFF : 0) + pn * 128 + wc * 32 + 8 * fq + 4 * n;
                const pg8::u32x4 cmv = *(const pg8::u32x4*)(cm + col); pg8::f32x4 csv;
                { const unsigned c0 = cmv.x, c1 = cmv.y, c2 = cmv.z, c3 = cmv.w; csv[0] = __builtin_bit_cast(float, c0); csv[1] = __builtin_bit_cast(float, c1); csv[2] = __builtin_bit_cast(float, c2); csv[3] = __builtin_bit_cast(float, c3); csv = csv * (1.0f / 127.0f); }
                const pg8::f32x4 w0 = *(const pg8::f32x4*)(wconv + col) * csv, w1 = *(const pg8::f32x4*)(wconv + NUP + col) * csv, w2 = *(const pg8::f32x4*)(wconv + 2 * NUP + col) * csv, bb = *(const pg8::f32x4*)(bconv + col);
#pragma unroll
                for (int ai = 0; ai < 2; ++ai)
#pragma unroll
                    for (int m = 3; m >= 0; --m) { const pg8::f32x4 cur = acc[ai][bj][m][n]; const pg8::f32x4 prv = (m > 0) ? acc[ai][bj][m - 1][n] : bnd[ai][bj][n];
                        pg8::f32x4 z1, z2;
#pragma unroll
                        for (int j = 0; j < 4; ++j) {
#if UPCONV_DPP
                            const float cf = cur[j], pf = prv[j];
                            const int ci = __builtin_bit_cast(int, cf), pi = __builtin_bit_cast(int, pf);
                            const int p1 = __builtin_amdgcn_mov_dpp(pi, 0x121, 0xf, 0xf, false), p2 = __builtin_amdgcn_mov_dpp(pi, 0x122, 0xf, 0xf, false);
                            z1[j] = __builtin_bit_cast(float, __builtin_amdgcn_update_dpp(p1, ci, 0x111, 0xf, 0xf, false));
                            z2[j] = __builtin_bit_cast(float, __builtin_amdgcn_update_dpp(p2, ci, 0x112, 0xf, 0xf, false));
#else
                            const float t1 = (fr == 15) ? prv[j] : cur[j], t2 = (fr >= 14) ? prv[j] : cur[j];
                            z1[j] = __builtin_bit_cast(float, __builtin_amdgcn_ds_bpermute(s1, __builtin_bit_cast(int, t1)));
                            z2[j] = __builtin_bit_cast(float, __builtin_amdgcn_ds_bpermute(s2, __builtin_bit_cast(int, t2)));
#endif
                        }
                        acc[ai][bj][m][n] = w2 * cur + w1 * z1 + w0 * z2 + bb; } }
        const int row0 = pm * 256 + wr * 64 + fr, col0 = pn * 128 + wc * 32 + 8 * fq;
#pragma unroll
        for (int ai = 0; ai < 2; ++ai)
#pragma unroll
            for (int m = 0; m < 4; ++m) { const pg8::f32x4 g0 = acc[ai][0][m][0], g1 = acc[ai][0][m][1], v0 = acc[ai][1][m][0], v1 = acc[ai][1][m][1];
                pg8::u32x4 w; w.x = pg8::cvt_pk_bf16(gelu_tanh(g0[0]) * v0[0], gelu_tanh(g0[1]) * v0[1]); w.y = pg8::cvt_pk_bf16(gelu_tanh(g0[2]) * v0[2], gelu_tanh(g0[3]) * v0[3]);
                w.z = pg8::cvt_pk_bf16(gelu_tanh(g1[0]) * v1[0], gelu_tanh(g1[1]) * v1[1]); w.w = pg8::cvt_pk_bf16(gelu_tanh(g1[2]) * v1[2], gelu_tanh(g1[3]) * v1[3]);
                EPI_ST(A2 + (size_t)(row0 + ai * 128 + m * 16) * DFF + col0, w); }
    }
};
struct EpiBranch {
    static constexpr bool PERM = true, AFTER_DRAIN = false, SEGMENTED = true; static constexpr int SEG_SHIFT = 3;
    const unsigned char* G8; pg8::bf16_t* Mb; EPI_DRY_MEMBER
    __device__ __forceinline__ void seg_hook(pg8::f32x4 (&acc)[2][2][4][2], const pg8::Unit& u, int seg, int wr, int wc, int fr, int fq) const {
        int t16 = (((wr * 4 + wc) * 64) + fq * 16 + fr) * 16;
        asm volatile("" : "+v"(t16));
        const unsigned char* Tp = G8 + ((size_t)((seg - 1) * (M / 256) + u.pm) * 8 + u.pn) * 65536 + t16; const unsigned char* Tn = Tp + (size_t)(M / 256) * 8 * 65536;
        pg8::u32x4 ga[8], gb[8];
#pragma unroll
        for (int c = 0; c < 8; ++c) { ga[c] = *(const pg8::u32x4*)(Tp + c * 8192); gb[c] = *(const pg8::u32x4*)(Tn + c * 8192); }
        asm volatile("" ::: "memory");
#pragma unroll
        for (int ai = 0; ai < 2; ++ai)
#pragma unroll
            for (int m = 0; m < 4; ++m) { const pg8::u32x4 a = ga[ai * 4 + m], b = gb[ai * 4 + m];
                acc[ai][0][m][0] = acc[ai][0][m][0] * gate_ratio4(a.x, b.x); acc[ai][0][m][1] = acc[ai][0][m][1] * gate_ratio4(a.y, b.y);
                acc[ai][1][m][0] = acc[ai][1][m][0] * gate_ratio4(a.z, b.z); acc[ai][1][m][1] = acc[ai][1][m][1] * gate_ratio4(a.w, b.w); }
        asm volatile("" ::: "memory");
    }
    __device__ __forceinline__ void operator()(const pg8::f32x4 (&acc)[2][2][4][2], const pg8::Unit& u, int wr, int wc, int fr, int fq) const {
        const int row0 = u.pm * 256 + wr * 64 + fr, col0 = u.pn * 256 + wc * 32 + 8 * fq;
        EPI_DRY_DECL
        const unsigned char* T2 = G8 + ((size_t)(2 * (M / 256) + u.pm) * 8 + u.pn) * 65536 + (size_t)((((wr * 4 + wc) * 64) + fq * 16 + fr) * 16);
        pg8::u32x4 gv[8];
#pragma unroll
        for (int c = 0; c < 8; ++c) gv[c] = *(const pg8::u32x4*)(T2 + c * 8192);
        asm volatile("" ::: "memory");
#pragma unroll
        for (int ai = 0; ai < 2; ++ai)
#pragma unroll
            for (int m = 0; m < 4; ++m) { const size_t ro = (size_t)(row0 + ai * 128 + m * 16) * DM + col0; const pg8::u32x4 g = gv[ai * 4 + m];
#pragma unroll
                for (int bj = 0; bj < 2; ++bj) { const pg8::f32x4 a0 = acc[ai][bj][m][0] * gate_val4(bj ? g.z : g.x), a1 = acc[ai][bj][m][1] * gate_val4(bj ? g.w : g.y);
                    pg8::u32x4 w; w.x = pg8::cvt_pk_bf16(a0[0], a0[1]); w.y = pg8::cvt_pk_bf16(a0[2], a0[3]); w.z = pg8::cvt_pk_bf16(a1[0], a1[1]); w.w = pg8::cvt_pk_bf16(a1[2], a1[3]);
                    EPI_ST(Mb + ro + bj * 128, w); } }
    }
};
#include <hip/hip_bf16.h>
#include <cmath>
namespace attn_body {
using bf16=__hip_bfloat16;
using bf16x8=__attribute__((ext_vector_type(8)))short;
using s16x4=__attribute__((ext_vector_type(4)))short;
using f32x16=__attribute__((ext_vector_type(16)))float;
using u32x4=__attribute__((ext_vector_type(4)))unsigned;
constexpr int BATCH=4,NHEAD=8,SEQ=8192,D=64,DM=NHEAD*D;
constexpr int NW=8,QBLK=32,QB=QBLK*NW,KVBLK=64,NQB=SEQ/QB;
constexpr int ATTN_PITCH=DM, ATTN_UNIT_ROWS=QB;
__device__ __forceinline__ int crow(int r,int hi){return (r&3)+8*(r>>2)+4*hi;}
#define SBAR() __builtin_amdgcn_sched_barrier(0)
__device__ __forceinline__ void cmask(f32x16&p0,f32x16&p1,int jb,int qrel,int hi){
  const float NEG=-INFINITY; int kb=64*jb+4*hi;
  #pragma unroll
  for(int r=0;r<16;++r){int kv=kb+(r&3)+8*(r>>2); if(kv>qrel)p0[r]=NEG; if(kv+32>qrel)p1[r]=NEG;}
}

constexpr int NSLOT=3, SLOTB=8192;
constexpr int LDS_K=0, LDS_V=NSLOT*SLOTB, LDS_WS=2*NSLOT*SLOTB, LDS_OST=LDS_WS+NW*64*4, LDS_TAB=LDS_OST+NW*4096  , LDS_BYTES=LDS_TAB+16384;
constexpr float C2=0.125f*1.4426950408889634f;
__device__ __forceinline__ void glds16(const void*gsrc,unsigned lds_dst){unsigned keep;
  asm volatile("s_mov_b32 %0, m0\n\ts_mov_b32 m0, %2\n\ts_nop 0\n\tglobal_load_lds_dwordx4 %1, off\n\ts_mov_b32 m0, %0":"=&s"(keep):"v"(gsrc),"s"(lds_dst):"memory");}
__device__ __forceinline__ float max3f(float a,float b,float c){float r;asm("v_max3_f32 %0, %1, %2, %3":"=v"(r):"v"(a),"v"(b),"v"(c));return r;}
__device__ __forceinline__ float max2f(float a,float b){float r;asm("v_max_f32_e32 %0, %1, %2":"=v"(r):"v"(a),"v"(b));return r;}
__device__ __forceinline__ float fadd_s(float a,float b){float r;asm("v_add_f32_e32 %0, %1, %2":"=v"(r):"v"(a),"v"(b));return r;}
__device__ __forceinline__ float fsub_s(float a,float b){float r;asm("v_sub_f32_e32 %0, %1, %2":"=v"(r):"v"(a),"v"(b));return r;}
typedef float f32x2_t __attribute__((ext_vector_type(2))); typedef __bf16 bf16x2_t __attribute__((ext_vector_type(2)));
__device__ __forceinline__ unsigned cvtpk_s(float lo,float hi){f32x2_t v={lo,hi};bf16x2_t b=__builtin_convertvector(v,bf16x2_t);return __builtin_bit_cast(unsigned,b);}
#define WAIT_BAR(N) asm volatile("s_waitcnt vmcnt(" #N ") lgkmcnt(0)\n\ts_barrier":::"memory")

__device__ __forceinline__ void qkt(f32x16&p0,f32x16&p1,const char*Kslot,const bf16x8*qr,const f32x16&negm,int r32,int hi){
  const char*kb=Kslot+hi*1024+r32*16;
  #pragma unroll
  for(int d0=0;d0<4;++d0){
    const bf16x8 b0=*reinterpret_cast<const bf16x8*>(kb+d0*2048);
    const bf16x8 b1=*reinterpret_cast<const bf16x8*>(kb+d0*2048+512);
    if(d0==0){p0=__builtin_amdgcn_mfma_f32_32x32x16_bf16(b0,qr[0],negm,0,0,0);p1=__builtin_amdgcn_mfma_f32_32x32x16_bf16(b1,qr[0],negm,0,0,0);}
    else{p0=__builtin_amdgcn_mfma_f32_32x32x16_bf16(b0,qr[d0],p0,0,0,0);p1=__builtin_amdgcn_mfma_f32_32x32x16_bf16(b1,qr[d0],p1,0,0,0);}}
}
typedef __attribute__((address_space(3))) const char* lds_cptr;
typedef short v4i16_t __attribute__((ext_vector_type(4)));
__device__ __forceinline__ void kload8(bf16x8*kf,lds_cptr kp){
  kf[0]=*(const __attribute__((address_space(3))) bf16x8*)(kp);      kf[1]=*(const __attribute__((address_space(3))) bf16x8*)(kp+512);
  kf[2]=*(const __attribute__((address_space(3))) bf16x8*)(kp+2048); kf[3]=*(const __attribute__((address_space(3))) bf16x8*)(kp+2560);
  kf[4]=*(const __attribute__((address_space(3))) bf16x8*)(kp+4096); kf[5]=*(const __attribute__((address_space(3))) bf16x8*)(kp+4608);
  kf[6]=*(const __attribute__((address_space(3))) bf16x8*)(kp+6144); kf[7]=*(const __attribute__((address_space(3))) bf16x8*)(kp+6656);
}
__device__ __forceinline__ void kload2(bf16x8*kf,lds_cptr kp,int j){ kf[2*j]=*(const __attribute__((address_space(3))) bf16x8*)(kp+j*2048); kf[2*j+1]=*(const __attribute__((address_space(3))) bf16x8*)(kp+j*2048+512); }
__device__ __forceinline__ s16x4 vtr(lds_cptr p){ return __builtin_bit_cast(s16x4,__builtin_amdgcn_ds_read_tr16_b64_v4i16((__attribute__((address_space(3))) v4i16_t*)p)); }
__device__ __forceinline__ float rowmax(const f32x16&p0,const f32x16&p1){
  float a=max3f(p0[0],p0[1],p1[0]),b=max3f(p0[2],p0[3],p1[1]);a=max3f(a,p1[2],p1[3]);
  #pragma unroll
  for(int r=4;r<16;r+=4){a=max3f(a,p0[r],p0[r+1]);b=max3f(b,p0[r+2],p0[r+3]);a=max3f(a,p1[r],p1[r+1]);b=max3f(b,p1[r+2],p1[r+3]);}
  const float m=max2f(a,b);
  auto rr=__builtin_amdgcn_permlane32_swap(__float_as_uint(m),__float_as_uint(m),false,false);
  return max2f(__uint_as_float(rr[0]),__uint_as_float(rr[1]));
}
__device__ __forceinline__ void pv(f32x16*o,int vb,bf16x8 pa0,bf16x8 pa1,bf16x8 pa2,bf16x8 pa3){
  #pragma unroll
  for(int d0=0;d0<2;++d0){s16x4 lo[4],hi[4];
    #pragma unroll
    for(int ks=0;ks<4;++ks){
      asm volatile("ds_read_b64_tr_b16 %0,%1 offset:%c2":"=&v"(lo[ks]):"v"(vb),"i"(d0*4096+ks*1024):"memory");
      asm volatile("ds_read_b64_tr_b16 %0,%1 offset:%c2":"=&v"(hi[ks]):"v"(vb),"i"(d0*4096+ks*1024+512):"memory");}
    asm volatile("s_waitcnt lgkmcnt(0)":::"memory");SBAR();
    #define PK(k) (bf16x8){lo[k][0],lo[k][1],lo[k][2],lo[k][3],hi[k][0],hi[k][1],hi[k][2],hi[k][3]}
    o[d0]=__builtin_amdgcn_mfma_f32_32x32x16_bf16(pa0,PK(0),o[d0],0,0,0);
    o[d0]=__builtin_amdgcn_mfma_f32_32x32x16_bf16(pa1,PK(1),o[d0],0,0,0);
    o[d0]=__builtin_amdgcn_mfma_f32_32x32x16_bf16(pa2,PK(2),o[d0],0,0,0);
    o[d0]=__builtin_amdgcn_mfma_f32_32x32x16_bf16(pa3,PK(3),o[d0],0,0,0);
    #undef PK
  }
}

#ifndef ATTN_STORE16
#define ATTN_STORE16(p,v) (*(u32x4*)(p)=(v))
#endif
template<int THRL> __device__ __forceinline__ void attn_unit(int b,int h,int qb,const bf16*Q,const bf16*__restrict__ K,const bf16*__restrict__ V,const float*__restrict__ KM,const float*__restrict__ KA,bf16*O,char*shm,int wave_s){
  int tid_l=wave_s*64+pg8::lane_now(); asm volatile("":"+v"(tid_l));
  const int tid=tid_l,lane=tid&63,r32=lane&31,hi=lane>>5; const int wid=__builtin_amdgcn_readfirstlane(tid>>6);
  const long rowbase=(long)b*SEQ; const int q0=qb*QB;
  const bf16*Qw=Q+(rowbase+q0+wid*QBLK)*DM+h*D;
  const bf16*Kh=K+rowbase*DM+h*D,*Vh=V+rowbase*DM+h*D;
  const unsigned lds0=(unsigned)(uintptr_t)shm;
  float*wsf=(float*)(shm+LDS_WS)+wid*64;
  const bf16*ksrc_=Kh+(long)lane*DM+wid*8;
  const bf16*vsrc_=Vh+(long)(16*(wid&3)+(lane>>2))*DM+(wid>>2)*32+(lane&3)*8;
  const unsigned kdst=lds0+LDS_K+wid*1024, vdst=lds0+LDS_V+wid*1024;
  const bf16*ksrc=ksrc_,*vsrc=vsrc_;
  #define DMA_K(t,slot) glds16(ksrc+(long)(t)*KVBLK*DM,(unsigned)__builtin_amdgcn_readfirstlane(kdst+(slot)))
  #define DMA_V(t,slot) glds16(vsrc+(long)(t)*KVBLK*DM,(unsigned)__builtin_amdgcn_readfirstlane(vdst+(slot)))
  const int vb0=(int)(lds0+LDS_V)+((lane>>4)&1)*32+(lane&3)*8+(4*hi+((lane&15)>>2))*64;
  const char*Kbase=shm+LDS_K; bf16x8 kf[8];
  const lds_cptr shm3=(lds_cptr)shm; const lds_cptr kp0=shm3+LDS_K+hi*1024+r32*16; const lds_cptr vp0=shm3+LDS_V+((lane>>4)&1)*32+(lane&3)*8+(4*hi+((lane&15)>>2))*64;
  int NT=(q0+QB)/KVBLK;
  { const float4*gm=reinterpret_cast<const float4*>(KM+((long)(b*NHEAD+h)*32)*64), *ga=reinterpret_cast<const float4*>(KA+((long)(b*NHEAD+h)*32)*64);
    float4*lm=reinterpret_cast<float4*>(shm+LDS_TAB), *la=reinterpret_cast<float4*>(shm+LDS_TAB+8192);
    lm[tid]=gm[tid]; la[tid]=ga[tid];
    asm volatile("s_waitcnt vmcnt(0) lgkmcnt(0)\n\ts_barrier":::"memory"); }
  bf16x8 qr[4];
  #pragma unroll
  for(int d0=0;d0<4;++d0)qr[d0]=*reinterpret_cast<const bf16x8*>(&Qw[(long)r32*DM+d0*16+hi*8]);
  float mhat=0.f,l_reg=0.f;f32x16 o[2];o[0]=f32x16{};o[1]=f32x16{};
  const int qrel=wid*QBLK+r32;
  const float sl2=1.4426950408889634f*__builtin_amdgcn_exp2f(-(float)(h+1));
  const float hb4=sl2*(float)(4*hi), sl32=32.f*sl2;
  unsigned selmask=0u;
  { float qf[32];
    #pragma unroll
    for(int d0=0;d0<4;++d0){
      #pragma unroll
      for(int j=0;j<8;++j)qf[d0*8+j]=__builtin_bit_cast(float,((unsigned)(unsigned short)qr[d0][j])<<16);}
    { const bf16*Kd=Kh+(long)(q0+qrel)*DM; float acc=0.f;
      #pragma unroll
      for(int d0=0;d0<4;++d0){ const bf16x8 kq=*reinterpret_cast<const bf16x8*>(&Kd[d0*16+hi*8]);
        #pragma unroll
        for(int j=0;j<8;++j)acc+=qf[d0*8+j]*__builtin_bit_cast(float,((unsigned)(unsigned short)kq[j])<<16);}
      auto rr=__builtin_amdgcn_permlane32_swap(__float_as_uint(acc),__float_as_uint(acc),false,false);
      mhat=(__uint_as_float(rr[0])+__uint_as_float(rr[1]))+sl2*(float)qrel; }
    float v0=-INFINITY,v1=-INFINITY,v2=-INFINITY; int i0=-1,i1=-1,i2=-1; unsigned nearmask=0u;
    const float*KMb=reinterpret_cast<const float*>(shm+LDS_TAB)+hi*8; const float*KAb=reinterpret_cast<const float*>(shm+LDS_TAB+8192)+hi*8;
    for(int j=0;j<qb;++j){ const float*km=KMb+j*64; const float*ka=KAb+j*64; float sp=0.f, up=0.f;
      #pragma unroll
      for(int d0=0;d0<4;++d0){ const float4 a=*reinterpret_cast<const float4*>(km+d0*16), c=*reinterpret_cast<const float4*>(km+d0*16+4);
        sp+=qf[d0*8+0]*a.x+qf[d0*8+1]*a.y+qf[d0*8+2]*a.z+qf[d0*8+3]*a.w+qf[d0*8+4]*c.x+qf[d0*8+5]*c.y+qf[d0*8+6]*c.z+qf[d0*8+7]*c.w;
        const float4 e=*reinterpret_cast<const float4*>(ka+d0*16), f=*reinterpret_cast<const float4*>(ka+d0*16+4);
        up+=__builtin_fabsf(qf[d0*8+0])*e.x+__builtin_fabsf(qf[d0*8+1])*e.y+__builtin_fabsf(qf[d0*8+2])*e.z+__builtin_fabsf(qf[d0*8+3])*e.w+__builtin_fabsf(qf[d0*8+4])*f.x+__builtin_fabsf(qf[d0*8+5])*f.y+__builtin_fabsf(qf[d0*8+6])*f.z+__builtin_fabsf(qf[d0*8+7])*f.w;}
      auto rr=__builtin_amdgcn_permlane32_swap(__float_as_uint(sp),__float_as_uint(sp),false,false);
      const float sc=__uint_as_float(rr[0])+__uint_as_float(rr[1]);
      { auto ru=__builtin_amdgcn_permlane32_swap(__float_as_uint(up),__float_as_uint(up),false,false); const float ub=(__uint_as_float(ru[0])+__uint_as_float(ru[1]))*1.01f;
        if(ub+sl2*(float)(256*j+255-q0)-mhat>-44.f)nearmask|=1u<<j; }
      if(sc>v2){ if(sc>v1){ v2=v1;i2=i1; if(sc>v0){v1=v0;i1=i0;v0=sc;i0=j;} else {v1=sc;i1=j;} } else {v2=sc;i2=j;} } }
    if(i0>=0)selmask|=1u<<i0; if(i1>=0)selmask|=1u<<i1; if(i2>=0)selmask|=1u<<i2;
    unsigned need=selmask&nearmask;
    #pragma unroll
    for(int o_=1;o_<64;o_<<=1)need|=(unsigned)__builtin_amdgcn_ds_bpermute((lane^o_)<<2,(int)need);
    volatile unsigned*xw=(volatile unsigned*)(shm+LDS_OST);
    if(lane==0)xw[wid]=need;
    asm volatile("s_waitcnt lgkmcnt(0)\n\ts_barrier":::"memory");
    unsigned na=xw[0]|xw[1]|xw[2]|xw[3]|xw[4]|xw[5]|xw[6]|xw[7];
    na=(unsigned)__builtin_amdgcn_readfirstlane((int)na)|(1u<<qb);
    const int nskip=__builtin_ctz(na);
    NT-=4*nskip; selmask>>=nskip; ksrc+=(long)nskip*256*DM; vsrc+=(long)nskip*256*DM; }
  f32x16 negm;
  #pragma unroll
  for(int r=0;r<16;++r)negm[r]=sl2*(float)((r&3)+8*(r>>2));
  asm volatile("":"+v"(negm));
  #define ABIAS(P0,P1,t) do{ const int tt_=(t); const bool on_=(tt_>=NT-4)||(((selmask>>(tt_>>2))&1u)!=0u); \
    const float L0_=on_?((sl2*(float)(64*(tt_-(NT-4)))+hb4)-mhat):-INFINITY; const float L1_=L0_+sl32; \
    _Pragma("unroll") for(int r=0;r<16;++r){P0[r]+=L0_;P1[r]+=L1_;} }while(0)
  #define CMASK(P0,P1,t) do{int jb_=(t)-(NT-4); if(jb_>=0)cmask(P0,P1,jb_,qrel,hi);}while(0)
  bool resc=false;
  #define START(P0,P1) do{ const float rm=rowmax(P0,P1); resc=false; \
    if(__any(rm>(float)THRL)){ const float dl=__builtin_fmaxf(rm,0.f); mhat+=dl; \
      _Pragma("unroll") for(int r=0;r<16;++r){P0[r]-=dl;P1[r]-=dl;} } \
    _Pragma("unroll") for(int r=0;r<16;++r)P0[r]=__builtin_amdgcn_exp2f(P0[r]); }while(0)
  #define RESC() do{ if(resc){ asm volatile("s_waitcnt lgkmcnt(0)":::"memory"); \
      _Pragma("unroll") for(int d_=0;d_<2;++d_) _Pragma("unroll") for(int r=0;r<16;++r)o[d_][r]*=wsf[crow(r,hi)]; } }while(0)
  f32x16 pA0,pA1,pB0,pB1;
  int sl_prev=0,sl_cur=0,sl_next=SLOTB;
  #define ROT() do{sl_prev=sl_cur;sl_cur=sl_next;sl_next=(sl_next==(NSLOT-1)*SLOTB)?0:sl_next+SLOTB;}while(0)
  DMA_K(0,0);DMA_V(0,0);DMA_K(1,SLOTB);
  DMA_K(2,2*SLOTB);
  WAIT_BAR(3);
  qkt(pA0,pA1,Kbase,qr,negm,r32,hi);asm volatile("s_nop 15\n\ts_nop 7":"+v"(pA0),"+v"(pA1));ABIAS(pA0,pA1,0);CMASK(pA0,pA1,0);
  START(pA0,pA1);
  _Pragma("unroll") for(int r=0;r<16;++r)pA1[r]=__builtin_amdgcn_exp2f(pA1[r]);
  WAIT_BAR(0);
  DMA_K(3,0);DMA_V(1,SLOTB);
  ROT();
  kload8(kf,kp0+sl_cur);
  WAIT_BAR(2);
  s16x4 vlo[8],vhi[8]; u32x4 pw0,pw1,pw2,pw3;
  #define PKW(P,B) cvtpk_s(P[B],P[B+1])
  #define PAF(k) __builtin_bit_cast(bf16x8,pw##k)
  #define VFR(i) (bf16x8){vlo[i][0],vlo[i][1],vlo[i][2],vlo[i][3],vhi[i][0],vhi[i][1],vhi[i][2],vhi[i][3]}
  #define PIN(x) asm volatile("":"+v"(x))
  #define MX3(a,b,c) __builtin_fmaxf(__builtin_fmaxf((a),(b)),(c))
  #define GAPA(MF,A0,A1,A2,A3,W0,W1,PW) do{ MF; sacc+=A0; sacc+=A1; sacc+=A2; sacc+=A3; PIN(sacc); W0; W1; PIN(PW); SBAR(); }while(0)
  #define EX(v) __builtin_amdgcn_exp2f(v)
  #define GAPB(MF,X,B) do{ MF; X[B]=EX(X[B]); X[B+1]=EX(X[B+1]); X[B+2]=EX(X[B+2]); X[B+3]=EX(X[B+3]); PIN(X); SBAR(); }while(0)
  #define VRD(i) do{ vlo[i]=vtr(vp_+(((i)>>2)*4096+((i)&3)*1024)); vhi[i]=vtr(vp_+(((i)>>2)*4096+((i)&3)*1024+512)); }while(0)
  #define KRD(G,j) do{ if(G){ kload2(kf,kp0+sl_next,j); SBAR(); } }while(0)
  #define STEP(C0,C1,P0,P1,t,GK,GV,GL) do{ SBAR(); \
    const lds_cptr vp_=vp0+sl_prev; \
    VRD(0); SBAR(); float sacc=(P0[0]+P0[1]); \
    GAPA(C0=__builtin_amdgcn_mfma_f32_32x32x16_bf16(kf[0],qr[0],negm,0,0,0), P0[2],P0[3],P0[4],P0[5],     pw0[0]=PKW(P0,0), pw0[1]=PKW(P0,2), pw0); \
    VRD(4); SBAR(); GAPA(C1=__builtin_amdgcn_mfma_f32_32x32x16_bf16(kf[1],qr[0],negm,0,0,0), P0[6],P0[7],P0[8],P0[9],     pw0[2]=PKW(P0,4), pw0[3]=PKW(P0,6), pw0); \
    VRD(1); SBAR(); GAPA(C0=__builtin_amdgcn_mfma_f32_32x32x16_bf16(kf[2],qr[1],C0,0,0,0),   P0[10],P0[11],P0[12],P0[13], pw1[0]=PKW(P0,8), pw1[1]=PKW(P0,10), pw1); \
    VRD(5); SBAR(); GAPA(C1=__builtin_amdgcn_mfma_f32_32x32x16_bf16(kf[3],qr[1],C1,0,0,0),   P0[14],P0[15],P1[0],P1[1],   pw1[2]=PKW(P0,12),pw1[3]=PKW(P0,14), pw1); \
    VRD(2); SBAR(); GAPA(C0=__builtin_amdgcn_mfma_f32_32x32x16_bf16(kf[4],qr[2],C0,0,0,0),   P1[2],P1[3],P1[4],P1[5],     pw2[0]=PKW(P1,0), pw2[1]=PKW(P1,2), pw2); \
    VRD(6); SBAR(); GAPA(C1=__builtin_amdgcn_mfma_f32_32x32x16_bf16(kf[5],qr[2],C1,0,0,0),   P1[6],P1[7],P1[8],P1[9],     pw2[2]=PKW(P1,4), pw2[3]=PKW(P1,6), pw2); \
    VRD(3); SBAR(); GAPA(C0=__builtin_amdgcn_mfma_f32_32x32x16_bf16(kf[6],qr[3],C0,0,0,0),   P1[10],P1[11],P1[12],P1[13], pw3[0]=PKW(P1,8), pw3[1]=PKW(P1,10), pw3); \
    VRD(7); SBAR(); GAPA(C1=__builtin_amdgcn_mfma_f32_32x32x16_bf16(kf[7],qr[3],C1,0,0,0),   P1[14],P1[15],0.f,0.f,       pw3[2]=PKW(P1,12),pw3[3]=PKW(P1,14), pw3); \
    l_reg+=sacc; \
    if(GK){DMA_K((t)+3,sl_cur);} if(GV){DMA_V((t)+1,sl_next);} \
    ABIAS(C0,C1,t); CMASK(C0,C1,t); \
    { float a=MX3(C0[0],C0[1],C1[0]),b=MX3(C0[2],C0[3],C1[1]); a=MX3(a,C1[2],C1[3]); \
      _Pragma("unroll") for(int r=4;r<16;r+=4){a=MX3(a,C0[r],C0[r+1]);b=MX3(b,C0[r+2],C0[r+3]);a=MX3(a,C1[r],C1[r+1]);b=MX3(b,C1[r+2],C1[r+3]);} \
      float rm=__builtin_fmaxf(a,b); { auto rr=__builtin_amdgcn_permlane32_swap(__float_as_uint(rm),__float_as_uint(rm),false,false); rm=__builtin_fmaxf(__uint_as_float(rr[0]),__uint_as_float(rr[1])); } \
      resc=false; \
      if(__builtin_expect(__any(rm>(float)THRL),0)){ const float dl=__builtin_fmaxf(rm,0.f); mhat+=dl; \
        _Pragma("unroll") for(int r=0;r<16;++r){C0[r]-=dl;C1[r]-=dl;} \
        const float f=__builtin_amdgcn_exp2f(-dl); l_reg*=f; if(hi==0)wsf[r32]=f; resc=true; } } \
    SBAR(); \
    GAPB(o[0]=__builtin_amdgcn_mfma_f32_32x32x16_bf16(PAF(0),VFR(0),o[0],0,0,0), C0,0); \
    GAPB(o[1]=__builtin_amdgcn_mfma_f32_32x32x16_bf16(PAF(0),VFR(4),o[1],0,0,0), C0,4); \
    KRD(GL,0); GAPB(o[0]=__builtin_amdgcn_mfma_f32_32x32x16_bf16(PAF(1),VFR(1),o[0],0,0,0), C0,8); \
    KRD(GL,1); GAPB(o[1]=__builtin_amdgcn_mfma_f32_32x32x16_bf16(PAF(1),VFR(5),o[1],0,0,0), C0,12); \
    KRD(GL,2); GAPB(o[0]=__builtin_amdgcn_mfma_f32_32x32x16_bf16(PAF(2),VFR(2),o[0],0,0,0), C1,0); \
    KRD(GL,3); GAPB(o[1]=__builtin_amdgcn_mfma_f32_32x32x16_bf16(PAF(2),VFR(6),o[1],0,0,0), C1,4); \
    GAPB(o[0]=__builtin_amdgcn_mfma_f32_32x32x16_bf16(PAF(3),VFR(3),o[0],0,0,0), C1,8); \
    GAPB(o[1]=__builtin_amdgcn_mfma_f32_32x32x16_bf16(PAF(3),VFR(7),o[1],0,0,0), C1,12); \
    }while(0)
  int t=1;
  #undef CMASK
  #define CMASK(P0,P1,t) do{}while(0)
  for(;t+5<NT;t+=2){
    STEP(pB0,pB1,pA0,pA1,t,true,true,true);     WAIT_BAR(2); RESC(); ROT();
    STEP(pA0,pA1,pB0,pB1,t+1,true,true,true);   WAIT_BAR(2); RESC(); ROT();
  }
  #undef CMASK
  #define CMASK(P0,P1,t) do{int jb_=(t)-(NT-4); if(jb_>=0)cmask(P0,P1,jb_,qrel,hi);}while(0)
  #define ENDW(tt) do{ if((tt)+3<NT){WAIT_BAR(2);} else if((tt)+2<NT){WAIT_BAR(1);} else {WAIT_BAR(0);} }while(0)
  for(;t+1<NT;t+=2){
    STEP(pB0,pB1,pA0,pA1,t,(t+3<NT),(t+1<NT),(t+1<NT));       ENDW(t);   RESC(); ROT();
    STEP(pA0,pA1,pB0,pB1,t+1,(t+4<NT),(t+2<NT),(t+2<NT));     ENDW(t+1); RESC(); ROT();
  }
  STEP(pB0,pB1,pA0,pA1,NT-1,false,false,false); RESC();
  { float sacc=pB0[0]+pB0[1]; _Pragma("unroll") for(int r=2;r<16;++r)sacc+=pB0[r]; _Pragma("unroll") for(int r=0;r<16;++r)sacc+=pB1[r]; l_reg+=sacc;
    pw0=(u32x4){PKW(pB0,0),PKW(pB0,2),PKW(pB0,4),PKW(pB0,6)};pw1=(u32x4){PKW(pB0,8),PKW(pB0,10),PKW(pB0,12),PKW(pB0,14)};pw2=(u32x4){PKW(pB1,0),PKW(pB1,2),PKW(pB1,4),PKW(pB1,6)};pw3=(u32x4){PKW(pB1,8),PKW(pB1,10),PKW(pB1,12),PKW(pB1,14)};
    SBAR(); pv(o,vb0+sl_cur,PAF(0),PAF(1),PAF(2),PAF(3)); }
  #undef PKW
  #undef PAF
  #undef VFR
  #undef PIN
  #undef MX3
  #undef GAPA
  #undef GAPB
  #undef EX
  #undef VRD
  #undef KRD
  #undef STEP
  #undef ENDW
  {auto rr=__builtin_amdgcn_permlane32_swap(__float_as_uint(l_reg),__float_as_uint(l_reg),false,false);l_reg=__uint_as_float(rr[0])+__uint_as_float(rr[1]);}
  if(hi==0)wsf[32+r32]=l_reg;asm volatile("s_waitcnt lgkmcnt(0)":::"memory");
  float rli[16];
  #pragma unroll
  for(int r=0;r<16;++r)rli[r]=__builtin_amdgcn_rcpf(wsf[32+crow(r,hi)]);
  bf16*Ow=O+(rowbase+q0+wid*QBLK)*DM+h*D;
  { bf16*stg=(bf16*)(shm+LDS_OST)+wid*2048;
    #pragma unroll
    for(int r=0;r<16;++r){const int orow=crow(r,hi);
      #pragma unroll
      for(int d0=0;d0<2;++d0)stg[orow*64+d0*32+r32]=__float2bfloat16(o[d0][r]*rli[r]);}
    asm volatile("s_waitcnt lgkmcnt(0)":::"memory");
    #pragma unroll
    for(int i=0;i<4;++i){const int row=i*8+(lane>>3),ch=lane&7; const u32x4 v=*(const u32x4*)(stg+row*64+ch*8); ATTN_STORE16(Ow+(long)row*DM+ch*8,v);} }
  asm volatile("s_waitcnt lgkmcnt(0)\n\ts_barrier":::"memory");
  #undef DMA_K
  #undef DMA_V
  #undef CMASK
  #undef ABIAS
  #undef START
  #undef RESC
  #undef ROT
}
constexpr int ATTN_LDS_BYTES=LDS_BYTES;
struct AttnTensors { const bf16* Q; const bf16* K; const bf16* V; const float* KM; const float* KA; bf16* O; };
struct AttnUnit { int bh; int qb; };
struct StaticOrder {
  int vcu;
  __device__ __forceinline__ explicit StaticOrder(int grid,int block):vcu((block%8)*(grid/8)+block/8){}
  __device__ __forceinline__ bool next(int i,AttnUnit&u)const{ if(i>=4)return false; const int s=vcu&7; u.bh=vcu>>3; u.qb=(i==0)?s:(i==1)?15-s:(i==2)?16+s:31-s; return true; }
  __device__ __forceinline__ void a_ready(const AttnUnit&)const{}
  __device__ __forceinline__ void done(const AttnUnit&)const{}
};
struct QueueOrder {
  unsigned* ctr; volatile unsigned* slot; int wv;
  __device__ __forceinline__ bool next(int,AttnUnit&u)const{
    if(wv==0&&pg8::lane_now()==0)*slot=__hip_atomic_fetch_add(ctr,1u,__ATOMIC_RELAXED,__HIP_MEMORY_SCOPE_AGENT);
    asm volatile("s_waitcnt vmcnt(0) lgkmcnt(0)\n\ts_barrier":::"memory");
    const unsigned idx=(unsigned)__builtin_amdgcn_readfirstlane((int)*slot);
    if(idx>=(unsigned)(BATCH*NHEAD*NQB))return false;
    u.qb=NQB-1-(int)(idx>>5); u.bh=(int)(idx&31u); return true; }
  __device__ __forceinline__ void a_ready(const AttnUnit&)const{}
  __device__ __forceinline__ void done(const AttnUnit&)const{}
};
template<class Sched,int THRL=8> __device__ __forceinline__ void attn_phase(char*lds,const AttnTensors&T,const Sched&S,int wave_s){
  AttnUnit u;
  for(int i=0;S.next(i,u);++i){ S.a_ready(u); attn_unit<THRL>(u.bh/NHEAD,u.bh%NHEAD,u.qb,T.Q,T.K,T.V,T.KM,T.KA,T.O,lds,wave_s); S.done(u); }
}
#undef SBAR
#undef WAIT_BAR
}
constexpr size_t MiB = (size_t)1 << 20;
constexpr size_t WS_CTL = 0, CTL_ZERO_BYTES = 2 * MiB;
constexpr size_t WS_W0 = 2 * MiB;
constexpr size_t WO_IN = 0, WO_SGU = 36 * MiB, WO_MOBA = 38 * MiB, WO_POOL = 40 * MiB, WO_OUT = 42 * MiB, WO_UP = 50 * MiB, WO_DOWN = 94 * MiB;
constexpr size_t WS_SMALL = 118 * MiB;
constexpr size_t WS_MOD = WS_SMALL + 768 * 1024;
constexpr size_t WS_KMEAN = 512 * 1024;
constexpr size_t WS_KABS = 1 * MiB;
constexpr size_t WS_SGUW = WS_SMALL;
constexpr size_t WS_POOLWT = WS_SMALL + 512 * 1024;
constexpr size_t WS_MODP = 120 * MiB;
constexpr size_t WS_TOPZ = 126 * MiB, WS_BOTZ = 137 * MiB;
constexpr size_t WS_H = 148 * MiB;
constexpr size_t WS_T6 = 276 * MiB;
constexpr size_t WS_G3 = 500 * MiB;
constexpr size_t WS_Y = 276 * MiB;
constexpr size_t WS_A2 = 500 * MiB;
constexpr size_t WS_XR = 884 * MiB;
constexpr size_t WS_H8 = WS_G3 + 192 * MiB;
constexpr size_t WO_IN8 = 6 * MiB;
constexpr size_t WS_CMAX = 64 * 1024;
constexpr size_t WS_CMAXG = WS_CMAX + 96 * 1024;
constexpr size_t WS_RS1 = WS_SMALL + 1280 * 1024 + 128 * 1024;
constexpr size_t WS_RS = WS_SMALL + 1280 * 1024;
constexpr size_t WS_END = 1012 * MiB;
constexpr int CW_TMO = 0, CW_CODE = 1, CW_BAR = 4096, CW_ATTNQ = 8192;
constexpr int RING_BYTES = 131072, XB_OFF = RING_BYTES  , LDSCTL_OFF = 139264, MISC_OFF = LDSCTL_OFF + 320, LDS_BYTES = 147456;

__device__ __forceinline__ float lane_xor(float v, int lane, int o) { return __builtin_bit_cast(float, __builtin_amdgcn_ds_bpermute((lane ^ o) << 2, __builtin_bit_cast(int, v))); }
__device__ __forceinline__ float wave_sum(float v, int lane) {
#pragma unroll
    for (int o = 1; o < 64; o <<= 1) v += lane_xor(v, lane, o);
    return v;
}
__device__ __forceinline__ float wave_max(float v, int lane) {
#pragma unroll
    for (int o = 1; o < 64; o <<= 1) v = fmaxf(v, lane_xor(v, lane, o));
    return v;
}
typedef unsigned u32x2v __attribute__((ext_vector_type(2)));
__device__ __forceinline__ void transpose_item(const float* W, int K, int N, bf16* WT, bool upperm, LAS float* scr, int item, int lane, int f8split = 1 << 30, unsigned char* W8 = nullptr, const unsigned* cmax8 = nullptr, const unsigned* cmaxg = nullptr) {
    const int nblk = N / 32, kb = item / nblk, nb = item % nblk, k0 = 64 * kb, n0 = 32 * nb;
    int drow0 = n0;
    if (upperm) drow0 = (n0 < DFF) ? (n0 >> 7) * 256 + (n0 & 127) : ((n0 - DFF) >> 7) * 256 + 128 + ((n0 - DFF) & 127);
    float v[32];
    const float* src = W + (size_t)(k0 + (lane >> 5)) * N + n0 + (lane & 31);
#pragma unroll
    for (int i = 0; i < 32; ++i) v[i] = src[(size_t)(2 * i) * N];
#pragma unroll
    for (int i = 0; i < 32; ++i) scr[(2 * i + (lane >> 5)) * 33 + (lane & 31)] = v[i];
    LDS_WAIT(); asm volatile("" ::: "memory");
    const int c = lane & 7;
    if (cmax8) {
#pragma unroll
        for (int j = 0; j < 4; ++j) { const int n = (lane >> 3) + 8 * j; const LAS float* s = scr + (8 * c) * 33 + n;
            const unsigned cb = cmax8[n0 + n]; const float cmx = __builtin_bit_cast(float, cb); const float inv = cmx > 0.f ? 127.0f / cmx : 0.f;
            u32x2v o; o.x = q8x4(s[0 * 33], s[1 * 33], s[2 * 33], s[3 * 33], inv); o.y = q8x4(s[4 * 33], s[5 * 33], s[6 * 33], s[7 * 33], inv);
            *(GAS u32x2v*)((unsigned char*)WT + (size_t)(drow0 + n) * K + k0 + 8 * c) = o; }
    } else if (n0 >= f8split) {
#pragma unroll
        for (int j = 0; j < 4; ++j) { const int n = (lane >> 3) + 8 * j; const LAS float* s = scr + (8 * c) * 33 + n;
            const unsigned cb = cmaxg[n0 - f8split + n]; const float cmx = __builtin_bit_cast(float, cb); const float inv = cmx > 0.f ? 127.0f / cmx : 0.f;
            u32x2v o; o.x = q8x4(s[0 * 33], s[1 * 33], s[2 * 33], s[3 * 33], inv); o.y = q8x4(s[4 * 33], s[5 * 33], s[6 * 33], s[7 * 33], inv);
            *(GAS u32x2v*)(W8 + (size_t)(n0 - f8split + n) * K + k0 + 8 * c) = o; }
    } else {
#pragma unroll
    for (int j = 0; j < 4; ++j) { const int n = (lane >> 3) + 8 * j; const LAS float* s = scr + (8 * c) * 33 + n;
        v4u o; o.x = pg8::cvt_pk_bf16(s[0 * 33], s[1 * 33]); o.y = pg8::cvt_pk_bf16(s[2 * 33], s[3 * 33]); o.z = pg8::cvt_pk_bf16(s[4 * 33], s[5 * 33]); o.w = pg8::cvt_pk_bf16(s[6 * 33], s[7 * 33]);
        *(GAS v4u*)(WT + (size_t)(drow0 + n) * K + k0 + 8 * c) = o; }
    }
    LDS_WAIT(); asm volatile("" ::: "memory");
}

__device__ __forceinline__ void strip_quant(const float* W, int N, unsigned char* WT8, bool upperm, unsigned* cmax_out, LAS unsigned char* lds, int strip, int lane, int wave) {
    const int n0 = 32 * strip;
    int drow0 = n0;
    if (upperm) drow0 = (n0 < DFF) ? (n0 >> 7) * 256 + (n0 & 127) : ((n0 - DFF) >> 7) * 256 + 128 + ((n0 - DFF) & 127);
    LAS float* scr = (LAS float*)(lds + wave * 8448);
    LAS float* cmx = (LAS float*)(lds + 8 * 8448);
    float v[4][32];
#pragma unroll
    for (int b = 0; b < 4; ++b) { const float* src = W + (size_t)((4 * wave + b) * 64 + (lane >> 5)) * N + n0 + (lane & 31);
#pragma unroll
        for (int i = 0; i < 32; ++i) v[b][i] = src[(size_t)(2 * i) * N]; }
    float m = 0.f;
#pragma unroll
    for (int b = 0; b < 4; ++b)
#pragma unroll
        for (int i = 0; i < 32; ++i) m = fmaxf(m, __builtin_fabsf(v[b][i]));
    m = fmaxf(m, lane_xor(m, lane, 32));
    if (lane < 32) cmx[wave * 32 + lane] = m;
    __syncthreads();
    const int c = lane & 7;
    float inv[4];
#pragma unroll
    for (int j = 0; j < 4; ++j) { const int n = (lane >> 3) + 8 * j; float mm = 0.f;
#pragma unroll
        for (int w = 0; w < 8; ++w) mm = fmaxf(mm, cmx[w * 32 + n]);
        inv[j] = mm > 0.f ? 127.0f / mm : 0.f;
        if (wave == 0 && c == 0) cmax_out[n0 + n] = __builtin_bit_cast(unsigned, mm); }
#pragma unroll
    for (int b = 0; b < 4; ++b) { const int k0 = (4 * wave + b) * 64;
#pragma unroll
        for (int i = 0; i < 32; ++i) scr[(2 * i + (lane >> 5)) * 33 + (lane & 31)] = v[b][i];
        LDS_WAIT(); asm volatile("" ::: "memory");
#pragma unroll
        for (int j = 0; j < 4; ++j) { const int n = (lane >> 3) + 8 * j; const LAS float* sp = scr + (8 * c) * 33 + n;
            u32x2v o; o.x = q8x4(sp[0 * 33], sp[1 * 33], sp[2 * 33], sp[3 * 33], inv[j]); o.y = q8x4(sp[4 * 33], sp[5 * 33], sp[6 * 33], sp[7 * 33], inv[j]);
            *(GAS u32x2v*)(WT8 + (size_t)(drow0 + n) * DM + k0 + 8 * c) = o; }
        LDS_WAIT(); asm volatile("" ::: "memory"); }
    __syncthreads();
}

template <int MODE, bool XIN_BF16, bool XOUT_BF16, bool H8OUT = false, bool HQOUT = false>
__device__ __forceinline__ void thin_phase(LAS unsigned char* lds, int tid, int lane, int wave, int bx, int G,
        const void* xin_, const bf16* yin, void* xout_, bf16* hout, unsigned char* hout8, float* rsout,
        const float* modA, const float* gA, const float* modS, const float* modT, const float* gS) {
    LAS float* vA = (LAS float*)lds; LAS float* vS = vA + 2048; LAS float* vT = vS + 2048;
    for (int rb = bx; rb < M / 128; rb += G) {
        const int b = rb >> 6;
        __syncthreads();
        for (int c = tid; c < DM; c += 512) {
            if (MODE != 0) vA[c] = modA[(size_t)b * 12288 + c] * gA[c];
            if (MODE != 2) { vS[c] = gS[c] * (1.0f + modS[(size_t)b * 12288 + c]); vT[c] = modT[(size_t)b * 12288 + c]; }
        }
        __syncthreads();
        for (int i = 0; i < 8; ++i) {
            size_t ro[2]; f32x4 x[2][8]; uint2 yr[2][8];
#pragma unroll
            for (int r = 0; r < 2; ++r) { ro[r] = (size_t)(rb * 128 + wave * 16 + i + 8 * r) * DM + 4 * lane;
#pragma unroll
                for (int j = 0; j < 8; ++j) {
                    if (XIN_BF16) { const uint2 w = *(const uint2*)((const bf16*)xin_ + ro[r] + 256 * j); x[r][j] = (f32x4){bf_lo(w.x), bf_hi(w.x), bf_lo(w.y), bf_hi(w.y)}; }
                    else x[r][j] = *(const f32x4*)((const float*)xin_ + ro[r] + 256 * j);
                    if (MODE != 0) yr[r][j] = *(const uint2*)(yin + ro[r] + 256 * j); } }
            asm volatile("" ::: "memory");
            if (MODE != 0) {
                float ss[2];
#pragma unroll
                for (int r = 0; r < 2; ++r) { ss[r] = 0.f;
#pragma unroll
                    for (int j = 0; j < 8; ++j) { const float y0 = bf_lo(yr[r][j].x), y1 = bf_hi(yr[r][j].x), y2 = bf_lo(yr[r][j].y), y3 = bf_hi(yr[r][j].y); ss[r] += (y0 * y0 + y1 * y1) + (y2 * y2 + y3 * y3); } }
#pragma unroll
                for (int o = 1; o < 64; o <<= 1) { const float t0 = lane_xor(ss[0], lane, o), t1 = lane_xor(ss[1], lane, o); ss[0] += t0; ss[1] += t1; }
#pragma unroll
                for (int r = 0; r < 2; ++r) { const float rstd = 1.0f / __builtin_sqrtf(ss[r] * (1.0f / DM) + EPS);
#pragma unroll
                    for (int j = 0; j < 8; ++j) { const f32x4 a = *(const LAS f32x4*)(vA + 4 * lane + 256 * j);
                        const f32x4 y = (f32x4){bf_lo(yr[r][j].x), bf_hi(yr[r][j].x), bf_lo(yr[r][j].y), bf_hi(yr[r][j].y)}; x[r][j] = x[r][j] + a * (y * rstd);
                        if (XOUT_BF16) { uint2 w; w.x = pk2(x[r][j][0], x[r][j][1]); w.y = pk2(x[r][j][2], x[r][j][3]); *(uint2*)((bf16*)xout_ + ro[r] + 256 * j) = w; }
                        else *(f32x4*)((float*)xout_ + ro[r] + 256 * j) = x[r][j]; } }
            }
            if (MODE != 2) {
                float ss[2];
#pragma unroll
                for (int r = 0; r < 2; ++r) { ss[r] = 0.f;
#pragma unroll
                    for (int j = 0; j < 8; ++j) ss[r] += (x[r][j][0] * x[r][j][0] + x[r][j][1] * x[r][j][1]) + (x[r][j][2] * x[r][j][2] + x[r][j][3] * x[r][j][3]); }
#pragma unroll
                for (int o = 1; o < 64; o <<= 1) { const float t0 = lane_xor(ss[0], lane, o), t1 = lane_xor(ss[1], lane, o); ss[0] += t0; ss[1] += t1; }
                if (HQOUT || H8OUT) {
                    float mx[2];
#pragma unroll
                    for (int r = 0; r < 2; ++r) { const float rstd = 1.0f / __builtin_sqrtf(ss[r] * (1.0f / DM) + EPS); mx[r] = 0.f;
#pragma unroll
                        for (int j = 0; j < 8; ++j) { const f32x4 sv = *(const LAS f32x4*)(vS + 4 * lane + 256 * j), tv = *(const LAS f32x4*)(vT + 4 * lane + 256 * j);
                            const f32x4 h = x[r][j] * rstd * sv + tv; x[r][j] = h;
                            mx[r] = fmaxf(fmaxf(mx[r], fmaxf(__builtin_fabsf(h[0]), __builtin_fabsf(h[1]))), fmaxf(__builtin_fabsf(h[2]), __builtin_fabsf(h[3]))); } }
#pragma unroll
                    for (int o = 1; o < 64; o <<= 1) { const float t0 = lane_xor(mx[0], lane, o), t1 = lane_xor(mx[1], lane, o); mx[0] = fmaxf(mx[0], t0); mx[1] = fmaxf(mx[1], t1); }
#pragma unroll
                    for (int r = 0; r < 2; ++r) { const float inv = mx[r] > 0.f ? 127.0f / mx[r] : 0.f;
                        if (lane == 0) rsout[ro[r] / DM] = mx[r] * (1.0f / 127.0f);
                        unsigned char* qdst = HQOUT ? (unsigned char*)hout : hout8;
#pragma unroll
                        for (int j = 0; j < 8; ++j) { *(unsigned*)(qdst + ro[r] + 256 * j) = q8x4(x[r][j][0], x[r][j][1], x[r][j][2], x[r][j][3], inv);
                            if (!HQOUT) { uint2 w; w.x = pk2(x[r][j][0], x[r][j][1]); w.y = pk2(x[r][j][2], x[r][j][3]); *(uint2*)(hout + ro[r] + 256 * j) = w; } } }
                } else
#pragma unroll
                for (int r = 0; r < 2; ++r) { const float rstd = 1.0f / __builtin_sqrtf(ss[r] * (1.0f / DM) + EPS);
#pragma unroll
                    for (int j = 0; j < 8; ++j) { const f32x4 sv = *(const LAS f32x4*)(vS + 4 * lane + 256 * j), tv = *(const LAS f32x4*)(vT + 4 * lane + 256 * j);
                        const f32x4 h = x[r][j] * rstd * sv + tv; uint2 w; w.x = pk2(h[0], h[1]); w.y = pk2(h[2], h[3]); *(uint2*)(hout + ro[r] + 256 * j) = w; } }
            }
        }
    }
    __syncthreads();
}

typedef float f32x16_t __attribute__((ext_vector_type(16)));
constexpr int VNT_LD = 136;
__device__ __forceinline__ void sgu_mfma_chunk(LAS unsigned char* lds, int chunk, const bf16* Vt, const bf16* Ut, bf16* Uo, const float* norm_g, const bf16* Wm  , const float* sgu_b, int lane, int wave) {
    LAS unsigned short* vnT = (LAS unsigned short*)lds;
    const int t0 = chunk * 128;
    float g8[8];
#pragma unroll
    for (int e = 0; e < 8; ++e) g8[e] = norm_g[lane + 64 * e];
    for (int i4 = 0; i4 < 4; ++i4) {
        float v[4][8];
#pragma unroll
        for (int i = 0; i < 4; ++i) { const bf16* vr = Vt + (size_t)(t0 + wave * 16 + i4 * 4 + i) * BW + lane;
#pragma unroll
            for (int e = 0; e < 8; ++e) v[i][e] = bf2f(vr[64 * e]); }
#pragma unroll
        for (int i = 0; i < 4; ++i) { const int s = wave * 16 + i4 * 4 + i; float sum = 0.f;
#pragma unroll
            for (int e = 0; e < 8; ++e) sum += v[i][e];
            const float mu = wave_sum(sum, lane) * (1.0f / BW); float q = 0.f;
#pragma unroll
            for (int e = 0; e < 8; ++e) { v[i][e] -= mu; q += v[i][e] * v[i][e]; }
            const float rstd = 1.0f / __builtin_sqrtf(wave_sum(q, lane) * (1.0f / BW) + EPS);
#pragma unroll
            for (int e = 0; e < 8; ++e) vnT[(lane + 64 * e) * VNT_LD + s] = (unsigned short)f2bf(v[i][e] * rstd * g8[e]); }
    }
    __syncthreads();
    const int r32 = lane & 31, hi = lane >> 5, g = wave;
    f32x16_t acc[4][2];
#pragma unroll
    for (int ti = 0; ti < 4; ++ti)
#pragma unroll
        for (int dj = 0; dj < 2; ++dj)
#pragma unroll
            for (int r = 0; r < 16; ++r) acc[ti][dj][r] = 0.f;
    const bf16* Wg = Wm + (size_t)g * 16384 + (size_t)r32 * 128 + 8 * hi;
    const LAS unsigned short* vb = vnT + (64 * g + r32) * VNT_LD + 8 * hi;
#pragma unroll
    for (int ks = 0; ks < 8; ++ks) {
        const bf16x8 b0 = *(const LAS bf16x8*)(vb + 16 * ks), b1 = *(const LAS bf16x8*)(vb + 32 * VNT_LD + 16 * ks);
#pragma unroll
        for (int ti = 0; ti < 4; ++ti) if (16 * ks <= 32 * ti + 31) {
            const bf16x8 a = *(const bf16x8*)(Wg + (size_t)ti * 32 * 128 + 16 * ks);
            acc[ti][0] = __builtin_amdgcn_mfma_f32_32x32x16_bf16(b0, a, acc[ti][0], 0, 0, 0);
            acc[ti][1] = __builtin_amdgcn_mfma_f32_32x32x16_bf16(b1, a, acc[ti][1], 0, 0, 0); }
    }
#pragma unroll
    for (int ti = 0; ti < 4; ++ti) { const int t = 32 * ti + r32; const float bs = sgu_b[g * 128 + t];
#pragma unroll
        for (int dj = 0; dj < 2; ++dj)
#pragma unroll
            for (int rg = 0; rg < 4; ++rg) { const size_t o = (size_t)(t0 + t) * BW + 64 * g + 32 * dj + 8 * rg + 4 * hi;
                const uint2 uu = *(const uint2*)(Ut + o); uint2 w;
                w.x = pk2(bf_lo(uu.x) * (acc[ti][dj][4 * rg + 0] + bs), bf_hi(uu.x) * (acc[ti][dj][4 * rg + 1] + bs)); w.y = pk2(bf_lo(uu.y) * (acc[ti][dj][4 * rg + 2] + bs), bf_hi(uu.y) * (acc[ti][dj][4 * rg + 3] + bs));
                *(uint2*)(Uo + o) = w; } }
    __syncthreads();
}

constexpr int PA_LD = 520;
template <int W> __device__ __forceinline__ void pool_window(LAS unsigned short* pa, const bf16* ZP, int t0, int c) {
    float z[64 + W - 1];
    const int pos0 = t0 & (SEQ - 1);
#pragma unroll
    for (int i = 0; i < 64 + W - 1; ++i) { const int dt = i - (W - 1); z[i] = (pos0 + dt >= 0) ? bf2f(ZP[(size_t)(t0 + dt) * BW + c]) : 0.f; }
#pragma unroll
    for (int tl = 0; tl < 64; ++tl) { float s = 0.f;
#pragma unroll
        for (int i = 0; i < W; ++i) s += z[tl + (W - 1) - i];
        const int pos = pos0 + tl; const float cnt = (float)((pos + 1 < W) ? pos + 1 : W);
        pa[tl * PA_LD + c] = (unsigned short)f2bf(s / cnt - z[tl + W - 1]); }
}
__device__ __forceinline__ void pool_mfma_tile(LAS unsigned char* lds, int tile, const bf16* ZP, bf16* YPo, const bf16* PWT  , const float* pool_scale, int tid, int lane, int wave) {
    LAS unsigned short* pa = (LAS unsigned short*)lds;
    const int t0 = tile * 64, c = tid, gsel = wave >> 1;
    if (gsel == 0) pool_window<2>(pa, ZP, t0, c); else if (gsel == 1) pool_window<4>(pa, ZP, t0, c); else if (gsel == 2) pool_window<8>(pa, ZP, t0, c); else pool_window<16>(pa, ZP, t0, c);
    __syncthreads();
    const int r32 = lane & 31, hi = lane >> 5, g = wave >> 1, dh = wave & 1;
    f32x16_t acc[2][2];
#pragma unroll
    for (int ti = 0; ti < 2; ++ti)
#pragma unroll
        for (int dj = 0; dj < 2; ++dj)
#pragma unroll
            for (int r = 0; r < 16; ++r) acc[ti][dj][r] = 0.f;
    const bf16* Bg = PWT + ((size_t)g * 128 + 64 * dh + r32) * 128 + 8 * hi;
    const LAS unsigned short* ab = pa + r32 * PA_LD + 128 * g + 8 * hi;
#pragma unroll
    for (int ks = 0; ks < 8; ++ks) {
        const bf16x8 b0 = *(const bf16x8*)(Bg + 16 * ks), b1 = *(const bf16x8*)(Bg + (size_t)32 * 128 + 16 * ks);
        const bf16x8 a0 = *(const LAS bf16x8*)(ab + 16 * ks), a1 = *(const LAS bf16x8*)(ab + 32 * PA_LD + 16 * ks);
        acc[0][0] = __builtin_amdgcn_mfma_f32_32x32x16_bf16(b0, a0, acc[0][0], 0, 0, 0); acc[0][1] = __builtin_amdgcn_mfma_f32_32x32x16_bf16(b1, a0, acc[0][1], 0, 0, 0);
        acc[1][0] = __builtin_amdgcn_mfma_f32_32x32x16_bf16(b0, a1, acc[1][0], 0, 0, 0); acc[1][1] = __builtin_amdgcn_mfma_f32_32x32x16_bf16(b1, a1, acc[1][1], 0, 0, 0);
    }
#pragma unroll
    for (int dj = 0; dj < 2; ++dj)
#pragma unroll
        for (int rg = 0; rg < 4; ++rg) { const int oc = 128 * g + 64 * dh + 32 * dj + 8 * rg + 4 * hi; const f32x4 sc = *(const f32x4*)(pool_scale + oc);
#pragma unroll
            for (int ti = 0; ti < 2; ++ti) { uint2 w; w.x = pk2(acc[ti][dj][4 * rg + 0] * sc[0], acc[ti][dj][4 * rg + 1] * sc[1]); w.y = pk2(acc[ti][dj][4 * rg + 2] * sc[2], acc[ti][dj][4 * rg + 3] * sc[3]);
                *(uint2*)(YPo + (size_t)(t0 + 32 * ti + r32) * BW + oc) = w; } }
    __syncthreads();
}

#ifndef NREP_GEMM
#define NREP_GEMM 1
#endif
#ifndef WGM_WIDE
#define WGM_WIDE 4
#endif
#ifndef WGM_NARROW
#define WGM_NARROW 4
#endif
#ifndef GP_ALIGN
#define GP_ALIGN true
#endif
#ifndef GP_SP2
#define GP_SP2 true
#endif
#ifndef PROBE_BAR2
#define PROBE_BAR2 0
#endif
#ifndef NREP_P0
#define NREP_P0 1
#endif
#ifndef NREP_ATTN
#define NREP_ATTN 1
#endif
#ifndef NREP_MIX
#define NREP_MIX 1
#endif
#ifndef NREP_THIN
#define NREP_THIN 1
#endif
#define PHASE_IDS() int tid_o = wave_s * 64 + pg8::lane_now(); asm volatile("" : "+v"(tid_o)); const int tid = tid_o, lane = tid & 63, wave = __builtin_amdgcn_readfirstlane(tid >> 6), gw = bx * NWAVES + wave, NGW = G * NWAVES; (void)lane; (void)gw; (void)NGW; (void)wave
struct Args { const float* in[23]; float* out; unsigned char* ws; };
__global__ void __launch_bounds__(NWAVES * 64, 2) fwd_kernel(Args args) {
    extern __shared__ __attribute__((aligned(16))) unsigned char lds_raw[];
    LAS unsigned char* lds = (LAS unsigned char*)lds_raw;
    const int G = gridDim.x, bx = blockIdx.x;
    int wave_s = __builtin_amdgcn_readfirstlane((int)(threadIdx.x >> 6)); asm volatile("" : "+s"(wave_s));
    gu32* ctl = (gu32*)(args.ws + WS_CTL);
    for (int u = threadIdx.x; u < (LDS_BYTES - LDSCTL_OFF) / 4; u += NWAVES * 64) ((LAS unsigned*)(lds + LDSCTL_OFF))[u] = 0u;
    __syncthreads();
    volatile LAS unsigned* MISC = (volatile LAS unsigned*)(lds + MISC_OFF);
    XcdBarrier bar = xcd_barrier_post((unsigned*)(ctl + CW_BAR), MISC + 8);
#define GRID_BAR() do { XcdBarrier b_ = bar; asm volatile("" : "+s"(b_.x), "+s"(b_.bar)); xcd_barrier(b_); if (PROBE_BAR2) xcd_barrier(b_); } while (0)
    const volatile __attribute__((address_space(4))) unsigned long long* kargs = (const volatile __attribute__((address_space(4))) unsigned long long*)__builtin_amdgcn_kernarg_segment_ptr();
#define INP(i) ((const float*)(const GAS float*)kargs[(i)])
#define OUTP ((float*)(GAS float*)kargs[23])
#define WSB ((unsigned char*)(GAS unsigned char*)kargs[24])
#define in_x INP(0)
#define in_c INP(1)
#define g_pre_mix INP(2)
#define g_post_mix INP(3)
#define g_pre_ffn INP(4)
#define g_post_ffn INP(5)
#define w_ada INP(6)
#define b_ada INP(7)
#define w_in INP(8)
#define b_in INP(9)
#define sgu_norm_g INP(10)
#define sgu_w INP(11)
#define sgu_b INP(12)
#define pool_w INP(13)
#define pool_scale INP(14)
#define w_sgu_out INP(15)
#define w_moba_out INP(16)
#define w_pool_out INP(17)
#define w_out INP(18)
#define w_up INP(19)
#define w_conv INP(20)
#define b_conv INP(21)
#define w_down INP(22)
#define out OUTP
#define MOD ((float*)(WSB + WS_MOD))
#define MODP ((float*)(WSB + WS_MODP))
#define KMEAN ((float*)(WSB + WS_KMEAN))
#define H ((bf16*)(WSB + WS_H))
#define T6 ((bf16*)(WSB + WS_T6))
#define G3 ((unsigned char*)(WSB + WS_G3))
#define H8 ((unsigned char*)(WSB + WS_H8))
#define Yb ((bf16*)(WSB + WS_Y))
#define XR ((bf16*)(WSB + WS_XR))
#define A2 ((bf16*)(WSB + WS_A2))
#define Ut T6
#define Qt (T6 + (size_t)1 * M * BW)
#define YP (T6 + (size_t)2 * M * BW)
#define Vt (T6 + (size_t)3 * M * BW)
#define Kt (T6 + (size_t)4 * M * BW)
#define VAt (T6 + (size_t)5 * M * BW)
#define ZPt (T6 + (size_t)6 * M * BW)

    for (int rep0_ = 0; rep0_ < NREP_P0; ++rep0_) {
    {   PHASE_IDS();
        LAS float* cond = (LAS float*)(lds + 69632);
        for (int i = tid; i < BATCH * DM; i += NWAVES * 64) { const float c = in_c[i]; cond[i] = c * sigmoid_f(c); }
        __syncthreads();
        for (int w0 = gw; w0 < 1536 + 64 * NWAVES; w0 += NGW) { const int wt = w0 - 64 * NWAVES; if (wt < 0) continue;
            const int ks = wt / 96, cb = wt % 96, l = cb / 48, n0 = (cb % 48) * 256 + 4 * lane;
            const float* wp = w_ada + ((size_t)l * DM + ks * 128) * 12288 + n0;
            f32x4 a0 = {0.f, 0.f, 0.f, 0.f}, a1 = a0, a2 = a0, a3 = a0;
#pragma unroll 8
            for (int k = 0; k < 128; ++k) { const f32x4 w = *(const f32x4*)(wp + (size_t)k * 12288); const int kk = ks * 128 + k;
                a0 += cond[kk] * w; a1 += cond[DM + kk] * w; a2 += cond[2 * DM + kk] * w; a3 += cond[3 * DM + kk] * w; }
            float* pp = MODP + (size_t)(ks * 8 + l * 4) * 12288 + n0;
            *(f32x4*)(pp) = a0; *(f32x4*)(pp + 12288) = a1; *(f32x4*)(pp + 2 * 12288) = a2; *(f32x4*)(pp + 3 * 12288) = a3;
        }
        LAS float* scr = (LAS float*)(lds + wave * 8448);
#define CONVERT_ITEMS(l, WB, LO, HI, SLOT, NSLOT) \
        for (int it = (LO) + (SLOT) * NWAVES + wave; it < (HI); it += (NSLOT) * NWAVES) { int r = it; \
            bf16* Wc = (bf16*)(WB); \
            if (r < 9216) { transpose_item(w_in + (size_t)(l) * DM * INW, DM, INW, (bf16*)((unsigned char*)Wc + WO_IN), false, scr, r, lane, 0, (unsigned char*)Wc + WO_IN, nullptr, (const unsigned*)(WSB + WS_CMAXG) + (size_t)(l) * 9216); continue; } r -= 9216; \
            if (r < 512) { transpose_item(w_sgu_out + (size_t)(l) * BW * DM, BW, DM, (bf16*)((unsigned char*)Wc + WO_SGU), false, scr, r, lane); continue; } r -= 512; \
            if (r < 512) { transpose_item(w_moba_out + (size_t)(l) * BW * DM, BW, DM, (bf16*)((unsigned char*)Wc + WO_MOBA), false, scr, r, lane); continue; } r -= 512; \
            if (r < 512) { transpose_item(w_pool_out + (size_t)(l) * BW * DM, BW, DM, (bf16*)((unsigned char*)Wc + WO_POOL), false, scr, r, lane); continue; } r -= 512; \
            if (r < 2048) { transpose_item(w_out + (size_t)(l) * DM * DM, DM, DM, (bf16*)((unsigned char*)Wc + WO_OUT), false, scr, r, lane); continue; } r -= 2048; \
            if (r < 11264) { transpose_item(w_up + (size_t)(l) * DM * NUP, DM, NUP, (bf16*)((unsigned char*)Wc + WO_UP), true, scr, r, lane, 1 << 30, nullptr, (const unsigned*)(WSB + WS_CMAX) + (size_t)(l) * NUP); continue; } r -= 11264; \
            transpose_item(w_down + (size_t)(l) * DFF * DM, DFF, DM, (bf16*)((unsigned char*)Wc + WO_DOWN), false, scr, r, lane); \
        }
#define QUANT_STRIPS(l, WB, S0, S1, SLOT, NSLOT) { __syncthreads(); \
          for (int st = (S0) + (SLOT); st < (S1); st += (NSLOT)) { \
              if (st < 288) strip_quant(w_in + (size_t)(l) * DM * INW, INW, (WB) + WO_IN, false, (unsigned*)(WSB + WS_CMAXG) + (size_t)(l) * 9216, lds, st, lane, wave); \
              else strip_quant(w_up + (size_t)(l) * DM * NUP, NUP, (WB) + WO_UP, true, (unsigned*)(WSB + WS_CMAX) + (size_t)(l) * NUP, lds, st - 288, lane, wave); } }
        QUANT_STRIPS(0, WSB + WS_W0, 0, 288, bx, G)
        { bf16* SW = (bf16*)(WSB + WS_SGUW); bf16* PW = (bf16*)(WSB + WS_POOLWT); const float* sw = sgu_w; const float* pw = pool_w;
          for (int i = bx * NWAVES * 64 + tid; i < 2 * 8 * 16384; i += G * NWAVES * 64) { const int t = (i >> 7) & 127, sI = i & 127; SW[i] = (bf16)((sI <= t) ? f2bf(sw[i]) : 0u); }
          for (int i = bx * NWAVES * 64 + tid; i < 2 * 4 * 16384; i += G * NWAVES * 64) { const int lg = i >> 14, d = (i >> 7) & 127, cI = i & 127; PW[i] = (bf16)f2bf(pw[(size_t)lg * 16384 + cI * 128 + d]); } }
        GRID_BAR();
    }
    {   PHASE_IDS();
        for (int v = bx * NWAVES * 64 + tid; v < 2 * BATCH * 12288; v += G * NWAVES * 64) {
            const int lb = v / 12288, n = v % 12288; float s = b_ada[(size_t)(lb >> 2) * 12288 + n];
            for (int ks = 0; ks < 16; ++ks) s += MODP[(size_t)(ks * 8 + lb) * 12288 + n];
            MOD[v] = s; }
        GRID_BAR();
    }
    { PHASE_IDS(); thin_phase<0, false, false, false, true>(lds, tid, lane, wave, bx, G, in_x, nullptr, nullptr, (bf16*)H8, nullptr, (float*)(WSB + WS_RS1), nullptr, nullptr, MOD + 2048, MOD + 0, g_pre_mix); }
    GRID_BAR();
    }

    for (int l = 0; l < DEPTH; ++l) {
#define Wl (l == 0 ? WSB + WS_W0 : (unsigned char*)OUTP)
#define modl (MOD + (size_t)l * BATCH * 12288)
        for (int rep_ = 0; rep_ < NREP_GEMM; ++rep_)
        { { pg8::Gemm g{(const bf16*)H8, (const bf16*)(Wl + WO_IN), M, 3072, DM / 2}; pg8::StaticOrder S; S.init(M, 3072, G, bx, WGM_WIDE);
            EpiInProj E{b_in + (size_t)l * INW, T6, KMEAN + (size_t)l * 65536, (unsigned*)(WSB + WS_KABS) + (size_t)l * 65536, (const float*)(WSB + WS_RS1), (const unsigned*)(WSB + WS_CMAXG) + (size_t)l * 9216};
            pg8::gemm_phase<EpiInProj, pg8::StaticOrder, GP_ALIGN, GP_SP2, false, true>(lds, g, S, E, wave_s); }
          GRID_BAR(); }
        { PHASE_IDS();
          for (int repa_ = NREP_ATTN - 1; repa_ >= 0; --repa_)
          { const attn_body::AttnTensors AT{(const attn_body::bf16*)Qt, (const attn_body::bf16*)Kt, (const attn_body::bf16*)VAt, KMEAN + (size_t)l * 65536, (const float*)(WSB + WS_KABS) + (size_t)l * 65536, repa_ ? (attn_body::bf16*)H : (attn_body::bf16*)Qt};
            const attn_body::QueueOrder AS{(unsigned*)(WSB + WS_CTL) + CW_ATTNQ + 64 * l + 16 * repa_, (volatile unsigned*)((char*)lds_raw + MISC_OFF + 64), wave_s};
            {
              const unsigned nent = (l == 0) ? 1536u : 1024u;
              for (;;) {
                  if (AS.wv == 0 && pg8::lane_now() == 0) *AS.slot = __hip_atomic_fetch_add(AS.ctr, 1u, __ATOMIC_RELAXED, __HIP_MEMORY_SCOPE_AGENT);
                  asm volatile("s_waitcnt vmcnt(0) lgkmcnt(0)\n\ts_barrier" ::: "memory");
                  const unsigned idx = (unsigned)__builtin_amdgcn_readfirstlane((int)*AS.slot);
                  if (idx >= nent) break;
                  unsigned a_ = idx; int bun = -1;
                  if (l == 0) { const unsigned grp = idx / 3u, rr = idx - 3u * grp; if (rr < 2u) a_ = 2u * grp + rr; else bun = (int)grp; }
                  if (bun < 0) { const int qb_ = attn_body::NQB - 1 - (int)(a_ >> 5), bh_ = (int)(a_ & 31u);
                      attn_body::attn_unit<8>(bh_ / attn_body::NHEAD, bh_ % attn_body::NHEAD, qb_, AT.Q, AT.K, AT.V, AT.KM, AT.KA, AT.O, (char*)lds_raw, wave_s); }
                  else { const int lane = pg8::lane_now(); LAS float* scr = (LAS float*)(lds + wave * 8448);
                      if (bun < 256) { const int c_ = bun; CONVERT_ITEMS(0, WSB + WS_W0, 9216, 12800, c_, 256) CONVERT_ITEMS(0, WSB + WS_W0, 24064, 29696, c_, 256) QUANT_STRIPS(0, WSB + WS_W0, 288, 640, c_, 256) }
                      else { const int c_ = bun - 256; CONVERT_ITEMS(1, (unsigned char*)OUTP, 9216, 12800, c_, 256) CONVERT_ITEMS(1, (unsigned char*)OUTP, 24064, 29696, c_, 256) QUANT_STRIPS(1, (unsigned char*)OUTP, 0, 640, c_, 256) }
                      __syncthreads(); }
              } } }
          __syncthreads();
          for (int repm_ = NREP_MIX - 1; repm_ >= 0; --repm_) {
          for (int chunk = bx; chunk < M / 128; chunk += G) sgu_mfma_chunk(lds, chunk, Vt, Ut, repm_ ? H : Ut, sgu_norm_g + (size_t)l * BW, (const bf16*)(WSB + WS_SGUW) + (size_t)l * 8 * 16384, sgu_b + (size_t)l * 8 * 128, lane, wave);
          for (int tile = bx; tile < M / 64; tile += G) pool_mfma_tile(lds, tile, ZPt, YP, (const bf16*)(WSB + WS_POOLWT) + (size_t)l * 4 * 16384, pool_scale + (size_t)l * BW, tid, lane, wave);
          }
          GRID_BAR(); }
        for (int rep_ = 0; rep_ < NREP_GEMM; ++rep_)
        {
          { pg8::Gemm g{(const bf16*)H8, (const bf16*)(Wl + WO_IN + WO_IN8), M, 6144, DM / 2}; pg8::StaticOrder S; S.init(M, 6144, G, bx, WGM_WIDE);
            EpiGate8 E{b_in + (size_t)l * INW + 3072, G3, (const float*)(WSB + WS_RS1), (const unsigned*)(WSB + WS_CMAXG) + (size_t)l * 9216 + 3072};
            pg8::gemm_phase<EpiGate8, pg8::StaticOrder, GP_ALIGN, GP_SP2, false, true>(lds, g, S, E, wave_s); }
          GRID_BAR(); }
        for (int rep_ = 0; rep_ < NREP_GEMM; ++rep_)
        { pg8::Gemm g{Ut, (const bf16*)(Wl + WO_SGU), M, DM, BW, 3, (size_t)M * BW * 2, (size_t)2 * MiB}; pg8::StaticOrder S; S.init(M, DM, G, bx, WGM_NARROW);
          EpiBranch E{G3, H};
          pg8::gemm_phase<EpiBranch, pg8::StaticOrder, GP_ALIGN, GP_SP2>(lds, g, S, E, wave_s);
          GRID_BAR(); }
        for (int rep_ = 0; rep_ < NREP_GEMM; ++rep_)
        { pg8::Gemm g{H, (const bf16*)(Wl + WO_OUT), M, DM, DM}; pg8::StaticOrder S; S.init(M, DM, G, bx, WGM_NARROW);
          EpiPlain E{Yb, DM};
          pg8::gemm_phase<EpiPlain, pg8::StaticOrder, GP_ALIGN, GP_SP2>(lds, g, S, E, wave_s);
          GRID_BAR(); }
        for (int rept_ = 0; rept_ < (l == 0 ? NREP_THIN : 1); ++rept_)
        { PHASE_IDS(); if (l == 0) thin_phase<1, false, true, false, true>(lds, tid, lane, wave, bx, G, in_x, Yb, XR, H, nullptr, (float*)(WSB + WS_RS), modl + 4096, g_post_mix + (size_t)l * DM, modl + 8192, modl + 6144, g_pre_ffn + (size_t)l * DM);
          else thin_phase<1, true, true, false, true>(lds, tid, lane, wave, bx, G, XR, Yb, XR, H, nullptr, (float*)(WSB + WS_RS), modl + 4096, g_post_mix + (size_t)l * DM, modl + 8192, modl + 6144, g_pre_ffn + (size_t)l * DM); }
        GRID_BAR();
        for (int rep_ = 0; rep_ < NREP_GEMM; ++rep_)
        { pg8::Gemm g{H, (const bf16*)(Wl + WO_UP), M, NUP, DM / 2}; pg8::StaticOrder S; S.init(M, NUP, G, bx, WGM_WIDE);
          EpiUpConv E{A2, w_conv + (size_t)l * 3 * NUP, b_conv + (size_t)l * NUP, (float*)(WSB + WS_TOPZ), (float*)(WSB + WS_BOTZ), (LAS float*)(lds + XB_OFF), (const float*)(WSB + WS_RS), (const unsigned*)(WSB + WS_CMAX) + (size_t)l * NUP};
          pg8::gemm_phase<EpiUpConv, pg8::StaticOrder, true, GP_SP2, false, true>(lds, g, S, E, wave_s);
          GRID_BAR(); }
        { PHASE_IDS(); const float* wc = w_conv + (size_t)l * 3 * NUP; const float* bc = b_conv + (size_t)l * NUP;
          const float* TZ = (const float*)(WSB + WS_TOPZ); const float* BZ = (const float*)(WSB + WS_BOTZ); bf16* a2 = A2;
          for (int it = bx * NWAVES * 64 + tid; it < (M / 256) * DFF; it += G * NWAVES * 64) { const int pm = it / DFF, n = it % DFF; if ((pm & 31) == 0) continue;
              const int cg = (n >> 7) * 256 + (n & 127);
              float res[2];
              float zc[2][2];
#pragma unroll
              for (int k = 0; k < 2; ++k) { const int c = cg + 128 * k, pc = n + DFF * k;
                  const float t0 = TZ[((size_t)pm * 2 + 0) * NUP + c], t1 = TZ[((size_t)pm * 2 + 1) * NUP + c], b0 = BZ[((size_t)(pm - 1) * 2 + 0) * NUP + c], b1 = BZ[((size_t)(pm - 1) * 2 + 1) * NUP + c];
                  const unsigned cmb = ((const unsigned*)(WSB + WS_CMAX))[(size_t)l * NUP + pc]; const float csc = __builtin_bit_cast(float, cmb) * (1.0f / 127.0f);
                  const float w0 = wc[pc] * csc, w1 = wc[NUP + pc] * csc, w2 = wc[2 * NUP + pc] * csc, bb = bc[pc];
                  zc[k][0] = w2 * t0 + w1 * b1 + w0 * b0 + bb; zc[k][1] = w2 * t1 + w1 * t0 + w0 * b1 + bb; }
              res[0] = gelu_tanh(zc[0][0]) * zc[1][0]; res[1] = gelu_tanh(zc[0][1]) * zc[1][1];
              a2[(size_t)(pm * 256 + 0) * DFF + n] = (bf16)f2bf(res[0]); a2[(size_t)(pm * 256 + 1) * DFF + n] = (bf16)f2bf(res[1]); }
          GRID_BAR(); }
        for (int rep_ = 0; rep_ < NREP_GEMM; ++rep_)
        { pg8::Gemm g{A2, (const bf16*)(Wl + WO_DOWN), M, DM, DFF}; pg8::StaticOrder S; S.init(M, DM, G, bx, WGM_NARROW);
          EpiPlain E{Yb, DM};
          pg8::gemm_phase<EpiPlain, pg8::StaticOrder, GP_ALIGN, GP_SP2>(lds, g, S, E, wave_s);
          GRID_BAR(); }
        if (l == 0) { PHASE_IDS(); thin_phase<1, true, true, false, true>(lds, tid, lane, wave, bx, G, XR, Yb, XR, (bf16*)H8, nullptr, (float*)(WSB + WS_RS1), modl + 10240, g_post_ffn, MOD + (size_t)BATCH * 12288 + 2048, MOD + (size_t)BATCH * 12288, g_pre_mix + DM);
            GRID_BAR(); }
        else { PHASE_IDS(); thin_phase<2, true, false>(lds, tid, lane, wave, bx, G, XR, Yb, out, nullptr, nullptr, nullptr, modl + 10240, g_post_ffn + (size_t)l * DM, nullptr, nullptr, nullptr); }
    }
#undef GRID_BAR
}
#undef INP
#undef OUTP
#undef WSB
#undef in_x
#undef in_c
#undef g_pre_mix
#undef g_post_mix
#undef g_pre_ffn
#undef g_post_ffn
#undef w_ada
#undef b_ada
#undef w_in
#undef b_in
#undef sgu_norm_g
#undef sgu_w
#undef sgu_b
#undef pool_w
#undef pool_scale
#undef w_sgu_out
#undef w_moba_out
#undef w_pool_out
#undef w_out
#undef w_up
#undef w_conv
#undef b_conv
#undef w_down
#undef out
#undef MOD
#undef MODP
#undef KMEAN
#undef H
#undef T6
#undef G3
#undef H8
#undef YP
#undef Yb
#undef A2
#undef Ut
#undef Vt
#undef Qt
#undef Kt
#undef VAt
#undef ZPt
#undef Wl
#undef XR
#undef CONVERT_ITEMS
#undef QUANT_STRIPS
#undef modl

extern "C" void kernel_launch(void* const* d_in, const int* in_sizes, int n_in, void* d_out, int out_size, void* d_ws, size_t ws_size, hipStream_t stream) {
    static int grid = 0;
    if (grid == 0) {
        if (n_in != 23 || in_sizes[0] != M * DM || out_size != M * DM || ws_size < WS_END) { fprintf(stderr, "kernel_launch: unexpected shapes (n_in %d, in0 %d, out %d, ws %zu); nothing launched\n", n_in, n_in > 0 ? in_sizes[0] : -1, out_size, ws_size); grid = -1; return; }
        int dev = 0, cus = 0;
        if (hipGetDevice(&dev) != hipSuccess || hipDeviceGetAttribute(&cus, hipDeviceAttributeMultiprocessorCount, dev) != hipSuccess) { grid = -1; return; }
        if (hipFuncSetAttribute((const void*)fwd_kernel, hipFuncAttributeMaxDynamicSharedMemorySize, LDS_BYTES) != hipSuccess) { fprintf(stderr, "kernel_launch: hipFuncSetAttribute failed\n"); grid = -1; return; }
        int per_cu = 0;
        if (hipOccupancyMaxActiveBlocksPerMultiprocessor(&per_cu, (const void*)fwd_kernel, NWAVES * 64, LDS_BYTES) != hipSuccess || per_cu < 1) fprintf(stderr, "kernel_launch: occupancy query says %d\n", per_cu);
        (void)hipGetLastError();
        grid = cus;
    }
    if (grid < 0) return;
    if (hipMemsetAsync((char*)d_ws + WS_CTL, 0, CTL_ZERO_BYTES, stream) != hipSuccess) return;
    Args a{};
    for (int i = 0; i < 23; ++i) a.in[i] = (const float*)d_in[i];
    a.out = (float*)d_out; a.ws = (unsigned char*)d_ws;
    hipLaunchKernelGGL(fwd_kernel, dim3(grid), dim3(NWAVES * 64), LDS_BYTES, stream, a);
}
```

```cpp
#include <hip/hip_runtime.h>
#include <cstdio>
#include <cstdint>
namespace pg8 {
#define PG8_LAS __attribute__((address_space(3)))
typedef unsigned short bf16_t;
typedef short bf16x8 __attribute__((ext_vector_type(8)));
typedef float f32x4 __attribute__((ext_vector_type(4)));
typedef unsigned u32x4 __attribute__((ext_vector_type(4)));
__device__ __forceinline__ int lane_now() { int l; asm volatile("v_mbcnt_lo_u32_b32 %0, -1, 0\n\tv_mbcnt_hi_u32_b32 %0, -1, %0" : "=v"(l)); return l; }
typedef int i32x4 __attribute__((ext_vector_type(4)));
typedef int i32x8 __attribute__((ext_vector_type(8)));
constexpr int BM = 256, BK = 64, HALF = 128, HTB = HALF * BK * 2  , STAGE_BYTES = 8 * HTB, NXCD = 8, WGM = 8;

__host__ __device__ __forceinline__ int lds_byte(int r, int c) { const int st = (r >> 4) * 2 + (c >> 5), rr = r & 15, cc = c & 31, ob = rr * 64 + cc * 2; return st * 1024 + (ob ^ (((ob >> 9) & 1) << 5)); }
__host__ __device__ __forceinline__ void stage_rc(int b, int& R, int& C) { const int st = b / 1024, sb = b % 1024, swz = sb ^ (((sb >> 9) & 1) << 5); R = (st >> 1) * 16 + swz / 64; C = (st & 1) * 32 + (swz % 64) / 2; }
__host__ __device__ __forceinline__ int perm32(int rho) { const int n = rho >> 4, i = rho & 15; return 8 * (i >> 2) + 4 * n + (i & 3); }

struct Unit { int pm, pn; };
struct Gemm { const bf16_t* A; const bf16_t* Bt; int M, N, K; int nseg; size_t segA, segB; };

struct StaticOrder {
    int nM, nN, nwg, G, c, wgm;
    __host__ __device__ void init(int M, int N, int G_, int c_, int wgm_ = WGM) { nM = M / BM; nN = N / BM; nwg = nM * nN; G = G_; c = c_; wgm = wgm_; }
    __host__ __device__ bool next(int i, Unit& u) const {
        const long L = (long)i * G + c; if (L >= nwg) return false;
        int wgid = (int)L; { const int q = nwg / NXCD, r = nwg % NXCD, xcd = wgid % NXCD, off = wgid / NXCD; wgid = (xcd < r ? xcd * (q + 1) : r * (q + 1) + (xcd - r) * q) + off; }
        const int nig = wgm * nN, gid = wgid / nig, fm = gid * wgm, gsz = (nM - fm) < wgm ? (nM - fm) : wgm;
        u.pm = fm + ((wgid % nig) % gsz); u.pn = (wgid % nig) / gsz; return true;
    }
    __device__ __forceinline__ void a_ready(const Unit&) const {}
    __device__ __forceinline__ void done(const Unit&) const {}
};

__device__ __forceinline__ unsigned cvt_pk_bf16(float lo, float hi) { unsigned r; asm volatile("v_cvt_pk_bf16_f32 %0, %1, %2" : "=v"(r) : "v"(lo), "v"(hi)); return r; }
typedef float f32x2 __attribute__((ext_vector_type(2)));
template <class Epi, class Sched, bool ALIGN_EPI = false, bool SP2 = false, bool FP8 = false, bool I8 = false>
__device__ __forceinline__ void gemm_phase(PG8_LAS unsigned char* lds, const Gemm g, const Sched& S, const Epi& E, int wave_s) {
    int tid_l = wave_s * 64 + lane_now(); asm volatile("" : "+v"(tid_l));
    const int tid = tid_l, wid = __builtin_amdgcn_readfirstlane(tid >> 6), lane = tid & 63, wr = wid >> 2, wc = wid & 3, fr = lane & 15, fq = lane >> 4;
    const int K = g.K, nt = (K / BK) * (Epi::SEGMENTED ? g.nseg : 1);
    unsigned voffA[2], voffB[2];
#pragma unroll
    for (int i = 0; i < 2; ++i) { int R, C; stage_rc(tid * 16 + i * 8192, R, C); const int Rb = Epi::PERM ? ((R & ~31) + perm32(R & 31)) : R;
        voffA[i] = (unsigned)(R * K + C) * 2u; voffB[i] = (unsigned)(Rb * K + C) * 2u; }
    const size_t kstep = (size_t)(BK * 2);
    const size_t hstep = (size_t)HALF * K * 2;
    const size_t tstep = 2 * hstep;
    const unsigned ldsw = (unsigned)wid * 1024u;
    const int aoff = lds_byte(wr * 64 + fr, fq * 8), boff = lds_byte(wc * 32 + fr, fq * 8);
#define PG8_SA(b, h) (((b) * 2 + (h)) * HTB)
#define PG8_SB(b, h) ((4 + (b) * 2 + (h)) * HTB)
#define PG8_STAGE(bufoff, gbase, voff) do { _Pragma("unroll") for (int _i = 0; _i < 2; ++_i) { unsigned vo_ = (voff)[_i]; if constexpr (FP8 || I8) asm volatile("" : "+v"(vo_));     \
        __builtin_amdgcn_global_load_lds((const unsigned*)((const char*)(gbase) + vo_), (PG8_LAS unsigned*)(lds + (bufoff) + ldsw + _i * 8192), 16, 0, 0); } } while (0)
#define PG8_LDA(dst, b, h) do { _Pragma("unroll") for (int m = 0; m < 4; ++m) _Pragma("unroll") for (int k = 0; k < 2; ++k) dst[m][k] = *(const PG8_LAS bf16x8*)(lds + PG8_SA(b, h) + aoff + m * 2048 + k * 1024); } while (0)
#define PG8_LDB(dst, b, h) do { _Pragma("unroll") for (int n = 0; n < 2; ++n) _Pragma("unroll") for (int k = 0; k < 2; ++k) dst[n][k] = *(const PG8_LAS bf16x8*)(lds + PG8_SB(b, h) + boff + n * 2048 + k * 1024); } while (0)
#define PG8_CAT8(v) __builtin_shufflevector(__builtin_bit_cast(i32x4, (v)[0]), __builtin_bit_cast(i32x4, (v)[1]), 0, 1, 2, 3, 4, 5, 6, 7)
#define PG8_MMA(ai, bj, At, Bt) do { __builtin_amdgcn_s_setprio(1); _Pragma("unroll") for (int m = 0; m < 4; ++m) _Pragma("unroll") for (int n = 0; n < 2; ++n) { \
        if constexpr (FP8) acc[ai][bj][m][n] = __builtin_amdgcn_mfma_scale_f32_16x16x128_f8f6f4(PG8_CAT8(Bt[n]), PG8_CAT8(At[m]), acc[ai][bj][m][n], 0, 0, 0, 0, 0, 0);     \
        else if constexpr (I8) { _Pragma("unroll") for (int k = 0; k < 2; ++k) acc[ai][bj][m][n] = __builtin_bit_cast(f32x4, __builtin_amdgcn_mfma_i32_16x16x64_i8(__builtin_bit_cast(i32x4, Bt[n][k]), __builtin_bit_cast(i32x4, At[m][k]), __builtin_bit_cast(i32x4, acc[ai][bj][m][n]), 0, 0, 0)); } \
        else { _Pragma("unroll") for (int k = 0; k < 2; ++k) acc[ai][bj][m][n] = __builtin_amdgcn_mfma_f32_16x16x32_bf16(Bt[n][k], At[m][k], acc[ai][bj][m][n], 0, 0, 0); } } __builtin_amdgcn_s_setprio(0); } while (0)
#define PG8_WAIT_V(n) asm volatile("s_waitcnt vmcnt(" #n ")" ::: "memory")
#define PG8_WAIT_L(n) asm volatile("s_waitcnt lgkmcnt(" #n ")" ::: "memory")
#define PG8_BAR __builtin_amdgcn_s_barrier()
#define PG8_SCHED __builtin_amdgcn_sched_barrier(0)
    Unit cur, nxt; int ui = 0;
    if (!S.next(0, cur)) return;
    f32x4 acc[2][2][4][2];
#pragma unroll
    for (int a = 0; a < 2; ++a)
#pragma unroll
        for (int b = 0; b < 2; ++b)
#pragma unroll
            for (int m = 0; m < 4; ++m)
#pragma unroll
                for (int n = 0; n < 2; ++n) acc[a][b][m][n] = (f32x4){0.f, 0.f, 0.f, 0.f};
    bf16x8 At[4][2], B0[2][2], B1[2][2];
    const char* cA = (const char*)g.A + (size_t)cur.pm * tstep; const char* cB = (const char*)g.Bt + (size_t)cur.pn * tstep;
    S.a_ready(cur);
    if constexpr (SP2) {
        PG8_STAGE(PG8_SB(0, 0), cB, voffB); PG8_STAGE(PG8_SB(0, 1), cB + hstep, voffB); PG8_STAGE(PG8_SA(0, 0), cA, voffA); PG8_STAGE(PG8_SA(0, 1), cA + hstep, voffA);
        if (wr == 1) PG8_BAR;
        PG8_WAIT_V(2); PG8_BAR;
        PG8_STAGE(PG8_SB(1, 0), cB + kstep, voffB); PG8_STAGE(PG8_SA(1, 0), cA + kstep, voffA); PG8_STAGE(PG8_SB(1, 1), cB + hstep + kstep, voffB);
        PG8_WAIT_V(6); PG8_BAR;
    } else {
        PG8_STAGE(PG8_SB(0, 0), cB, voffB); PG8_STAGE(PG8_SA(0, 0), cA, voffA); PG8_STAGE(PG8_SB(0, 1), cB + hstep, voffB); PG8_STAGE(PG8_SA(0, 1), cA + hstep, voffA);
        if (wr == 1) PG8_BAR;
        PG8_WAIT_V(4); PG8_BAR;
        PG8_STAGE(PG8_SB(1, 0), cB + kstep, voffB); PG8_STAGE(PG8_SA(1, 0), cA + kstep, voffA); PG8_STAGE(PG8_SB(1, 1), cB + hstep + kstep, voffB);
        PG8_WAIT_V(6); PG8_BAR;
    }
    for (;;) {
        const bool has_next = S.next(ui + 1, nxt);
        const char* nA = has_next ? (const char*)g.A + (size_t)nxt.pm * tstep : cA; const char* nB = has_next ? (const char*)g.Bt + (size_t)nxt.pn * tstep : cB;
        for (int t = 0; t < nt; t += 2) {
            const bool last = (t == nt - 2);
            const char* a1; const char* a2; const char* b2;
            if constexpr (Epi::SEGMENTED) {
                constexpr int SH = Epi::SEG_SHIFT, SM = (1 << SH) - 1;
                a1 = cA + (size_t)((t + 1) >> SH) * g.segA + (size_t)((t + 1) & SM) * kstep;
                a2 = last ? nA : cA + (size_t)((t + 2) >> SH) * g.segA + (size_t)((t + 2) & SM) * kstep; b2 = last ? nB : cB + (size_t)((t + 2) >> SH) * g.segB + (size_t)((t + 2) & SM) * kstep;
                if (t != 0 && (t & SM) == 0) E.seg_hook(acc, cur, t >> SH, wr, wc, fr, fq);
            } else {
                a1 = cA + (size_t)(t + 1) * kstep;
                a2 = last ? nA : cA + (size_t)(t + 2) * kstep; b2 = last ? nB : cB + (size_t)(t + 2) * kstep;
            }
            const char* a3 = a2 + kstep; const char* b3 = b2 + kstep;
            if (last && has_next) S.a_ready(nxt);
            if constexpr (SP2) {
            PG8_LDB(B0, 0, 0); PG8_LDB(B1, 0, 1); PG8_SCHED; PG8_LDA(At, 0, 0); PG8_STAGE(PG8_SA(1, 1), a1 + hstep, voffA);
            PG8_WAIT_V(8); PG8_WAIT_L(0); PG8_BAR; PG8_MMA(0, 0, At, B0); PG8_MMA(0, 1, At, B1); PG8_BAR; PG8_SCHED;
            PG8_LDA(At, 0, 1); PG8_STAGE(PG8_SB(0, 0), b2, voffB); PG8_STAGE(PG8_SB(0, 1), b2 + hstep, voffB); PG8_STAGE(PG8_SA(0, 0), a2, voffA);
            PG8_WAIT_V(8); PG8_WAIT_L(0); PG8_BAR; PG8_MMA(1, 0, At, B0); PG8_MMA(1, 1, At, B1); PG8_BAR; PG8_SCHED;
            PG8_LDB(B0, 1, 0); PG8_LDB(B1, 1, 1); PG8_SCHED; PG8_LDA(At, 1, 0); PG8_STAGE(PG8_SA(0, 1), a2 + hstep, voffA);
            PG8_WAIT_V(8); PG8_WAIT_L(0); PG8_BAR; PG8_MMA(0, 0, At, B0); PG8_MMA(0, 1, At, B1); PG8_BAR; PG8_SCHED;
            PG8_LDA(At, 1, 1); PG8_STAGE(PG8_SB(1, 0), b3, voffB); PG8_STAGE(PG8_SB(1, 1), b3 + hstep, voffB); PG8_STAGE(PG8_SA(1, 0), a3, voffA);
            PG8_WAIT_V(8); PG8_WAIT_L(0); PG8_BAR; PG8_MMA(1, 0, At, B0); PG8_MMA(1, 1, At, B1); PG8_BAR; PG8_SCHED;
            } else {
            PG8_LDB(B0, 0, 0); PG8_SCHED; PG8_LDA(At, 0, 0); PG8_STAGE(PG8_SA(1, 1), a1 + hstep, voffA);
            PG8_WAIT_L(8); PG8_BAR; PG8_WAIT_L(0); PG8_MMA(0, 0, At, B0); PG8_BAR; PG8_SCHED;
            PG8_LDB(B1, 0, 1); PG8_STAGE(PG8_SB(0, 0), b2, voffB);
            PG8_BAR; PG8_WAIT_L(0); PG8_MMA(0, 1, At, B1); PG8_BAR;
            PG8_LDA(At, 0, 1); PG8_STAGE(PG8_SA(0, 0), a2, voffA);
            PG8_BAR; PG8_WAIT_L(0); PG8_MMA(1, 0, At, B0); PG8_BAR; PG8_SCHED;
            PG8_STAGE(PG8_SB(0, 1), b2 + hstep, voffB);
            PG8_WAIT_V(6); PG8_BAR; PG8_MMA(1, 1, At, B1); PG8_BAR;
            PG8_LDB(B0, 1, 0); PG8_SCHED; PG8_LDA(At, 1, 0); PG8_STAGE(PG8_SA(0, 1), a2 + hstep, voffA);
            PG8_WAIT_L(8); PG8_BAR; PG8_WAIT_L(0); PG8_MMA(0, 0, At, B0); PG8_BAR; PG8_SCHED;
            PG8_LDB(B1, 1, 1); PG8_STAGE(PG8_SB(1, 0), b3, voffB);
            PG8_BAR; PG8_WAIT_L(0); PG8_MMA(0, 1, At, B1); PG8_BAR;
            PG8_LDA(At, 1, 1); PG8_STAGE(PG8_SA(1, 0), a3, voffA);
            PG8_BAR; PG8_WAIT_L(0); PG8_MMA(1, 0, At, B0); PG8_BAR; PG8_SCHED;
            PG8_STAGE(PG8_SB(1, 1), b3 + hstep, voffB);
            PG8_WAIT_V(6); PG8_BAR; PG8_MMA(1, 1, At, B1); PG8_BAR;
            }
        }
        if constexpr (ALIGN_EPI) { if (wr == 0) PG8_BAR; }
        if constexpr (!Epi::AFTER_DRAIN) { E(acc, cur, wr, wc, fr, fq); S.done(cur); }
        if (!has_next) break;
#pragma unroll
        for (int a = 0; a < 2; ++a)
#pragma unroll
            for (int b = 0; b < 2; ++b)
#pragma unroll
                for (int m = 0; m < 4; ++m)
#pragma unroll
                    for (int n = 0; n < 2; ++n) acc[a][b][m][n] = (f32x4){0.f, 0.f, 0.f, 0.f};
        cur = nxt; cA = nA; cB = nB; ++ui;
        if constexpr (ALIGN_EPI) { if (wr == 1) PG8_BAR; }
    }
    PG8_WAIT_V(0);
    if constexpr (!ALIGN_EPI) { if (wr == 0) PG8_BAR; }
    PG8_BAR;
    if constexpr (Epi::AFTER_DRAIN) { E.fused(acc, cur, wr, wc, fr, fq, lds, wid, lane); S.done(cur); }
#undef PG8_SA
#undef PG8_SB
#undef PG8_STAGE
#undef PG8_LDA
#undef PG8_LDB
#undef PG8_MMA
#undef PG8_CAT8
#undef PG8_WAIT_V
#undef PG8_WAIT_L
#undef PG8_BAR
#undef PG8_SCHED
}
}
#define GAS __attribute__((address_space(1)))
#define LAS __attribute__((address_space(3)))
typedef unsigned short bf16;
typedef unsigned v4u __attribute__((ext_vector_type(4)));
typedef float f32x4 __attribute__((ext_vector_type(4)));
typedef short bf16x8 __attribute__((ext_vector_type(8)));
typedef GAS unsigned gu32;
typedef GAS unsigned long long gu64;
#define RLX_AGENT __ATOMIC_RELAXED, __HIP_MEMORY_SCOPE_AGENT
#define LDS_WAIT() asm volatile("s_waitcnt lgkmcnt(0)" ::: "memory")
#define VM_WAIT() asm volatile("s_waitcnt vmcnt(0)" ::: "memory")
__device__ __forceinline__ unsigned long long rt() { return __builtin_amdgcn_s_memrealtime(); }
__device__ __forceinline__ unsigned f2bf(float f) { unsigned u = __builtin_bit_cast(unsigned, f); return (u + 0x7fffu + ((u >> 16) & 1u)) >> 16; }
__device__ __forceinline__ unsigned pk2(float lo, float hi) { return f2bf(lo) | (f2bf(hi) << 16); }
#define XB_TMO      128
#define XB_XCNT(j)  (256  + 64 * (j))
#define XB_XSUB(j)  (1280 + 64 * (j))
#define XB_XGEN(j)  (2304 + 64 * (j))
#define XB_TOP      3328
#define XB_TOPGEN   3392
#define XCD_BAR_WORDS 3456
#define XB_SPIN_CAP (1u << 18)

__device__ __forceinline__ unsigned xb_ld(unsigned* p)              { return __hip_atomic_load(p, __ATOMIC_RELAXED, __HIP_MEMORY_SCOPE_AGENT); }
__device__ __forceinline__ unsigned xb_add(unsigned* p, unsigned v) { return __hip_atomic_fetch_add(p, v, __ATOMIC_RELAXED, __HIP_MEMORY_SCOPE_AGENT); }
__device__ __forceinline__ unsigned xb_xcc_id() { return (unsigned)__builtin_amdgcn_s_getreg((3 << 11) | 20) & 0xFu; }
#define XB_SPIN(cond, bar) do { unsigned _sp = 0; while (cond) { __builtin_amdgcn_s_sleep(1); \
    if ((++_sp & 255u) == 0u) { if (xb_ld(&(bar)[XB_TMO])) break; if (_sp > XB_SPIN_CAP) { atomicAdd(&(bar)[XB_TMO], 1u); break; } } } } while (0)

struct XcdBarrier {
    unsigned* bar; unsigned x; int wv;
    volatile LAS unsigned* st;
};

__device__ __forceinline__ XcdBarrier xcd_barrier_post(unsigned* bar, volatile LAS unsigned* st) {
    XcdBarrier b; b.bar = bar; b.x = xb_xcc_id(); b.st = st; b.wv = __builtin_amdgcn_readfirstlane((int)(threadIdx.x >> 6));
    if (threadIdx.x == 0) (void)xb_add(&bar[XB_XCNT(b.x)], 1u);
    return b;
}
__device__ __forceinline__ void xcd_barrier_complete(unsigned* bar, unsigned x, unsigned& nloc, unsigned& nx) {
    const unsigned G = gridDim.x * gridDim.y * gridDim.z;
    unsigned sum, cnt, mine, sp = 0u;
    for (;;) {
        sum = 0u; cnt = 0u; mine = 0u;
#pragma unroll
        for (unsigned j = 0; j < 16; ++j) { const unsigned c = xb_ld(&bar[XB_XCNT(j)]); sum += c; cnt += (c > 0u) ? 1u : 0u; mine = (j == x) ? c : mine; }
        if (sum == G) break;
        __builtin_amdgcn_s_sleep(1);
        if ((++sp & 255u) == 0u) { if (xb_ld(&bar[XB_TMO])) break; if (sp > XB_SPIN_CAP) { atomicAdd(&bar[XB_TMO], 1u); break; } }
    }
    nloc = mine > 0u ? mine : 1u; nx = cnt > 0u ? cnt : 1u;
}

__device__ __forceinline__ void xcd_barrier(const XcdBarrier& b) {
    asm volatile("s_waitcnt vmcnt(0)" ::: "memory");
    __syncthreads();
    if (b.wv == 0 && pg8::lane_now() == 0) {
        unsigned* bar = b.bar;
        __builtin_amdgcn_s_waitcnt(0);
        unsigned nloc = b.st[0], nx = b.st[1];
        if (nloc == 0u) { xcd_barrier_complete(bar, b.x, nloc, nx); b.st[0] = nloc; b.st[1] = nx; }
        const unsigned old = xb_add(&bar[XB_XSUB(b.x)], 1u);
        const unsigned gen = old / nloc;
        if (old + 1u == (gen + 1u) * nloc) {
            __builtin_amdgcn_fence(__ATOMIC_RELEASE, "agent");
            asm volatile("s_waitcnt vmcnt(0)" ::: "memory");
            const unsigned og = xb_add(&bar[XB_TOP], 1u);
            const unsigned tg = og / nx;
            if (og + 1u == (tg + 1u) * nx) xb_add(&bar[XB_TOPGEN], 1u);
            else XB_SPIN(xb_ld(&bar[XB_TOPGEN]) == tg, bar);
            __builtin_amdgcn_fence(__ATOMIC_ACQUIRE, "agent");
            xb_add(&bar[XB_XGEN(b.x)], 1u);
            asm volatile("s_waitcnt vmcnt(0)" ::: "memory");
        } else {
            XB_SPIN(xb_ld(&bar[XB_XGEN(b.x)]) == gen, bar);
            __builtin_amdgcn_fence(__ATOMIC_ACQUIRE, "agent");
            asm volatile("s_waitcnt vmcnt(0)" ::: "memory");
        }
    }
    __syncthreads();
}
constexpr int BATCH = 4, SEQ = 8192, DM = 2048, M = BATCH * SEQ, BW = 512, INW = 9216, DFF = 5632, NUP = 2 * DFF, DEPTH = 2;
constexpr int NWAVES = 8;
constexpr float EPS = 1e-6f;
constexpr float LOG2E = 1.4426950408889634f;
constexpr float QSCALE = 0.125f * LOG2E;

__device__ __forceinline__ float bf_lo(unsigned w) { return __builtin_bit_cast(float, w << 16); }
__device__ __forceinline__ float bf_hi(unsigned w) { return __builtin_bit_cast(float, w & 0xffff0000u); }
__device__ __forceinline__ float bf2f(unsigned short h) { return __builtin_bit_cast(float, ((unsigned)h) << 16); }
constexpr float W8_SCALE = 32.0f, W8_INV = 1.0f / 32.0f;
__device__ __forceinline__ float sigmoid_f(float v) { return __builtin_amdgcn_rcpf(1.0f + __builtin_amdgcn_exp2f(-LOG2E * v)); }
__device__ __forceinline__ unsigned gate_q4(const pg8::f32x4 x) {
    float t[4];
#pragma unroll
    for (int j = 0; j < 4; ++j) t[j] = fmaxf(__builtin_fmaf(sigmoid_f(x[j]), 255.0f, 12582912.0f), 12582913.0f);
    return __builtin_amdgcn_perm(__builtin_bit_cast(unsigned, t[1]), __builtin_bit_cast(unsigned, t[0]), 0x0c0c0400u) | __builtin_amdgcn_perm(__builtin_bit_cast(unsigned, t[3]), __builtin_bit_cast(unsigned, t[2]), 0x04000c0cu);
}
__device__ __forceinline__ unsigned q8x4(float a, float b, float c, float d, float inv) {
    const float t0 = __builtin_fmaf(a, inv, 12582912.0f), t1 = __builtin_fmaf(b, inv, 12582912.0f), t2 = __builtin_fmaf(c, inv, 12582912.0f), t3 = __builtin_fmaf(d, inv, 12582912.0f);
    return __builtin_amdgcn_perm(__builtin_bit_cast(unsigned, t1), __builtin_bit_cast(unsigned, t0), 0x0c0c0400u) | __builtin_amdgcn_perm(__builtin_bit_cast(unsigned, t3), __builtin_bit_cast(unsigned, t2), 0x04000c0cu);
}
__device__ __forceinline__ float ub0(unsigned q) { float r; asm("v_cvt_f32_ubyte0 %0, %1" : "=v"(r) : "v"(q)); return r; }
__device__ __forceinline__ float ub1(unsigned q) { float r; asm("v_cvt_f32_ubyte1 %0, %1" : "=v"(r) : "v"(q)); return r; }
__device__ __forceinline__ float ub2(unsigned q) { float r; asm("v_cvt_f32_ubyte2 %0, %1" : "=v"(r) : "v"(q)); return r; }
__device__ __forceinline__ float ub3(unsigned q) { float r; asm("v_cvt_f32_ubyte3 %0, %1" : "=v"(r) : "v"(q)); return r; }
__device__ __forceinline__ pg8::f32x4 gate_ratio4(unsigned a, unsigned b) { pg8::f32x4 r; r[0] = ub0(a) * __builtin_amdgcn_rcpf(ub0(b)); r[1] = ub1(a) * __builtin_amdgcn_rcpf(ub1(b)); r[2] = ub2(a) * __builtin_amdgcn_rcpf(ub2(b)); r[3] = ub3(a) * __builtin_amdgcn_rcpf(ub3(b)); return r; }
__device__ __forceinline__ pg8::f32x4 gate_val4(unsigned a) { pg8::f32x4 r; r[0] = ub0(a); r[1] = ub1(a); r[2] = ub2(a); r[3] = ub3(a); return r * (1.0f / 255.0f); }
__device__ __forceinline__ float gelu_tanh(float v) {
    const float u = __builtin_fmaf(v * v, -0.10294324f, -2.3022082f);
    return v * __builtin_amdgcn_rcpf(1.0f + __builtin_amdgcn_exp2f(v * u));
}

#ifndef UPCONV_DPP
#define UPCONV_DPP 1
#endif
#define EPI_ST(p, v) (*(pg8::u32x4*)(p) = (v))
#define EPI_DRY_DECL
#define EPI_DRY_MEMBER
struct EpiPlain {
    static constexpr bool PERM = true, AFTER_DRAIN = false, SEGMENTED = false;
    pg8::bf16_t* O; int ldc; EPI_DRY_MEMBER
    __device__ __forceinline__ void operator()(const pg8::f32x4 (&acc)[2][2][4][2], const pg8::Unit& u, int wr, int wc, int fr, int fq) const {
        EPI_DRY_DECL
        const int row0 = u.pm * 256 + wr * 64 + fr, col0 = u.pn * 256 + wc * 32 + 8 * fq;
#pragma unroll
        for (int ai = 0; ai < 2; ++ai)
#pragma unroll
            for (int m = 0; m < 4; ++m) { pg8::bf16_t* rowp = O + (size_t)(row0 + ai * 128 + m * 16) * ldc + col0;
#pragma unroll
                for (int bj = 0; bj < 2; ++bj) { const pg8::f32x4 v0 = acc[ai][bj][m][0], v1 = acc[ai][bj][m][1];
                    pg8::u32x4 w; w.x = pg8::cvt_pk_bf16(v0[0], v0[1]); w.y = pg8::cvt_pk_bf16(v0[2], v0[3]); w.z = pg8::cvt_pk_bf16(v1[0], v1[1]); w.w = pg8::cvt_pk_bf16(v1[2], v1[3]);
                    EPI_ST(rowp + bj * 128, w); } }
    }
};
struct EpiInProj {
    static constexpr bool PERM = true, AFTER_DRAIN = false, SEGMENTED = false;
    const float* bias; pg8::bf16_t* T6; float* kmean; unsigned* kabs; const float* rs; const unsigned* cm; EPI_DRY_MEMBER
    __device__ __forceinline__ void operator()(pg8::f32x4 (&acc)[2][2][4][2], const pg8::Unit& u, int wr, int wc, int fr, int fq) const {
        EPI_DRY_DECL
        const int pn = u.pn; int mode, ldc, colt; pg8::bf16_t* base;
        {
            pg8::f32x4 cv[2][2];
#pragma unroll
            for (int bj = 0; bj < 2; ++bj)
#pragma unroll
                for (int n = 0; n < 2; ++n) { const pg8::u32x4 cmv = *(const pg8::u32x4*)(cm + pn * 256 + wc * 32 + 8 * fq + bj * 128 + 4 * n); const unsigned c0 = cmv.x, c1 = cmv.y, c2 = cmv.z, c3 = cmv.w;
                    pg8::f32x4 t; t[0] = __builtin_bit_cast(float, c0); t[1] = __builtin_bit_cast(float, c1); t[2] = __builtin_bit_cast(float, c2); t[3] = __builtin_bit_cast(float, c3); cv[bj][n] = t * (1.0f / 127.0f); }
#pragma unroll
            for (int ai = 0; ai < 2; ++ai)
#pragma unroll
                for (int m = 0; m < 4; ++m) { const float rsv = rs[u.pm * 256 + ai * 128 + wr * 64 + m * 16 + fr];
#pragma unroll
                    for (int bj = 0; bj < 2; ++bj)
#pragma unroll
                        for (int n = 0; n < 2; ++n) { pg8::f32x4 t;
#pragma unroll
                            for (int j = 0; j < 4; ++j) { const float af = acc[ai][bj][m][n][j]; t[j] = (float)__builtin_bit_cast(int, af); }
                            acc[ai][bj][m][n] = (t * rsv) * cv[bj][n]; } }
        }
        if (pn < 12) { const int t = pn >> 1, slot = (t == 0) ? 0 : (t == 1) ? 3 : (t == 2) ? 1 : t + 1;
            base = T6 + (size_t)slot * M * BW; ldc = BW; colt = (pn & 1) * 256; mode = t < 2 ? 1 : (t == 2 ? 2 : 0); }
        else { base = T6; ldc = DM; colt = 0; mode = 0; }
        const int row0 = u.pm * 256 + wr * 64 + fr, col0 = colt + wc * 32 + 8 * fq, bcol0 = pn * 256 + wc * 32 + 8 * fq;
        pg8::f32x4 bv[2][2];
#pragma unroll
        for (int bj = 0; bj < 2; ++bj)
#pragma unroll
            for (int n = 0; n < 2; ++n) bv[bj][n] = *(const pg8::f32x4*)(bias + bcol0 + bj * 128 + 4 * n);
        if (pn == 6 || pn == 7) {
            const int lane = fq * 16 + fr; const int b = u.pm >> 5, jblk = u.pm & 31;
#pragma unroll
            for (int bj = 0; bj < 2; ++bj)
#pragma unroll
                for (int n = 0; n < 2; ++n) { pg8::f32x4 s = bv[bj][n] * 8.0f;
#pragma unroll
                    for (int ai = 0; ai < 2; ++ai)
#pragma unroll
                        for (int m = 0; m < 4; ++m) s = s + acc[ai][bj][m][n];
                    pg8::f32x4 mx = {0.f, 0.f, 0.f, 0.f};
#pragma unroll
                    for (int ai = 0; ai < 2; ++ai)
#pragma unroll
                        for (int m = 0; m < 4; ++m) { const pg8::f32x4 kv = acc[ai][bj][m][n] + bv[bj][n];
#pragma unroll
                            for (int j = 0; j < 4; ++j) mx[j] = fmaxf(mx[j], __builtin_fabsf(kv[j])); }
#pragma unroll
                    for (int j = 0; j < 4; ++j) { float v = s[j]; float a = mx[j];
#pragma unroll
                        for (int o = 1; o < 16; o <<= 1) { v += __builtin_bit_cast(float, __builtin_amdgcn_ds_bpermute((lane ^ o) << 2, __builtin_bit_cast(int, v)));
                            a = fmaxf(a, __builtin_bit_cast(float, __builtin_amdgcn_ds_bpermute((lane ^ o) << 2, __builtin_bit_cast(int, a)))); }
                        if (fr == 0) { const int col = (pn & 1) * 256 + bj * 128 + wc * 32 + 8 * fq + 4 * n + j; const size_t ki = ((size_t)(b * 8 + (col >> 6)) * 32 + jblk) * 64 + (col & 63);
                            atomicAdd(kmean + ki, v * (1.0f / 256.0f)); atomicMax(kabs + ki, __builtin_bit_cast(unsigned, a)); } } }
        }
#pragma unroll
        for (int ai = 0; ai < 2; ++ai)
#pragma unroll
            for (int m = 0; m < 4; ++m) { pg8::bf16_t* rowp = base + (size_t)(row0 + ai * 128 + m * 16) * ldc + col0;
#pragma unroll
                for (int bj = 0; bj < 2; ++bj) { pg8::f32x4 v0 = acc[ai][bj][m][0] + bv[bj][0], v1 = acc[ai][bj][m][1] + bv[bj][1];
                    if (mode == 1) {
#pragma unroll
                        for (int j = 0; j < 4; ++j) { v0[j] = gelu_tanh(v0[j]); v1[j] = gelu_tanh(v1[j]); } }
                    else if (mode == 2) { v0 = v0 * QSCALE; v1 = v1 * QSCALE; }
                    pg8::u32x4 w; w.x = pg8::cvt_pk_bf16(v0[0], v0[1]); w.y = pg8::cvt_pk_bf16(v0[2], v0[3]); w.z = pg8::cvt_pk_bf16(v1[0], v1[1]); w.w = pg8::cvt_pk_bf16(v1[2], v1[3]);
                    EPI_ST(rowp + bj * 128, w); } }
    }
};
struct EpiGate8 {
    static constexpr bool PERM = true, AFTER_DRAIN = false, SEGMENTED = false;
    const float* bias; unsigned char* G8; const float* rs; const unsigned* cm; EPI_DRY_MEMBER
    __device__ __forceinline__ void operator()(const pg8::f32x4 (&acc)[2][2][4][2], const pg8::Unit& u, int wr, int wc, int fr_in, int fq_in) const {
        EPI_DRY_DECL
        int fr = fr_in, fq = fq_in; asm volatile("" : "+v"(fr), "+v"(fq));
        const int pn = u.pn, bcol0 = pn * 256 + wc * 32 + 8 * fq;
        pg8::f32x4 bv[2][2];
#pragma unroll
        for (int bj = 0; bj < 2; ++bj)
#pragma unroll
            for (int n = 0; n < 2; ++n) bv[bj][n] = *(const pg8::f32x4*)(bias + bcol0 + bj * 128 + 4 * n);
        pg8::f32x4 cv[2][2];
#pragma unroll
        for (int bj = 0; bj < 2; ++bj)
#pragma unroll
            for (int n = 0; n < 2; ++n) { const pg8::u32x4 cmv = *(const pg8::u32x4*)(cm + bcol0 + bj * 128 + 4 * n); const unsigned c0 = cmv.x, c1 = cmv.y, c2 = cmv.z, c3 = cmv.w;
                pg8::f32x4 t; t[0] = __builtin_bit_cast(float, c0); t[1] = __builtin_bit_cast(float, c1); t[2] = __builtin_bit_cast(float, c2); t[3] = __builtin_bit_cast(float, c3); cv[bj][n] = t * (1.0f / 127.0f); }
        unsigned char* tp = G8 + ((size_t)((pn >> 3) * (M / 256) + u.pm) * 8 + (pn & 7)) * 65536 + (size_t)((((wr * 4 + wc) * 64) + fq * 16 + fr) * 16);
#pragma unroll
        for (int ai = 0; ai < 2; ++ai)
#pragma unroll
            for (int m = 0; m < 4; ++m) { pg8::u32x4 w; const float rsv = rs[u.pm * 256 + ai * 128 + wr * 64 + m * 16 + fr];
                pg8::f32x4 z[2][2];
#pragma unroll
                for (int bj = 0; bj < 2; ++bj)
#pragma unroll
                    for (int n = 0; n < 2; ++n) { pg8::f32x4 t;
#pragma unroll
                        for (int j = 0; j < 4; ++j) { const float af = acc[ai][bj][m][n][j]; t[j] = (float)__builtin_bit_cast(int, af); }
                        z[bj][n] = (t * rsv) * cv[bj][n] + bv[bj][n]; }
                w.x = gate_q4(z[0][0]); w.y = gate_q4(z[0][1]); w.z = gate_q4(z[1][0]); w.w = gate_q4(z[1][1]);
                EPI_ST(tp + (ai * 4 + m) * 8192, w); }
    }
};
struct EpiUpConv {
    static constexpr bool PERM = true, AFTER_DRAIN = false, SEGMENTED = false;
    pg8::bf16_t* A2; const float* wconv; const float* bconv; float* topz; float* botz; PG8_LAS float* xb; const float* rs; const unsigned* cm; EPI_DRY_MEMBER
    __device__ __forceinline__ void operator()(pg8::f32x4 (&acc)[2][2][4][2], const pg8::Unit& u, int wr, int wc, int fr_in, int fq_in) const {
        EPI_DRY_DECL
        int fr = fr_in, fq = fq_in; asm volatile("" : "+v"(fr), "+v"(fq));
        const int lane = fq * 16 + fr, wv = wr * 4 + wc, pm = u.pm, pn = u.pn;
#pragma unroll
        for (int ai = 0; ai < 2; ++ai)
#pragma unroll
            for (int m = 0; m < 4; ++m) { const float rsv = rs[pm * 256 + ai * 128 + wr * 64 + m * 16 + fr];
#pragma unroll
                for (int bj = 0; bj < 2; ++bj)
#pragma unroll
                    for (int n = 0; n < 2; ++n) { pg8::f32x4 t;
#pragma unroll
                        for (int j = 0; j < 4; ++j) { const float af = acc[ai][bj][m][n][j]; t[j] = (float)__builtin_bit_cast(int, af); }
                        acc[ai][bj][m][n] = t * rsv; } }
        if (fr >= 14) {
#pragma unroll
            for (int ai = 0; ai < 2; ++ai)
#pragma unroll
                for (int bj = 0; bj < 2; ++bj) { PG8_LAS pg8::f32x4* p = (PG8_LAS pg8::f32x4*)(xb + ((((wv * 2 + ai) * 2 + (fr - 14)) * 4 + fq) * 2 + bj) * 8); p[0] = acc[ai][bj][3][0]; p[1] = acc[ai][bj][3][1]; }
        }
        const int ecol = pn * 256 + wc * 32 + 8 * fq;
        if (wr == 0 && fr < 2) { float* t = topz + ((size_t)pm * 2 + fr) * NUP + ecol;
#pragma unroll
            for (int bj = 0; bj < 2; ++bj)
#pragma unroll
                for (int n = 0; n < 2; ++n) *(pg8::f32x4*)(t + bj * 128 + 4 * n) = acc[0][bj][0][n]; }
        if (wr == 1 && fr >= 14) { float* t = botz + ((size_t)pm * 2 + (fr - 14)) * NUP + ecol;
#pragma unroll
            for (int bj = 0; bj < 2; ++bj)
#pragma unroll
                for (int n = 0; n < 2; ++n) *(pg8::f32x4*)(t + bj * 128 + 4 * n) = acc[1][bj][3][n]; }
        asm volatile("s_waitcnt lgkmcnt(0)" ::: "memory"); __builtin_amdgcn_s_barrier(); asm volatile("" ::: "memory");
        pg8::f32x4 bnd[2][2][2];
#pragma unroll
        for (int ai = 0; ai < 2; ++ai) { const int sw = (wr == 1) ? wc : 4 + wc, sai = (wr == 1) ? ai : 0; const bool have = (wr == 1) || (ai == 1);
#pragma unroll
            for (int bj = 0; bj < 2; ++bj) { pg8::f32x4 a = {0.f, 0.f, 0.f, 0.f}, b = a;
                if (have && fr >= 14) { const PG8_LAS pg8::f32x4* p = (const PG8_LAS pg8::f32x4*)(xb + ((((sw * 2 + sai) * 2 + (fr - 14)) * 4 + fq) * 2 + bj) * 8); a = p[0]; b = p[1]; }
                bnd[ai][bj][0] = a; bnd[ai][bj][1] = b; } }
        const int s1 = (fr >= 1 ? lane - 1 : lane + 15) << 2, s2 = (fr >= 2 ? lane - 2 : lane + 14) << 2;
#pragma unroll
        for (int bj = 0; bj < 2; ++bj)
#pragma unroll
            for (int n = 0; n < 2; ++n) { const int col = (bj ? DFF : 0) + pn * 128 + wc * 32 + 8 * fq + 4 * n;
                const pg8::u32x4 cmv = *(const pg8::u32x4*)(cm + col); pg8::f32x4 csv;
                { const unsigned c0 = cmv.x, c1 = cmv.y, c2 = cmv.z, c3 = cmv.w; csv[0] = __builtin_bit_cast(float, c0); csv[1] = __builtin_bit_cast(float, c1); csv[2] = __builtin_bit_cast(float, c2); csv[3] = __builtin_bit_cast(float, c3); csv = csv * (1.0f / 127.0f); }
                const pg8::f32x4 w0 = *(const pg8::f32x4*)(wconv + col) * csv, w1 = *(const pg8::f32x4*)(wconv + NUP + col) * csv, w2 = *(const pg8::f32x4*)(wconv + 2 * NUP + col) * csv, bb = *(const pg8::f32x4*)(bconv + col);
#pragma unroll
                for (int ai = 0; ai < 2; ++ai)
#pragma unroll
                    for (int m = 3; m >= 0; --m) { const pg8::f32x4 cur = acc[ai][bj][m][n]; const pg8::f32x4 prv = (m > 0) ? acc[ai][bj][m - 1][n] : bnd[ai][bj][n];
                        pg8::f32x4 z1, z2;
#pragma unroll
                        for (int j = 0; j < 4; ++j) {
#if UPCONV_DPP
                            const float cf = cur[j], pf = prv[j];
                            const int ci = __builtin_bit_cast(int, cf), pi = __builtin_bit_cast(int, pf);
                            const int p1 = __builtin_amdgcn_mov_dpp(pi, 0x121, 0xf, 0xf, false), p2 = __builtin_amdgcn_mov_dpp(pi, 0x122, 0xf, 0xf, false);
                            z1[j] = __builtin_bit_cast(float, __builtin_amdgcn_update_dpp(p1, ci, 0x111, 0xf, 0xf, false));
                            z2[j] = __builtin_bit_cast(float, __builtin_amdgcn_update_dpp(p2, ci, 0x112, 0xf, 0xf, false));
#else
                            const float t1 = (fr == 15) ? prv[j] : cur[j], t2 = (fr >= 14) ? prv[j] : cur[j];
                            z1[j] = __builtin_bit_cast(float, __builtin_amdgcn_ds_bpermute(s1, __builtin_bit_cast(int, t1)));
                            z2[j] = __builtin_bit_cast(float, __builtin_amdgcn_ds_bpermute(s2, __builtin_bit_cast(int, t2)));
#endif
                        }
                        acc[ai][bj][m][n] = w2 * cur + w1 * z1 + w0 * z2 + bb; } }
        const int row0 = pm * 256 + wr * 64 + fr, col0 = pn * 128 + wc * 32 + 8 * fq;
#pragma unroll
        for (int ai = 0; ai < 2; ++ai)
#pragma unroll
            for (int m = 0; m < 4; ++m) { const pg8::f32x4 g0 = acc[ai][0][m][0], g1 = acc[ai][0][m][1], v0 = acc[ai][1][m][0], v1 = acc[ai][1][m][1];
                pg8::u32x4 w; w.x = pg8::cvt_pk_bf16(gelu_tanh(g0[0]) * v0[0], gelu_tanh(g0[1]) * v0[1]); w.y = pg8::cvt_pk_bf16(gelu_tanh(g0[2]) * v0[2], gelu_tanh(g0[3]) * v0[3]);
                w.z = pg8::cvt_pk_bf16(gelu_tanh(g1[0]) * v1[0], gelu_tanh(g1[1]) * v1[1]); w.w = pg8::cvt_pk_bf16(gelu_tanh(g1[2]) * v1[2], gelu_tanh(g1[3]) * v1[3]);
                EPI_ST(A2 + (size_t)(row0 + ai * 128 + m * 16) * DFF + col0, w); }
    }
};
struct EpiBranch {
    static constexpr bool PERM = true, AFTER_DRAIN = false, SEGMENTED = true; static constexpr int SEG_SHIFT = 3;
    const unsigned char* G8; pg8::bf16_t* Mb; EPI_DRY_MEMBER
    __device__ __forceinline__ void seg_hook(pg8::f32x4 (&acc)[2][2][4][2], const pg8::Unit& u, int seg, int wr, int wc, int fr, int fq) const {
        int t16 = (((wr * 4 + wc) * 64) + fq * 16 + fr) * 16;
        asm volatile("" : "+v"(t16));
        const unsigned char* Tp = G8 + ((size_t)((seg - 1) * (M / 256) + u.pm) * 8 + u.pn) * 65536 + t16; const unsigned char* Tn = Tp + (size_t)(M / 256) * 8 * 65536;
        pg8::u32x4 ga[8], gb[8];
#pragma unroll
        for (int c = 0; c < 8; ++c) { ga[c] = *(const pg8::u32x4*)(Tp + c * 8192); gb[c] = *(const pg8::u32x4*)(Tn + c * 8192); }
        asm volatile("" ::: "memory");
#pragma unroll
        for (int ai = 0; ai < 2; ++ai)
#pragma unroll
            for (int m = 0; m < 4; ++m) { const pg8::u32x4 a = ga[ai * 4 + m], b = gb[ai * 4 + m];
                acc[ai][0][m][0] = acc[ai][0][m][0] * gate_ratio4(a.x, b.x); acc[ai][0][m][1] = acc[ai][0][m][1] * gate_ratio4(a.y, b.y);
                acc[ai][1][m][0] = acc[ai][1][m][0] * gate_ratio4(a.z, b.z); acc[ai][1][m][1] = acc[ai][1][m][1] * gate_ratio4(a.w, b.w); }
        asm volatile("" ::: "memory");
    }
    __device__ __forceinline__ void operator()(const pg8::f32x4 (&acc)[2][2][4][2], const pg8::Unit& u, int wr, int wc, int fr, int fq) const {
        const int row0 = u.pm * 256 + wr * 64 + fr, col0 = u.pn * 256 + wc * 32 + 8 * fq;
        EPI_DRY_DECL
        const unsigned char* T2 = G8 + ((size_t)(2 * (M / 256) + u.pm) * 8 + u.pn) * 65536 + (size_t)((((wr * 4 + wc) * 64) + fq * 16 + fr) * 16);
        pg8::u32x4 gv[8];
#pragma unroll
        for (int c = 0; c < 8; ++c) gv[c] = *(const pg8::u32x4*)(T2 + c * 8192);
        asm volatile("" ::: "memory");
#pragma unroll
        for (int ai = 0; ai < 2; ++ai)
#pragma unroll
            for (int m = 0; m < 4; ++m) { const size_t ro = (size_t)(row0 + ai * 128 + m * 16) * DM + col0; const pg8::u32x4 g = gv[ai * 4 + m];
#pragma unroll
                for (int bj = 0; bj < 2; ++bj) { const pg8::f32x4 a0 = acc[ai][bj][m][0] * gate_val4(bj ? g.z : g.x), a1 = acc[ai][bj][m][1] * gate_val4(bj ? g.w : g.y);
                    pg8::u32x4 w; w.x = pg8::cvt_pk_bf16(a0[0], a0[1]); w.y = pg8::cvt_pk_bf16(a0[2], a0[3]); w.z = pg8::cvt_pk_bf16(a1[0], a1[1]); w.w = pg8::cvt_pk_bf16(a1[2], a1[3]);
                    EPI_ST(Mb + ro + bj * 128, w); } }
    }
};
#include <hip/hip_bf16.h>
#include <cmath>
namespace attn_body {
using bf16=__hip_bfloat16;
using bf16x8=__attribute__((ext_vector_type(8)))short;
using s16x4=__attribute__((ext_vector_type(4)))short;
using f32x16=__attribute__((ext_vector_type(16)))float;
using u32x4=__attribute__((ext_vector_type(4)))unsigned;
constexpr int BATCH=4,NHEAD=8,SEQ=8192,D=64,DM=NHEAD*D;
constexpr int NW=8,QBLK=32,QB=QBLK*NW,KVBLK=64,NQB=SEQ/QB;
constexpr int ATTN_PITCH=DM, ATTN_UNIT_ROWS=QB;
__device__ __forceinline__ int crow(int r,int hi){return (r&3)+8*(r>>2)+4*hi;}
#define SBAR() __builtin_amdgcn_sched_barrier(0)
__device__ __forceinline__ void cmask(f32x16&p0,f32x16&p1,int jb,int qrel,int hi){
  const float NEG=-INFINITY; int kb=64*jb+4*hi;
  #pragma unroll
  for(int r=0;r<16;++r){int kv=kb+(r&3)+8*(r>>2); if(kv>qrel)p0[r]=NEG; if(kv+32>qrel)p1[r]=NEG;}
}

constexpr int NSLOT=3, SLOTB=8192;
constexpr int LDS_K=0, LDS_V=NSLOT*SLOTB, LDS_WS=2*NSLOT*SLOTB, LDS_OST=LDS_WS+NW*64*4, LDS_TAB=LDS_OST+NW*4096  , LDS_BYTES=LDS_TAB+16384;
constexpr float C2=0.125f*1.4426950408889634f;
__device__ __forceinline__ void glds16(const void*gsrc,unsigned lds_dst){unsigned keep;
  asm volatile("s_mov_b32 %0, m0\n\ts_mov_b32 m0, %2\n\ts_nop 0\n\tglobal_load_lds_dwordx4 %1, off\n\ts_mov_b32 m0, %0":"=&s"(keep):"v"(gsrc),"s"(lds_dst):"memory");}
__device__ __forceinline__ float max3f(float a,float b,float c){float r;asm("v_max3_f32 %0, %1, %2, %3":"=v"(r):"v"(a),"v"(b),"v"(c));return r;}
__device__ __forceinline__ float max2f(float a,float b){float r;asm("v_max_f32_e32 %0, %1, %2":"=v"(r):"v"(a),"v"(b));return r;}
__device__ __forceinline__ float fadd_s(float a,float b){float r;asm("v_add_f32_e32 %0, %1, %2":"=v"(r):"v"(a),"v"(b));return r;}
__device__ __forceinline__ float fsub_s(float a,float b){float r;asm("v_sub_f32_e32 %0, %1, %2":"=v"(r):"v"(a),"v"(b));return r;}
typedef float f32x2_t __attribute__((ext_vector_type(2))); typedef __bf16 bf16x2_t __attribute__((ext_vector_type(2)));
__device__ __forceinline__ unsigned cvtpk_s(float lo,float hi){f32x2_t v={lo,hi};bf16x2_t b=__builtin_convertvector(v,bf16x2_t);return __builtin_bit_cast(unsigned,b);}
#define WAIT_BAR(N) asm volatile("s_waitcnt vmcnt(" #N ") lgkmcnt(0)\n\ts_barrier":::"memory")

__device__ __forceinline__ void qkt(f32x16&p0,f32x16&p1,const char*Kslot,const bf16x8*qr,const f32x16&negm,int r32,int hi){
  const char*kb=Kslot+hi*1024+r32*16;
  #pragma unroll
  for(int d0=0;d0<4;++d0){
    const bf16x8 b0=*reinterpret_cast<const bf16x8*>(kb+d0*2048);
    const bf16x8 b1=*reinterpret_cast<const bf16x8*>(kb+d0*2048+512);
    if(d0==0){p0=__builtin_amdgcn_mfma_f32_32x32x16_bf16(b0,qr[0],negm,0,0,0);p1=__builtin_amdgcn_mfma_f32_32x32x16_bf16(b1,qr[0],negm,0,0,0);}
    else{p0=__builtin_amdgcn_mfma_f32_32x32x16_bf16(b0,qr[d0],p0,0,0,0);p1=__builtin_amdgcn_mfma_f32_32x32x16_bf16(b1,qr[d0],p1,0,0,0);}}
}
typedef __attribute__((address_space(3))) const char* lds_cptr;
typedef short v4i16_t __attribute__((ext_vector_type(4)));
__device__ __forceinline__ void kload8(bf16x8*kf,lds_cptr kp){
  kf[0]=*(const __attribute__((address_space(3))) bf16x8*)(kp);      kf[1]=*(const __attribute__((address_space(3))) bf16x8*)(kp+512);
  kf[2]=*(const __attribute__((address_space(3))) bf16x8*)(kp+2048); kf[3]=*(const __attribute__((address_space(3))) bf16x8*)(kp+2560);
  kf[4]=*(const __attribute__((address_space(3))) bf16x8*)(kp+4096); kf[5]=*(const __attribute__((address_space(3))) bf16x8*)(kp+4608);
  kf[6]=*(const __attribute__((address_space(3))) bf16x8*)(kp+6144); kf[7]=*(const __attribute__((address_space(3))) bf16x8*)(kp+6656);
}
__device__ __forceinline__ void kload2(bf16x8*kf,lds_cptr kp,int j){ kf[2*j]=*(const __attribute__((address_space(3))) bf16x8*)(kp+j*2048); kf[2*j+1]=*(const __attribute__((address_space(3))) bf16x8*)(kp+j*2048+512); }
__device__ __forceinline__ s16x4 vtr(lds_cptr p){ return __builtin_bit_cast(s16x4,__builtin_amdgcn_ds_read_tr16_b64_v4i16((__attribute__((address_space(3))) v4i16_t*)p)); }
__device__ __forceinline__ float rowmax(const f32x16&p0,const f32x16&p1){
  float a=max3f(p0[0],p0[1],p1[0]),b=max3f(p0[2],p0[3],p1[1]);a=max3f(a,p1[2],p1[3]);
  #pragma unroll
  for(int r=4;r<16;r+=4){a=max3f(a,p0[r],p0[r+1]);b=max3f(b,p0[r+2],p0[r+3]);a=max3f(a,p1[r],p1[r+1]);b=max3f(b,p1[r+2],p1[r+3]);}
  const float m=max2f(a,b);
  auto rr=__builtin_amdgcn_permlane32_swap(__float_as_uint(m),__float_as_uint(m),false,false);
  return max2f(__uint_as_float(rr[0]),__uint_as_float(rr[1]));
}
__device__ __forceinline__ void pv(f32x16*o,int vb,bf16x8 pa0,bf16x8 pa1,bf16x8 pa2,bf16x8 pa3){
  #pragma unroll
  for(int d0=0;d0<2;++d0){s16x4 lo[4],hi[4];
    #pragma unroll
    for(int ks=0;ks<4;++ks){
      asm volatile("ds_read_b64_tr_b16 %0,%1 offset:%c2":"=&v"(lo[ks]):"v"(vb),"i"(d0*4096+ks*1024):"memory");
      asm volatile("ds_read_b64_tr_b16 %0,%1 offset:%c2":"=&v"(hi[ks]):"v"(vb),"i"(d0*4096+ks*1024+512):"memory");}
    asm volatile("s_waitcnt lgkmcnt(0)":::"memory");SBAR();
    #define PK(k) (bf16x8){lo[k][0],lo[k][1],lo[k][2],lo[k][3],hi[k][0],hi[k][1],hi[k][2],hi[k][3]}
    o[d0]=__builtin_amdgcn_mfma_f32_32x32x16_bf16(pa0,PK(0),o[d0],0,0,0);
    o[d0]=__builtin_amdgcn_mfma_f32_32x32x16_bf16(pa1,PK(1),o[d0],0,0,0);
    o[d0]=__builtin_amdgcn_mfma_f32_32x32x16_bf16(pa2,PK(2),o[d0],0,0,0);
    o[d0]=__builtin_amdgcn_mfma_f32_32x32x16_bf16(pa3,PK(3),o[d0],0,0,0);
    #undef PK
  }
}

#ifndef ATTN_STORE16
#define ATTN_STORE16(p,v) (*(u32x4*)(p)=(v))
#endif
template<int THRL> __device__ __forceinline__ void attn_unit(int b,int h,int qb,const bf16*Q,const bf16*__restrict__ K,const bf16*__restrict__ V,const float*__restrict__ KM,const float*__restrict__ KA,bf16*O,char*shm,int wave_s){
  int tid_l=wave_s*64+pg8::lane_now(); asm volatile("":"+v"(tid_l));
  const int tid=tid_l,lane=tid&63,r32=lane&31,hi=lane>>5; const int wid=__builtin_amdgcn_readfirstlane(tid>>6);
  const long rowbase=(long)b*SEQ; const int q0=qb*QB;
  const bf16*Qw=Q+(rowbase+q0+wid*QBLK)*DM+h*D;
  const bf16*Kh=K+rowbase*DM+h*D,*Vh=V+rowbase*DM+h*D;
  const unsigned lds0=(unsigned)(uintptr_t)shm;
  float*wsf=(float*)(shm+LDS_WS)+wid*64;
  const bf16*ksrc_=Kh+(long)lane*DM+wid*8;
  const bf16*vsrc_=Vh+(long)(16*(wid&3)+(lane>>2))*DM+(wid>>2)*32+(lane&3)*8;
  const unsigned kdst=lds0+LDS_K+wid*1024, vdst=lds0+LDS_V+wid*1024;
  const bf16*ksrc=ksrc_,*vsrc=vsrc_;
  #define DMA_K(t,slot) glds16(ksrc+(long)(t)*KVBLK*DM,(unsigned)__builtin_amdgcn_readfirstlane(kdst+(slot)))
  #define DMA_V(t,slot) glds16(vsrc+(long)(t)*KVBLK*DM,(unsigned)__builtin_amdgcn_readfirstlane(vdst+(slot)))
  const int vb0=(int)(lds0+LDS_V)+((lane>>4)&1)*32+(lane&3)*8+(4*hi+((lane&15)>>2))*64;
  const char*Kbase=shm+LDS_K; bf16x8 kf[8];
  const lds_cptr shm3=(lds_cptr)shm; const lds_cptr kp0=shm3+LDS_K+hi*1024+r32*16; const lds_cptr vp0=shm3+LDS_V+((lane>>4)&1)*32+(lane&3)*8+(4*hi+((lane&15)>>2))*64;
  int NT=(q0+QB)/KVBLK;
  { const float4*gm=reinterpret_cast<const float4*>(KM+((long)(b*NHEAD+h)*32)*64), *ga=reinterpret_cast<const float4*>(KA+((long)(b*NHEAD+h)*32)*64);
    float4*lm=reinterpret_cast<float4*>(shm+LDS_TAB), *la=reinterpret_cast<float4*>(shm+LDS_TAB+8192);
    lm[tid]=gm[tid]; la[tid]=ga[tid];
    asm volatile("s_waitcnt vmcnt(0) lgkmcnt(0)\n\ts_barrier":::"memory"); }
  bf16x8 qr[4];
  #pragma unroll
  for(int d0=0;d0<4;++d0)qr[d0]=*reinterpret_cast<const bf16x8*>(&Qw[(long)r32*DM+d0*16+hi*8]);
  float mhat=0.f,l_reg=0.f;f32x16 o[2];o[0]=f32x16{};o[1]=f32x16{};
  const int qrel=wid*QBLK+r32;
  const float sl2=1.4426950408889634f*__builtin_amdgcn_exp2f(-(float)(h+1));
  const float hb4=sl2*(float)(4*hi), sl32=32.f*sl2;
  unsigned selmask=0u;
  { float qf[32];
    #pragma unroll
    for(int d0=0;d0<4;++d0){
      #pragma unroll
      for(int j=0;j<8;++j)qf[d0*8+j]=__builtin_bit_cast(float,((unsigned)(unsigned short)qr[d0][j])<<16);}
    { const bf16*Kd=Kh+(long)(q0+qrel)*DM; float acc=0.f;
      #pragma unroll
      for(int d0=0;d0<4;++d0){ const bf16x8 kq=*reinterpret_cast<const bf16x8*>(&Kd[d0*16+hi*8]);
        #pragma unroll
        for(int j=0;j<8;++j)acc+=qf[d0*8+j]*__builtin_bit_cast(float,((unsigned)(unsigned short)kq[j])<<16);}
      auto rr=__builtin_amdgcn_permlane32_swap(__float_as_uint(acc),__float_as_uint(acc),false,false);
      mhat=(__uint_as_float(rr[0])+__uint_as_float(rr[1]))+sl2*(float)qrel; }
    float v0=-INFINITY,v1=-INFINITY,v2=-INFINITY; int i0=-1,i1=-1,i2=-1; unsigned nearmask=0u;
    const float*KMb=reinterpret_cast<const float*>(shm+LDS_TAB)+hi*8; const float*KAb=reinterpret_cast<const float*>(shm+LDS_TAB+8192)+hi*8;
    for(int j=0;j<qb;++j){ const float*km=KMb+j*64; const float*ka=KAb+j*64; float sp=0.f, up=0.f;
      #pragma unroll
      for(int d0=0;d0<4;++d0){ const float4 a=*reinterpret_cast<const float4*>(km+d0*16), c=*reinterpret_cast<const float4*>(km+d0*16+4);
        sp+=qf[d0*8+0]*a.x+qf[d0*8+1]*a.y+qf[d0*8+2]*a.z+qf[d0*8+3]*a.w+qf[d0*8+4]*c.x+qf[d0*8+5]*c.y+qf[d0*8+6]*c.z+qf[d0*8+7]*c.w;
        const float4 e=*reinterpret_cast<const float4*>(ka+d0*16), f=*reinterpret_cast<const float4*>(ka+d0*16+4);
        up+=__builtin_fabsf(qf[d0*8+0])*e.x+__builtin_fabsf(qf[d0*8+1])*e.y+__builtin_fabsf(qf[d0*8+2])*e.z+__builtin_fabsf(qf[d0*8+3])*e.w+__builtin_fabsf(qf[d0*8+4])*f.x+__builtin_fabsf(qf[d0*8+5])*f.y+__builtin_fabsf(qf[d0*8+6])*f.z+__builtin_fabsf(qf[d0*8+7])*f.w;}
      auto rr=__builtin_amdgcn_permlane32_swap(__float_as_uint(sp),__float_as_uint(sp),false,false);
      const float sc=__uint_as_float(rr[0])+__uint_as_float(rr[1]);
      { auto ru=__builtin_amdgcn_permlane32_swap(__float_as_uint(up),__float_as_uint(up),false,false); const float ub=(__uint_as_float(ru[0])+__uint_as_float(ru[1]))*1.01f;
        if(ub+sl2*(float)(256*j+255-q0)-mhat>-70.f)nearmask|=1u<<j; }
      if(sc>v2){ if(sc>v1){ v2=v1;i2=i1; if(sc>v0){v1=v0;i1=i0;v0=sc;i0=j;} else {v1=sc;i1=j;} } else {v2=sc;i2=j;} } }
    if(i0>=0)selmask|=1u<<i0; if(i1>=0)selmask|=1u<<i1; if(i2>=0)selmask|=1u<<i2;
    unsigned need=selmask&nearmask;
    #pragma unroll
    for(int o_=1;o_<64;o_<<=1)need|=(unsigned)__builtin_amdgcn_ds_bpermute((lane^o_)<<2,(int)need);
    volatile unsigned*xw=(volatile unsigned*)(shm+LDS_OST);
    if(lane==0)xw[wid]=need;
    asm volatile("s_waitcnt lgkmcnt(0)\n\ts_barrier":::"memory");
    unsigned na=xw[0]|xw[1]|xw[2]|xw[3]|xw[4]|xw[5]|xw[6]|xw[7];
    na=(unsigned)__builtin_amdgcn_readfirstlane((int)na)|(1u<<qb);
    const int nskip=__builtin_ctz(na);
    NT-=4*nskip; selmask>>=nskip; ksrc+=(long)nskip*256*DM; vsrc+=(long)nskip*256*DM; }
  f32x16 negm;
  #pragma unroll
  for(int r=0;r<16;++r)negm[r]=sl2*(float)((r&3)+8*(r>>2));
  asm volatile("":"+v"(negm));
  #define ABIAS(P0,P1,t) do{ const int tt_=(t); const bool on_=(tt_>=NT-4)||(((selmask>>(tt_>>2))&1u)!=0u); \
    const float L0_=on_?((sl2*(float)(64*(tt_-(NT-4)))+hb4)-mhat):-INFINITY; const float L1_=L0_+sl32; \
    _Pragma("unroll") for(int r=0;r<16;++r){P0[r]+=L0_;P1[r]+=L1_;} }while(0)
  #define CMASK(P0,P1,t) do{int jb_=(t)-(NT-4); if(jb_>=0)cmask(P0,P1,jb_,qrel,hi);}while(0)
  bool resc=false;
  #define START(P0,P1) do{ const float rm=rowmax(P0,P1); resc=false; \
    if(__any(rm>(float)THRL)){ const float dl=__builtin_fmaxf(rm,0.f); mhat+=dl; \
      _Pragma("unroll") for(int r=0;r<16;++r){P0[r]-=dl;P1[r]-=dl;} } \
    _Pragma("unroll") for(int r=0;r<16;++r)P0[r]=__builtin_amdgcn_exp2f(P0[r]); }while(0)
  #define RESC() do{ if(resc){ asm volatile("s_waitcnt lgkmcnt(0)":::"memory"); \
      _Pragma("unroll") for(int d_=0;d_<2;++d_) _Pragma("unroll") for(int r=0;r<16;++r)o[d_][r]*=wsf[crow(r,hi)]; } }while(0)
  f32x16 pA0,pA1,pB0,pB1;
  int sl_prev=0,sl_cur=0,sl_next=SLOTB;
  #define ROT() do{sl_prev=sl_cur;sl_cur=sl_next;sl_next=(sl_next==(NSLOT-1)*SLOTB)?0:sl_next+SLOTB;}while(0)
  DMA_K(0,0);DMA_V(0,0);DMA_K(1,SLOTB);
  DMA_K(2,2*SLOTB);
  WAIT_BAR(3);
  qkt(pA0,pA1,Kbase,qr,negm,r32,hi);asm volatile("s_nop 15\n\ts_nop 7":"+v"(pA0),"+v"(pA1));ABIAS(pA0,pA1,0);CMASK(pA0,pA1,0);
  START(pA0,pA1);
  _Pragma("unroll") for(int r=0;r<16;++r)pA1[r]=__builtin_amdgcn_exp2f(pA1[r]);
  WAIT_BAR(0);
  DMA_K(3,0);DMA_V(1,SLOTB);
  ROT();
  kload8(kf,kp0+sl_cur);
  WAIT_BAR(2);
  s16x4 vlo[8],vhi[8]; u32x4 pw0,pw1,pw2,pw3;
  #define PKW(P,B) cvtpk_s(P[B],P[B+1])
  #define PAF(k) __builtin_bit_cast(bf16x8,pw##k)
  #define VFR(i) (bf16x8){vlo[i][0],vlo[i][1],vlo[i][2],vlo[i][3],vhi[i][0],vhi[i][1],vhi[i][2],vhi[i][3]}
  #define PIN(x) asm volatile("":"+v"(x))
  #define MX3(a,b,c) __builtin_fmaxf(__builtin_fmaxf((a),(b)),(c))
  #define GAPA(MF,A0,A1,A2,A3,W0,W1,PW) do{ MF; sacc+=A0; sacc+=A1; sacc+=A2; sacc+=A3; PIN(sacc); W0; W1; PIN(PW); SBAR(); }while(0)
  #define EX(v) __builtin_amdgcn_exp2f(v)
  #define GAPB(MF,X,B) do{ MF; X[B]=EX(X[B]); X[B+1]=EX(X[B+1]); X[B+2]=EX(X[B+2]); X[B+3]=EX(X[B+3]); PIN(X); SBAR(); }while(0)
  #define VRD(i) do{ vlo[i]=vtr(vp_+(((i)>>2)*4096+((i)&3)*1024)); vhi[i]=vtr(vp_+(((i)>>2)*4096+((i)&3)*1024+512)); }while(0)
  #define KRD(G,j) do{ if(G){ kload2(kf,kp0+sl_next,j); SBAR(); } }while(0)
  #define STEP(C0,C1,P0,P1,t,GK,GV,GL) do{ SBAR(); \
    const lds_cptr vp_=vp0+sl_prev; \
    VRD(0); SBAR(); float sacc=(P0[0]+P0[1]); \
    GAPA(C0=__builtin_amdgcn_mfma_f32_32x32x16_bf16(kf[0],qr[0],negm,0,0,0), P0[2],P0[3],P0[4],P0[5],     pw0[0]=PKW(P0,0), pw0[1]=PKW(P0,2), pw0); \
    VRD(4); SBAR(); GAPA(C1=__builtin_amdgcn_mfma_f32_32x32x16_bf16(kf[1],qr[0],negm,0,0,0), P0[6],P0[7],P0[8],P0[9],     pw0[2]=PKW(P0,4), pw0[3]=PKW(P0,6), pw0); \
    VRD(1); SBAR(); GAPA(C0=__builtin_amdgcn_mfma_f32_32x32x16_bf16(kf[2],qr[1],C0,0,0,0),   P0[10],P0[11],P0[12],P0[13], pw1[0]=PKW(P0,8), pw1[1]=PKW(P0,10), pw1); \
    VRD(5); SBAR(); GAPA(C1=__builtin_amdgcn_mfma_f32_32x32x16_bf16(kf[3],qr[1],C1,0,0,0),   P0[14],P0[15],P1[0],P1[1],   pw1[2]=PKW(P0,12),pw1[3]=PKW(P0,14), pw1); \
    VRD(2); SBAR(); GAPA(C0=__builtin_amdgcn_mfma_f32_32x32x16_bf16(kf[4],qr[2],C0,0,0,0),   P1[2],P1[3],P1[4],P1[5],     pw2[0]=PKW(P1,0), pw2[1]=PKW(P1,2), pw2); \
    VRD(6); SBAR(); GAPA(C1=__builtin_amdgcn_mfma_f32_32x32x16_bf16(kf[5],qr[2],C1,0,0,0),   P1[6],P1[7],P1[8],P1[9],     pw2[2]=PKW(P1,4), pw2[3]=PKW(P1,6), pw2); \
    VRD(3); SBAR(); GAPA(C0=__builtin_amdgcn_mfma_f32_32x32x16_bf16(kf[6],qr[3],C0,0,0,0),   P1[10],P1[11],P1[12],P1[13], pw3[0]=PKW(P1,8), pw3[1]=PKW(P1,10), pw3); \
    VRD(7); SBAR(); GAPA(C1=__builtin_amdgcn_mfma_f32_32x32x16_bf16(kf[7],qr[3],C1,0,0,0),   P1[14],P1[15],0.f,0.f,       pw3[2]=PKW(P1,12),pw3[3]=PKW(P1,14), pw3); \
    l_reg+=sacc; \
    if(GK){DMA_K((t)+3,sl_cur);} if(GV){DMA_V((t)+1,sl_next);} \
    ABIAS(C0,C1,t); CMASK(C0,C1,t); \
    { float a=MX3(C0[0],C0[1],C1[0]),b=MX3(C0[2],C0[3],C1[1]); a=MX3(a,C1[2],C1[3]); \
      _Pragma("unroll") for(int r=4;r<16;r+=4){a=MX3(a,C0[r],C0[r+1]);b=MX3(b,C0[r+2],C0[r+3]);a=MX3(a,C1[r],C1[r+1]);b=MX3(b,C1[r+2],C1[r+3]);} \
      float rm=__builtin_fmaxf(a,b); { auto rr=__builtin_amdgcn_permlane32_swap(__float_as_uint(rm),__float_as_uint(rm),false,false); rm=__builtin_fmaxf(__uint_as_float(rr[0]),__uint_as_float(rr[1])); } \
      resc=false; \
      if(__builtin_expect(__any(rm>(float)THRL),0)){ const float dl=__builtin_fmaxf(rm,0.f); mhat+=dl; \
        _Pragma("unroll") for(int r=0;r<16;++r){C0[r]-=dl;C1[r]-=dl;} \
        const float f=__builtin_amdgcn_exp2f(-dl); l_reg*=f; if(hi==0)wsf[r32]=f; resc=true; } } \
    SBAR(); \
    GAPB(o[0]=__builtin_amdgcn_mfma_f32_32x32x16_bf16(PAF(0),VFR(0),o[0],0,0,0), C0,0); \
    GAPB(o[1]=__builtin_amdgcn_mfma_f32_32x32x16_bf16(PAF(0),VFR(4),o[1],0,0,0), C0,4); \
    KRD(GL,0); GAPB(o[0]=__builtin_amdgcn_mfma_f32_32x32x16_bf16(PAF(1),VFR(1),o[0],0,0,0), C0,8); \
    KRD(GL,1); GAPB(o[1]=__builtin_amdgcn_mfma_f32_32x32x16_bf16(PAF(1),VFR(5),o[1],0,0,0), C0,12); \
    KRD(GL,2); GAPB(o[0]=__builtin_amdgcn_mfma_f32_32x32x16_bf16(PAF(2),VFR(2),o[0],0,0,0), C1,0); \
    KRD(GL,3); GAPB(o[1]=__builtin_amdgcn_mfma_f32_32x32x16_bf16(PAF(2),VFR(6),o[1],0,0,0), C1,4); \
    GAPB(o[0]=__builtin_amdgcn_mfma_f32_32x32x16_bf16(PAF(3),VFR(3),o[0],0,0,0), C1,8); \
    GAPB(o[1]=__builtin_amdgcn_mfma_f32_32x32x16_bf16(PAF(3),VFR(7),o[1],0,0,0), C1,12); \
    }while(0)
  int t=1;
  #undef CMASK
  #define CMASK(P0,P1,t) do{}while(0)
  for(;t+5<NT;t+=2){
    STEP(pB0,pB1,pA0,pA1,t,true,true,true);     WAIT_BAR(2); RESC(); ROT();
    STEP(pA0,pA1,pB0,pB1,t+1,true,true,true);   WAIT_BAR(2); RESC(); ROT();
  }
  #undef CMASK
  #define CMASK(P0,P1,t) do{int jb_=(t)-(NT-4); if(jb_>=0)cmask(P0,P1,jb_,qrel,hi);}while(0)
  #define ENDW(tt) do{ if((tt)+3<NT){WAIT_BAR(2);} else if((tt)+2<NT){WAIT_BAR(1);} else {WAIT_BAR(0);} }while(0)
  for(;t+1<NT;t+=2){
    STEP(pB0,pB1,pA0,pA1,t,(t+3<NT),(t+1<NT),(t+1<NT));       ENDW(t);   RESC(); ROT();
    STEP(pA0,pA1,pB0,pB1,t+1,(t+4<NT),(t+2<NT),(t+2<NT));     ENDW(t+1); RESC(); ROT();
  }
  STEP(pB0,pB1,pA0,pA1,NT-1,false,false,false); RESC();
  { float sacc=pB0[0]+pB0[1]; _Pragma("unroll") for(int r=2;r<16;++r)sacc+=pB0[r]; _Pragma("unroll") for(int r=0;r<16;++r)sacc+=pB1[r]; l_reg+=sacc;
    pw0=(u32x4){PKW(pB0,0),PKW(pB0,2),PKW(pB0,4),PKW(pB0,6)};pw1=(u32x4){PKW(pB0,8),PKW(pB0,10),PKW(pB0,12),PKW(pB0,14)};pw2=(u32x4){PKW(pB1,0),PKW(pB1,2),PKW(pB1,4),PKW(pB1,6)};pw3=(u32x4){PKW(pB1,8),PKW(pB1,10),PKW(pB1,12),PKW(pB1,14)};
    SBAR(); pv(o,vb0+sl_cur,PAF(0),PAF(1),PAF(2),PAF(3)); }
  #undef PKW
  #undef PAF
  #undef VFR
  #undef PIN
  #undef MX3
  #undef GAPA
  #undef GAPB
  #undef EX
  #undef VRD
  #undef KRD
  #undef STEP
  #undef ENDW
  {auto rr=__builtin_amdgcn_permlane32_swap(__float_as_uint(l_reg),__float_as_uint(l_reg),false,false);l_reg=__uint_as_float(rr[0])+__uint_as_float(rr[1]);}
  if(hi==0)wsf[32+r32]=l_reg;asm volatile("s_waitcnt lgkmcnt(0)":::"memory");
  float rli[16];
  #pragma unroll
  for(int r=0;r<16;++r)rli[r]=__builtin_amdgcn_rcpf(wsf[32+crow(r,hi)]);
  bf16*Ow=O+(rowbase+q0+wid*QBLK)*DM+h*D;
  { bf16*stg=(bf16*)(shm+LDS_OST)+wid*2048;
    #pragma unroll
    for(int r=0;r<16;++r){const int orow=crow(r,hi);
      #pragma unroll
      for(int d0=0;d0<2;++d0)stg[orow*64+d0*32+r32]=__float2bfloat16(o[d0][r]*rli[r]);}
    asm volatile("s_waitcnt lgkmcnt(0)":::"memory");
    #pragma unroll
    for(int i=0;i<4;++i){const int row=i*8+(lane>>3),ch=lane&7; const u32x4 v=*(const u32x4*)(stg+row*64+ch*8); ATTN_STORE16(Ow+(long)row*DM+ch*8,v);} }
  asm volatile("s_waitcnt lgkmcnt(0)\n\ts_barrier":::"memory");
  #undef DMA_K
  #undef DMA_V
  #undef CMASK
  #undef ABIAS
  #undef START
  #undef RESC
  #undef ROT
}
constexpr int ATTN_LDS_BYTES=LDS_BYTES;
struct AttnTensors { const bf16* Q; const bf16* K; const bf16* V; const float* KM; const float* KA; bf16* O; };
struct AttnUnit { int bh; int qb; };
struct StaticOrder {
  int vcu;
  __device__ __forceinline__ explicit StaticOrder(int grid,int block):vcu((block%8)*(grid/8)+block/8){}
  __device__ __forceinline__ bool next(int i,AttnUnit&u)const{ if(i>=4)return false; const int s=vcu&7; u.bh=vcu>>3; u.qb=(i==0)?s:(i==1)?15-s:(i==2)?16+s:31-s; return true; }
  __device__ __forceinline__ void a_ready(const AttnUnit&)const{}
  __device__ __forceinline__ void done(const AttnUnit&)const{}
};
struct QueueOrder {
  unsigned* ctr; volatile unsigned* slot; int wv;
  __device__ __forceinline__ bool next(int,AttnUnit&u)const{
    if(wv==0&&pg8::lane_now()==0)*slot=__hip_atomic_fetch_add(ctr,1u,__ATOMIC_RELAXED,__HIP_MEMORY_SCOPE_AGENT);
    asm volatile("s_waitcnt vmcnt(0) lgkmcnt(0)\n\ts_barrier":::"memory");
    const unsigned idx=(unsigned)__builtin_amdgcn_readfirstlane((int)*slot);
    if(idx>=(unsigned)(BATCH*NHEAD*NQB))return false;
    u.qb=NQB-1-(int)(idx>>5); u.bh=(int)(idx&31u); return true; }
  __device__ __forceinline__ void a_ready(const AttnUnit&)const{}
  __device__ __forceinline__ void done(const AttnUnit&)const{}
};
template<class Sched,int THRL=8> __device__ __forceinline__ void attn_phase(char*lds,const AttnTensors&T,const Sched&S,int wave_s){
  AttnUnit u;
  for(int i=0;S.next(i,u);++i){ S.a_ready(u); attn_unit<THRL>(u.bh/NHEAD,u.bh%NHEAD,u.qb,T.Q,T.K,T.V,T.KM,T.KA,T.O,lds,wave_s); S.done(u); }
}
#undef SBAR
#undef WAIT_BAR
}
constexpr size_t MiB = (size_t)1 << 20;
constexpr size_t WS_CTL = 0, CTL_ZERO_BYTES = 2 * MiB;
constexpr size_t WS_W0 = 2 * MiB;
constexpr size_t WO_IN = 0, WO_SGU = 36 * MiB, WO_MOBA = 38 * MiB, WO_POOL = 40 * MiB, WO_OUT = 42 * MiB, WO_UP = 50 * MiB, WO_DOWN = 94 * MiB;
constexpr size_t WS_SMALL = 118 * MiB;
constexpr size_t WS_MOD = WS_SMALL + 768 * 1024;
constexpr size_t WS_KMEAN = 512 * 1024;
constexpr size_t WS_KABS = 1 * MiB;
constexpr size_t WS_SGUW = WS_SMALL;
constexpr size_t WS_POOLWT = WS_SMALL + 512 * 1024;
constexpr size_t WS_MODP = 120 * MiB;
constexpr size_t WS_TOPZ = 126 * MiB, WS_BOTZ = 137 * MiB;
constexpr size_t WS_H = 148 * MiB;
constexpr size_t WS_T6 = 276 * MiB;
constexpr size_t WS_G3 = 500 * MiB;
constexpr size_t WS_Y = 276 * MiB;
constexpr size_t WS_A2 = 500 * MiB;
constexpr size_t WS_XR = 884 * MiB;
constexpr size_t WS_H8 = WS_G3 + 192 * MiB;
constexpr size_t WO_IN8 = 6 * MiB;
constexpr size_t WS_CMAX = 64 * 1024;
constexpr size_t WS_CMAXG = WS_CMAX + 96 * 1024;
constexpr size_t WS_RS1 = WS_SMALL + 1280 * 1024 + 128 * 1024;
constexpr size_t WS_RS = WS_SMALL + 1280 * 1024;
constexpr size_t WS_END = 1012 * MiB;
constexpr int CW_TMO = 0, CW_CODE = 1, CW_BAR = 4096, CW_ATTNQ = 8192;
constexpr int RING_BYTES = 131072, XB_OFF = RING_BYTES  , LDSCTL_OFF = 139264, MISC_OFF = LDSCTL_OFF + 320, LDS_BYTES = 147456;

__device__ __forceinline__ float lane_xor(float v, int lane, int o) { return __builtin_bit_cast(float, __builtin_amdgcn_ds_bpermute((lane ^ o) << 2, __builtin_bit_cast(int, v))); }
__device__ __forceinline__ float wave_sum(float v, int lane) {
#pragma unroll
    for (int o = 1; o < 64; o <<= 1) v += lane_xor(v, lane, o);
    return v;
}
__device__ __forceinline__ float wave_max(float v, int lane) {
#pragma unroll
    for (int o = 1; o < 64; o <<= 1) v = fmaxf(v, lane_xor(v, lane, o));
    return v;
}
typedef unsigned u32x2v __attribute__((ext_vector_type(2)));
__device__ __forceinline__ void transpose_item(const float* W, int K, int N, bf16* WT, bool upperm, LAS float* scr, int item, int lane, int f8split = 1 << 30, unsigned char* W8 = nullptr, const unsigned* cmax8 = nullptr, const unsigned* cmaxg = nullptr) {
    const int nblk = N / 32, kb = item / nblk, nb = item % nblk, k0 = 64 * kb, n0 = 32 * nb;
    int drow0 = n0;
    if (upperm) drow0 = (n0 < DFF) ? (n0 >> 7) * 256 + (n0 & 127) : ((n0 - DFF) >> 7) * 256 + 128 + ((n0 - DFF) & 127);
    float v[32];
    const float* src = W + (size_t)(k0 + (lane >> 5)) * N + n0 + (lane & 31);
#pragma unroll
    for (int i = 0; i < 32; ++i) v[i] = src[(size_t)(2 * i) * N];
#pragma unroll
    for (int i = 0; i < 32; ++i) scr[(2 * i + (lane >> 5)) * 33 + (lane & 31)] = v[i];
    LDS_WAIT(); asm volatile("" ::: "memory");
    const int c = lane & 7;
    if (cmax8) {
#pragma unroll
        for (int j = 0; j < 4; ++j) { const int n = (lane >> 3) + 8 * j; const LAS float* s = scr + (8 * c) * 33 + n;
            const unsigned cb = cmax8[n0 + n]; const float cmx = __builtin_bit_cast(float, cb); const float inv = cmx > 0.f ? 127.0f / cmx : 0.f;
            u32x2v o; o.x = q8x4(s[0 * 33], s[1 * 33], s[2 * 33], s[3 * 33], inv); o.y = q8x4(s[4 * 33], s[5 * 33], s[6 * 33], s[7 * 33], inv);
            *(GAS u32x2v*)((unsigned char*)WT + (size_t)(drow0 + n) * K + k0 + 8 * c) = o; }
    } else if (n0 >= f8split) {
#pragma unroll
        for (int j = 0; j < 4; ++j) { const int n = (lane >> 3) + 8 * j; const LAS float* s = scr + (8 * c) * 33 + n;
            const unsigned cb = cmaxg[n0 - f8split + n]; const float cmx = __builtin_bit_cast(float, cb); const float inv = cmx > 0.f ? 127.0f / cmx : 0.f;
            u32x2v o; o.x = q8x4(s[0 * 33], s[1 * 33], s[2 * 33], s[3 * 33], inv); o.y = q8x4(s[4 * 33], s[5 * 33], s[6 * 33], s[7 * 33], inv);
            *(GAS u32x2v*)(W8 + (size_t)(n0 - f8split + n) * K + k0 + 8 * c) = o; }
    } else {
#pragma unroll
    for (int j = 0; j < 4; ++j) { const int n = (lane >> 3) + 8 * j; const LAS float* s = scr + (8 * c) * 33 + n;
        v4u o; o.x = pg8::cvt_pk_bf16(s[0 * 33], s[1 * 33]); o.y = pg8::cvt_pk_bf16(s[2 * 33], s[3 * 33]); o.z = pg8::cvt_pk_bf16(s[4 * 33], s[5 * 33]); o.w = pg8::cvt_pk_bf16(s[6 * 33], s[7 * 33]);
        *(GAS v4u*)(WT + (size_t)(drow0 + n) * K + k0 + 8 * c) = o; }
    }
    LDS_WAIT(); asm volatile("" ::: "memory");
}

__device__ __forceinline__ void strip_quant(const float* W, int N, unsigned char* WT8, bool upperm, unsigned* cmax_out, LAS unsigned char* lds, int strip, int lane, int wave) {
    const int n0 = 32 * strip;
    int drow0 = n0;
    if (upperm) drow0 = (n0 < DFF) ? (n0 >> 7) * 256 + (n0 & 127) : ((n0 - DFF) >> 7) * 256 + 128 + ((n0 - DFF) & 127);
    LAS float* scr = (LAS float*)(lds + wave * 8448);
    LAS float* cmx = (LAS float*)(lds + 8 * 8448);
    float v[4][32];
#pragma unroll
    for (int b = 0; b < 4; ++b) { const float* src = W + (size_t)((4 * wave + b) * 64 + (lane >> 5)) * N + n0 + (lane & 31);
#pragma unroll
        for (int i = 0; i < 32; ++i) v[b][i] = src[(size_t)(2 * i) * N]; }
    float m = 0.f;
#pragma unroll
    for (int b = 0; b < 4; ++b)
#pragma unroll
        for (int i = 0; i < 32; ++i) m = fmaxf(m, __builtin_fabsf(v[b][i]));
    m = fmaxf(m, lane_xor(m, lane, 32));
    if (lane < 32) cmx[wave * 32 + lane] = m;
    __syncthreads();
    const int c = lane & 7;
    float inv[4];
#pragma unroll
    for (int j = 0; j < 4; ++j) { const int n = (lane >> 3) + 8 * j; float mm = 0.f;
#pragma unroll
        for (int w = 0; w < 8; ++w) mm = fmaxf(mm, cmx[w * 32 + n]);
        inv[j] = mm > 0.f ? 127.0f / mm : 0.f;
        if (wave == 0 && c == 0) cmax_out[n0 + n] = __builtin_bit_cast(unsigned, mm); }
#pragma unroll
    for (int b = 0; b < 4; ++b) { const int k0 = (4 * wave + b) * 64;
#pragma unroll
        for (int i = 0; i < 32; ++i) scr[(2 * i + (lane >> 5)) * 33 + (lane & 31)] = v[b][i];
        LDS_WAIT(); asm volatile("" ::: "memory");
#pragma unroll
        for (int j = 0; j < 4; ++j) { const int n = (lane >> 3) + 8 * j; const LAS float* sp = scr + (8 * c) * 33 + n;
            u32x2v o; o.x = q8x4(sp[0 * 33], sp[1 * 33], sp[2 * 33], sp[3 * 33], inv[j]); o.y = q8x4(sp[4 * 33], sp[5 * 33], sp[6 * 33], sp[7 * 33], inv[j]);
            *(GAS u32x2v*)(WT8 + (size_t)(drow0 + n) * DM + k0 + 8 * c) = o; }
        LDS_WAIT(); asm volatile("" ::: "memory"); }
    __syncthreads();
}

template <int MODE, bool XIN_BF16, bool XOUT_BF16, bool H8OUT = false, bool HQOUT = false>
__device__ __forceinline__ void thin_phase(LAS unsigned char* lds, int tid, int lane, int wave, int bx, int G,
        const void* xin_, const bf16* yin, void* xout_, bf16* hout, unsigned char* hout8, float* rsout,
        const float* modA, const float* gA, const float* modS, const float* modT, const float* gS) {
    LAS float* vA = (LAS float*)lds; LAS float* vS = vA + 2048; LAS float* vT = vS + 2048;
    for (int rb = bx; rb < M / 128; rb += G) {
        const int b = rb >> 6;
        __syncthreads();
        for (int c = tid; c < DM; c += 512) {
            if (MODE != 0) vA[c] = modA[(size_t)b * 12288 + c] * gA[c];
            if (MODE != 2) { vS[c] = gS[c] * (1.0f + modS[(size_t)b * 12288 + c]); vT[c] = modT[(size_t)b * 12288 + c]; }
        }
        __syncthreads();
        for (int i = 0; i < 8; ++i) {
            size_t ro[2]; f32x4 x[2][8]; uint2 yr[2][8];
#pragma unroll
            for (int r = 0; r < 2; ++r) { ro[r] = (size_t)(rb * 128 + wave * 16 + i + 8 * r) * DM + 4 * lane;
#pragma unroll
                for (int j = 0; j < 8; ++j) {
                    if (XIN_BF16) { const uint2 w = *(const uint2*)((const bf16*)xin_ + ro[r] + 256 * j); x[r][j] = (f32x4){bf_lo(w.x), bf_hi(w.x), bf_lo(w.y), bf_hi(w.y)}; }
                    else x[r][j] = *(const f32x4*)((const float*)xin_ + ro[r] + 256 * j);
                    if (MODE != 0) yr[r][j] = *(const uint2*)(yin + ro[r] + 256 * j); } }
            asm volatile("" ::: "memory");
            if (MODE != 0) {
                float ss[2];
#pragma unroll
                for (int r = 0; r < 2; ++r) { ss[r] = 0.f;
#pragma unroll
                    for (int j = 0; j < 8; ++j) { const float y0 = bf_lo(yr[r][j].x), y1 = bf_hi(yr[r][j].x), y2 = bf_lo(yr[r][j].y), y3 = bf_hi(yr[r][j].y); ss[r] += (y0 * y0 + y1 * y1) + (y2 * y2 + y3 * y3); } }
#pragma unroll
                for (int o = 1; o < 64; o <<= 1) { const float t0 = lane_xor(ss[0], lane, o), t1 = lane_xor(ss[1], lane, o); ss[0] += t0; ss[1] += t1; }
#pragma unroll
                for (int r = 0; r < 2; ++r) { const float rstd = 1.0f / __builtin_sqrtf(ss[r] * (1.0f / DM) + EPS);
#pragma unroll
                    for (int j = 0; j < 8; ++j) { const f32x4 a = *(const LAS f32x4*)(vA + 4 * lane + 256 * j);
                        const f32x4 y = (f32x4){bf_lo(yr[r][j].x), bf_hi(yr[r][j].x), bf_lo(yr[r][j].y), bf_hi(yr[r][j].y)}; x[r][j] = x[r][j] + a * (y * rstd);
                        if (XOUT_BF16) { uint2 w; w.x = pk2(x[r][j][0], x[r][j][1]); w.y = pk2(x[r][j][2], x[r][j][3]); *(uint2*)((bf16*)xout_ + ro[r] + 256 * j) = w; }
                        else *(f32x4*)((float*)xout_ + ro[r] + 256 * j) = x[r][j]; } }
            }
            if (MODE != 2) {
                float ss[2];
#pragma unroll
                for (int r = 0; r < 2; ++r) { ss[r] = 0.f;
#pragma unroll
                    for (int j = 0; j < 8; ++j) ss[r] += (x[r][j][0] * x[r][j][0] + x[r][j][1] * x[r][j][1]) + (x[r][j][2] * x[r][j][2] + x[r][j][3] * x[r][j][3]); }
#pragma unroll
                for (int o = 1; o < 64; o <<= 1) { const float t0 = lane_xor(ss[0], lane, o), t1 = lane_xor(ss[1], lane, o); ss[0] += t0; ss[1] += t1; }
                if (HQOUT || H8OUT) {
                    float mx[2];
#pragma unroll
                    for (int r = 0; r < 2; ++r) { const float rstd = 1.0f / __builtin_sqrtf(ss[r] * (1.0f / DM) + EPS); mx[r] = 0.f;
#pragma unroll
                        for (int j = 0; j < 8; ++j) { const f32x4 sv = *(const LAS f32x4*)(vS + 4 * lane + 256 * j), tv = *(const LAS f32x4*)(vT + 4 * lane + 256 * j);
                            const f32x4 h = x[r][j] * rstd * sv + tv; x[r][j] = h;
                            mx[r] = fmaxf(fmaxf(mx[r], fmaxf(__builtin_fabsf(h[0]), __builtin_fabsf(h[1]))), fmaxf(__builtin_fabsf(h[2]), __builtin_fabsf(h[3]))); } }
#pragma unroll
                    for (int o = 1; o < 64; o <<= 1) { const float t0 = lane_xor(mx[0], lane, o), t1 = lane_xor(mx[1], lane, o); mx[0] = fmaxf(mx[0], t0); mx[1] = fmaxf(mx[1], t1); }
#pragma unroll
                    for (int r = 0; r < 2; ++r) { const float inv = mx[r] > 0.f ? 127.0f / mx[r] : 0.f;
                        if (lane == 0) rsout[ro[r] / DM] = mx[r] * (1.0f / 127.0f);
                        unsigned char* qdst = HQOUT ? (unsigned char*)hout : hout8;
#pragma unroll
                        for (int j = 0; j < 8; ++j) { *(unsigned*)(qdst + ro[r] + 256 * j) = q8x4(x[r][j][0], x[r][j][1], x[r][j][2], x[r][j][3], inv);
                            if (!HQOUT) { uint2 w; w.x = pk2(x[r][j][0], x[r][j][1]); w.y = pk2(x[r][j][2], x[r][j][3]); *(uint2*)(hout + ro[r] + 256 * j) = w; } } }
                } else
#pragma unroll
                for (int r = 0; r < 2; ++r) { const float rstd = 1.0f / __builtin_sqrtf(ss[r] * (1.0f / DM) + EPS);
#pragma unroll
                    for (int j = 0; j < 8; ++j) { const f32x4 sv = *(const LAS f32x4*)(vS + 4 * lane + 256 * j), tv = *(const LAS f32x4*)(vT + 4 * lane + 256 * j);
                        const f32x4 h = x[r][j] * rstd * sv + tv; uint2 w; w.x = pk2(h[0], h[1]); w.y = pk2(h[2], h[3]); *(uint2*)(hout + ro[r] + 256 * j) = w; } }
            }
        }
    }
    __syncthreads();
}

typedef float f32x16_t __attribute__((ext_vector_type(16)));
constexpr int VNT_LD = 136;
__device__ __forceinline__ void sgu_mfma_chunk(LAS unsigned char* lds, int chunk, const bf16* Vt, const bf16* Ut, bf16* Uo, const float* norm_g, const bf16* Wm  , const float* sgu_b, int lane, int wave) {
    LAS unsigned short* vnT = (LAS unsigned short*)lds;
    const int t0 = chunk * 128;
    const int r32 = lane & 31, hi = lane >> 5, g = wave;
    const bf16* Wg = Wm + (size_t)g * 16384 + (size_t)r32 * 128 + 8 * hi;
    bf16x8 wa[4][8];
#pragma unroll
    for (int ti = 0; ti < 4; ++ti)
#pragma unroll
        for (int ks = 0; ks < 8; ++ks) if (16 * ks <= 32 * ti + 31) wa[ti][ks] = *(const bf16x8*)(Wg + (size_t)ti * 32 * 128 + 16 * ks);
    float g8[8];
#pragma unroll
    for (int e = 0; e < 8; ++e) g8[e] = norm_g[lane + 64 * e];
    for (int i8 = 0; i8 < 2; ++i8) {
        float v[8][8], s1[8], s2[8];
#pragma unroll
        for (int i = 0; i < 8; ++i) { const bf16* vr = Vt + (size_t)(t0 + wave * 16 + i8 * 8 + i) * BW + lane;
#pragma unroll
            for (int e = 0; e < 8; ++e) v[i][e] = bf2f(vr[64 * e]); }
#pragma unroll
        for (int i = 0; i < 8; ++i) { s1[i] = 0.f; s2[i] = 0.f;
#pragma unroll
            for (int e = 0; e < 8; ++e) { s1[i] += v[i][e]; s2[i] += v[i][e] * v[i][e]; } }
#pragma unroll
        for (int o = 1; o < 64; o <<= 1) { float t1[8], t2[8];
#pragma unroll
            for (int i = 0; i < 8; ++i) { t1[i] = lane_xor(s1[i], lane, o); t2[i] = lane_xor(s2[i], lane, o); }
#pragma unroll
            for (int i = 0; i < 8; ++i) { s1[i] += t1[i]; s2[i] += t2[i]; } }
#pragma unroll
        for (int i = 0; i < 8; ++i) { const int sI = wave * 16 + i8 * 8 + i; const float mu = s1[i] * (1.0f / BW);
            const float var = fmaxf(s2[i] * (1.0f / BW) - mu * mu, 0.f); const float rstd = 1.0f / __builtin_sqrtf(var + EPS);
#pragma unroll
            for (int e = 0; e < 8; ++e) vnT[(lane + 64 * e) * VNT_LD + sI] = (unsigned short)f2bf((v[i][e] - mu) * rstd * g8[e]); }
    }
    __syncthreads();
    f32x16_t acc[4][2];
#pragma unroll
    for (int ti = 0; ti < 4; ++ti)
#pragma unroll
        for (int dj = 0; dj < 2; ++dj)
#pragma unroll
            for (int r = 0; r < 16; ++r) acc[ti][dj][r] = 0.f;
    const LAS unsigned short* vb = vnT + (64 * g + r32) * VNT_LD + 8 * hi;
#pragma unroll
    for (int ks = 0; ks < 8; ++ks) {
        const bf16x8 b0 = *(const LAS bf16x8*)(vb + 16 * ks), b1 = *(const LAS bf16x8*)(vb + 32 * VNT_LD + 16 * ks);
#pragma unroll
        for (int ti = 0; ti < 4; ++ti) if (16 * ks <= 32 * ti + 31) {
            acc[ti][0] = __builtin_amdgcn_mfma_f32_32x32x16_bf16(b0, wa[ti][ks], acc[ti][0], 0, 0, 0);
            acc[ti][1] = __builtin_amdgcn_mfma_f32_32x32x16_bf16(b1, wa[ti][ks], acc[ti][1], 0, 0, 0); }
    }
#pragma unroll
    for (int ti = 0; ti < 4; ++ti) { const int t = 32 * ti + r32; const float bs = sgu_b[g * 128 + t];
#pragma unroll
        for (int dj = 0; dj < 2; ++dj)
#pragma unroll
            for (int rg = 0; rg < 4; ++rg) { const size_t o = (size_t)(t0 + t) * BW + 64 * g + 32 * dj + 8 * rg + 4 * hi;
                const uint2 uu = *(const uint2*)(Ut + o); uint2 w;
                w.x = pk2(bf_lo(uu.x) * (acc[ti][dj][4 * rg + 0] + bs), bf_hi(uu.x) * (acc[ti][dj][4 * rg + 1] + bs)); w.y = pk2(bf_lo(uu.y) * (acc[ti][dj][4 * rg + 2] + bs), bf_hi(uu.y) * (acc[ti][dj][4 * rg + 3] + bs));
                *(uint2*)(Uo + o) = w; } }
    __syncthreads();
}

constexpr int PA_LD = 520;
template <int W> __device__ __forceinline__ void pool_window(LAS unsigned short* pa, const bf16* ZP, int t0, int c) {
    float z[64 + W - 1];
    const int pos0 = t0 & (SEQ - 1);
#pragma unroll
    for (int i = 0; i < 64 + W - 1; ++i) { const int dt = i - (W - 1); z[i] = (pos0 + dt >= 0) ? bf2f(ZP[(size_t)(t0 + dt) * BW + c]) : 0.f; }
    float s = 0.f;
#pragma unroll
    for (int i = 0; i < W - 1; ++i) s += z[i];
#pragma unroll
    for (int tl = 0; tl < 64; ++tl) { s += z[tl + W - 1];
        const int pos = pos0 + tl; const float rc = (pos + 1 < W) ? __builtin_amdgcn_rcpf((float)(pos + 1)) : (1.0f / W);
        pa[tl * PA_LD + c] = (unsigned short)f2bf(s * rc - z[tl + W - 1]);
        s -= z[tl]; }
}
__device__ __forceinline__ void pool_mfma_tile(LAS unsigned char* lds, int tile, const bf16* ZP, bf16* YPo, const bf16* PWT  , const float* pool_scale, int tid, int lane, int wave) {
    LAS unsigned short* pa = (LAS unsigned short*)lds;
    const int t0 = tile * 64, c = tid, gsel = wave >> 1;
    bf16x8 pb0[8], pb1[8];
    { const bf16* Bg0 = PWT + ((size_t)(wave >> 1) * 128 + 64 * (wave & 1) + (lane & 31)) * 128 + 8 * (lane >> 5);
#pragma unroll
      for (int ks = 0; ks < 8; ++ks) { pb0[ks] = *(const bf16x8*)(Bg0 + 16 * ks); pb1[ks] = *(const bf16x8*)(Bg0 + (size_t)32 * 128 + 16 * ks); } }
    if (gsel == 0) pool_window<2>(pa, ZP, t0, c); else if (gsel == 1) pool_window<4>(pa, ZP, t0, c); else if (gsel == 2) pool_window<8>(pa, ZP, t0, c); else pool_window<16>(pa, ZP, t0, c);
    __syncthreads();
    const int r32 = lane & 31, hi = lane >> 5, g = wave >> 1, dh = wave & 1;
    f32x16_t acc[2][2];
#pragma unroll
    for (int ti = 0; ti < 2; ++ti)
#pragma unroll
        for (int dj = 0; dj < 2; ++dj)
#pragma unroll
            for (int r = 0; r < 16; ++r) acc[ti][dj][r] = 0.f;
    const LAS unsigned short* ab = pa + r32 * PA_LD + 128 * g + 8 * hi;
#pragma unroll
    for (int ks = 0; ks < 8; ++ks) {
        const bf16x8 b0 = pb0[ks], b1 = pb1[ks];
        const bf16x8 a0 = *(const LAS bf16x8*)(ab + 16 * ks), a1 = *(const LAS bf16x8*)(ab + 32 * PA_LD + 16 * ks);
        acc[0][0] = __builtin_amdgcn_mfma_f32_32x32x16_bf16(b0, a0, acc[0][0], 0, 0, 0); acc[0][1] = __builtin_amdgcn_mfma_f32_32x32x16_bf16(b1, a0, acc[0][1], 0, 0, 0);
        acc[1][0] = __builtin_amdgcn_mfma_f32_32x32x16_bf16(b0, a1, acc[1][0], 0, 0, 0); acc[1][1] = __builtin_amdgcn_mfma_f32_32x32x16_bf16(b1, a1, acc[1][1], 0, 0, 0);
    }
#pragma unroll
    for (int dj = 0; dj < 2; ++dj)
#pragma unroll
        for (int rg = 0; rg < 4; ++rg) { const int oc = 128 * g + 64 * dh + 32 * dj + 8 * rg + 4 * hi; const f32x4 sc = *(const f32x4*)(pool_scale + oc);
#pragma unroll
            for (int ti = 0; ti < 2; ++ti) { uint2 w; w.x = pk2(acc[ti][dj][4 * rg + 0] * sc[0], acc[ti][dj][4 * rg + 1] * sc[1]); w.y = pk2(acc[ti][dj][4 * rg + 2] * sc[2], acc[ti][dj][4 * rg + 3] * sc[3]);
                *(uint2*)(YPo + (size_t)(t0 + 32 * ti + r32) * BW + oc) = w; } }
    __syncthreads();
}

#ifndef NREP_GEMM
#define NREP_GEMM 1
#endif
#ifndef WGM_WIDE
#define WGM_WIDE 4
#endif
#ifndef WGM_NARROW
#define WGM_NARROW 4
#endif
#ifndef GP_ALIGN
#define GP_ALIGN true
#endif
#ifndef GP_SP2
#define GP_SP2 true
#endif
#ifndef PROBE_BAR2
#define PROBE_BAR2 0
#endif
#ifndef NREP_P0
#define NREP_P0 1
#endif
#ifndef NREP_ATTN
#define NREP_ATTN 1
#endif
#ifndef NREP_MIX
#define NREP_MIX 1
#endif
#ifndef NREP_THIN
#define NREP_THIN 1
#endif
#define PHASE_IDS() int tid_o = wave_s * 64 + pg8::lane_now(); asm volatile("" : "+v"(tid_o)); const int tid = tid_o, lane = tid & 63, wave = __builtin_amdgcn_readfirstlane(tid >> 6), gw = bx * NWAVES + wave, NGW = G * NWAVES; (void)lane; (void)gw; (void)NGW; (void)wave
struct Args { const float* in[23]; float* out; unsigned char* ws; };
__global__ void __launch_bounds__(NWAVES * 64, 2) fwd_kernel(Args args) {
    extern __shared__ __attribute__((aligned(16))) unsigned char lds_raw[];
    LAS unsigned char* lds = (LAS unsigned char*)lds_raw;
    const int G = gridDim.x, bx = blockIdx.x;
    int wave_s = __builtin_amdgcn_readfirstlane((int)(threadIdx.x >> 6)); asm volatile("" : "+s"(wave_s));
    gu32* ctl = (gu32*)(args.ws + WS_CTL);
    for (int u = threadIdx.x; u < (LDS_BYTES - LDSCTL_OFF) / 4; u += NWAVES * 64) ((LAS unsigned*)(lds + LDSCTL_OFF))[u] = 0u;
    __syncthreads();
    volatile LAS unsigned* MISC = (volatile LAS unsigned*)(lds + MISC_OFF);
    XcdBarrier bar = xcd_barrier_post((unsigned*)(ctl + CW_BAR), MISC + 8);
#define GRID_BAR() do { XcdBarrier b_ = bar; asm volatile("" : "+s"(b_.x), "+s"(b_.bar)); xcd_barrier(b_); if (PROBE_BAR2) xcd_barrier(b_); } while (0)
    const volatile __attribute__((address_space(4))) unsigned long long* kargs = (const volatile __attribute__((address_space(4))) unsigned long long*)__builtin_amdgcn_kernarg_segment_ptr();
#define INP(i) ((const float*)(const GAS float*)kargs[(i)])
#define OUTP ((float*)(GAS float*)kargs[23])
#define WSB ((unsigned char*)(GAS unsigned char*)kargs[24])
#define in_x INP(0)
#define in_c INP(1)
#define g_pre_mix INP(2)
#define g_post_mix INP(3)
#define g_pre_ffn INP(4)
#define g_post_ffn INP(5)
#define w_ada INP(6)
#define b_ada INP(7)
#define w_in INP(8)
#define b_in INP(9)
#define sgu_norm_g INP(10)
#define sgu_w INP(11)
#define sgu_b INP(12)
#define pool_w INP(13)
#define pool_scale INP(14)
#define w_sgu_out INP(15)
#define w_moba_out INP(16)
#define w_pool_out INP(17)
#define w_out INP(18)
#define w_up INP(19)
#define w_conv INP(20)
#define b_conv INP(21)
#define w_down INP(22)
#define out OUTP
#define MOD ((float*)(WSB + WS_MOD))
#define MODP ((float*)(WSB + WS_MODP))
#define KMEAN ((float*)(WSB + WS_KMEAN))
#define H ((bf16*)(WSB + WS_H))
#define T6 ((bf16*)(WSB + WS_T6))
#define G3 ((unsigned char*)(WSB + WS_G3))
#define H8 ((unsigned char*)(WSB + WS_H8))
#define Yb ((bf16*)(WSB + WS_Y))
#define XR ((bf16*)(WSB + WS_XR))
#define A2 ((bf16*)(WSB + WS_A2))
#define Ut T6
#define Qt (T6 + (size_t)1 * M * BW)
#define YP (T6 + (size_t)2 * M * BW)
#define Vt (T6 + (size_t)3 * M * BW)
#define Kt (T6 + (size_t)4 * M * BW)
#define VAt (T6 + (size_t)5 * M * BW)
#define ZPt (T6 + (size_t)6 * M * BW)

    for (int rep0_ = 0; rep0_ < NREP_P0; ++rep0_) {
    {   PHASE_IDS();
        LAS float* cond = (LAS float*)(lds + 69632);
        for (int i = tid; i < BATCH * DM; i += NWAVES * 64) { const float c = in_c[i]; cond[i] = c * sigmoid_f(c); }
        __syncthreads();
        for (int w0 = gw; w0 < 1536 + 64 * NWAVES; w0 += NGW) { const int wt = w0 - 64 * NWAVES; if (wt < 0) continue;
            const int ks = wt / 96, cb = wt % 96, l = cb / 48, n0 = (cb % 48) * 256 + 4 * lane;
            const float* wp = w_ada + ((size_t)l * DM + ks * 128) * 12288 + n0;
            f32x4 a0 = {0.f, 0.f, 0.f, 0.f}, a1 = a0, a2 = a0, a3 = a0;
#pragma unroll 8
            for (int k = 0; k < 128; ++k) { const f32x4 w = *(const f32x4*)(wp + (size_t)k * 12288); const int kk = ks * 128 + k;
                a0 += cond[kk] * w; a1 += cond[DM + kk] * w; a2 += cond[2 * DM + kk] * w; a3 += cond[3 * DM + kk] * w; }
            float* pp = MODP + (size_t)(ks * 8 + l * 4) * 12288 + n0;
            *(f32x4*)(pp) = a0; *(f32x4*)(pp + 12288) = a1; *(f32x4*)(pp + 2 * 12288) = a2; *(f32x4*)(pp + 3 * 12288) = a3;
        }
        LAS float* scr = (LAS float*)(lds + wave * 8448);
#define CONVERT_ITEMS(l, WB, LO, HI, SLOT, NSLOT) \
        for (int it = (LO) + (SLOT) * NWAVES + wave; it < (HI); it += (NSLOT) * NWAVES) { int r = it; \
            bf16* Wc = (bf16*)(WB); \
            if (r < 9216) { transpose_item(w_in + (size_t)(l) * DM * INW, DM, INW, (bf16*)((unsigned char*)Wc + WO_IN), false, scr, r, lane, 0, (unsigned char*)Wc + WO_IN, nullptr, (const unsigned*)(WSB + WS_CMAXG) + (size_t)(l) * 9216); continue; } r -= 9216; \
            if (r < 512) { transpose_item(w_sgu_out + (size_t)(l) * BW * DM, BW, DM, (bf16*)((unsigned char*)Wc + WO_SGU), false, scr, r, lane); continue; } r -= 512; \
            if (r < 512) { transpose_item(w_moba_out + (size_t)(l) * BW * DM, BW, DM, (bf16*)((unsigned char*)Wc + WO_MOBA), false, scr, r, lane); continue; } r -= 512; \
            if (r < 512) { transpose_item(w_pool_out + (size_t)(l) * BW * DM, BW, DM, (bf16*)((unsigned char*)Wc + WO_POOL), false, scr, r, lane); continue; } r -= 512; \
            if (r < 2048) { transpose_item(w_out + (size_t)(l) * DM * DM, DM, DM, (bf16*)((unsigned char*)Wc + WO_OUT), false, scr, r, lane); continue; } r -= 2048; \
            if (r < 11264) { transpose_item(w_up + (size_t)(l) * DM * NUP, DM, NUP, (bf16*)((unsigned char*)Wc + WO_UP), true, scr, r, lane, 1 << 30, nullptr, (const unsigned*)(WSB + WS_CMAX) + (size_t)(l) * NUP); continue; } r -= 11264; \
            transpose_item(w_down + (size_t)(l) * DFF * DM, DFF, DM, (bf16*)((unsigned char*)Wc + WO_DOWN), false, scr, r, lane); \
        }
#define QUANT_STRIPS(l, WB, S0, S1, SLOT, NSLOT) { __syncthreads(); \
          for (int st = (S0) + (SLOT); st < (S1); st += (NSLOT)) { \
              if (st < 288) strip_quant(w_in + (size_t)(l) * DM * INW, INW, (WB) + WO_IN, false, (unsigned*)(WSB + WS_CMAXG) + (size_t)(l) * 9216, lds, st, lane, wave); \
              else strip_quant(w_up + (size_t)(l) * DM * NUP, NUP, (WB) + WO_UP, true, (unsigned*)(WSB + WS_CMAX) + (size_t)(l) * NUP, lds, st - 288, lane, wave); } }
        QUANT_STRIPS(0, WSB + WS_W0, 0, 288, bx, G)
        { bf16* SW = (bf16*)(WSB + WS_SGUW); bf16* PW = (bf16*)(WSB + WS_POOLWT); const float* sw = sgu_w; const float* pw = pool_w;
          for (int i = bx * NWAVES * 64 + tid; i < 2 * 8 * 16384; i += G * NWAVES * 64) { const int t = (i >> 7) & 127, sI = i & 127; SW[i] = (bf16)((sI <= t) ? f2bf(sw[i]) : 0u); }
          for (int i = bx * NWAVES * 64 + tid; i < 2 * 4 * 16384; i += G * NWAVES * 64) { const int lg = i >> 14, d = (i >> 7) & 127, cI = i & 127; PW[i] = (bf16)f2bf(pw[(size_t)lg * 16384 + cI * 128 + d]); } }
        GRID_BAR();
    }
    {   PHASE_IDS();
        for (int v = bx * NWAVES * 64 + tid; v < 2 * BATCH * 12288; v += G * NWAVES * 64) {
            const int lb = v / 12288, n = v % 12288; float s = b_ada[(size_t)(lb >> 2) * 12288 + n];
            for (int ks = 0; ks < 16; ++ks) s += MODP[(size_t)(ks * 8 + lb) * 12288 + n];
            MOD[v] = s; }
        GRID_BAR();
    }
    { PHASE_IDS(); thin_phase<0, false, false, false, true>(lds, tid, lane, wave, bx, G, in_x, nullptr, nullptr, (bf16*)H8, nullptr, (float*)(WSB + WS_RS1), nullptr, nullptr, MOD + 2048, MOD + 0, g_pre_mix); }
    GRID_BAR();
    }

    for (int l = 0; l < DEPTH; ++l) {
#define Wl (l == 0 ? WSB + WS_W0 : (unsigned char*)OUTP)
#define modl (MOD + (size_t)l * BATCH * 12288)
        for (int rep_ = 0; rep_ < NREP_GEMM; ++rep_)
        { { pg8::Gemm g{(const bf16*)H8, (const bf16*)(Wl + WO_IN), M, 3072, DM / 2}; pg8::StaticOrder S; S.init(M, 3072, G, bx, WGM_WIDE);
            EpiInProj E{b_in + (size_t)l * INW, T6, KMEAN + (size_t)l * 65536, (unsigned*)(WSB + WS_KABS) + (size_t)l * 65536, (const float*)(WSB + WS_RS1), (const unsigned*)(WSB + WS_CMAXG) + (size_t)l * 9216};
            pg8::gemm_phase<EpiInProj, pg8::StaticOrder, GP_ALIGN, GP_SP2, false, true>(lds, g, S, E, wave_s); }
          GRID_BAR(); }
        { PHASE_IDS();
          for (int repa_ = NREP_ATTN - 1; repa_ >= 0; --repa_)
          { const attn_body::AttnTensors AT{(const attn_body::bf16*)Qt, (const attn_body::bf16*)Kt, (const attn_body::bf16*)VAt, KMEAN + (size_t)l * 65536, (const float*)(WSB + WS_KABS) + (size_t)l * 65536, repa_ ? (attn_body::bf16*)H : (attn_body::bf16*)Qt};
            const attn_body::QueueOrder AS{(unsigned*)(WSB + WS_CTL) + CW_ATTNQ + 64 * l + 16 * repa_, (volatile unsigned*)((char*)lds_raw + MISC_OFF + 64), wave_s};
            {
              const unsigned nent = (l == 0) ? 1536u : 1024u;
              for (;;) {
                  if (AS.wv == 0 && pg8::lane_now() == 0) *AS.slot = __hip_atomic_fetch_add(AS.ctr, 1u, __ATOMIC_RELAXED, __HIP_MEMORY_SCOPE_AGENT);
                  asm volatile("s_waitcnt vmcnt(0) lgkmcnt(0)\n\ts_barrier" ::: "memory");
                  const unsigned idx = (unsigned)__builtin_amdgcn_readfirstlane((int)*AS.slot);
                  if (idx >= nent) break;
                  unsigned a_ = idx; int bun = -1;
                  if (l == 0) { const unsigned grp = idx / 3u, rr = idx - 3u * grp; if (rr < 2u) a_ = 2u * grp + rr; else bun = (int)grp; }
                  if (bun < 0) { const int qb_ = attn_body::NQB - 1 - (int)(a_ >> 5), bh_ = (int)(a_ & 31u);
                      attn_body::attn_unit<8>(bh_ / attn_body::NHEAD, bh_ % attn_body::NHEAD, qb_, AT.Q, AT.K, AT.V, AT.KM, AT.KA, AT.O, (char*)lds_raw, wave_s); }
                  else { const int lane = pg8::lane_now(); LAS float* scr = (LAS float*)(lds + wave * 8448);
                      if (bun < 256) { const int c_ = bun; CONVERT_ITEMS(0, WSB + WS_W0, 9216, 12800, c_, 256) CONVERT_ITEMS(0, WSB + WS_W0, 24064, 29696, c_, 256) QUANT_STRIPS(0, WSB + WS_W0, 288, 640, c_, 256) }
                      else { const int c_ = bun - 256; CONVERT_ITEMS(1, (unsigned char*)OUTP, 9216, 12800, c_, 256) CONVERT_ITEMS(1, (unsigned char*)OUTP, 24064, 29696, c_, 256) QUANT_STRIPS(1, (unsigned char*)OUTP, 0, 640, c_, 256) }
                      __syncthreads(); }
              } } }
          __syncthreads();
          for (int repm_ = NREP_MIX - 1; repm_ >= 0; --repm_) {
          for (int chunk = bx; chunk < M / 128; chunk += G) sgu_mfma_chunk(lds, chunk, Vt, Ut, repm_ ? H : Ut, sgu_norm_g + (size_t)l * BW, (const bf16*)(WSB + WS_SGUW) + (size_t)l * 8 * 16384, sgu_b + (size_t)l * 8 * 128, lane, wave);
          for (int tile = bx; tile < M / 64; tile += G) pool_mfma_tile(lds, tile, ZPt, YP, (const bf16*)(WSB + WS_POOLWT) + (size_t)l * 4 * 16384, pool_scale + (size_t)l * BW, tid, lane, wave);
          }
          GRID_BAR(); }
        for (int rep_ = 0; rep_ < NREP_GEMM; ++rep_)
        {
          { pg8::Gemm g{(const bf16*)H8, (const bf16*)(Wl + WO_IN + WO_IN8), M, 6144, DM / 2}; pg8::StaticOrder S; S.init(M, 6144, G, bx, WGM_WIDE);
            EpiGate8 E{b_in + (size_t)l * INW + 3072, G3, (const float*)(WSB + WS_RS1), (const unsigned*)(WSB + WS_CMAXG) + (size_t)l * 9216 + 3072};
            pg8::gemm_phase<EpiGate8, pg8::StaticOrder, GP_ALIGN, GP_SP2, false, true>(lds, g, S, E, wave_s); }
          GRID_BAR(); }
        for (int rep_ = 0; rep_ < NREP_GEMM; ++rep_)
        { pg8::Gemm g{Ut, (const bf16*)(Wl + WO_SGU), M, DM, BW, 3, (size_t)M * BW * 2, (size_t)2 * MiB}; pg8::StaticOrder S; S.init(M, DM, G, bx, WGM_NARROW);
          EpiBranch E{G3, H};
          pg8::gemm_phase<EpiBranch, pg8::StaticOrder, GP_ALIGN, GP_SP2>(lds, g, S, E, wave_s);
          GRID_BAR(); }
        for (int rep_ = 0; rep_ < NREP_GEMM; ++rep_)
        { pg8::Gemm g{H, (const bf16*)(Wl + WO_OUT), M, DM, DM}; pg8::StaticOrder S; S.init(M, DM, G, bx, WGM_NARROW);
          EpiPlain E{Yb, DM};
          pg8::gemm_phase<EpiPlain, pg8::StaticOrder, GP_ALIGN, GP_SP2>(lds, g, S, E, wave_s);
          GRID_BAR(); }
        for (int rept_ = 0; rept_ < (l == 0 ? NREP_THIN : 1); ++rept_)
        { PHASE_IDS(); if (l == 0) thin_phase<1, false, true, false, true>(lds, tid, lane, wave, bx, G, in_x, Yb, XR, H, nullptr, (float*)(WSB + WS_RS), modl + 4096, g_post_mix + (size_t)l * DM, modl + 8192, modl + 6144, g_pre_ffn + (size_t)l * DM);
          else thin_phase<1, true, true, false, true>(lds, tid, lane, wave, bx, G, XR, Yb, XR, H, nullptr, (float*)(WSB + WS_RS), modl + 4096, g_post_mix + (size_t)l * DM, modl + 8192, modl + 6144, g_pre_ffn + (size_t)l * DM); }
        GRID_BAR();
        for (int rep_ = 0; rep_ < NREP_GEMM; ++rep_)
        { pg8::Gemm g{H, (const bf16*)(Wl + WO_UP), M, NUP, DM / 2}; pg8::StaticOrder S; S.init(M, NUP, G, bx, WGM_WIDE);
          EpiUpConv E{A2, w_conv + (size_t)l * 3 * NUP, b_conv + (size_t)l * NUP, (float*)(WSB + WS_TOPZ), (float*)(WSB + WS_BOTZ), (LAS float*)(lds + XB_OFF), (const float*)(WSB + WS_RS), (const unsigned*)(WSB + WS_CMAX) + (size_t)l * NUP};
          pg8::gemm_phase<EpiUpConv, pg8::StaticOrder, true, GP_SP2, false, true>(lds, g, S, E, wave_s);
          GRID_BAR(); }
        { PHASE_IDS(); const float* wc = w_conv + (size_t)l * 3 * NUP; const float* bc = b_conv + (size_t)l * NUP;
          const float* TZ = (const float*)(WSB + WS_TOPZ); const float* BZ = (const float*)(WSB + WS_BOTZ); bf16* a2 = A2;
          for (int it = bx * NWAVES * 64 + tid; it < (M / 256) * DFF; it += G * NWAVES * 64) { const int pm = it / DFF, n = it % DFF; if ((pm & 31) == 0) continue;
              const int cg = (n >> 7) * 256 + (n & 127);
              float res[2];
              float zc[2][2];
#pragma unroll
              for (int k = 0; k < 2; ++k) { const int c = cg + 128 * k, pc = n + DFF * k;
                  const float t0 = TZ[((size_t)pm * 2 + 0) * NUP + c], t1 = TZ[((size_t)pm * 2 + 1) * NUP + c], b0 = BZ[((size_t)(pm - 1) * 2 + 0) * NUP + c], b1 = BZ[((size_t)(pm - 1) * 2 + 1) * NUP + c];
                  const unsigned cmb = ((const unsigned*)(WSB + WS_CMAX))[(size_t)l * NUP + pc]; const float csc = __builtin_bit_cast(float, cmb) * (1.0f / 127.0f);
                  const float w0 = wc[pc] * csc, w1 = wc[NUP + pc] * csc, w2 = wc[2 * NUP + pc] * csc, bb = bc[pc];
                  zc[k][0] = w2 * t0 + w1 * b1 + w0 * b0 + bb; zc[k][1] = w2 * t1 + w1 * t0 + w0 * b1 + bb; }
              res[0] = gelu_tanh(zc[0][0]) * zc[1][0]; res[1] = gelu_tanh(zc[0][1]) * zc[1][1];
              a2[(size_t)(pm * 256 + 0) * DFF + n] = (bf16)f2bf(res[0]); a2[(size_t)(pm * 256 + 1) * DFF + n] = (bf16)f2bf(res[1]); }
          GRID_BAR(); }
        for (int rep_ = 0; rep_ < NREP_GEMM; ++rep_)
        { pg8::Gemm g{A2, (const bf16*)(Wl + WO_DOWN), M, DM, DFF}; pg8::StaticOrder S; S.init(M, DM, G, bx, WGM_NARROW);
          EpiPlain E{Yb, DM};
          pg8::gemm_phase<EpiPlain, pg8::StaticOrder, GP_ALIGN, GP_SP2>(lds, g, S, E, wave_s);
          GRID_BAR(); }
        if (l == 0) { PHASE_IDS(); thin_phase<1, true, true, false, true>(lds, tid, lane, wave, bx, G, XR, Yb, XR, (bf16*)H8, nullptr, (float*)(WSB + WS_RS1), modl + 10240, g_post_ffn, MOD + (size_t)BATCH * 12288 + 2048, MOD + (size_t)BATCH * 12288, g_pre_mix + DM);
            GRID_BAR(); }
        else { PHASE_IDS(); thin_phase<2, true, false>(lds, tid, lane, wave, bx, G, XR, Yb, out, nullptr, nullptr, nullptr, modl + 10240, g_post_ffn + (size_t)l * DM, nullptr, nullptr, nullptr); }
    }
#undef GRID_BAR
}
#undef INP
#undef OUTP
#undef WSB
#undef in_x
#undef in_c
#undef g_pre_mix
#undef g_post_mix
#undef g_pre_ffn
#undef g_post_ffn
#undef w_ada
#undef b_ada
#undef w_in
#undef b_in
#undef sgu_norm_g
#undef sgu_w
#undef sgu_b
#undef pool_w
#undef pool_scale
#undef w_sgu_out
#undef w_moba_out
#undef w_pool_out
#undef w_out
#undef w_up
#undef w_conv
#undef b_conv
#undef w_down
#undef out
#undef MOD
#undef MODP
#undef KMEAN
#undef H
#undef T6
#undef G3
#undef H8
#undef YP
#undef Yb
#undef A2
#undef Ut
#undef Vt
#undef Qt
#undef Kt
#undef VAt
#undef ZPt
#undef Wl
#undef XR
#undef CONVERT_ITEMS
#undef QUANT_STRIPS
#undef modl

extern "C" void kernel_launch(void* const* d_in, const int* in_sizes, int n_in, void* d_out, int out_size, void* d_ws, size_t ws_size, hipStream_t stream) {
    static int grid = 0;
    if (grid == 0) {
        if (n_in != 23 || in_sizes[0] != M * DM || out_size != M * DM || ws_size < WS_END) { fprintf(stderr, "kernel_launch: unexpected shapes (n_in %d, in0 %d, out %d, ws %zu); nothing launched\n", n_in, n_in > 0 ? in_sizes[0] : -1, out_size, ws_size); grid = -1; return; }
        int dev = 0, cus = 0;
        if (hipGetDevice(&dev) != hipSuccess || hipDeviceGetAttribute(&cus, hipDeviceAttributeMultiprocessorCount, dev) != hipSuccess) { grid = -1; return; }
        if (hipFuncSetAttribute((const void*)fwd_kernel, hipFuncAttributeMaxDynamicSharedMemorySize, LDS_BYTES) != hipSuccess) { fprintf(stderr, "kernel_launch: hipFuncSetAttribute failed\n"); grid = -1; return; }
        int per_cu = 0;
        if (hipOccupancyMaxActiveBlocksPerMultiprocessor(&per_cu, (const void*)fwd_kernel, NWAVES * 64, LDS_BYTES) != hipSuccess || per_cu < 1) fprintf(stderr, "kernel_launch: occupancy query says %d\n", per_cu);
        (void)hipGetLastError();
        grid = cus;
    }
    if (grid < 0) return;
    if (hipMemsetAsync((char*)d_ws + WS_CTL, 0, CTL_ZERO_BYTES, stream) != hipSuccess) return;
    Args a{};
    for (int i = 0; i < 23; ++i) a.in[i] = (const float*)d_in[i];
    a.out = (float*)d_out; a.ws = (unsigned char*)d_ws;
    hipLaunchKernelGGL(fwd_kernel, dim3(grid), dim3(NWAVES * 64), LDS_BYTES, stream, a);
}
```

```cpp
#include <hip/hip_runtime.h>
#include <cstdio>
#include <cstdint>
namespace pg8 {
#define PG8_LAS __attribute__((address_space(3)))
typedef unsigned short bf16_t;
typedef short bf16x8 __attribute__((ext_vector_type(8)));
typedef float f32x4 __attribute__((ext_vector_type(4)));
typedef unsigned u32x4 __attribute__((ext_vector_type(4)));
__device__ __forceinline__ int lane_now() { int l; asm volatile("v_mbcnt_lo_u32_b32 %0, -1, 0\n\tv_mbcnt_hi_u32_b32 %0, -1, %0" : "=v"(l)); return l; }
typedef int i32x4 __attribute__((ext_vector_type(4)));
typedef int i32x8 __attribute__((ext_vector_type(8)));
constexpr int BM = 256, BK = 64, HALF = 128, HTB = HALF * BK * 2  , STAGE_BYTES = 8 * HTB, NXCD = 8, WGM = 8;

__host__ __device__ __forceinline__ int lds_byte(int r, int c) { const int st = (r >> 4) * 2 + (c >> 5), rr = r & 15, cc = c & 31, ob = rr * 64 + cc * 2; return st * 1024 + (ob ^ (((ob >> 9) & 1) << 5)); }
__host__ __device__ __forceinline__ void stage_rc(int b, int& R, int& C) { const int st = b / 1024, sb = b % 1024, swz = sb ^ (((sb >> 9) & 1) << 5); R = (st >> 1) * 16 + swz / 64; C = (st & 1) * 32 + (swz % 64) / 2; }
__host__ __device__ __forceinline__ int perm32(int rho) { const int n = rho >> 4, i = rho & 15; return 8 * (i >> 2) + 4 * n + (i & 3); }

struct Unit { int pm, pn; };
struct Gemm { const bf16_t* A; const bf16_t* Bt; int M, N, K; int nseg; size_t segA, segB; };

struct StaticOrder {
    int nM, nN, nwg, G, c, wgm;
    __host__ __device__ void init(int M, int N, int G_, int c_, int wgm_ = WGM) { nM = M / BM; nN = N / BM; nwg = nM * nN; G = G_; c = c_; wgm = wgm_; }
    __host__ __device__ bool next(int i, Unit& u) const {
        const long L = (long)i * G + c; if (L >= nwg) return false;
        int wgid = (int)L; { const int q = nwg / NXCD, r = nwg % NXCD, xcd = wgid % NXCD, off = wgid / NXCD; wgid = (xcd < r ? xcd * (q + 1) : r * (q + 1) + (xcd - r) * q) + off; }
        const int nig = wgm * nN, gid = wgid / nig, fm = gid * wgm, gsz = (nM - fm) < wgm ? (nM - fm) : wgm;
        u.pm = fm + ((wgid % nig) % gsz); u.pn = (wgid % nig) / gsz; return true;
    }
    __device__ __forceinline__ void a_ready(const Unit&) const {}
    __device__ __forceinline__ void done(const Unit&) const {}
};

__device__ __forceinline__ unsigned cvt_pk_bf16(float lo, float hi) { unsigned r; asm volatile("v_cvt_pk_bf16_f32 %0, %1, %2" : "=v"(r) : "v"(lo), "v"(hi)); return r; }
typedef float f32x2 __attribute__((ext_vector_type(2)));
template <class Epi, class Sched, bool ALIGN_EPI = false, bool SP2 = false, bool FP8 = false, bool I8 = false>
__device__ __forceinline__ void gemm_phase(PG8_LAS unsigned char* lds, const Gemm g, const Sched& S, const Epi& E, int wave_s) {
    int tid_l = wave_s * 64 + lane_now(); asm volatile("" : "+v"(tid_l));
    const int tid = tid_l, wid = __builtin_amdgcn_readfirstlane(tid >> 6), lane = tid & 63, wr = wid >> 2, wc = wid & 3, fr = lane & 15, fq = lane >> 4;
    const int K = g.K, nt = (K / BK) * (Epi::SEGMENTED ? g.nseg : 1);
    unsigned voffA[2], voffB[2];
#pragma unroll
    for (int i = 0; i < 2; ++i) { int R, C; stage_rc(tid * 16 + i * 8192, R, C); const int Rb = Epi::PERM ? ((R & ~31) + perm32(R & 31)) : R;
        voffA[i] = (unsigned)(R * K + C) * 2u; voffB[i] = (unsigned)(Rb * K + C) * 2u; }
    const size_t kstep = (size_t)(BK * 2);
    const size_t hstep = (size_t)HALF * K * 2;
    const size_t tstep = 2 * hstep;
    const unsigned ldsw = (unsigned)wid * 1024u;
    const int aoff = lds_byte(wr * 64 + fr, fq * 8), boff = lds_byte(wc * 32 + fr, fq * 8);
#define PG8_SA(b, h) (((b) * 2 + (h)) * HTB)
#define PG8_SB(b, h) ((4 + (b) * 2 + (h)) * HTB)
#define PG8_STAGE(bufoff, gbase, voff) do { _Pragma("unroll") for (int _i = 0; _i < 2; ++_i) { unsigned vo_ = (voff)[_i]; if constexpr (FP8 || I8) asm volatile("" : "+v"(vo_));     \
        __builtin_amdgcn_global_load_lds((const unsigned*)((const char*)(gbase) + vo_), (PG8_LAS unsigned*)(lds + (bufoff) + ldsw + _i * 8192), 16, 0, 0); } } while (0)
#define PG8_LDA(dst, b, h) do { _Pragma("unroll") for (int m = 0; m < 4; ++m) _Pragma("unroll") for (int k = 0; k < 2; ++k) dst[m][k] = *(const PG8_LAS bf16x8*)(lds + PG8_SA(b, h) + aoff + m * 2048 + k * 1024); } while (0)
#define PG8_LDB(dst, b, h) do { _Pragma("unroll") for (int n = 0; n < 2; ++n) _Pragma("unroll") for (int k = 0; k < 2; ++k) dst[n][k] = *(const PG8_LAS bf16x8*)(lds + PG8_SB(b, h) + boff + n * 2048 + k * 1024); } while (0)
#define PG8_CAT8(v) __builtin_shufflevector(__builtin_bit_cast(i32x4, (v)[0]), __builtin_bit_cast(i32x4, (v)[1]), 0, 1, 2, 3, 4, 5, 6, 7)
#define PG8_MMA(ai, bj, At, Bt) do { __builtin_amdgcn_s_setprio(1); _Pragma("unroll") for (int m = 0; m < 4; ++m) _Pragma("unroll") for (int n = 0; n < 2; ++n) { \
        if constexpr (FP8) acc[ai][bj][m][n] = __builtin_amdgcn_mfma_scale_f32_16x16x128_f8f6f4(PG8_CAT8(Bt[n]), PG8_CAT8(At[m]), acc[ai][bj][m][n], 0, 0, 0, 0, 0, 0);     \
        else if constexpr (I8) { _Pragma("unroll") for (int k = 0; k < 2; ++k) acc[ai][bj][m][n] = __builtin_bit_cast(f32x4, __builtin_amdgcn_mfma_i32_16x16x64_i8(__builtin_bit_cast(i32x4, Bt[n][k]), __builtin_bit_cast(i32x4, At[m][k]), __builtin_bit_cast(i32x4, acc[ai][bj][m][n]), 0, 0, 0)); } \
        else { _Pragma("unroll") for (int k = 0; k < 2; ++k) acc[ai][bj][m][n] = __builtin_amdgcn_mfma_f32_16x16x32_bf16(Bt[n][k], At[m][k], acc[ai][bj][m][n], 0, 0, 0); } } __builtin_amdgcn_s_setprio(0); } while (0)
#define PG8_WAIT_V(n) asm volatile("s_waitcnt vmcnt(" #n ")" ::: "memory")
#define PG8_WAIT_L(n) asm volatile("s_waitcnt lgkmcnt(" #n ")" ::: "memory")
#define PG8_BAR __builtin_amdgcn_s_barrier()
#define PG8_SCHED __builtin_amdgcn_sched_barrier(0)
    Unit cur, nxt; int ui = 0;
    if (!S.next(0, cur)) return;
    f32x4 acc[2][2][4][2];
#pragma unroll
    for (int a = 0; a < 2; ++a)
#pragma unroll
        for (int b = 0; b < 2; ++b)
#pragma unroll
            for (int m = 0; m < 4; ++m)
#pragma unroll
                for (int n = 0; n < 2; ++n) acc[a][b][m][n] = (f32x4){0.f, 0.f, 0.f, 0.f};
    bf16x8 At[4][2], B0[2][2], B1[2][2];
    const char* cA = (const char*)g.A + (size_t)cur.pm * tstep; const char* cB = (const char*)g.Bt + (size_t)cur.pn * tstep;
    S.a_ready(cur);
    if constexpr (SP2) {
        PG8_STAGE(PG8_SB(0, 0), cB, voffB); PG8_STAGE(PG8_SB(0, 1), cB + hstep, voffB); PG8_STAGE(PG8_SA(0, 0), cA, voffA); PG8_STAGE(PG8_SA(0, 1), cA + hstep, voffA);
        if (wr == 1) PG8_BAR;
        PG8_WAIT_V(2); PG8_BAR;
        PG8_STAGE(PG8_SB(1, 0), cB + kstep, voffB); PG8_STAGE(PG8_SA(1, 0), cA + kstep, voffA); PG8_STAGE(PG8_SB(1, 1), cB + hstep + kstep, voffB);
        PG8_WAIT_V(6); PG8_BAR;
    } else {
        PG8_STAGE(PG8_SB(0, 0), cB, voffB); PG8_STAGE(PG8_SA(0, 0), cA, voffA); PG8_STAGE(PG8_SB(0, 1), cB + hstep, voffB); PG8_STAGE(PG8_SA(0, 1), cA + hstep, voffA);
        if (wr == 1) PG8_BAR;
        PG8_WAIT_V(4); PG8_BAR;
        PG8_STAGE(PG8_SB(1, 0), cB + kstep, voffB); PG8_STAGE(PG8_SA(1, 0), cA + kstep, voffA); PG8_STAGE(PG8_SB(1, 1), cB + hstep + kstep, voffB);
        PG8_WAIT_V(6); PG8_BAR;
    }
    for (;;) {
        const bool has_next = S.next(ui + 1, nxt);
        const char* nA = has_next ? (const char*)g.A + (size_t)nxt.pm * tstep : cA; const char* nB = has_next ? (const char*)g.Bt + (size_t)nxt.pn * tstep : cB;
        for (int t = 0; t < nt; t += 2) {
            const bool last = (t == nt - 2);
            const char* a1; const char* a2; const char* b2;
            if constexpr (Epi::SEGMENTED) {
                constexpr int SH = Epi::SEG_SHIFT, SM = (1 << SH) - 1;
                a1 = cA + (size_t)((t + 1) >> SH) * g.segA + (size_t)((t + 1) & SM) * kstep;
                a2 = last ? nA : cA + (size_t)((t + 2) >> SH) * g.segA + (size_t)((t + 2) & SM) * kstep; b2 = last ? nB : cB + (size_t)((t + 2) >> SH) * g.segB + (size_t)((t + 2) & SM) * kstep;
                if (t != 0 && (t & SM) == 0) E.seg_hook(acc, cur, t >> SH, wr, wc, fr, fq);
            } else {
                a1 = cA + (size_t)(t + 1) * kstep;
                a2 = last ? nA : cA + (size_t)(t + 2) * kstep; b2 = last ? nB : cB + (size_t)(t + 2) * kstep;
            }
            const char* a3 = a2 + kstep; const char* b3 = b2 + kstep;
            if (last && has_next) S.a_ready(nxt);
            if constexpr (SP2) {
            PG8_LDB(B0, 0, 0); PG8_LDB(B1, 0, 1); PG8_SCHED; PG8_LDA(At, 0, 0); PG8_STAGE(PG8_SA(1, 1), a1 + hstep, voffA);
            PG8_WAIT_V(8); PG8_WAIT_L(0); PG8_BAR; PG8_MMA(0, 0, At, B0); PG8_MMA(0, 1, At, B1); PG8_BAR; PG8_SCHED;
            PG8_LDA(At, 0, 1); PG8_STAGE(PG8_SB(0, 0), b2, voffB); PG8_STAGE(PG8_SB(0, 1), b2 + hstep, voffB); PG8_STAGE(PG8_SA(0, 0), a2, voffA);
            PG8_WAIT_V(8); PG8_WAIT_L(0); PG8_BAR; PG8_MMA(1, 0, At, B0); PG8_MMA(1, 1, At, B1); PG8_BAR; PG8_SCHED;
            PG8_LDB(B0, 1, 0); PG8_LDB(B1, 1, 1); PG8_SCHED; PG8_LDA(At, 1, 0); PG8_STAGE(PG8_SA(0, 1), a2 + hstep, voffA);
            PG8_WAIT_V(8); PG8_WAIT_L(0); PG8_BAR; PG8_MMA(0, 0, At, B0); PG8_MMA(0, 1, At, B1); PG8_BAR; PG8_SCHED;
            PG8_LDA(At, 1, 1); PG8_STAGE(PG8_SB(1, 0), b3, voffB); PG8_STAGE(PG8_SB(1, 1), b3 + hstep, voffB); PG8_STAGE(PG8_SA(1, 0), a3, voffA);
            PG8_WAIT_V(8); PG8_WAIT_L(0); PG8_BAR; PG8_MMA(1, 0, At, B0); PG8_MMA(1, 1, At, B1); PG8_BAR; PG8_SCHED;
            } else {
            PG8_LDB(B0, 0, 0); PG8_SCHED; PG8_LDA(At, 0, 0); PG8_STAGE(PG8_SA(1, 1), a1 + hstep, voffA);
            PG8_WAIT_L(8); PG8_BAR; PG8_WAIT_L(0); PG8_MMA(0, 0, At, B0); PG8_BAR; PG8_SCHED;
            PG8_LDB(B1, 0, 1); PG8_STAGE(PG8_SB(0, 0), b2, voffB);
            PG8_BAR; PG8_WAIT_L(0); PG8_MMA(0, 1, At, B1); PG8_BAR;
            PG8_LDA(At, 0, 1); PG8_STAGE(PG8_SA(0, 0), a2, voffA);
            PG8_BAR; PG8_WAIT_L(0); PG8_MMA(1, 0, At, B0); PG8_BAR; PG8_SCHED;
            PG8_STAGE(PG8_SB(0, 1), b2 + hstep, voffB);
            PG8_WAIT_V(6); PG8_BAR; PG8_MMA(1, 1, At, B1); PG8_BAR;
            PG8_LDB(B0, 1, 0); PG8_SCHED; PG8_LDA(At, 1, 0); PG8_STAGE(PG8_SA(0, 1), a2 + hstep, voffA);
            PG8_WAIT_L(8); PG8_BAR; PG8_WAIT_L(0); PG8_MMA(0, 0, At, B0); PG8_BAR; PG8_SCHED;
            PG8_LDB(B1, 1, 1); PG8_STAGE(PG8_SB(1, 0), b3, voffB);
            PG8_BAR; PG8_WAIT_L(0); PG8_MMA(0, 1, At, B1); PG8_BAR;
            PG8_LDA(At, 1, 1); PG8_STAGE(PG8_SA(1, 0), a3, voffA);
            PG8_BAR; PG8_WAIT_L(0); PG8_MMA(1, 0, At, B0); PG8_BAR; PG8_SCHED;
            PG8_STAGE(PG8_SB(1, 1), b3 + hstep, voffB);
            PG8_WAIT_V(6); PG8_BAR; PG8_MMA(1, 1, At, B1); PG8_BAR;
            }
        }
        if constexpr (ALIGN_EPI) { if (wr == 0) PG8_BAR; }
        if constexpr (!Epi::AFTER_DRAIN) { E(acc, cur, wr, wc, fr, fq); S.done(cur); }
        if (!has_next) break;
#pragma unroll
        for (int a = 0; a < 2; ++a)
#pragma unroll
            for (int b = 0; b < 2; ++b)
#pragma unroll
                for (int m = 0; m < 4; ++m)
#pragma unroll
                    for (int n = 0; n < 2; ++n) acc[a][b][m][n] = (f32x4){0.f, 0.f, 0.f, 0.f};
        cur = nxt; cA = nA; cB = nB; ++ui;
        if constexpr (ALIGN_EPI) { if (wr == 1) PG8_BAR; }
    }
    PG8_WAIT_V(0);
    if constexpr (!ALIGN_EPI) { if (wr == 0) PG8_BAR; }
    PG8_BAR;
    if constexpr (Epi::AFTER_DRAIN) { E.fused(acc, cur, wr, wc, fr, fq, lds, wid, lane); S.done(cur); }
#undef PG8_SA
#undef PG8_SB
#undef PG8_STAGE
#undef PG8_LDA
#undef PG8_LDB
#undef PG8_MMA
#undef PG8_CAT8
#undef PG8_WAIT_V
#undef PG8_WAIT_L
#undef PG8_BAR
#undef PG8_SCHED
}
}
#define GAS __attribute__((address_space(1)))
#define LAS __attribute__((address_space(3)))
typedef unsigned short bf16;
typedef unsigned v4u __attribute__((ext_vector_type(4)));
typedef float f32x4 __attribute__((ext_vector_type(4)));
typedef short bf16x8 __attribute__((ext_vector_type(8)));
typedef GAS unsigned gu32;
typedef GAS unsigned long long gu64;
#define RLX_AGENT __ATOMIC_RELAXED, __HIP_MEMORY_SCOPE_AGENT
#define LDS_WAIT() asm volatile("s_waitcnt lgkmcnt(0)" ::: "memory")
#define VM_WAIT() asm volatile("s_waitcnt vmcnt(0)" ::: "memory")
__device__ __forceinline__ unsigned long long rt() { return __builtin_amdgcn_s_memrealtime(); }
__device__ __forceinline__ unsigned f2bf(float f) { unsigned u = __builtin_bit_cast(unsigned, f); return (u + 0x7fffu + ((u >> 16) & 1u)) >> 16; }
__device__ __forceinline__ unsigned pk2(float lo, float hi) { return f2bf(lo) | (f2bf(hi) << 16); }
#define XB_TMO      128
#define XB_XCNT(j)  (256  + 64 * (j))
#define XB_XSUB(j)  (1280 + 64 * (j))
#define XB_XGEN(j)  (2304 + 64 * (j))
#define XB_TOP      3328
#define XB_TOPGEN   3392
#define XCD_BAR_WORDS 3456
#define XB_SPIN_CAP (1u << 18)

__device__ __forceinline__ unsigned xb_ld(unsigned* p)              { return __hip_atomic_load(p, __ATOMIC_RELAXED, __HIP_MEMORY_SCOPE_AGENT); }
__device__ __forceinline__ unsigned xb_add(unsigned* p, unsigned v) { return __hip_atomic_fetch_add(p, v, __ATOMIC_RELAXED, __HIP_MEMORY_SCOPE_AGENT); }
__device__ __forceinline__ unsigned xb_xcc_id() { return (unsigned)__builtin_amdgcn_s_getreg((3 << 11) | 20) & 0xFu; }
#define XB_SPIN(cond, bar) do { unsigned _sp = 0; while (cond) { __builtin_amdgcn_s_sleep(1); \
    if ((++_sp & 255u) == 0u) { if (xb_ld(&(bar)[XB_TMO])) break; if (_sp > XB_SPIN_CAP) { atomicAdd(&(bar)[XB_TMO], 1u); break; } } } } while (0)

struct XcdBarrier {
    unsigned* bar; unsigned x; int wv;
    volatile LAS unsigned* st;
};

__device__ __forceinline__ XcdBarrier xcd_barrier_post(unsigned* bar, volatile LAS unsigned* st) {
    XcdBarrier b; b.bar = bar; b.x = xb_xcc_id(); b.st = st; b.wv = __builtin_amdgcn_readfirstlane((int)(threadIdx.x >> 6));
    if (threadIdx.x == 0) (void)xb_add(&bar[XB_XCNT(b.x)], 1u);
    return b;
}
__device__ __forceinline__ void xcd_barrier_complete(unsigned* bar, unsigned x, unsigned& nloc, unsigned& nx) {
    const unsigned G = gridDim.x * gridDim.y * gridDim.z;
    unsigned sum, cnt, mine, sp = 0u;
    for (;;) {
        sum = 0u; cnt = 0u; mine = 0u;
#pragma unroll
        for (unsigned j = 0; j < 16; ++j) { const unsigned c = xb_ld(&bar[XB_XCNT(j)]); sum += c; cnt += (c > 0u) ? 1u : 0u; mine = (j == x) ? c : mine; }
        if (sum == G) break;
        __builtin_amdgcn_s_sleep(1);
        if ((++sp & 255u) == 0u) { if (xb_ld(&bar[XB_TMO])) break; if (sp > XB_SPIN_CAP) { atomicAdd(&bar[XB_TMO], 1u); break; } }
    }
    nloc = mine > 0u ? mine : 1u; nx = cnt > 0u ? cnt : 1u;
}

__device__ __forceinline__ void xcd_barrier(const XcdBarrier& b) {
    asm volatile("s_waitcnt vmcnt(0)" ::: "memory");
    __syncthreads();
    if (b.wv == 0 && pg8::lane_now() == 0) {
        unsigned* bar = b.bar;
        __builtin_amdgcn_s_waitcnt(0);
        unsigned nloc = b.st[0], nx = b.st[1];
        if (nloc == 0u) { xcd_barrier_complete(bar, b.x, nloc, nx); b.st[0] = nloc; b.st[1] = nx; }
        const unsigned old = xb_add(&bar[XB_XSUB(b.x)], 1u);
        const unsigned gen = old / nloc;
        if (old + 1u == (gen + 1u) * nloc) {
            __builtin_amdgcn_fence(__ATOMIC_RELEASE, "agent");
            asm volatile("s_waitcnt vmcnt(0)" ::: "memory");
            const unsigned og = xb_add(&bar[XB_TOP], 1u);
            const unsigned tg = og / nx;
            if (og + 1u == (tg + 1u) * nx) xb_add(&bar[XB_TOPGEN], 1u);
            else XB_SPIN(xb_ld(&bar[XB_TOPGEN]) == tg, bar);
            __builtin_amdgcn_fence(__ATOMIC_ACQUIRE, "agent");
            xb_add(&bar[XB_XGEN(b.x)], 1u);
            asm volatile("s_waitcnt vmcnt(0)" ::: "memory");
        } else {
            XB_SPIN(xb_ld(&bar[XB_XGEN(b.x)]) == gen, bar);
            __builtin_amdgcn_fence(__ATOMIC_ACQUIRE, "agent");
            asm volatile("s_waitcnt vmcnt(0)" ::: "memory");
        }
    }
    __syncthreads();
}
constexpr int BATCH = 4, SEQ = 8192, DM = 2048, M = BATCH * SEQ, BW = 512, INW = 9216, DFF = 5632, NUP = 2 * DFF, DEPTH = 2;
constexpr int NWAVES = 8;
constexpr float EPS = 1e-6f;
constexpr float LOG2E = 1.4426950408889634f;
constexpr float QSCALE = 0.125f * LOG2E;

__device__ __forceinline__ float bf_lo(unsigned w) { return __builtin_bit_cast(float, w << 16); }
__device__ __forceinline__ float bf_hi(unsigned w) { return __builtin_bit_cast(float, w & 0xffff0000u); }
__device__ __forceinline__ float bf2f(unsigned short h) { return __builtin_bit_cast(float, ((unsigned)h) << 16); }
constexpr float W8_SCALE = 32.0f, W8_INV = 1.0f / 32.0f;
__device__ __forceinline__ float sigmoid_f(float v) { return __builtin_amdgcn_rcpf(1.0f + __builtin_amdgcn_exp2f(-LOG2E * v)); }
__device__ __forceinline__ unsigned gate_q4(const pg8::f32x4 x) {
    float t[4];
#pragma unroll
    for (int j = 0; j < 4; ++j) t[j] = fmaxf(__builtin_fmaf(sigmoid_f(x[j]), 255.0f, 12582912.0f), 12582913.0f);
    return __builtin_amdgcn_perm(__builtin_bit_cast(unsigned, t[1]), __builtin_bit_cast(unsigned, t[0]), 0x0c0c0400u) | __builtin_amdgcn_perm(__builtin_bit_cast(unsigned, t[3]), __builtin_bit_cast(unsigned, t[2]), 0x04000c0cu);
}
__device__ __forceinline__ unsigned q8x4(float a, float b, float c, float d, float inv) {
    const float t0 = __builtin_fmaf(a, inv, 12582912.0f), t1 = __builtin_fmaf(b, inv, 12582912.0f), t2 = __builtin_fmaf(c, inv, 12582912.0f), t3 = __builtin_fmaf(d, inv, 12582912.0f);
    return __builtin_amdgcn_perm(__builtin_bit_cast(unsigned, t1), __builtin_bit_cast(unsigned, t0), 0x0c0c0400u) | __builtin_amdgcn_perm(__builtin_bit_cast(unsigned, t3), __builtin_bit_cast(unsigned, t2), 0x04000c0cu);
}
__device__ __forceinline__ float ub0(unsigned q) { float r; asm("v_cvt_f32_ubyte0 %0, %1" : "=v"(r) : "v"(q)); return r; }
__device__ __forceinline__ float ub1(unsigned q) { float r; asm("v_cvt_f32_ubyte1 %0, %1" : "=v"(r) : "v"(q)); return r; }
__device__ __forceinline__ float ub2(unsigned q) { float r; asm("v_cvt_f32_ubyte2 %0, %1" : "=v"(r) : "v"(q)); return r; }
__device__ __forceinline__ float ub3(unsigned q) { float r; asm("v_cvt_f32_ubyte3 %0, %1" : "=v"(r) : "v"(q)); return r; }
__device__ __forceinline__ pg8::f32x4 gate_ratio4(unsigned a, unsigned b) { pg8::f32x4 r; r[0] = ub0(a) * __builtin_amdgcn_rcpf(ub0(b)); r[1] = ub1(a) * __builtin_amdgcn_rcpf(ub1(b)); r[2] = ub2(a) * __builtin_amdgcn_rcpf(ub2(b)); r[3] = ub3(a) * __builtin_amdgcn_rcpf(ub3(b)); return r; }
__device__ __forceinline__ pg8::f32x4 gate_val4(unsigned a) { pg8::f32x4 r; r[0] = ub0(a); r[1] = ub1(a); r[2] = ub2(a); r[3] = ub3(a); return r * (1.0f / 255.0f); }
__device__ __forceinline__ float gelu_tanh(float v) {
    const float u = __builtin_fmaf(v * v, -0.10294324f, -2.3022082f);
    return v * __builtin_amdgcn_rcpf(1.0f + __builtin_amdgcn_exp2f(v * u));
}

#ifndef UPCONV_DPP
#define UPCONV_DPP 1
#endif
#define EPI_ST(p, v) (*(pg8::u32x4*)(p) = (v))
#define EPI_DRY_DECL
#define EPI_DRY_MEMBER
struct EpiPlain {
    static constexpr bool PERM = true, AFTER_DRAIN = false, SEGMENTED = false;
    pg8::bf16_t* O; int ldc; EPI_DRY_MEMBER
    __device__ __forceinline__ void operator()(const pg8::f32x4 (&acc)[2][2][4][2], const pg8::Unit& u, int wr, int wc, int fr, int fq) const {
        EPI_DRY_DECL
        const int row0 = u.pm * 256 + wr * 64 + fr, col0 = u.pn * 256 + wc * 32 + 8 * fq;
#pragma unroll
        for (int ai = 0; ai < 2; ++ai)
#pragma unroll
            for (int m = 0; m < 4; ++m) { pg8::bf16_t* rowp = O + (size_t)(row0 + ai * 128 + m * 16) * ldc + col0;
#pragma unroll
                for (int bj = 0; bj < 2; ++bj) { const pg8::f32x4 v0 = acc[ai][bj][m][0], v1 = acc[ai][bj][m][1];
                    pg8::u32x4 w; w.x = pg8::cvt_pk_bf16(v0[0], v0[1]); w.y = pg8::cvt_pk_bf16(v0[2], v0[3]); w.z = pg8::cvt_pk_bf16(v1[0], v1[1]); w.w = pg8::cvt_pk_bf16(v1[2], v1[3]);
                    EPI_ST(rowp + bj * 128, w); } }
    }
};
struct EpiInProj {
    static constexpr bool PERM = true, AFTER_DRAIN = false, SEGMENTED = false;
    const float* bias; pg8::bf16_t* T6; float* kmean; unsigned* kabs; const float* rs; const unsigned* cm; EPI_DRY_MEMBER
    __device__ __forceinline__ void operator()(pg8::f32x4 (&acc)[2][2][4][2], const pg8::Unit& u, int wr, int wc, int fr, int fq) const {
        EPI_DRY_DECL
        const int pn = u.pn; int mode, ldc, colt; pg8::bf16_t* base;
        {
            pg8::f32x4 cv[2][2];
#pragma unroll
            for (int bj = 0; bj < 2; ++bj)
#pragma unroll
                for (int n = 0; n < 2; ++n) { const pg8::u32x4 cmv = *(const pg8::u32x4*)(cm + pn * 256 + wc * 32 + 8 * fq + bj * 128 + 4 * n); const unsigned c0 = cmv.x, c1 = cmv.y, c2 = cmv.z, c3 = cmv.w;
                    pg8::f32x4 t; t[0] = __builtin_bit_cast(float, c0); t[1] = __builtin_bit_cast(float, c1); t[2] = __builtin_bit_cast(float, c2); t[3] = __builtin_bit_cast(float, c3); cv[bj][n] = t * (1.0f / 127.0f); }
#pragma unroll
            for (int ai = 0; ai < 2; ++ai)
#pragma unroll
                for (int m = 0; m < 4; ++m) { const float rsv = rs[u.pm * 256 + ai * 128 + wr * 64 + m * 16 + fr];
#pragma unroll
                    for (int bj = 0; bj < 2; ++bj)
#pragma unroll
                        for (int n = 0; n < 2; ++n) { pg8::f32x4 t;
#pragma unroll
                            for (int j = 0; j < 4; ++j) { const float af = acc[ai][bj][m][n][j]; t[j] = (float)__builtin_bit_cast(int, af); }
                            acc[ai][bj][m][n] = (t * rsv) * cv[bj][n]; } }
        }
        if (pn < 12) { const int t = pn >> 1, slot = (t == 0) ? 0 : (t == 1) ? 3 : (t == 2) ? 1 : t + 1;
            base = T6 + (size_t)slot * M * BW; ldc = BW; colt = (pn & 1) * 256; mode = t < 2 ? 1 : (t == 2 ? 2 : 0); }
        else { base = T6; ldc = DM; colt = 0; mode = 0; }
        const int row0 = u.pm * 256 + wr * 64 + fr, col0 = colt + wc * 32 + 8 * fq, bcol0 = pn * 256 + wc * 32 + 8 * fq;
        pg8::f32x4 bv[2][2];
#pragma unroll
        for (int bj = 0; bj < 2; ++bj)
#pragma unroll
            for (int n = 0; n < 2; ++n) bv[bj][n] = *(const pg8::f32x4*)(bias + bcol0 + bj * 128 + 4 * n);
        if (pn == 6 || pn == 7) {
            const int lane = fq * 16 + fr; const int b = u.pm >> 5, jblk = u.pm & 31;
#pragma unroll
            for (int bj = 0; bj < 2; ++bj)
#pragma unroll
                for (int n = 0; n < 2; ++n) { pg8::f32x4 s = bv[bj][n] * 8.0f;
#pragma unroll
                    for (int ai = 0; ai < 2; ++ai)
#pragma unroll
                        for (int m = 0; m < 4; ++m) s = s + acc[ai][bj][m][n];
                    pg8::f32x4 mx = {0.f, 0.f, 0.f, 0.f};
#pragma unroll
                    for (int ai = 0; ai < 2; ++ai)
#pragma unroll
                        for (int m = 0; m < 4; ++m) { const pg8::f32x4 kv = acc[ai][bj][m][n] + bv[bj][n];
#pragma unroll
                            for (int j = 0; j < 4; ++j) mx[j] = fmaxf(mx[j], __builtin_fabsf(kv[j])); }
#pragma unroll
                    for (int j = 0; j < 4; ++j) { float v = s[j]; float a = mx[j];
#pragma unroll
                        for (int o = 1; o < 16; o <<= 1) { v += __builtin_bit_cast(float, __builtin_amdgcn_ds_bpermute((lane ^ o) << 2, __builtin_bit_cast(int, v)));
                            a = fmaxf(a, __builtin_bit_cast(float, __builtin_amdgcn_ds_bpermute((lane ^ o) << 2, __builtin_bit_cast(int, a)))); }
                        if (fr == 0) { const int col = (pn & 1) * 256 + bj * 128 + wc * 32 + 8 * fq + 4 * n + j; const size_t ki = ((size_t)(b * 8 + (col >> 6)) * 32 + jblk) * 64 + (col & 63);
                            atomicAdd(kmean + ki, v * (1.0f / 256.0f)); atomicMax(kabs + ki, __builtin_bit_cast(unsigned, a)); } } }
        }
#pragma unroll
        for (int ai = 0; ai < 2; ++ai)
#pragma unroll
            for (int m = 0; m < 4; ++m) { pg8::bf16_t* rowp = base + (size_t)(row0 + ai * 128 + m * 16) * ldc + col0;
#pragma unroll
                for (int bj = 0; bj < 2; ++bj) { pg8::f32x4 v0 = acc[ai][bj][m][0] + bv[bj][0], v1 = acc[ai][bj][m][1] + bv[bj][1];
                    if (mode == 1) {
#pragma unroll
                        for (int j = 0; j < 4; ++j) { v0[j] = gelu_tanh(v0[j]); v1[j] = gelu_tanh(v1[j]); } }
                    else if (mode == 2) { v0 = v0 * QSCALE; v1 = v1 * QSCALE; }
                    pg8::u32x4 w; w.x = pg8::cvt_pk_bf16(v0[0], v0[1]); w.y = pg8::cvt_pk_bf16(v0[2], v0[3]); w.z = pg8::cvt_pk_bf16(v1[0], v1[1]); w.w = pg8::cvt_pk_bf16(v1[2], v1[3]);
                    EPI_ST(rowp + bj * 128, w); } }
    }
};
struct EpiGate8 {
    static constexpr bool PERM = true, AFTER_DRAIN = false, SEGMENTED = false;
    const float* bias; unsigned char* G8; const float* rs; const unsigned* cm; EPI_DRY_MEMBER
    __device__ __forceinline__ void operator()(const pg8::f32x4 (&acc)[2][2][4][2], const pg8::Unit& u, int wr, int wc, int fr_in, int fq_in) const {
        EPI_DRY_DECL
        int fr = fr_in, fq = fq_in; asm volatile("" : "+v"(fr), "+v"(fq));
        const int pn = u.pn, bcol0 = pn * 256 + wc * 32 + 8 * fq;
        pg8::f32x4 bv[2][2];
#pragma unroll
        for (int bj = 0; bj < 2; ++bj)
#pragma unroll
            for (int n = 0; n < 2; ++n) bv[bj][n] = *(const pg8::f32x4*)(bias + bcol0 + bj * 128 + 4 * n);
        pg8::f32x4 cv[2][2];
#pragma unroll
        for (int bj = 0; bj < 2; ++bj)
#pragma unroll
            for (int n = 0; n < 2; ++n) { const pg8::u32x4 cmv = *(const pg8::u32x4*)(cm + bcol0 + bj * 128 + 4 * n); const unsigned c0 = cmv.x, c1 = cmv.y, c2 = cmv.z, c3 = cmv.w;
                pg8::f32x4 t; t[0] = __builtin_bit_cast(float, c0); t[1] = __builtin_bit_cast(float, c1); t[2] = __builtin_bit_cast(float, c2); t[3] = __builtin_bit_cast(float, c3); cv[bj][n] = t * (1.0f / 127.0f); }
        unsigned char* tp = G8 + ((size_t)((pn >> 3) * (M / 256) + u.pm) * 8 + (pn & 7)) * 65536 + (size_t)((((wr * 4 + wc) * 64) + fq * 16 + fr) * 16);
#pragma unroll
        for (int ai = 0; ai < 2; ++ai)
#pragma unroll
            for (int m = 0; m < 4; ++m) { pg8::u32x4 w; const float rsv = rs[u.pm * 256 + ai * 128 + wr * 64 + m * 16 + fr];
                pg8::f32x4 z[2][2];
#pragma unroll
                for (int bj = 0; bj < 2; ++bj)
#pragma unroll
                    for (int n = 0; n < 2; ++n) { pg8::f32x4 t;
#pragma unroll
                        for (int j = 0; j < 4; ++j) { const float af = acc[ai][bj][m][n][j]; t[j] = (float)__builtin_bit_cast(int, af); }
                        z[bj][n] = (t * rsv) * cv[bj][n] + bv[bj][n]; }
                w.x = gate_q4(z[0][0]); w.y = gate_q4(z[0][1]); w.z = gate_q4(z[1][0]); w.w = gate_q4(z[1][1]);
                EPI_ST(tp + (ai * 4 + m) * 8192, w); }
    }
};
struct EpiUpConv {
    static constexpr bool PERM = true, AFTER_DRAIN = false, SEGMENTED = false;
    pg8::bf16_t* A2; const float* wconv; const float* bconv; float* topz; float* botz; PG8_LAS float* xb; const float* rs; const unsigned* cm; EPI_DRY_MEMBER
    __device__ __forceinline__ void operator()(pg8::f32x4 (&acc)[2][2][4][2], const pg8::Unit& u, int wr, int wc, int fr_in, int fq_in) const {
        EPI_DRY_DECL
        int fr = fr_in, fq = fq_in; asm volatile("" : "+v"(fr), "+v"(fq));
        const int lane = fq * 16 + fr, wv = wr * 4 + wc, pm = u.pm, pn = u.pn;
#pragma unroll
        for (int ai = 0; ai < 2; ++ai)
#pragma unroll
            for (int m = 0; m < 4; ++m) { const float rsv = rs[pm * 256 + ai * 128 + wr * 64 + m * 16 + fr];
#pragma unroll
                for (int bj = 0; bj < 2; ++bj)
#pragma unroll
                    for (int n = 0; n < 2; ++n) { pg8::f32x4 t;
#pragma unroll
                        for (int j = 0; j < 4; ++j) { const float af = acc[ai][bj][m][n][j]; t[j] = (float)__builtin_bit_cast(int, af); }
                        acc[ai][bj][m][n] = t * rsv; } }
        if (fr >= 14) {
#pragma unroll
            for (int ai = 0; ai < 2; ++ai)
#pragma unroll
                for (int bj = 0; bj < 2; ++bj) { PG8_LAS pg8::f32x4* p = (PG8_LAS pg8::f32x4*)(xb + ((((wv * 2 + ai) * 2 + (fr - 14)) * 4 + fq) * 2 + bj) * 8); p[0] = acc[ai][bj][3][0]; p[1] = acc[ai][bj][3][1]; }
        }
        const int ecol = pn * 256 + wc * 32 + 8 * fq;
        if (wr == 0 && fr < 2) { float* t = topz + ((size_t)pm * 2 + fr) * NUP + ecol;
#pragma unroll
            for (int bj = 0; bj < 2; ++bj)
#pragma unroll
                for (int n = 0; n < 2; ++n) *(pg8::f32x4*)(t + bj * 128 + 4 * n) = acc[0][bj][0][n]; }
        if (wr == 1 && fr >= 14) { float* t = botz + ((size_t)pm * 2 + (fr - 14)) * NUP + ecol;
#pragma unroll
            for (int bj = 0; bj < 2; ++bj)
#pragma unroll
                for (int n = 0; n < 2; ++n) *(pg8::f32x4*)(t + bj * 128 + 4 * n) = acc[1][bj][3][n]; }
        asm volatile("s_waitcnt lgkmcnt(0)" ::: "memory"); __builtin_amdgcn_s_barrier(); asm volatile("" ::: "memory");
        pg8::f32x4 bnd[2][2][2];
#pragma unroll
        for (int ai = 0; ai < 2; ++ai) { const int sw = (wr == 1) ? wc : 4 + wc, sai = (wr == 1) ? ai : 0; const bool have = (wr == 1) || (ai == 1);
#pragma unroll
            for (int bj = 0; bj < 2; ++bj) { pg8::f32x4 a = {0.f, 0.f, 0.f, 0.f}, b = a;
                if (have && fr >= 14) { const PG8_LAS pg8::f32x4* p = (const PG8_LAS pg8::f32x4*)(xb + ((((sw * 2 + sai) * 2 + (fr - 14)) * 4 + fq) * 2 + bj) * 8); a = p[0]; b = p[1]; }
                bnd[ai][bj][0] = a; bnd[ai][bj][1] = b; } }
        const int s1 = (fr >= 1 ? lane - 1 : lane + 15) << 2, s2 = (fr >= 2 ? lane - 2 : lane + 14) << 2;
#pragma unroll
        for (int bj = 0; bj < 2; ++bj)
#pragma unroll
            for (int n = 0; n < 2; ++n) { const int col = (bj ? DFF : 0) + pn * 128 + wc * 32 + 8 * fq + 4 * n;
                const pg8::u32x4 cmv = *(const pg8::u32x4*)(cm + col); pg8::f32x4 csv;
                { const unsigned c0 = cmv.x, c1 = cmv.y, c2 = cmv.z, c3 = cmv.w; csv[0] = __builtin_bit_cast(float, c0); csv[1] = __builtin_bit_cast(float, c1); csv[2] = __builtin_bit_cast(float, c2); csv[3] = __builtin_bit_cast(float, c3); csv = csv * (1.0f / 127.0f); }
                const pg8::f32x4 w0 = *(const pg8::f32x4*)(wconv + col) * csv, w1 = *(const pg8::f32x4*)(wconv + NUP + col) * csv, w2 = *(const pg8::f32x4*)(wconv + 2 * NUP + col) * csv, bb = *(const pg8::f32x4*)(bconv + col);
#pragma unroll
                for (int ai = 0; ai < 2; ++ai)
#pragma unroll
                    for (int m = 3; m >= 0; --m) { const pg8::f32x4 cur = acc[ai][bj][m][n]; const pg8::f32x4 prv = (m > 0) ? acc[ai][bj][m - 1][n] : bnd[ai][bj][n];
                        pg8::f32x4 z1, z2;
#pragma unroll
                        for (int j = 0; j < 4; ++j) {
#if UPCONV_DPP
                            const float cf = cur[j], pf = prv[j];
                            const int ci = __builtin_bit_cast(int, cf), pi = __builtin_bit_cast(int, pf);
                            const int p1 = __builtin_amdgcn_mov_dpp(pi, 0x121, 0xf, 0xf, false), p2 = __builtin_amdgcn_mov_dpp(pi, 0x122, 0xf, 0xf, false);
                            z1[j] = __builtin_bit_cast(float, __builtin_amdgcn_update_dpp(p1, ci, 0x111, 0xf, 0xf, false));
                            z2[j] = __builtin_bit_cast(float, __builtin_amdgcn_update_dpp(p2, ci, 0x112, 0xf, 0xf, false));
#else
                            const float t1 = (fr == 15) ? prv[j] : cur[j], t2 = (fr >= 14) ? prv[j] : cur[j];
                            z1[j] = __builtin_bit_cast(float, __builtin_amdgcn_ds_bpermute(s1, __builtin_bit_cast(int, t1)));
                            z2[j] = __builtin_bit_cast(float, __builtin_amdgcn_ds_bpermute(s2, __builtin_bit_cast(int, t2)));
#endif
                        }
                        acc[ai][bj][m][n] = w2 * cur + w1 * z1 + w0 * z2 + bb; } }
        const int row0 = pm * 256 + wr * 64 + fr, col0 = pn * 128 + wc * 32 + 8 * fq;
#pragma unroll
        for (int ai = 0; ai < 2; ++ai)
#pragma unroll
            for (int m = 0; m < 4; ++m) { const pg8::f32x4 g0 = acc[ai][0][m][0], g1 = acc[ai][0][m][1], v0 = acc[ai][1][m][0], v1 = acc[ai][1][m][1];
                pg8::u32x4 w; w.x = pg8::cvt_pk_bf16(gelu_tanh(g0[0]) * v0[0], gelu_tanh(g0[1]) * v0[1]); w.y = pg8::cvt_pk_bf16(gelu_tanh(g0[2]) * v0[2], gelu_tanh(g0[3]) * v0[3]);
                w.z = pg8::cvt_pk_bf16(gelu_tanh(g1[0]) * v1[0], gelu_tanh(g1[1]) * v1[1]); w.w = pg8::cvt_pk_bf16(gelu_tanh(g1[2]) * v1[2], gelu_tanh(g1[3]) * v1[3]);
                EPI_ST(A2 + (size_t)(row0 + ai * 128 + m * 16) * DFF + col0, w); }
    }
};
struct EpiBranch {
    static constexpr bool PERM = true, AFTER_DRAIN = false, SEGMENTED = true; static constexpr int SEG_SHIFT = 3;
    const unsigned char* G8; pg8::bf16_t* Mb; EPI_DRY_MEMBER
    __device__ __forceinline__ void seg_hook(pg8::f32x4 (&acc)[2][2][4][2], const pg8::Unit& u, int seg, int wr, int wc, int fr, int fq) const {
        int t16 = (((wr * 4 + wc) * 64) + fq * 16 + fr) * 16;
        asm volatile("" : "+v"(t16));
        const unsigned char* Tp = G8 + ((size_t)((seg - 1) * (M / 256) + u.pm) * 8 + u.pn) * 65536 + t16; const unsigned char* Tn = Tp + (size_t)(M / 256) * 8 * 65536;
        pg8::u32x4 ga[8], gb[8];
#pragma unroll
        for (int c = 0; c < 8; ++c) { ga[c] = *(const pg8::u32x4*)(Tp + c * 8192); gb[c] = *(const pg8::u32x4*)(Tn + c * 8192); }
        asm volatile("" ::: "memory");
#pragma unroll
        for (int ai = 0; ai < 2; ++ai)
#pragma unroll
            for (int m = 0; m < 4; ++m) { const pg8::u32x4 a = ga[ai * 4 + m], b = gb[ai * 4 + m];
                acc[ai][0][m][0] = acc[ai][0][m][0] * gate_ratio4(a.x, b.x); acc[ai][0][m][1] = acc[ai][0][m][1] * gate_ratio4(a.y, b.y);
                acc[ai][1][m][0] = acc[ai][1][m][0] * gate_ratio4(a.z, b.z); acc[ai][1][m][1] = acc[ai][1][m][1] * gate_ratio4(a.w, b.w); }
        asm volatile("" ::: "memory");
    }
    __device__ __forceinline__ void operator()(const pg8::f32x4 (&acc)[2][2][4][2], const pg8::Unit& u, int wr, int wc, int fr, int fq) const {
        const int row0 = u.pm * 256 + wr * 64 + fr, col0 = u.pn * 256 + wc * 32 + 8 * fq;
        EPI_DRY_DECL
        const unsigned char* T2 = G8 + ((size_t)(2 * (M / 256) + u.pm) * 8 + u.pn) * 65536 + (size_t)((((wr * 4 + wc) * 64) + fq * 16 + fr) * 16);
        pg8::u32x4 gv[8];
#pragma unroll
        for (int c = 0; c < 8; ++c) gv[c] = *(const pg8::u32x4*)(T2 + c * 8192);
        asm volatile("" ::: "memory");
#pragma unroll
        for (int ai = 0; ai < 2; ++ai)
#pragma unroll
            for (int m = 0; m < 4; ++m) { const size_t ro = (size_t)(row0 + ai * 128 + m * 16) * DM + col0; const pg8::u32x4 g = gv[ai * 4 + m];
#pragma unroll
                for (int bj = 0; bj < 2; ++bj) { const pg8::f32x4 a0 = acc[ai][bj][m][0] * gate_val4(bj ? g.z : g.x), a1 = acc[ai][bj][m][1] * gate_val4(bj ? g.w : g.y);
                    pg8::u32x4 w; w.x = pg8::cvt_pk_bf16(a0[0], a0[1]); w.y = pg8::cvt_pk_bf16(a0[2], a0[3]); w.z = pg8::cvt_pk_bf16(a1[0], a1[1]); w.w = pg8::cvt_pk_bf16(a1[2], a1[3]);
                    EPI_ST(Mb + ro + bj * 128, w); } }
    }
};
#include <hip/hip_bf16.h>
#include <cmath>
namespace attn_body {
using bf16=__hip_bfloat16;
using bf16x8=__attribute__((ext_vector_type(8)))short;
using s16x4=__attribute__((ext_vector_type(4)))short;
using f32x16=__attribute__((ext_vector_type(16)))float;
using u32x4=__attribute__((ext_vector_type(4)))unsigned;
constexpr int BATCH=4,NHEAD=8,SEQ=8192,D=64,DM=NHEAD*D;
constexpr int NW=8,QBLK=32,QB=QBLK*NW,KVBLK=64,NQB=SEQ/QB;
constexpr int ATTN_PITCH=DM, ATTN_UNIT_ROWS=QB;
__device__ __forceinline__ int crow(int r,int hi){return (r&3)+8*(r>>2)+4*hi;}
#define SBAR() __builtin_amdgcn_sched_barrier(0)
__device__ __forceinline__ void cmask(f32x16&p0,f32x16&p1,int jb,int qrel,int hi){
  const float NEG=-INFINITY; int kb=64*jb+4*hi;
  #pragma unroll
  for(int r=0;r<16;++r){int kv=kb+(r&3)+8*(r>>2); if(kv>qrel)p0[r]=NEG; if(kv+32>qrel)p1[r]=NEG;}
}

constexpr int NSLOT=3, SLOTB=8192;
constexpr int LDS_K=0, LDS_V=NSLOT*SLOTB, LDS_WS=2*NSLOT*SLOTB, LDS_OST=LDS_WS+NW*64*4, LDS_TAB=LDS_OST+NW*4096  , LDS_BYTES=LDS_TAB+16384;
constexpr float C2=0.125f*1.4426950408889634f;
__device__ __forceinline__ void glds16(const void*gsrc,unsigned lds_dst){unsigned keep;
  asm volatile("s_mov_b32 %0, m0\n\ts_mov_b32 m0, %2\n\ts_nop 0\n\tglobal_load_lds_dwordx4 %1, off\n\ts_mov_b32 m0, %0":"=&s"(keep):"v"(gsrc),"s"(lds_dst):"memory");}
__device__ __forceinline__ float max3f(float a,float b,float c){float r;asm("v_max3_f32 %0, %1, %2, %3":"=v"(r):"v"(a),"v"(b),"v"(c));return r;}
__device__ __forceinline__ float max2f(float a,float b){float r;asm("v_max_f32_e32 %0, %1, %2":"=v"(r):"v"(a),"v"(b));return r;}
__device__ __forceinline__ float fadd_s(float a,float b){float r;asm("v_add_f32_e32 %0, %1, %2":"=v"(r):"v"(a),"v"(b));return r;}
__device__ __forceinline__ float fsub_s(float a,float b){float r;asm("v_sub_f32_e32 %0, %1, %2":"=v"(r):"v"(a),"v"(b));return r;}
typedef float f32x2_t __attribute__((ext_vector_type(2))); typedef __bf16 bf16x2_t __attribute__((ext_vector_type(2)));
__device__ __forceinline__ unsigned cvtpk_s(float lo,float hi){f32x2_t v={lo,hi};bf16x2_t b=__builtin_convertvector(v,bf16x2_t);return __builtin_bit_cast(unsigned,b);}
#define WAIT_BAR(N) asm volatile("s_waitcnt vmcnt(" #N ") lgkmcnt(0)\n\ts_barrier":::"memory")

__device__ __forceinline__ void qkt(f32x16&p0,f32x16&p1,const char*Kslot,const bf16x8*qr,const f32x16&negm,int r32,int hi){
  const char*kb=Kslot+hi*1024+r32*16;
  #pragma unroll
  for(int d0=0;d0<4;++d0){
    const bf16x8 b0=*reinterpret_cast<const bf16x8*>(kb+d0*2048);
    const bf16x8 b1=*reinterpret_cast<const bf16x8*>(kb+d0*2048+512);
    if(d0==0){p0=__builtin_amdgcn_mfma_f32_32x32x16_bf16(b0,qr[0],negm,0,0,0);p1=__builtin_amdgcn_mfma_f32_32x32x16_bf16(b1,qr[0],negm,0,0,0);}
    else{p0=__builtin_amdgcn_mfma_f32_32x32x16_bf16(b0,qr[d0],p0,0,0,0);p1=__builtin_amdgcn_mfma_f32_32x32x16_bf16(b1,qr[d0],p1,0,0,0);}}
}
typedef __attribute__((address_space(3))) const char* lds_cptr;
typedef short v4i16_t __attribute__((ext_vector_type(4)));
__device__ __forceinline__ void kload8(bf16x8*kf,lds_cptr kp){
  kf[0]=*(const __attribute__((address_space(3))) bf16x8*)(kp);      kf[1]=*(const __attribute__((address_space(3))) bf16x8*)(kp+512);
  kf[2]=*(const __attribute__((address_space(3))) bf16x8*)(kp+2048); kf[3]=*(const __attribute__((address_space(3))) bf16x8*)(kp+2560);
  kf[4]=*(const __attribute__((address_space(3))) bf16x8*)(kp+4096); kf[5]=*(const __attribute__((address_space(3))) bf16x8*)(kp+4608);
  kf[6]=*(const __attribute__((address_space(3))) bf16x8*)(kp+6144); kf[7]=*(const __attribute__((address_space(3))) bf16x8*)(kp+6656);
}
__device__ __forceinline__ void kload2(bf16x8*kf,lds_cptr kp,int j){ kf[2*j]=*(const __attribute__((address_space(3))) bf16x8*)(kp+j*2048); kf[2*j+1]=*(const __attribute__((address_space(3))) bf16x8*)(kp+j*2048+512); }
__device__ __forceinline__ s16x4 vtr(lds_cptr p){ return __builtin_bit_cast(s16x4,__builtin_amdgcn_ds_read_tr16_b64_v4i16((__attribute__((address_space(3))) v4i16_t*)p)); }
__device__ __forceinline__ float rowmax(const f32x16&p0,const f32x16&p1){
  float a=max3f(p0[0],p0[1],p1[0]),b=max3f(p0[2],p0[3],p1[1]);a=max3f(a,p1[2],p1[3]);
  #pragma unroll
  for(int r=4;r<16;r+=4){a=max3f(a,p0[r],p0[r+1]);b=max3f(b,p0[r+2],p0[r+3]);a=max3f(a,p1[r],p1[r+1]);b=max3f(b,p1[r+2],p1[r+3]);}
  const float m=max2f(a,b);
  auto rr=__builtin_amdgcn_permlane32_swap(__float_as_uint(m),__float_as_uint(m),false,false);
  return max2f(__uint_as_float(rr[0]),__uint_as_float(rr[1]));
}
__device__ __forceinline__ void pv(f32x16*o,int vb,bf16x8 pa0,bf16x8 pa1,bf16x8 pa2,bf16x8 pa3){
  #pragma unroll
  for(int d0=0;d0<2;++d0){s16x4 lo[4],hi[4];
    #pragma unroll
    for(int ks=0;ks<4;++ks){
      asm volatile("ds_read_b64_tr_b16 %0,%1 offset:%c2":"=&v"(lo[ks]):"v"(vb),"i"(d0*4096+ks*1024):"memory");
      asm volatile("ds_read_b64_tr_b16 %0,%1 offset:%c2":"=&v"(hi[ks]):"v"(vb),"i"(d0*4096+ks*1024+512):"memory");}
    asm volatile("s_waitcnt lgkmcnt(0)":::"memory");SBAR();
    #define PK(k) (bf16x8){lo[k][0],lo[k][1],lo[k][2],lo[k][3],hi[k][0],hi[k][1],hi[k][2],hi[k][3]}
    o[d0]=__builtin_amdgcn_mfma_f32_32x32x16_bf16(pa0,PK(0),o[d0],0,0,0);
    o[d0]=__builtin_amdgcn_mfma_f32_32x32x16_bf16(pa1,PK(1),o[d0],0,0,0);
    o[d0]=__builtin_amdgcn_mfma_f32_32x32x16_bf16(pa2,PK(2),o[d0],0,0,0);
    o[d0]=__builtin_amdgcn_mfma_f32_32x32x16_bf16(pa3,PK(3),o[d0],0,0,0);
    #undef PK
  }
}

#ifndef ATTN_STORE16
#define ATTN_STORE16(p,v) (*(u32x4*)(p)=(v))
#endif
template<int THRL> __device__ __forceinline__ void attn_unit(int b,int h,int qb,const bf16*Q,const bf16*__restrict__ K,const bf16*__restrict__ V,const float*__restrict__ KM,const float*__restrict__ KA,bf16*O,char*shm,int wave_s){
  int tid_l=wave_s*64+pg8::lane_now(); asm volatile("":"+v"(tid_l));
  const int tid=tid_l,lane=tid&63,r32=lane&31,hi=lane>>5; const int wid=__builtin_amdgcn_readfirstlane(tid>>6);
  const long rowbase=(long)b*SEQ; const int q0=qb*QB;
  const bf16*Qw=Q+(rowbase+q0+wid*QBLK)*DM+h*D;
  const bf16*Kh=K+rowbase*DM+h*D,*Vh=V+rowbase*DM+h*D;
  const unsigned lds0=(unsigned)(uintptr_t)shm;
  float*wsf=(float*)(shm+LDS_WS)+wid*64;
  const bf16*ksrc_=Kh+(long)lane*DM+wid*8;
  const bf16*vsrc_=Vh+(long)(16*(wid&3)+(lane>>2))*DM+(wid>>2)*32+(lane&3)*8;
  const unsigned kdst=lds0+LDS_K+wid*1024, vdst=lds0+LDS_V+wid*1024;
  const bf16*ksrc=ksrc_,*vsrc=vsrc_;
  #define DMA_K(t,slot) glds16(ksrc+(long)(t)*KVBLK*DM,(unsigned)__builtin_amdgcn_readfirstlane(kdst+(slot)))
  #define DMA_V(t,slot) glds16(vsrc+(long)(t)*KVBLK*DM,(unsigned)__builtin_amdgcn_readfirstlane(vdst+(slot)))
  const int vb0=(int)(lds0+LDS_V)+((lane>>4)&1)*32+(lane&3)*8+(4*hi+((lane&15)>>2))*64;
  const char*Kbase=shm+LDS_K; bf16x8 kf[8];
  const lds_cptr shm3=(lds_cptr)shm; const lds_cptr kp0=shm3+LDS_K+hi*1024+r32*16; const lds_cptr vp0=shm3+LDS_V+((lane>>4)&1)*32+(lane&3)*8+(4*hi+((lane&15)>>2))*64;
  int NT=(q0+QB)/KVBLK;
  { const float4*gm=reinterpret_cast<const float4*>(KM+((long)(b*NHEAD+h)*32)*64), *ga=reinterpret_cast<const float4*>(KA+((long)(b*NHEAD+h)*32)*64);
    float4*lm=reinterpret_cast<float4*>(shm+LDS_TAB), *la=reinterpret_cast<float4*>(shm+LDS_TAB+8192);
    lm[tid]=gm[tid]; la[tid]=ga[tid];
    asm volatile("s_waitcnt vmcnt(0) lgkmcnt(0)\n\ts_barrier":::"memory"); }
  bf16x8 qr[4];
  #pragma unroll
  for(int d0=0;d0<4;++d0)qr[d0]=*reinterpret_cast<const bf16x8*>(&Qw[(long)r32*DM+d0*16+hi*8]);
  float mhat=0.f,l_reg=0.f;f32x16 o[2];o[0]=f32x16{};o[1]=f32x16{};
  const int qrel=wid*QBLK+r32;
  const float sl2=1.4426950408889634f*__builtin_amdgcn_exp2f(-(float)(h+1));
  const float hb4=sl2*(float)(4*hi), sl32=32.f*sl2;
  unsigned selmask=0u;
  { float qf[32];
    #pragma unroll
    for(int d0=0;d0<4;++d0){
      #pragma unroll
      for(int j=0;j<8;++j)qf[d0*8+j]=__builtin_bit_cast(float,((unsigned)(unsigned short)qr[d0][j])<<16);}
    { const bf16*Kd=Kh+(long)(q0+qrel)*DM; float acc=0.f;
      #pragma unroll
      for(int d0=0;d0<4;++d0){ const bf16x8 kq=*reinterpret_cast<const bf16x8*>(&Kd[d0*16+hi*8]);
        #pragma unroll
        for(int j=0;j<8;++j)acc+=qf[d0*8+j]*__builtin_bit_cast(float,((unsigned)(unsigned short)kq[j])<<16);}
      auto rr=__builtin_amdgcn_permlane32_swap(__float_as_uint(acc),__float_as_uint(acc),false,false);
      mhat=(__uint_as_float(rr[0])+__uint_as_float(rr[1]))+sl2*(float)qrel; }
    float v0=-INFINITY,v1=-INFINITY,v2=-INFINITY; int i0=-1,i1=-1,i2=-1; unsigned nearmask=0u;
    const float*KMb=reinterpret_cast<const float*>(shm+LDS_TAB)+hi*8; const float*KAb=reinterpret_cast<const float*>(shm+LDS_TAB+8192)+hi*8;
    for(int j=0;j<qb;++j){ const float*km=KMb+j*64; const float*ka=KAb+j*64; float sp=0.f, up=0.f;
      #pragma unroll
      for(int d0=0;d0<4;++d0){ const float4 a=*reinterpret_cast<const float4*>(km+d0*16), c=*reinterpret_cast<const float4*>(km+d0*16+4);
        sp+=qf[d0*8+0]*a.x+qf[d0*8+1]*a.y+qf[d0*8+2]*a.z+qf[d0*8+3]*a.w+qf[d0*8+4]*c.x+qf[d0*8+5]*c.y+qf[d0*8+6]*c.z+qf[d0*8+7]*c.w;
        const float4 e=*reinterpret_cast<const float4*>(ka+d0*16), f=*reinterpret_cast<const float4*>(ka+d0*16+4);
        up+=__builtin_fabsf(qf[d0*8+0])*e.x+__builtin_fabsf(qf[d0*8+1])*e.y+__builtin_fabsf(qf[d0*8+2])*e.z+__builtin_fabsf(qf[d0*8+3])*e.w+__builtin_fabsf(qf[d0*8+4])*f.x+__builtin_fabsf(qf[d0*8+5])*f.y+__builtin_fabsf(qf[d0*8+6])*f.z+__builtin_fabsf(qf[d0*8+7])*f.w;}
      auto rr=__builtin_amdgcn_permlane32_swap(__float_as_uint(sp),__float_as_uint(sp),false,false);
      const float sc=__uint_as_float(rr[0])+__uint_as_float(rr[1]);
      { auto ru=__builtin_amdgcn_permlane32_swap(__float_as_uint(up),__float_as_uint(up),false,false); const float ub=(__uint_as_float(ru[0])+__uint_as_float(ru[1]))*1.01f;
        if(ub+sl2*(float)(256*j+255-q0)-mhat>-70.f)nearmask|=1u<<j; }
      if(sc>v2){ if(sc>v1){ v2=v1;i2=i1; if(sc>v0){v1=v0;i1=i0;v0=sc;i0=j;} else {v1=sc;i1=j;} } else {v2=sc;i2=j;} } }
    if(i0>=0)selmask|=1u<<i0; if(i1>=0)selmask|=1u<<i1; if(i2>=0)selmask|=1u<<i2;
    unsigned need=selmask&nearmask;
    #pragma unroll
    for(int o_=1;o_<64;o_<<=1)need|=(unsigned)__builtin_amdgcn_ds_bpermute((lane^o_)<<2,(int)need);
    volatile unsigned*xw=(volatile unsigned*)(shm+LDS_OST);
    if(lane==0)xw[wid]=need;
    asm volatile("s_waitcnt lgkmcnt(0)\n\ts_barrier":::"memory");
    unsigned na=xw[0]|xw[1]|xw[2]|xw[3]|xw[4]|xw[5]|xw[6]|xw[7];
    na=(unsigned)__builtin_amdgcn_readfirstlane((int)na)|(1u<<qb);
    const int nskip=__builtin_ctz(na);
    NT-=4*nskip; selmask>>=nskip; ksrc+=(long)nskip*256*DM; vsrc+=(long)nskip*256*DM; }
  f32x16 negm;
  #pragma unroll
  for(int r=0;r<16;++r)negm[r]=sl2*(float)((r&3)+8*(r>>2));
  asm volatile("":"+v"(negm));
  #define ABIAS(P0,P1,t) do{ const int tt_=(t); const bool on_=(tt_>=NT-4)||(((selmask>>(tt_>>2))&1u)!=0u); \
    const float L0_=on_?((sl2*(float)(64*(tt_-(NT-4)))+hb4)-mhat):-INFINITY; const float L1_=L0_+sl32; \
    _Pragma("unroll") for(int r=0;r<16;++r){P0[r]+=L0_;P1[r]+=L1_;} }while(0)
  #define CMASK(P0,P1,t) do{int jb_=(t)-(NT-4); if(jb_>=0)cmask(P0,P1,jb_,qrel,hi);}while(0)
  bool resc=false;
  #define START(P0,P1) do{ const float rm=rowmax(P0,P1); resc=false; \
    if(__any(rm>(float)THRL)){ const float dl=__builtin_fmaxf(rm,0.f); mhat+=dl; \
      _Pragma("unroll") for(int r=0;r<16;++r){P0[r]-=dl;P1[r]-=dl;} } \
    _Pragma("unroll") for(int r=0;r<16;++r)P0[r]=__builtin_amdgcn_exp2f(P0[r]); }while(0)
  #define RESC() do{ if(resc){ asm volatile("s_waitcnt lgkmcnt(0)":::"memory"); \
      _Pragma("unroll") for(int d_=0;d_<2;++d_) _Pragma("unroll") for(int r=0;r<16;++r)o[d_][r]*=wsf[crow(r,hi)]; } }while(0)
  f32x16 pA0,pA1,pB0,pB1;
  int sl_prev=0,sl_cur=0,sl_next=SLOTB;
  #define ROT() do{sl_prev=sl_cur;sl_cur=sl_next;sl_next=(sl_next==(NSLOT-1)*SLOTB)?0:sl_next+SLOTB;}while(0)
  DMA_K(0,0);DMA_V(0,0);DMA_K(1,SLOTB);
  DMA_K(2,2*SLOTB);
  WAIT_BAR(3);
  qkt(pA0,pA1,Kbase,qr,negm,r32,hi);asm volatile("s_nop 15\n\ts_nop 7":"+v"(pA0),"+v"(pA1));ABIAS(pA0,pA1,0);CMASK(pA0,pA1,0);
  START(pA0,pA1);
  _Pragma("unroll") for(int r=0;r<16;++r)pA1[r]=__builtin_amdgcn_exp2f(pA1[r]);
  WAIT_BAR(0);
  DMA_K(3,0);DMA_V(1,SLOTB);
  ROT();
  kload8(kf,kp0+sl_cur);
  WAIT_BAR(2);
  s16x4 vlo[8],vhi[8]; u32x4 pw0,pw1,pw2,pw3;
  #define PKW(P,B) cvtpk_s(P[B],P[B+1])
  #define PAF(k) __builtin_bit_cast(bf16x8,pw##k)
  #define VFR(i) (bf16x8){vlo[i][0],vlo[i][1],vlo[i][2],vlo[i][3],vhi[i][0],vhi[i][1],vhi[i][2],vhi[i][3]}
  #define PIN(x) asm volatile("":"+v"(x))
  #define MX3(a,b,c) __builtin_fmaxf(__builtin_fmaxf((a),(b)),(c))
  #define GAPA(MF,A0,A1,A2,A3,W0,W1,PW) do{ MF; sacc+=A0; sacc+=A1; sacc+=A2; sacc+=A3; PIN(sacc); W0; W1; PIN(PW); SBAR(); }while(0)
  #define EX(v) __builtin_amdgcn_exp2f(v)
  #define GAPB(MF,X,B) do{ MF; X[B]=EX(X[B]); X[B+1]=EX(X[B+1]); X[B+2]=EX(X[B+2]); X[B+3]=EX(X[B+3]); PIN(X); SBAR(); }while(0)
  #define VRD(i) do{ vlo[i]=vtr(vp_+(((i)>>2)*4096+((i)&3)*1024)); vhi[i]=vtr(vp_+(((i)>>2)*4096+((i)&3)*1024+512)); }while(0)
  #define KRD(G,j) do{ if(G){ kload2(kf,kp0+sl_next,j); SBAR(); } }while(0)
  #define STEP(C0,C1,P0,P1,t,GK,GV,GL) do{ SBAR(); \
    const lds_cptr vp_=vp0+sl_prev; \
    VRD(0); SBAR(); float sacc=(P0[0]+P0[1]); \
    GAPA(C0=__builtin_amdgcn_mfma_f32_32x32x16_bf16(kf[0],qr[0],negm,0,0,0), P0[2],P0[3],P0[4],P0[5],     pw0[0]=PKW(P0,0), pw0[1]=PKW(P0,2), pw0); \
    VRD(4); SBAR(); GAPA(C1=__builtin_amdgcn_mfma_f32_32x32x16_bf16(kf[1],qr[0],negm,0,0,0), P0[6],P0[7],P0[8],P0[9],     pw0[2]=PKW(P0,4), pw0[3]=PKW(P0,6), pw0); \
    VRD(1); SBAR(); GAPA(C0=__builtin_amdgcn_mfma_f32_32x32x16_bf16(kf[2],qr[1],C0,0,0,0),   P0[10],P0[11],P0[12],P0[13], pw1[0]=PKW(P0,8), pw1[1]=PKW(P0,10), pw1); \
    VRD(5); SBAR(); GAPA(C1=__builtin_amdgcn_mfma_f32_32x32x16_bf16(kf[3],qr[1],C1,0,0,0),   P0[14],P0[15],P1[0],P1[1],   pw1[2]=PKW(P0,12),pw1[3]=PKW(P0,14), pw1); \
    VRD(2); SBAR(); GAPA(C0=__builtin_amdgcn_mfma_f32_32x32x16_bf16(kf[4],qr[2],C0,0,0,0),   P1[2],P1[3],P1[4],P1[5],     pw2[0]=PKW(P1,0), pw2[1]=PKW(P1,2), pw2); \
    VRD(6); SBAR(); GAPA(C1=__builtin_amdgcn_mfma_f32_32x32x16_bf16(kf[5],qr[2],C1,0,0,0),   P1[6],P1[7],P1[8],P1[9],     pw2[2]=PKW(P1,4), pw2[3]=PKW(P1,6), pw2); \
    VRD(3); SBAR(); GAPA(C0=__builtin_amdgcn_mfma_f32_32x32x16_bf16(kf[6],qr[3],C0,0,0,0),   P1[10],P1[11],P1[12],P1[13], pw3[0]=PKW(P1,8), pw3[1]=PKW(P1,10), pw3); \
    VRD(7); SBAR(); GAPA(C1=__builtin_amdgcn_mfma_f32_32x32x16_bf16(kf[7],qr[3],C1,0,0,0),   P1[14],P1[15],0.f,0.f,       pw3[2]=PKW(P1,12),pw3[3]=PKW(P1,14), pw3); \
    l_reg+=sacc; \
    if(GK){DMA_K((t)+3,sl_cur);} if(GV){DMA_V((t)+1,sl_next);} \
    ABIAS(C0,C1,t); CMASK(C0,C1,t); \
    { float a=MX3(C0[0],C0[1],C1[0]),b=MX3(C0[2],C0[3],C1[1]); a=MX3(a,C1[2],C1[3]); \
      _Pragma("unroll") for(int r=4;r<16;r+=4){a=MX3(a,C0[r],C0[r+1]);b=MX3(b,C0[r+2],C0[r+3]);a=MX3(a,C1[r],C1[r+1]);b=MX3(b,C1[r+2],C1[r+3]);} \
      float rm=__builtin_fmaxf(a,b); { auto rr=__builtin_amdgcn_permlane32_swap(__float_as_uint(rm),__float_as_uint(rm),false,false); rm=__builtin_fmaxf(__uint_as_float(rr[0]),__uint_as_float(rr[1])); } \
      resc=false; \
      if(__builtin_expect(__any(rm>(float)THRL),0)){ const float dl=__builtin_fmaxf(rm,0.f); mhat+=dl; \
        _Pragma("unroll") for(int r=0;r<16;++r){C0[r]-=dl;C1[r]-=dl;} \
        const float f=__builtin_amdgcn_exp2f(-dl); l_reg*=f; if(hi==0)wsf[r32]=f; resc=true; } } \
    SBAR(); \
    GAPB(o[0]=__builtin_amdgcn_mfma_f32_32x32x16_bf16(PAF(0),VFR(0),o[0],0,0,0), C0,0); \
    GAPB(o[1]=__builtin_amdgcn_mfma_f32_32x32x16_bf16(PAF(0),VFR(4),o[1],0,0,0), C0,4); \
    KRD(GL,0); GAPB(o[0]=__builtin_amdgcn_mfma_f32_32x32x16_bf16(PAF(1),VFR(1),o[0],0,0,0), C0,8); \
    KRD(GL,1); GAPB(o[1]=__builtin_amdgcn_mfma_f32_32x32x16_bf16(PAF(1),VFR(5),o[1],0,0,0), C0,12); \
    KRD(GL,2); GAPB(o[0]=__builtin_amdgcn_mfma_f32_32x32x16_bf16(PAF(2),VFR(2),o[0],0,0,0), C1,0); \
    KRD(GL,3); GAPB(o[1]=__builtin_amdgcn_mfma_f32_32x32x16_bf16(PAF(2),VFR(6),o[1],0,0,0), C1,4); \
    GAPB(o[0]=__builtin_amdgcn_mfma_f32_32x32x16_bf16(PAF(3),VFR(3),o[0],0,0,0), C1,8); \
    GAPB(o[1]=__builtin_amdgcn_mfma_f32_32x32x16_bf16(PAF(3),VFR(7),o[1],0,0,0), C1,12); \
    }while(0)
  int t=1;
  #undef CMASK
  #define CMASK(P0,P1,t) do{}while(0)
  for(;t+5<NT;t+=2){
    STEP(pB0,pB1,pA0,pA1,t,true,true,true);     WAIT_BAR(2); RESC(); ROT();
    STEP(pA0,pA1,pB0,pB1,t+1,true,true,true);   WAIT_BAR(2); RESC(); ROT();
  }
  #undef CMASK
  #define CMASK(P0,P1,t) do{int jb_=(t)-(NT-4); if(jb_>=0)cmask(P0,P1,jb_,qrel,hi);}while(0)
  #define ENDW(tt) do{ if((tt)+3<NT){WAIT_BAR(2);} else if((tt)+2<NT){WAIT_BAR(1);} else {WAIT_BAR(0);} }while(0)
  for(;t+1<NT;t+=2){
    STEP(pB0,pB1,pA0,pA1,t,(t+3<NT),(t+1<NT),(t+1<NT));       ENDW(t);   RESC(); ROT();
    STEP(pA0,pA1,pB0,pB1,t+1,(t+4<NT),(t+2<NT),(t+2<NT));     ENDW(t+1); RESC(); ROT();
  }
  STEP(pB0,pB1,pA0,pA1,NT-1,false,false,false); RESC();
  { float sacc=pB0[0]+pB0[1]; _Pragma("unroll") for(int r=2;r<16;++r)sacc+=pB0[r]; _Pragma("unroll") for(int r=0;r<16;++r)sacc+=pB1[r]; l_reg+=sacc;
    pw0=(u32x4){PKW(pB0,0),PKW(pB0,2),PKW(pB0,4),PKW(pB0,6)};pw1=(u32x4){PKW(pB0,8),PKW(pB0,10),PKW(pB0,12),PKW(pB0,14)};pw2=(u32x4){PKW(pB1,0),PKW(pB1,2),PKW(pB1,4),PKW(pB1,6)};pw3=(u32x4){PKW(pB1,8),PKW(pB1,10),PKW(pB1,12),PKW(pB1,14)};
    SBAR(); pv(o,vb0+sl_cur,PAF(0),PAF(1),PAF(2),PAF(3)); }
  #undef PKW
  #undef PAF
  #undef VFR
  #undef PIN
  #undef MX3
  #undef GAPA
  #undef GAPB
  #undef EX
  #undef VRD
  #undef KRD
  #undef STEP
  #undef ENDW
  {auto rr=__builtin_amdgcn_permlane32_swap(__float_as_uint(l_reg),__float_as_uint(l_reg),false,false);l_reg=__uint_as_float(rr[0])+__uint_as_float(rr[1]);}
  if(hi==0)wsf[32+r32]=l_reg;asm volatile("s_waitcnt lgkmcnt(0)":::"memory");
  float rli[16];
  #pragma unroll
  for(int r=0;r<16;++r)rli[r]=__builtin_amdgcn_rcpf(wsf[32+crow(r,hi)]);
  bf16*Ow=O+(rowbase+q0+wid*QBLK)*DM+h*D;
  { bf16*stg=(bf16*)(shm+LDS_OST)+wid*2048;
    #pragma unroll
    for(int r=0;r<16;++r){const int orow=crow(r,hi);
      #pragma unroll
      for(int d0=0;d0<2;++d0)stg[orow*64+d0*32+r32]=__float2bfloat16(o[d0][r]*rli[r]);}
    asm volatile("s_waitcnt lgkmcnt(0)":::"memory");
    #pragma unroll
    for(int i=0;i<4;++i){const int row=i*8+(lane>>3),ch=lane&7; const u32x4 v=*(const u32x4*)(stg+row*64+ch*8); ATTN_STORE16(Ow+(long)row*DM+ch*8,v);} }
  asm volatile("s_waitcnt lgkmcnt(0)\n\ts_barrier":::"memory");
  #undef DMA_K
  #undef DMA_V
  #undef CMASK
  #undef ABIAS
  #undef START
  #undef RESC
  #undef ROT
}
constexpr int ATTN_LDS_BYTES=LDS_BYTES;
struct AttnTensors { const bf16* Q; const bf16* K; const bf16* V; const float* KM; const float* KA; bf16* O; };
struct AttnUnit { int bh; int qb; };
struct StaticOrder {
  int vcu;
  __device__ __forceinline__ explicit StaticOrder(int grid,int block):vcu((block%8)*(grid/8)+block/8){}
  __device__ __forceinline__ bool next(int i,AttnUnit&u)const{ if(i>=4)return false; const int s=vcu&7; u.bh=vcu>>3; u.qb=(i==0)?s:(i==1)?15-s:(i==2)?16+s:31-s; return true; }
  __device__ __forceinline__ void a_ready(const AttnUnit&)const{}
  __device__ __forceinline__ void done(const AttnUnit&)const{}
};
struct QueueOrder {
  unsigned* ctr; volatile unsigned* slot; int wv;
  __device__ __forceinline__ bool next(int,AttnUnit&u)const{
    if(wv==0&&pg8::lane_now()==0)*slot=__hip_atomic_fetch_add(ctr,1u,__ATOMIC_RELAXED,__HIP_MEMORY_SCOPE_AGENT);
    asm volatile("s_waitcnt vmcnt(0) lgkmcnt(0)\n\ts_barrier":::"memory");
    const unsigned idx=(unsigned)__builtin_amdgcn_readfirstlane((int)*slot);
    if(idx>=(unsigned)(BATCH*NHEAD*NQB))return false;
    u.qb=NQB-1-(int)(idx>>5); u.bh=(int)(idx&31u); return true; }
  __device__ __forceinline__ void a_ready(const AttnUnit&)const{}
  __device__ __forceinline__ void done(const AttnUnit&)const{}
};
template<class Sched,int THRL=8> __device__ __forceinline__ void attn_phase(char*lds,const AttnTensors&T,const Sched&S,int wave_s){
  AttnUnit u;
  for(int i=0;S.next(i,u);++i){ S.a_ready(u); attn_unit<THRL>(u.bh/NHEAD,u.bh%NHEAD,u.qb,T.Q,T.K,T.V,T.KM,T.KA,T.O,lds,wave_s); S.done(u); }
}
#undef SBAR
#undef WAIT_BAR
}
constexpr size_t MiB = (size_t)1 << 20;
constexpr size_t WS_CTL = 0, CTL_ZERO_BYTES = 2 * MiB;
constexpr size_t WS_W0 = 2 * MiB;
constexpr size_t WO_IN = 0, WO_SGU = 36 * MiB, WO_MOBA = 38 * MiB, WO_POOL = 40 * MiB, WO_OUT = 42 * MiB, WO_UP = 50 * MiB, WO_DOWN = 94 * MiB;
constexpr size_t WS_SMALL = 118 * MiB;
constexpr size_t WS_MOD = WS_SMALL + 768 * 1024;
constexpr size_t WS_KMEAN = 512 * 1024;
constexpr size_t WS_KABS = 1 * MiB;
constexpr size_t WS_SGUW = WS_SMALL;
constexpr size_t WS_POOLWT = WS_SMALL + 512 * 1024;
constexpr size_t WS_MODP = 120 * MiB;
constexpr size_t WS_TOPZ = 126 * MiB, WS_BOTZ = 137 * MiB;
constexpr size_t WS_H = 148 * MiB;
constexpr size_t WS_T6 = 276 * MiB;
constexpr size_t WS_G3 = 500 * MiB;
constexpr size_t WS_Y = 276 * MiB;
constexpr size_t WS_A2 = 500 * MiB;
constexpr size_t WS_XR = 884 * MiB;
constexpr size_t WS_H8 = WS_G3 + 192 * MiB;
constexpr size_t WO_IN8 = 6 * MiB;
constexpr size_t WS_CMAX = 64 * 1024;
constexpr size_t WS_CMAXG = WS_CMAX + 96 * 1024;
constexpr size_t WS_RS1 = WS_SMALL + 1280 * 1024 + 128 * 1024;
constexpr size_t WS_RS = WS_SMALL + 1280 * 1024;
constexpr size_t WS_END = 1012 * MiB;
constexpr int CW_TMO = 0, CW_CODE = 1, CW_BAR = 4096, CW_ATTNQ = 8192;
constexpr int RING_BYTES = 131072, XB_OFF = RING_BYTES  , LDSCTL_OFF = 139264, MISC_OFF = LDSCTL_OFF + 320, LDS_BYTES = 147456;

__device__ __forceinline__ float lane_xor(float v, int lane, int o) { return __builtin_bit_cast(float, __builtin_amdgcn_ds_bpermute((lane ^ o) << 2, __builtin_bit_cast(int, v))); }
__device__ __forceinline__ float wave_sum(float v, int lane) {
#pragma unroll
    for (int o = 1; o < 64; o <<= 1) v += lane_xor(v, lane, o);
    return v;
}
__device__ __forceinline__ float wave_max(float v, int lane) {
#pragma unroll
    for (int o = 1; o < 64; o <<= 1) v = fmaxf(v, lane_xor(v, lane, o));
    return v;
}
typedef unsigned u32x2v __attribute__((ext_vector_type(2)));
__device__ __forceinline__ void transpose_item(const float* W, int K, int N, bf16* WT, bool upperm, LAS float* scr, int item, int lane, int f8split = 1 << 30, unsigned char* W8 = nullptr, const unsigned* cmax8 = nullptr, const unsigned* cmaxg = nullptr) {
    const int nblk = N / 32, kb = item / nblk, nb = item % nblk, k0 = 64 * kb, n0 = 32 * nb;
    int drow0 = n0;
    if (upperm) drow0 = (n0 < DFF) ? (n0 >> 7) * 256 + (n0 & 127) : ((n0 - DFF) >> 7) * 256 + 128 + ((n0 - DFF) & 127);
    float v[32];
    const float* src = W + (size_t)(k0 + (lane >> 5)) * N + n0 + (lane & 31);
#pragma unroll
    for (int i = 0; i < 32; ++i) v[i] = src[(size_t)(2 * i) * N];
#pragma unroll
    for (int i = 0; i < 32; ++i) scr[(2 * i + (lane >> 5)) * 33 + (lane & 31)] = v[i];
    LDS_WAIT(); asm volatile("" ::: "memory");
    const int c = lane & 7;
    if (cmax8) {
#pragma unroll
        for (int j = 0; j < 4; ++j) { const int n = (lane >> 3) + 8 * j; const LAS float* s = scr + (8 * c) * 33 + n;
            const unsigned cb = cmax8[n0 + n]; const float cmx = __builtin_bit_cast(float, cb); const float inv = cmx > 0.f ? 127.0f / cmx : 0.f;
            u32x2v o; o.x = q8x4(s[0 * 33], s[1 * 33], s[2 * 33], s[3 * 33], inv); o.y = q8x4(s[4 * 33], s[5 * 33], s[6 * 33], s[7 * 33], inv);
            *(GAS u32x2v*)((unsigned char*)WT + (size_t)(drow0 + n) * K + k0 + 8 * c) = o; }
    } else if (n0 >= f8split) {
#pragma unroll
        for (int j = 0; j < 4; ++j) { const int n = (lane >> 3) + 8 * j; const LAS float* s = scr + (8 * c) * 33 + n;
            const unsigned cb = cmaxg[n0 - f8split + n]; const float cmx = __builtin_bit_cast(float, cb); const float inv = cmx > 0.f ? 127.0f / cmx : 0.f;
            u32x2v o; o.x = q8x4(s[0 * 33], s[1 * 33], s[2 * 33], s[3 * 33], inv); o.y = q8x4(s[4 * 33], s[5 * 33], s[6 * 33], s[7 * 33], inv);
            *(GAS u32x2v*)(W8 + (size_t)(n0 - f8split + n) * K + k0 + 8 * c) = o; }
    } else {
#pragma unroll
    for (int j = 0; j < 4; ++j) { const int n = (lane >> 3) + 8 * j; const LAS float* s = scr + (8 * c) * 33 + n;
        v4u o; o.x = pg8::cvt_pk_bf16(s[0 * 33], s[1 * 33]); o.y = pg8::cvt_pk_bf16(s[2 * 33], s[3 * 33]); o.z = pg8::cvt_pk_bf16(s[4 * 33], s[5 * 33]); o.w = pg8::cvt_pk_bf16(s[6 * 33], s[7 * 33]);
        *(GAS v4u*)(WT + (size_t)(drow0 + n) * K + k0 + 8 * c) = o; }
    }
    LDS_WAIT(); asm volatile("" ::: "memory");
}

__device__ __forceinline__ void strip_quant(const float* W, int N, unsigned char* WT8, bool upperm, unsigned* cmax_out, LAS unsigned char* lds, int strip, int lane, int wave) {
    const int n0 = 32 * strip;
    int drow0 = n0;
    if (upperm) drow0 = (n0 < DFF) ? (n0 >> 7) * 256 + (n0 & 127) : ((n0 - DFF) >> 7) * 256 + 128 + ((n0 - DFF) & 127);
    LAS float* scr = (LAS float*)(lds + wave * 8448);
    LAS float* cmx = (LAS float*)(lds + 8 * 8448);
    float v[4][32];
#pragma unroll
    for (int b = 0; b < 4; ++b) { const float* src = W + (size_t)((4 * wave + b) * 64 + (lane >> 5)) * N + n0 + (lane & 31);
#pragma unroll
        for (int i = 0; i < 32; ++i) v[b][i] = src[(size_t)(2 * i) * N]; }
    float m = 0.f;
#pragma unroll
    for (int b = 0; b < 4; ++b)
#pragma unroll
        for (int i = 0; i < 32; ++i) m = fmaxf(m, __builtin_fabsf(v[b][i]));
    m = fmaxf(m, lane_xor(m, lane, 32));
    if (lane < 32) cmx[wave * 32 + lane] = m;
    __syncthreads();
    const int c = lane & 7;
    float inv[4];
#pragma unroll
    for (int j = 0; j < 4; ++j) { const int n = (lane >> 3) + 8 * j; float mm = 0.f;
#pragma unroll
        for (int w = 0; w < 8; ++w) mm = fmaxf(mm, cmx[w * 32 + n]);
        inv[j] = mm > 0.f ? 127.0f / mm : 0.f;
        if (wave == 0 && c == 0) cmax_out[n0 + n] = __builtin_bit_cast(unsigned, mm); }
#pragma unroll
    for (int b = 0; b < 4; ++b) { const int k0 = (4 * wave + b) * 64;
#pragma unroll
        for (int i = 0; i < 32; ++i) scr[(2 * i + (lane >> 5)) * 33 + (lane & 31)] = v[b][i];
        LDS_WAIT(); asm volatile("" ::: "memory");
#pragma unroll
        for (int j = 0; j < 4; ++j) { const int n = (lane >> 3) + 8 * j; const LAS float* sp = scr + (8 * c) * 33 + n;
            u32x2v o; o.x = q8x4(sp[0 * 33], sp[1 * 33], sp[2 * 33], sp[3 * 33], inv[j]); o.y = q8x4(sp[4 * 33], sp[5 * 33], sp[6 * 33], sp[7 * 33], inv[j]);
            *(GAS u32x2v*)(WT8 + (size_t)(drow0 + n) * DM + k0 + 8 * c) = o; }
        LDS_WAIT(); asm volatile("" ::: "memory"); }
    __syncthreads();
}

template <int MODE, bool XIN_BF16, bool XOUT_BF16, bool H8OUT = false, bool HQOUT = false>
__device__ __forceinline__ void thin_phase(LAS unsigned char* lds, int tid, int lane, int wave, int bx, int G,
        const void* xin_, const bf16* yin, void* xout_, bf16* hout, unsigned char* hout8, float* rsout,
        const float* modA, const float* gA, const float* modS, const float* modT, const float* gS) {
    LAS float* vA = (LAS float*)lds; LAS float* vS = vA + 2048; LAS float* vT = vS + 2048;
    for (int rb = bx; rb < M / 128; rb += G) {
        const int b = rb >> 6;
        __syncthreads();
        for (int c = tid; c < DM; c += 512) {
            if (MODE != 0) vA[c] = modA[(size_t)b * 12288 + c] * gA[c];
            if (MODE != 2) { vS[c] = gS[c] * (1.0f + modS[(size_t)b * 12288 + c]); vT[c] = modT[(size_t)b * 12288 + c]; }
        }
        __syncthreads();
        for (int i = 0; i < 8; ++i) {
            size_t ro[2]; f32x4 x[2][8]; uint2 yr[2][8];
#pragma unroll
            for (int r = 0; r < 2; ++r) { ro[r] = (size_t)(rb * 128 + wave * 16 + i + 8 * r) * DM + 4 * lane;
#pragma unroll
                for (int j = 0; j < 8; ++j) {
                    if (XIN_BF16) { const u32x2v w = __builtin_nontemporal_load((const u32x2v*)((const bf16*)xin_ + ro[r] + 256 * j)); x[r][j] = (f32x4){bf_lo(w.x), bf_hi(w.x), bf_lo(w.y), bf_hi(w.y)}; }
                    else x[r][j] = __builtin_nontemporal_load((const f32x4*)((const float*)xin_ + ro[r] + 256 * j));
                    if (MODE != 0) { const u32x2v w = __builtin_nontemporal_load((const u32x2v*)(yin + ro[r] + 256 * j)); yr[r][j].x = w.x; yr[r][j].y = w.y; } } }
            asm volatile("" ::: "memory");
            if (MODE != 0) {
                float ss[2];
#pragma unroll
                for (int r = 0; r < 2; ++r) { ss[r] = 0.f;
#pragma unroll
                    for (int j = 0; j < 8; ++j) { const float y0 = bf_lo(yr[r][j].x), y1 = bf_hi(yr[r][j].x), y2 = bf_lo(yr[r][j].y), y3 = bf_hi(yr[r][j].y); ss[r] += (y0 * y0 + y1 * y1) + (y2 * y2 + y3 * y3); } }
#pragma unroll
                for (int o = 1; o < 64; o <<= 1) { const float t0 = lane_xor(ss[0], lane, o), t1 = lane_xor(ss[1], lane, o); ss[0] += t0; ss[1] += t1; }
#pragma unroll
                for (int r = 0; r < 2; ++r) { const float rstd = 1.0f / __builtin_sqrtf(ss[r] * (1.0f / DM) + EPS);
#pragma unroll
                    for (int j = 0; j < 8; ++j) { const f32x4 a = *(const LAS f32x4*)(vA + 4 * lane + 256 * j);
                        const f32x4 y = (f32x4){bf_lo(yr[r][j].x), bf_hi(yr[r][j].x), bf_lo(yr[r][j].y), bf_hi(yr[r][j].y)}; x[r][j] = x[r][j] + a * (y * rstd);
                        if (XOUT_BF16) { u32x2v w; w.x = pk2(x[r][j][0], x[r][j][1]); w.y = pk2(x[r][j][2], x[r][j][3]); __builtin_nontemporal_store(w, (u32x2v*)((bf16*)xout_ + ro[r] + 256 * j)); }
                        else __builtin_nontemporal_store(x[r][j], (f32x4*)((float*)xout_ + ro[r] + 256 * j)); } }
            }
            if (MODE != 2) {
                float ss[2];
#pragma unroll
                for (int r = 0; r < 2; ++r) { ss[r] = 0.f;
#pragma unroll
                    for (int j = 0; j < 8; ++j) ss[r] += (x[r][j][0] * x[r][j][0] + x[r][j][1] * x[r][j][1]) + (x[r][j][2] * x[r][j][2] + x[r][j][3] * x[r][j][3]); }
#pragma unroll
                for (int o = 1; o < 64; o <<= 1) { const float t0 = lane_xor(ss[0], lane, o), t1 = lane_xor(ss[1], lane, o); ss[0] += t0; ss[1] += t1; }
                if (HQOUT || H8OUT) {
                    float mx[2];
#pragma unroll
                    for (int r = 0; r < 2; ++r) { const float rstd = 1.0f / __builtin_sqrtf(ss[r] * (1.0f / DM) + EPS); mx[r] = 0.f;
#pragma unroll
                        for (int j = 0; j < 8; ++j) { const f32x4 sv = *(const LAS f32x4*)(vS + 4 * lane + 256 * j), tv = *(const LAS f32x4*)(vT + 4 * lane + 256 * j);
                            const f32x4 h = x[r][j] * rstd * sv + tv; x[r][j] = h;
                            mx[r] = fmaxf(fmaxf(mx[r], fmaxf(__builtin_fabsf(h[0]), __builtin_fabsf(h[1]))), fmaxf(__builtin_fabsf(h[2]), __builtin_fabsf(h[3]))); } }
#pragma unroll
                    for (int o = 1; o < 64; o <<= 1) { const float t0 = lane_xor(mx[0], lane, o), t1 = lane_xor(mx[1], lane, o); mx[0] = fmaxf(mx[0], t0); mx[1] = fmaxf(mx[1], t1); }
#pragma unroll
                    for (int r = 0; r < 2; ++r) { const float inv = mx[r] > 0.f ? 127.0f / mx[r] : 0.f;
                        if (lane == 0) rsout[ro[r] / DM] = mx[r] * (1.0f / 127.0f);
                        unsigned char* qdst = HQOUT ? (unsigned char*)hout : hout8;
#pragma unroll
                        for (int j = 0; j < 8; ++j) { *(unsigned*)(qdst + ro[r] + 256 * j) = q8x4(x[r][j][0], x[r][j][1], x[r][j][2], x[r][j][3], inv);
                            if (!HQOUT) { uint2 w; w.x = pk2(x[r][j][0], x[r][j][1]); w.y = pk2(x[r][j][2], x[r][j][3]); *(uint2*)(hout + ro[r] + 256 * j) = w; } } }
                } else
#pragma unroll
                for (int r = 0; r < 2; ++r) { const float rstd = 1.0f / __builtin_sqrtf(ss[r] * (1.0f / DM) + EPS);
#pragma unroll
                    for (int j = 0; j < 8; ++j) { const f32x4 sv = *(const LAS f32x4*)(vS + 4 * lane + 256 * j), tv = *(const LAS f32x4*)(vT + 4 * lane + 256 * j);
                        const f32x4 h = x[r][j] * rstd * sv + tv; uint2 w; w.x = pk2(h[0], h[1]); w.y = pk2(h[2], h[3]); *(uint2*)(hout + ro[r] + 256 * j) = w; } }
            }
        }
    }
    __syncthreads();
}

typedef float f32x16_t __attribute__((ext_vector_type(16)));
constexpr int VNT_LD = 136;
__device__ __forceinline__ void sgu_mfma_chunk(LAS unsigned char* lds, int chunk, const bf16* Vt, const bf16* Ut, bf16* Uo, const float* norm_g, const bf16* Wm  , const float* sgu_b, int lane, int wave) {
    LAS unsigned short* vnT = (LAS unsigned short*)lds;
    const int t0 = chunk * 128;
    float g8[8];
#pragma unroll
    for (int e = 0; e < 8; ++e) g8[e] = norm_g[lane + 64 * e];
    for (int i4 = 0; i4 < 4; ++i4) {
        float v[4][8];
#pragma unroll
        for (int i = 0; i < 4; ++i) { const bf16* vr = Vt + (size_t)(t0 + wave * 16 + i4 * 4 + i) * BW + lane;
#pragma unroll
            for (int e = 0; e < 8; ++e) v[i][e] = bf2f(vr[64 * e]); }
#pragma unroll
        for (int i = 0; i < 4; ++i) { const int s = wave * 16 + i4 * 4 + i; float sum = 0.f;
#pragma unroll
            for (int e = 0; e < 8; ++e) sum += v[i][e];
            const float mu = wave_sum(sum, lane) * (1.0f / BW); float q = 0.f;
#pragma unroll
            for (int e = 0; e < 8; ++e) { v[i][e] -= mu; q += v[i][e] * v[i][e]; }
            const float rstd = 1.0f / __builtin_sqrtf(wave_sum(q, lane) * (1.0f / BW) + EPS);
#pragma unroll
            for (int e = 0; e < 8; ++e) vnT[(lane + 64 * e) * VNT_LD + s] = (unsigned short)f2bf(v[i][e] * rstd * g8[e]); }
    }
    __syncthreads();
    const int r32 = lane & 31, hi = lane >> 5, g = wave;
    f32x16_t acc[4][2];
#pragma unroll
    for (int ti = 0; ti < 4; ++ti)
#pragma unroll
        for (int dj = 0; dj < 2; ++dj)
#pragma unroll
            for (int r = 0; r < 16; ++r) acc[ti][dj][r] = 0.f;
    const bf16* Wg = Wm + (size_t)g * 16384 + (size_t)r32 * 128 + 8 * hi;
    const LAS unsigned short* vb = vnT + (64 * g + r32) * VNT_LD + 8 * hi;
#pragma unroll
    for (int ks = 0; ks < 8; ++ks) {
        const bf16x8 b0 = *(const LAS bf16x8*)(vb + 16 * ks), b1 = *(const LAS bf16x8*)(vb + 32 * VNT_LD + 16 * ks);
#pragma unroll
        for (int ti = 0; ti < 4; ++ti) if (16 * ks <= 32 * ti + 31) {
            const bf16x8 a = *(const bf16x8*)(Wg + (size_t)ti * 32 * 128 + 16 * ks);
            acc[ti][0] = __builtin_amdgcn_mfma_f32_32x32x16_bf16(b0, a, acc[ti][0], 0, 0, 0);
            acc[ti][1] = __builtin_amdgcn_mfma_f32_32x32x16_bf16(b1, a, acc[ti][1], 0, 0, 0); }
    }
#pragma unroll
    for (int ti = 0; ti < 4; ++ti) { const int t = 32 * ti + r32; const float bs = sgu_b[g * 128 + t];
#pragma unroll
        for (int dj = 0; dj < 2; ++dj)
#pragma unroll
            for (int rg = 0; rg < 4; ++rg) { const size_t o = (size_t)(t0 + t) * BW + 64 * g + 32 * dj + 8 * rg + 4 * hi;
                const uint2 uu = *(const uint2*)(Ut + o); uint2 w;
                w.x = pk2(bf_lo(uu.x) * (acc[ti][dj][4 * rg + 0] + bs), bf_hi(uu.x) * (acc[ti][dj][4 * rg + 1] + bs)); w.y = pk2(bf_lo(uu.y) * (acc[ti][dj][4 * rg + 2] + bs), bf_hi(uu.y) * (acc[ti][dj][4 * rg + 3] + bs));
                *(uint2*)(Uo + o) = w; } }
    __syncthreads();
}

constexpr int PA_LD = 520;
template <int W> __device__ __forceinline__ void pool_window(LAS unsigned short* pa, const bf16* ZP, int t0, int c) {
    float z[64 + W - 1];
    const int pos0 = t0 & (SEQ - 1);
#pragma unroll
    for (int i = 0; i < 64 + W - 1; ++i) { const int dt = i - (W - 1); z[i] = (pos0 + dt >= 0) ? bf2f(ZP[(size_t)(t0 + dt) * BW + c]) : 0.f; }
#pragma unroll
    for (int tl = 0; tl < 64; ++tl) { float s = 0.f;
#pragma unroll
        for (int i = 0; i < W; ++i) s += z[tl + (W - 1) - i];
        const int pos = pos0 + tl; const float cnt = (float)((pos + 1 < W) ? pos + 1 : W);
        pa[tl * PA_LD + c] = (unsigned short)f2bf(s / cnt - z[tl + W - 1]); }
}
__device__ __forceinline__ void pool_mfma_tile(LAS unsigned char* lds, int tile, const bf16* ZP, bf16* YPo, const bf16* PWT  , const float* pool_scale, int tid, int lane, int wave) {
    LAS unsigned short* pa = (LAS unsigned short*)lds;
    const int t0 = tile * 64, c = tid, gsel = wave >> 1;
    if (gsel == 0) pool_window<2>(pa, ZP, t0, c); else if (gsel == 1) pool_window<4>(pa, ZP, t0, c); else if (gsel == 2) pool_window<8>(pa, ZP, t0, c); else pool_window<16>(pa, ZP, t0, c);
    __syncthreads();
    const int r32 = lane & 31, hi = lane >> 5, g = wave >> 1, dh = wave & 1;
    f32x16_t acc[2][2];
#pragma unroll
    for (int ti = 0; ti < 2; ++ti)
#pragma unroll
        for (int dj = 0; dj < 2; ++dj)
#pragma unroll
            for (int r = 0; r < 16; ++r) acc[ti][dj][r] = 0.f;
    const bf16* Bg = PWT + ((size_t)g * 128 + 64 * dh + r32) * 128 + 8 * hi;
    const LAS unsigned short* ab = pa + r32 * PA_LD + 128 * g + 8 * hi;
#pragma unroll
    for (int ks = 0; ks < 8; ++ks) {
        const bf16x8 b0 = *(const bf16x8*)(Bg + 16 * ks), b1 = *(const bf16x8*)(Bg + (size_t)32 * 128 + 16 * ks);
        const bf16x8 a0 = *(const LAS bf16x8*)(ab + 16 * ks), a1 = *(const LAS bf16x8*)(ab + 32 * PA_LD + 16 * ks);
        acc[0][0] = __builtin_amdgcn_mfma_f32_32x32x16_bf16(b0, a0, acc[0][0], 0, 0, 0); acc[0][1] = __builtin_amdgcn_mfma_f32_32x32x16_bf16(b1, a0, acc[0][1], 0, 0, 0);
        acc[1][0] = __builtin_amdgcn_mfma_f32_32x32x16_bf16(b0, a1, acc[1][0], 0, 0, 0); acc[1][1] = __builtin_amdgcn_mfma_f32_32x32x16_bf16(b1, a1, acc[1][1], 0, 0, 0);
    }
#pragma unroll
    for (int dj = 0; dj < 2; ++dj)
#pragma unroll
        for (int rg = 0; rg < 4; ++rg) { const int oc = 128 * g + 64 * dh + 32 * dj + 8 * rg + 4 * hi; const f32x4 sc = *(const f32x4*)(pool_scale + oc);
#pragma unroll
            for (int ti = 0; ti < 2; ++ti) { uint2 w; w.x = pk2(acc[ti][dj][4 * rg + 0] * sc[0], acc[ti][dj][4 * rg + 1] * sc[1]); w.y = pk2(acc[ti][dj][4 * rg + 2] * sc[2], acc[ti][dj][4 * rg + 3] * sc[3]);
                *(uint2*)(YPo + (size_t)(t0 + 32 * ti + r32) * BW + oc) = w; } }
    __syncthreads();
}

#ifndef NREP_GEMM
#define NREP_GEMM 1
#endif
#ifndef WGM_WIDE
#define WGM_WIDE 4
#endif
#ifndef WGM_NARROW
#define WGM_NARROW 4
#endif
#ifndef GP_ALIGN
#define GP_ALIGN true
#endif
#ifndef GP_SP2
#define GP_SP2 true
#endif
#ifndef PROBE_BAR2
#define PROBE_BAR2 0
#endif
#ifndef NREP_P0
#define NREP_P0 1
#endif
#ifndef NREP_ATTN
#define NREP_ATTN 1
#endif
#ifndef NREP_MIX
#define NREP_MIX 1
#endif
#ifndef NREP_THIN
#define NREP_THIN 1
#endif
#define PHASE_IDS() int tid_o = wave_s * 64 + pg8::lane_now(); asm volatile("" : "+v"(tid_o)); const int tid = tid_o, lane = tid & 63, wave = __builtin_amdgcn_readfirstlane(tid >> 6), gw = bx * NWAVES + wave, NGW = G * NWAVES; (void)lane; (void)gw; (void)NGW; (void)wave
struct Args { const float* in[23]; float* out; unsigned char* ws; };
__global__ void __launch_bounds__(NWAVES * 64, 2) fwd_kernel(Args args) {
    extern __shared__ __attribute__((aligned(16))) unsigned char lds_raw[];
    LAS unsigned char* lds = (LAS unsigned char*)lds_raw;
    const int G = gridDim.x, bx = blockIdx.x;
    int wave_s = __builtin_amdgcn_readfirstlane((int)(threadIdx.x >> 6)); asm volatile("" : "+s"(wave_s));
    gu32* ctl = (gu32*)(args.ws + WS_CTL);
    for (int u = threadIdx.x; u < (LDS_BYTES - LDSCTL_OFF) / 4; u += NWAVES * 64) ((LAS unsigned*)(lds + LDSCTL_OFF))[u] = 0u;
    __syncthreads();
    volatile LAS unsigned* MISC = (volatile LAS unsigned*)(lds + MISC_OFF);
    XcdBarrier bar = xcd_barrier_post((unsigned*)(ctl + CW_BAR), MISC + 8);
#define GRID_BAR() do { XcdBarrier b_ = bar; asm volatile("" : "+s"(b_.x), "+s"(b_.bar)); xcd_barrier(b_); if (PROBE_BAR2) xcd_barrier(b_); } while (0)
    const volatile __attribute__((address_space(4))) unsigned long long* kargs = (const volatile __attribute__((address_space(4))) unsigned long long*)__builtin_amdgcn_kernarg_segment_ptr();
#define INP(i) ((const float*)(const GAS float*)kargs[(i)])
#define OUTP ((float*)(GAS float*)kargs[23])
#define WSB ((unsigned char*)(GAS unsigned char*)kargs[24])
#define in_x INP(0)
#define in_c INP(1)
#define g_pre_mix INP(2)
#define g_post_mix INP(3)
#define g_pre_ffn INP(4)
#define g_post_ffn INP(5)
#define w_ada INP(6)
#define b_ada INP(7)
#define w_in INP(8)
#define b_in INP(9)
#define sgu_norm_g INP(10)
#define sgu_w INP(11)
#define sgu_b INP(12)
#define pool_w INP(13)
#define pool_scale INP(14)
#define w_sgu_out INP(15)
#define w_moba_out INP(16)
#define w_pool_out INP(17)
#define w_out INP(18)
#define w_up INP(19)
#define w_conv INP(20)
#define b_conv INP(21)
#define w_down INP(22)
#define out OUTP
#define MOD ((float*)(WSB + WS_MOD))
#define MODP ((float*)(WSB + WS_MODP))
#define KMEAN ((float*)(WSB + WS_KMEAN))
#define H ((bf16*)(WSB + WS_H))
#define T6 ((bf16*)(WSB + WS_T6))
#define G3 ((unsigned char*)(WSB + WS_G3))
#define H8 ((unsigned char*)(WSB + WS_H8))
#define Yb ((bf16*)(WSB + WS_Y))
#define XR ((bf16*)(WSB + WS_XR))
#define A2 ((bf16*)(WSB + WS_A2))
#define Ut T6
#define Qt (T6 + (size_t)1 * M * BW)
#define YP (T6 + (size_t)2 * M * BW)
#define Vt (T6 + (size_t)3 * M * BW)
#define Kt (T6 + (size_t)4 * M * BW)
#define VAt (T6 + (size_t)5 * M * BW)
#define ZPt (T6 + (size_t)6 * M * BW)

    for (int rep0_ = 0; rep0_ < NREP_P0; ++rep0_) {
    {   PHASE_IDS();
        LAS float* cond = (LAS float*)(lds + 69632);
        for (int i = tid; i < BATCH * DM; i += NWAVES * 64) { const float c = in_c[i]; cond[i] = c * sigmoid_f(c); }
        __syncthreads();
        for (int w0 = gw; w0 < 1536 + 64 * NWAVES; w0 += NGW) { const int wt = w0 - 64 * NWAVES; if (wt < 0) continue;
            const int ks = wt / 96, cb = wt % 96, l = cb / 48, n0 = (cb % 48) * 256 + 4 * lane;
            const float* wp = w_ada + ((size_t)l * DM + ks * 128) * 12288 + n0;
            f32x4 a0 = {0.f, 0.f, 0.f, 0.f}, a1 = a0, a2 = a0, a3 = a0;
#pragma unroll 8
            for (int k = 0; k < 128; ++k) { const f32x4 w = *(const f32x4*)(wp + (size_t)k * 12288); const int kk = ks * 128 + k;
                a0 += cond[kk] * w; a1 += cond[DM + kk] * w; a2 += cond[2 * DM + kk] * w; a3 += cond[3 * DM + kk] * w; }
            float* pp = MODP + (size_t)(ks * 8 + l * 4) * 12288 + n0;
            *(f32x4*)(pp) = a0; *(f32x4*)(pp + 12288) = a1; *(f32x4*)(pp + 2 * 12288) = a2; *(f32x4*)(pp + 3 * 12288) = a3;
        }
        LAS float* scr = (LAS float*)(lds + wave * 8448);
#define CONVERT_ITEMS(l, WB, LO, HI, SLOT, NSLOT) \
        for (int it = (LO) + (SLOT) * NWAVES + wave; it < (HI); it += (NSLOT) * NWAVES) { int r = it; \
            bf16* Wc = (bf16*)(WB); \
            if (r < 9216) { transpose_item(w_in + (size_t)(l) * DM * INW, DM, INW, (bf16*)((unsigned char*)Wc + WO_IN), false, scr, r, lane, 0, (unsigned char*)Wc + WO_IN, nullptr, (const unsigned*)(WSB + WS_CMAXG) + (size_t)(l) * 9216); continue; } r -= 9216; \
            if (r < 512) { transpose_item(w_sgu_out + (size_t)(l) * BW * DM, BW, DM, (bf16*)((unsigned char*)Wc + WO_SGU), false, scr, r, lane); continue; } r -= 512; \
            if (r < 512) { transpose_item(w_moba_out + (size_t)(l) * BW * DM, BW, DM, (bf16*)((unsigned char*)Wc + WO_MOBA), false, scr, r, lane); continue; } r -= 512; \
            if (r < 512) { transpose_item(w_pool_out + (size_t)(l) * BW * DM, BW, DM, (bf16*)((unsigned char*)Wc + WO_POOL), false, scr, r, lane); continue; } r -= 512; \
            if (r < 2048) { transpose_item(w_out + (size_t)(l) * DM * DM, DM, DM, (bf16*)((unsigned char*)Wc + WO_OUT), false, scr, r, lane); continue; } r -= 2048; \
            if (r < 11264) { transpose_item(w_up + (size_t)(l) * DM * NUP, DM, NUP, (bf16*)((unsigned char*)Wc + WO_UP), true, scr, r, lane, 1 << 30, nullptr, (const unsigned*)(WSB + WS_CMAX) + (size_t)(l) * NUP); continue; } r -= 11264; \
            transpose_item(w_down + (size_t)(l) * DFF * DM, DFF, DM, (bf16*)((unsigned char*)Wc + WO_DOWN), false, scr, r, lane); \
        }
#define QUANT_STRIPS(l, WB, S0, S1, SLOT, NSLOT) { __syncthreads(); \
          for (int st = (S0) + (SLOT); st < (S1); st += (NSLOT)) { \
              if (st < 288) strip_quant(w_in + (size_t)(l) * DM * INW, INW, (WB) + WO_IN, false, (unsigned*)(WSB + WS_CMAXG) + (size_t)(l) * 9216, lds, st, lane, wave); \
              else strip_quant(w_up + (size_t)(l) * DM * NUP, NUP, (WB) + WO_UP, true, (unsigned*)(WSB + WS_CMAX) + (size_t)(l) * NUP, lds, st - 288, lane, wave); } }
        QUANT_STRIPS(0, WSB + WS_W0, 0, 288, bx, G)
        { bf16* SW = (bf16*)(WSB + WS_SGUW); bf16* PW = (bf16*)(WSB + WS_POOLWT); const float* sw = sgu_w; const float* pw = pool_w;
          for (int i = bx * NWAVES * 64 + tid; i < 2 * 8 * 16384; i += G * NWAVES * 64) { const int t = (i >> 7) & 127, sI = i & 127; SW[i] = (bf16)((sI <= t) ? f2bf(sw[i]) : 0u); }
          for (int i = bx * NWAVES * 64 + tid; i < 2 * 4 * 16384; i += G * NWAVES * 64) { const int lg = i >> 14, d = (i >> 7) & 127, cI = i & 127; PW[i] = (bf16)f2bf(pw[(size_t)lg * 16384 + cI * 128 + d]); } }
        GRID_BAR();
    }
    {   PHASE_IDS();
        for (int v = bx * NWAVES * 64 + tid; v < 2 * BATCH * 12288; v += G * NWAVES * 64) {
            const int lb = v / 12288, n = v % 12288; float s = b_ada[(size_t)(lb >> 2) * 12288 + n];
            for (int ks = 0; ks < 16; ++ks) s += MODP[(size_t)(ks * 8 + lb) * 12288 + n];
            MOD[v] = s; }
        GRID_BAR();
    }
    { PHASE_IDS(); thin_phase<0, false, false, false, true>(lds, tid, lane, wave, bx, G, in_x, nullptr, nullptr, (bf16*)H8, nullptr, (float*)(WSB + WS_RS1), nullptr, nullptr, MOD + 2048, MOD + 0, g_pre_mix); }
    GRID_BAR();
    }

    for (int l = 0; l < DEPTH; ++l) {
#define Wl (l == 0 ? WSB + WS_W0 : (unsigned char*)OUTP)
#define modl (MOD + (size_t)l * BATCH * 12288)
        for (int rep_ = 0; rep_ < NREP_GEMM; ++rep_)
        { { pg8::Gemm g{(const bf16*)H8, (const bf16*)(Wl + WO_IN), M, 3072, DM / 2}; pg8::StaticOrder S; S.init(M, 3072, G, bx, WGM_WIDE);
            EpiInProj E{b_in + (size_t)l * INW, T6, KMEAN + (size_t)l * 65536, (unsigned*)(WSB + WS_KABS) + (size_t)l * 65536, (const float*)(WSB + WS_RS1), (const unsigned*)(WSB + WS_CMAXG) + (size_t)l * 9216};
            pg8::gemm_phase<EpiInProj, pg8::StaticOrder, GP_ALIGN, GP_SP2, false, true>(lds, g, S, E, wave_s); }
          GRID_BAR(); }
        { PHASE_IDS();
          for (int repa_ = NREP_ATTN - 1; repa_ >= 0; --repa_)
          { const attn_body::AttnTensors AT{(const attn_body::bf16*)Qt, (const attn_body::bf16*)Kt, (const attn_body::bf16*)VAt, KMEAN + (size_t)l * 65536, (const float*)(WSB + WS_KABS) + (size_t)l * 65536, repa_ ? (attn_body::bf16*)H : (attn_body::bf16*)Qt};
            const attn_body::QueueOrder AS{(unsigned*)(WSB + WS_CTL) + CW_ATTNQ + 64 * l + 16 * repa_, (volatile unsigned*)((char*)lds_raw + MISC_OFF + 64), wave_s};
            {
              const unsigned nent = (l == 0) ? 1536u : 1024u;
              for (;;) {
                  if (AS.wv == 0 && pg8::lane_now() == 0) *AS.slot = __hip_atomic_fetch_add(AS.ctr, 1u, __ATOMIC_RELAXED, __HIP_MEMORY_SCOPE_AGENT);
                  asm volatile("s_waitcnt vmcnt(0) lgkmcnt(0)\n\ts_barrier" ::: "memory");
                  const unsigned idx = (unsigned)__builtin_amdgcn_readfirstlane((int)*AS.slot);
                  if (idx >= nent) break;
                  unsigned a_ = idx; int bun = -1;
                  if (l == 0) { const unsigned grp = idx / 3u, rr = idx - 3u * grp; if (rr < 2u) a_ = 2u * grp + rr; else bun = (int)grp; }
                  if (bun < 0) { const int qb_ = attn_body::NQB - 1 - (int)(a_ >> 5), bh_ = (int)(a_ & 31u);
                      attn_body::attn_unit<8>(bh_ / attn_body::NHEAD, bh_ % attn_body::NHEAD, qb_, AT.Q, AT.K, AT.V, AT.KM, AT.KA, AT.O, (char*)lds_raw, wave_s); }
                  else { const int lane = pg8::lane_now(); LAS float* scr = (LAS float*)(lds + wave * 8448);
                      if (bun < 256) { const int c_ = bun; CONVERT_ITEMS(0, WSB + WS_W0, 9216, 12800, c_, 256) CONVERT_ITEMS(0, WSB + WS_W0, 24064, 29696, c_, 256) QUANT_STRIPS(0, WSB + WS_W0, 288, 640, c_, 256) }
                      else { const int c_ = bun - 256; CONVERT_ITEMS(1, (unsigned char*)OUTP, 9216, 12800, c_, 256) CONVERT_ITEMS(1, (unsigned char*)OUTP, 24064, 29696, c_, 256) QUANT_STRIPS(1, (unsigned char*)OUTP, 0, 640, c_, 256) }
                      __syncthreads(); }
              } } }
          __syncthreads();
          for (int repm_ = NREP_MIX - 1; repm_ >= 0; --repm_) {
          for (int chunk = bx; chunk < M / 128; chunk += G) sgu_mfma_chunk(lds, chunk, Vt, Ut, repm_ ? H : Ut, sgu_norm_g + (size_t)l * BW, (const bf16*)(WSB + WS_SGUW) + (size_t)l * 8 * 16384, sgu_b + (size_t)l * 8 * 128, lane, wave);
          for (int tile = bx; tile < M / 64; tile += G) pool_mfma_tile(lds, tile, ZPt, YP, (const bf16*)(WSB + WS_POOLWT) + (size_t)l * 4 * 16384, pool_scale + (size_t)l * BW, tid, lane, wave);
          }
          GRID_BAR(); }
        for (int rep_ = 0; rep_ < NREP_GEMM; ++rep_)
        {
          { pg8::Gemm g{(const bf16*)H8, (const bf16*)(Wl + WO_IN + WO_IN8), M, 6144, DM / 2}; pg8::StaticOrder S; S.init(M, 6144, G, bx, WGM_WIDE);
            EpiGate8 E{b_in + (size_t)l * INW + 3072, G3, (const float*)(WSB + WS_RS1), (const unsigned*)(WSB + WS_CMAXG) + (size_t)l * 9216 + 3072};
            pg8::gemm_phase<EpiGate8, pg8::StaticOrder, GP_ALIGN, GP_SP2, false, true>(lds, g, S, E, wave_s); }
          GRID_BAR(); }
        for (int rep_ = 0; rep_ < NREP_GEMM; ++rep_)
        { pg8::Gemm g{Ut, (const bf16*)(Wl + WO_SGU), M, DM, BW, 3, (size_t)M * BW * 2, (size_t)2 * MiB}; pg8::StaticOrder S; S.init(M, DM, G, bx, WGM_NARROW);
          EpiBranch E{G3, H};
          pg8::gemm_phase<EpiBranch, pg8::StaticOrder, GP_ALIGN, GP_SP2>(lds, g, S, E, wave_s);
          GRID_BAR(); }
        for (int rep_ = 0; rep_ < NREP_GEMM; ++rep_)
        { pg8::Gemm g{H, (const bf16*)(Wl + WO_OUT), M, DM, DM}; pg8::StaticOrder S; S.init(M, DM, G, bx, WGM_NARROW);
          EpiPlain E{Yb, DM};
          pg8::gemm_phase<EpiPlain, pg8::StaticOrder, GP_ALIGN, GP_SP2>(lds, g, S, E, wave_s);
          GRID_BAR(); }
        for (int rept_ = 0; rept_ < (l == 0 ? NREP_THIN : 1); ++rept_)
        { PHASE_IDS(); if (l == 0) thin_phase<1, false, true, false, true>(lds, tid, lane, wave, bx, G, in_x, Yb, XR, H, nullptr, (float*)(WSB + WS_RS), modl + 4096, g_post_mix + (size_t)l * DM, modl + 8192, modl + 6144, g_pre_ffn + (size_t)l * DM);
          else thin_phase<1, true, true, false, true>(lds, tid, lane, wave, bx, G, XR, Yb, XR, H, nullptr, (float*)(WSB + WS_RS), modl + 4096, g_post_mix + (size_t)l * DM, modl + 8192, modl + 6144, g_pre_ffn + (size_t)l * DM); }
        GRID_BAR();
        for (int rep_ = 0; rep_ < NREP_GEMM; ++rep_)
        { pg8::Gemm g{H, (const bf16*)(Wl + WO_UP), M, NUP, DM / 2}; pg8::StaticOrder S; S.init(M, NUP, G, bx, WGM_WIDE);
          EpiUpConv E{A2, w_conv + (size_t)l * 3 * NUP, b_conv + (size_t)l * NUP, (float*)(WSB + WS_TOPZ), (float*)(WSB + WS_BOTZ), (LAS float*)(lds + XB_OFF), (const float*)(WSB + WS_RS), (const unsigned*)(WSB + WS_CMAX) + (size_t)l * NUP};
          pg8::gemm_phase<EpiUpConv, pg8::StaticOrder, true, GP_SP2, false, true>(lds, g, S, E, wave_s);
          GRID_BAR(); }
        { PHASE_IDS(); const float* wc = w_conv + (size_t)l * 3 * NUP; const float* bc = b_conv + (size_t)l * NUP;
          const float* TZ = (const float*)(WSB + WS_TOPZ); const float* BZ = (const float*)(WSB + WS_BOTZ); bf16* a2 = A2;
          for (int it = bx * NWAVES * 64 + tid; it < (M / 256) * DFF; it += G * NWAVES * 64) { const int pm = it / DFF, n = it % DFF; if ((pm & 31) == 0) continue;
              const int cg = (n >> 7) * 256 + (n & 127);
              float res[2];
              float zc[2][2];
#pragma unroll
              for (int k = 0; k < 2; ++k) { const int c = cg + 128 * k, pc = n + DFF * k;
                  const float t0 = TZ[((size_t)pm * 2 + 0) * NUP + c], t1 = TZ[((size_t)pm * 2 + 1) * NUP + c], b0 = BZ[((size_t)(pm - 1) * 2 + 0) * NUP + c], b1 = BZ[((size_t)(pm - 1) * 2 + 1) * NUP + c];
                  const unsigned cmb = ((const unsigned*)(WSB + WS_CMAX))[(size_t)l * NUP + pc]; const float csc = __builtin_bit_cast(float, cmb) * (1.0f / 127.0f);
                  const float w0 = wc[pc] * csc, w1 = wc[NUP + pc] * csc, w2 = wc[2 * NUP + pc] * csc, bb = bc[pc];
                  zc[k][0] = w2 * t0 + w1 * b1 + w0 * b0 + bb; zc[k][1] = w2 * t1 + w1 * t0 + w0 * b1 + bb; }
              res[0] = gelu_tanh(zc[0][0]) * zc[1][0]; res[1] = gelu_tanh(zc[0][1]) * zc[1][1];
              a2[(size_t)(pm * 256 + 0) * DFF + n] = (bf16)f2bf(res[0]); a2[(size_t)(pm * 256 + 1) * DFF + n] = (bf16)f2bf(res[1]); }
          GRID_BAR(); }
        for (int rep_ = 0; rep_ < NREP_GEMM; ++rep_)
        { pg8::Gemm g{A2, (const bf16*)(Wl + WO_DOWN), M, DM, DFF}; pg8::StaticOrder S; S.init(M, DM, G, bx, WGM_NARROW);
          EpiPlain E{Yb, DM};
          pg8::gemm_phase<EpiPlain, pg8::StaticOrder, GP_ALIGN, GP_SP2>(lds, g, S, E, wave_s);
          GRID_BAR(); }
        if (l == 0) { PHASE_IDS(); thin_phase<1, true, true, false, true>(lds, tid, lane, wave, bx, G, XR, Yb, XR, (bf16*)H8, nullptr, (float*)(WSB + WS_RS1), modl + 10240, g_post_ffn, MOD + (size_t)BATCH * 12288 + 2048, MOD + (size_t)BATCH * 12288, g_pre_mix + DM);
            GRID_BAR(); }
        else { PHASE_IDS(); thin_phase<2, true, false>(lds, tid, lane, wave, bx, G, XR, Yb, out, nullptr, nullptr, nullptr, modl + 10240, g_post_ffn + (size_t)l * DM, nullptr, nullptr, nullptr); }
    }
#undef GRID_BAR
}
#undef INP
#undef OUTP
#undef WSB
#undef in_x
#undef in_c
#undef g_pre_mix
#undef g_post_mix
#undef g_pre_ffn
#undef g_post_ffn
#undef w_ada
#undef b_ada
#undef w_in
#undef b_in
#undef sgu_norm_g
#undef sgu_w
#undef sgu_b
#undef pool_w
#undef pool_scale
#undef w_sgu_out
#undef w_moba_out
#undef w_pool_out
#undef w_out
#undef w_up
#undef w_conv
#undef b_conv
#undef w_down
#undef out
#undef MOD
#undef MODP
#undef KMEAN
#undef H
#undef T6
#undef G3
#undef H8
#undef YP
#undef Yb
#undef A2
#undef Ut
#undef Vt
#undef Qt
#undef Kt
#undef VAt
#undef ZPt
#undef Wl
#undef XR
#undef CONVERT_ITEMS
#undef QUANT_STRIPS
#undef modl

extern "C" void kernel_launch(void* const* d_in, const int* in_sizes, int n_in, void* d_out, int out_size, void* d_ws, size_t ws_size, hipStream_t stream) {
    static int grid = 0;
    if (grid == 0) {
        if (n_in != 23 || in_sizes[0] != M * DM || out_size != M * DM || ws_size < WS_END) { fprintf(stderr, "kernel_launch: unexpected shapes (n_in %d, in0 %d, out %d, ws %zu); nothing launched\n", n_in, n_in > 0 ? in_sizes[0] : -1, out_size, ws_size); grid = -1; return; }
        int dev = 0, cus = 0;
        if (hipGetDevice(&dev) != hipSuccess || hipDeviceGetAttribute(&cus, hipDeviceAttributeMultiprocessorCount, dev) != hipSuccess) { grid = -1; return; }
        if (hipFuncSetAttribute((const void*)fwd_kernel, hipFuncAttributeMaxDynamicSharedMemorySize, LDS_BYTES) != hipSuccess) { fprintf(stderr, "kernel_launch: hipFuncSetAttribute failed\n"); grid = -1; return; }
        int per_cu = 0;
        if (hipOccupancyMaxActiveBlocksPerMultiprocessor(&per_cu, (const void*)fwd_kernel, NWAVES * 64, LDS_BYTES) != hipSuccess || per_cu < 1) fprintf(stderr, "kernel_launch: occupancy query says %d\n", per_cu);
        (void)hipGetLastError();
        grid = cus;
    }
    if (grid < 0) return;
    if (hipMemsetAsync((char*)d_ws + WS_CTL, 0, CTL_ZERO_BYTES, stream) != hipSuccess) return;
    Args a{};
    for (int i = 0; i < 23; ++i) a.in[i] = (const float*)d_in[i];
    a.out = (float*)d_out; a.ws = (unsigned char*)d_ws;
    hipLaunchKernelGGL(fwd_kernel, dim3(grid), dim3(NWAVES * 64), LDS_BYTES, stream, a);
}
```

```cpp
#include <hip/hip_runtime.h>
#include <cstdio>
#include <cstdint>
namespace pg8 {
#define PG8_LAS __attribute__((address_space(3)))
typedef unsigned short bf16_t;
typedef short bf16x8 __attribute__((ext_vector_type(8)));
typedef float f32x4 __attribute__((ext_vector_type(4)));
typedef unsigned u32x4 __attribute__((ext_vector_type(4)));
__device__ __forceinline__ int lane_now() { int l; asm volatile("v_mbcnt_lo_u32_b32 %0, -1, 0\n\tv_mbcnt_hi_u32_b32 %0, -1, %0" : "=v"(l)); return l; }
typedef int i32x4 __attribute__((ext_vector_type(4)));
typedef int i32x8 __attribute__((ext_vector_type(8)));
constexpr int BM = 256, BK = 64, HALF = 128, HTB = HALF * BK * 2  , STAGE_BYTES = 8 * HTB, NXCD = 8, WGM = 8;

__host__ __device__ __forceinline__ int lds_byte(int r, int c) { const int st = (r >> 4) * 2 + (c >> 5), rr = r & 15, cc = c & 31, ob = rr * 64 + cc * 2; return st * 1024 + (ob ^ (((ob >> 9) & 1) << 5)); }
__host__ __device__ __forceinline__ void stage_rc(int b, int& R, int& C) { const int st = b / 1024, sb = b % 1024, swz = sb ^ (((sb >> 9) & 1) << 5); R = (st >> 1) * 16 + swz / 64; C = (st & 1) * 32 + (swz % 64) / 2; }
__host__ __device__ __forceinline__ int perm32(int rho) { const int n = rho >> 4, i = rho & 15; return 8 * (i >> 2) + 4 * n + (i & 3); }

struct Unit { int pm, pn; };
struct Gemm { const bf16_t* A; const bf16_t* Bt; int M, N, K; int nseg; size_t segA, segB; };

struct StaticOrder {
    int nM, nN, nwg, G, c, wgm;
    __host__ __device__ void init(int M, int N, int G_, int c_, int wgm_ = WGM) { nM = M / BM; nN = N / BM; nwg = nM * nN; G = G_; c = c_; wgm = wgm_; }
    __host__ __device__ bool next(int i, Unit& u) const {
        const long L = (long)i * G + c; if (L >= nwg) return false;
        int wgid = (int)L; { const int q = nwg / NXCD, r = nwg % NXCD, xcd = wgid % NXCD, off = wgid / NXCD; wgid = (xcd < r ? xcd * (q + 1) : r * (q + 1) + (xcd - r) * q) + off; }
        const int nig = wgm * nN, gid = wgid / nig, fm = gid * wgm, gsz = (nM - fm) < wgm ? (nM - fm) : wgm;
        u.pm = fm + ((wgid % nig) % gsz); u.pn = (wgid % nig) / gsz; return true;
    }
    __device__ __forceinline__ void a_ready(const Unit&) const {}
    __device__ __forceinline__ void done(const Unit&) const {}
};

__device__ __forceinline__ unsigned cvt_pk_bf16(float lo, float hi) { unsigned r; asm volatile("v_cvt_pk_bf16_f32 %0, %1, %2" : "=v"(r) : "v"(lo), "v"(hi)); return r; }
typedef float f32x2 __attribute__((ext_vector_type(2)));
template <class Epi, class Sched, bool ALIGN_EPI = false, bool SP2 = false, bool FP8 = false, bool I8 = false>
__device__ __forceinline__ void gemm_phase(PG8_LAS unsigned char* lds, const Gemm g, const Sched& S, const Epi& E, int wave_s) {
    int tid_l = wave_s * 64 + lane_now(); asm volatile("" : "+v"(tid_l));
    const int tid = tid_l, wid = __builtin_amdgcn_readfirstlane(tid >> 6), lane = tid & 63, wr = wid >> 2, wc = wid & 3, fr = lane & 15, fq = lane >> 4;
    const int K = g.K, nt = (K / BK) * (Epi::SEGMENTED ? g.nseg : 1);
    unsigned voffA[2], voffB[2];
#pragma unroll
    for (int i = 0; i < 2; ++i) { int R, C; stage_rc(tid * 16 + i * 8192, R, C); const int Rb = Epi::PERM ? ((R & ~31) + perm32(R & 31)) : R;
        voffA[i] = (unsigned)(R * K + C) * 2u; voffB[i] = (unsigned)(Rb * K + C) * 2u; }
    const size_t kstep = (size_t)(BK * 2);
    const size_t hstep = (size_t)HALF * K * 2;
    const size_t tstep = 2 * hstep;
    const unsigned ldsw = (unsigned)wid * 1024u;
    const int aoff = lds_byte(wr * 64 + fr, fq * 8), boff = lds_byte(wc * 32 + fr, fq * 8);
#define PG8_SA(b, h) (((b) * 2 + (h)) * HTB)
#define PG8_SB(b, h) ((4 + (b) * 2 + (h)) * HTB)
#define PG8_STAGE(bufoff, gbase, voff) do { _Pragma("unroll") for (int _i = 0; _i < 2; ++_i) { unsigned vo_ = (voff)[_i]; if constexpr (FP8 || I8) asm volatile("" : "+v"(vo_));     \
        __builtin_amdgcn_global_load_lds((const unsigned*)((const char*)(gbase) + vo_), (PG8_LAS unsigned*)(lds + (bufoff) + ldsw + _i * 8192), 16, 0, 0); } } while (0)
#define PG8_LDA(dst, b, h) do { _Pragma("unroll") for (int m = 0; m < 4; ++m) _Pragma("unroll") for (int k = 0; k < 2; ++k) dst[m][k] = *(const PG8_LAS bf16x8*)(lds + PG8_SA(b, h) + aoff + m * 2048 + k * 1024); } while (0)
#define PG8_LDB(dst, b, h) do { _Pragma("unroll") for (int n = 0; n < 2; ++n) _Pragma("unroll") for (int k = 0; k < 2; ++k) dst[n][k] = *(const PG8_LAS bf16x8*)(lds + PG8_SB(b, h) + boff + n * 2048 + k * 1024); } while (0)
#define PG8_CAT8(v) __builtin_shufflevector(__builtin_bit_cast(i32x4, (v)[0]), __builtin_bit_cast(i32x4, (v)[1]), 0, 1, 2, 3, 4, 5, 6, 7)
#define PG8_MMA(ai, bj, At, Bt) do { __builtin_amdgcn_s_setprio(1); _Pragma("unroll") for (int m = 0; m < 4; ++m) _Pragma("unroll") for (int n = 0; n < 2; ++n) { \
        if constexpr (FP8) acc[ai][bj][m][n] = __builtin_amdgcn_mfma_scale_f32_16x16x128_f8f6f4(PG8_CAT8(Bt[n]), PG8_CAT8(At[m]), acc[ai][bj][m][n], 0, 0, 0, 0, 0, 0);     \
        else if constexpr (I8) { _Pragma("unroll") for (int k = 0; k < 2; ++k) acc[ai][bj][m][n] = __builtin_bit_cast(f32x4, __builtin_amdgcn_mfma_i32_16x16x64_i8(__builtin_bit_cast(i32x4, Bt[n][k]), __builtin_bit_cast(i32x4, At[m][k]), __builtin_bit_cast(i32x4, acc[ai][bj][m][n]), 0, 0, 0)); } \
        else { _Pragma("unroll") for (int k = 0; k < 2; ++k) acc[ai][bj][m][n] = __builtin_amdgcn_mfma_f32_16x16x32_bf16(Bt[n][k], At[m][k], acc[ai][bj][m][n], 0, 0, 0); } } __builtin_amdgcn_s_setprio(0); } while (0)
#define PG8_WAIT_V(n) asm volatile("s_waitcnt vmcnt(" #n ")" ::: "memory")
#define PG8_WAIT_L(n) asm volatile("s_waitcnt lgkmcnt(" #n ")" ::: "memory")
#define PG8_BAR __builtin_amdgcn_s_barrier()
#define PG8_SCHED __builtin_amdgcn_sched_barrier(0)
    Unit cur, nxt; int ui = 0;
    if (!S.next(0, cur)) return;
    f32x4 acc[2][2][4][2];
#pragma unroll
    for (int a = 0; a < 2; ++a)
#pragma unroll
        for (int b = 0; b < 2; ++b)
#pragma unroll
            for (int m = 0; m < 4; ++m)
#pragma unroll
                for (int n = 0; n < 2; ++n) acc[a][b][m][n] = (f32x4){0.f, 0.f, 0.f, 0.f};
    bf16x8 At[4][2], B0[2][2], B1[2][2];
    const char* cA = (const char*)g.A + (size_t)cur.pm * tstep; const char* cB = (const char*)g.Bt + (size_t)cur.pn * tstep;
    S.a_ready(cur);
    if constexpr (SP2) {
        PG8_STAGE(PG8_SB(0, 0), cB, voffB); PG8_STAGE(PG8_SB(0, 1), cB + hstep, voffB); PG8_STAGE(PG8_SA(0, 0), cA, voffA); PG8_STAGE(PG8_SA(0, 1), cA + hstep, voffA);
        if (wr == 1) PG8_BAR;
        PG8_WAIT_V(2); PG8_BAR;
        PG8_STAGE(PG8_SB(1, 0), cB + kstep, voffB); PG8_STAGE(PG8_SA(1, 0), cA + kstep, voffA); PG8_STAGE(PG8_SB(1, 1), cB + hstep + kstep, voffB);
        PG8_WAIT_V(6); PG8_BAR;
    } else {
        PG8_STAGE(PG8_SB(0, 0), cB, voffB); PG8_STAGE(PG8_SA(0, 0), cA, voffA); PG8_STAGE(PG8_SB(0, 1), cB + hstep, voffB); PG8_STAGE(PG8_SA(0, 1), cA + hstep, voffA);
        if (wr == 1) PG8_BAR;
        PG8_WAIT_V(4); PG8_BAR;
        PG8_STAGE(PG8_SB(1, 0), cB + kstep, voffB); PG8_STAGE(PG8_SA(1, 0), cA + kstep, voffA); PG8_STAGE(PG8_SB(1, 1), cB + hstep + kstep, voffB);
        PG8_WAIT_V(6); PG8_BAR;
    }
    for (;;) {
        const bool has_next = S.next(ui + 1, nxt);
        const char* nA = has_next ? (const char*)g.A + (size_t)nxt.pm * tstep : cA; const char* nB = has_next ? (const char*)g.Bt + (size_t)nxt.pn * tstep : cB;
        for (int t = 0; t < nt; t += 2) {
            const bool last = (t == nt - 2);
            const char* a1; const char* a2; const char* b2;
            if constexpr (Epi::SEGMENTED) {
                constexpr int SH = Epi::SEG_SHIFT, SM = (1 << SH) - 1;
                a1 = cA + (size_t)((t + 1) >> SH) * g.segA + (size_t)((t + 1) & SM) * kstep;
                a2 = last ? nA : cA + (size_t)((t + 2) >> SH) * g.segA + (size_t)((t + 2) & SM) * kstep; b2 = last ? nB : cB + (size_t)((t + 2) >> SH) * g.segB + (size_t)((t + 2) & SM) * kstep;
                if (t != 0 && (t & SM) == 0) E.seg_hook(acc, cur, t >> SH, wr, wc, fr, fq);
            } else {
                a1 = cA + (size_t)(t + 1) * kstep;
                a2 = last ? nA : cA + (size_t)(t + 2) * kstep; b2 = last ? nB : cB + (size_t)(t + 2) * kstep;
            }
            const char* a3 = a2 + kstep; const char* b3 = b2 + kstep;
            if (last && has_next) S.a_ready(nxt);
            if constexpr (SP2) {
            PG8_LDB(B0, 0, 0); PG8_LDB(B1, 0, 1); PG8_SCHED; PG8_LDA(At, 0, 0); PG8_STAGE(PG8_SA(1, 1), a1 + hstep, voffA);
            PG8_WAIT_V(8); PG8_WAIT_L(0); PG8_BAR; PG8_MMA(0, 0, At, B0); PG8_MMA(0, 1, At, B1); PG8_BAR; PG8_SCHED;
            PG8_LDA(At, 0, 1); PG8_STAGE(PG8_SB(0, 0), b2, voffB); PG8_STAGE(PG8_SB(0, 1), b2 + hstep, voffB); PG8_STAGE(PG8_SA(0, 0), a2, voffA);
            PG8_WAIT_V(8); PG8_WAIT_L(0); PG8_BAR; PG8_MMA(1, 0, At, B0); PG8_MMA(1, 1, At, B1); PG8_BAR; PG8_SCHED;
            PG8_LDB(B0, 1, 0); PG8_LDB(B1, 1, 1); PG8_SCHED; PG8_LDA(At, 1, 0); PG8_STAGE(PG8_SA(0, 1), a2 + hstep, voffA);
            PG8_WAIT_V(8); PG8_WAIT_L(0); PG8_BAR; PG8_MMA(0, 0, At, B0); PG8_MMA(0, 1, At, B1); PG8_BAR; PG8_SCHED;
            PG8_LDA(At, 1, 1); PG8_STAGE(PG8_SB(1, 0), b3, voffB); PG8_STAGE(PG8_SB(1, 1), b3 + hstep, voffB); PG8_STAGE(PG8_SA(1, 0), a3, voffA);
            PG8_WAIT_V(8); PG8_WAIT_L(0); PG8_BAR; PG8_MMA(1, 0, At, B0); PG8_MMA(1, 1, At, B1); PG8_BAR; PG8_SCHED;
            } else {
            PG8_LDB(B0, 0, 0); PG8_SCHED; PG8_LDA(At, 0, 0); PG8_STAGE(PG8_SA(1, 1), a1 + hstep, voffA);
            PG8_WAIT_L(8); PG8_BAR; PG8_WAIT_L(0); PG8_MMA(0, 0, At, B0); PG8_BAR; PG8_SCHED;
            PG8_LDB(B1, 0, 1); PG8_STAGE(PG8_SB(0, 0), b2, voffB);
            PG8_BAR; PG8_WAIT_L(0); PG8_MMA(0, 1, At, B1); PG8_BAR;
            PG8_LDA(At, 0, 1); PG8_STAGE(PG8_SA(0, 0), a2, voffA);
            PG8_BAR; PG8_WAIT_L(0); PG8_MMA(1, 0, At, B0); PG8_BAR; PG8_SCHED;
            PG8_STAGE(PG8_SB(0, 1), b2 + hstep, voffB);
            PG8_WAIT_V(6); PG8_BAR; PG8_MMA(1, 1, At, B1); PG8_BAR;
            PG8_LDB(B0, 1, 0); PG8_SCHED; PG8_LDA(At, 1, 0); PG8_STAGE(PG8_SA(0, 1), a2 + hstep, voffA);
            PG8_WAIT_L(8); PG8_BAR; PG8_WAIT_L(0); PG8_MMA(0, 0, At, B0); PG8_BAR; PG8_SCHED;
            PG8_LDB(B1, 1, 1); PG8_STAGE(PG8_SB(1, 0), b3, voffB);
            PG8_BAR; PG8_WAIT_L(0); PG8_MMA(0, 1, At, B1); PG8_BAR;
            PG8_LDA(At, 1, 1); PG8_STAGE(PG8_SA(1, 0), a3, voffA);
            PG8_BAR; PG8_WAIT_L(0); PG8_MMA(1, 0, At, B0); PG8_BAR; PG8_SCHED;
            PG8_STAGE(PG8_SB(1, 1), b3 + hstep, voffB);
            PG8_WAIT_V(6); PG8_BAR; PG8_MMA(1, 1, At, B1); PG8_BAR;
            }
        }
        if constexpr (ALIGN_EPI) { if (wr == 0) PG8_BAR; }
        if constexpr (!Epi::AFTER_DRAIN) { E(acc, cur, wr, wc, fr, fq); S.done(cur); }
        if (!has_next) break;
#pragma unroll
        for (int a = 0; a < 2; ++a)
#pragma unroll
            for (int b = 0; b < 2; ++b)
#pragma unroll
                for (int m = 0; m < 4; ++m)
#pragma unroll
                    for (int n = 0; n < 2; ++n) acc[a][b][m][n] = (f32x4){0.f, 0.f, 0.f, 0.f};
        cur = nxt; cA = nA; cB = nB; ++ui;
        if constexpr (ALIGN_EPI) { if (wr == 1) PG8_BAR; }
    }
    PG8_WAIT_V(0);
    if constexpr (!ALIGN_EPI) { if (wr == 0) PG8_BAR; }
    PG8_BAR;
    if constexpr (Epi::AFTER_DRAIN) { E.fused(acc, cur, wr, wc, fr, fq, lds, wid, lane); S.done(cur); }
#undef PG8_SA
#undef PG8_SB
#undef PG8_STAGE
#undef PG8_LDA
#undef PG8_LDB
#undef PG8_MMA
#undef PG8_CAT8
#undef PG8_WAIT_V
#undef PG8_WAIT_L
#undef PG8_BAR
#undef PG8_SCHED
}
}
#define GAS __attribute__((address_space(1)))
#define LAS __attribute__((address_space(3)))
typedef unsigned short bf16;
typedef unsigned v4u __attribute__((ext_vector_type(4)));
typedef float f32x4 __attribute__((ext_vector_type(4)));
typedef short bf16x8 __attribute__((ext_vector_type(8)));
typedef GAS unsigned gu32;
typedef GAS unsigned long long gu64;
#define RLX_AGENT __ATOMIC_RELAXED, __HIP_MEMORY_SCOPE_AGENT
#define LDS_WAIT() asm volatile("s_waitcnt lgkmcnt(0)" ::: "memory")
#define VM_WAIT() asm volatile("s_waitcnt vmcnt(0)" ::: "memory")
__device__ __forceinline__ unsigned long long rt() { return __builtin_amdgcn_s_memrealtime(); }
__device__ __forceinline__ unsigned f2bf(float f) { unsigned u = __builtin_bit_cast(unsigned, f); return (u + 0x7fffu + ((u >> 16) & 1u)) >> 16; }
__device__ __forceinline__ unsigned pk2(float lo, float hi) { return f2bf(lo) | (f2bf(hi) << 16); }
#define XB_TMO      128
#define XB_XCNT(j)  (256  + 64 * (j))
#define XB_XSUB(j)  (1280 + 64 * (j))
#define XB_XGEN(j)  (2304 + 64 * (j))
#define XB_TOP      3328
#define XB_TOPGEN   3392
#define XCD_BAR_WORDS 3456
#define XB_SPIN_CAP (1u << 18)

__device__ __forceinline__ unsigned xb_ld(unsigned* p)              { return __hip_atomic_load(p, __ATOMIC_RELAXED, __HIP_MEMORY_SCOPE_AGENT); }
__device__ __forceinline__ unsigned xb_add(unsigned* p, unsigned v) { return __hip_atomic_fetch_add(p, v, __ATOMIC_RELAXED, __HIP_MEMORY_SCOPE_AGENT); }
__device__ __forceinline__ unsigned xb_xcc_id() { return (unsigned)__builtin_amdgcn_s_getreg((3 << 11) | 20) & 0xFu; }
#define XB_SPIN(cond, bar) do { unsigned _sp = 0; while (cond) { __builtin_amdgcn_s_sleep(1); \
    if ((++_sp & 255u) == 0u) { if (xb_ld(&(bar)[XB_TMO])) break; if (_sp > XB_SPIN_CAP) { atomicAdd(&(bar)[XB_TMO], 1u); break; } } } } while (0)

struct XcdBarrier {
    unsigned* bar; unsigned x; int wv;
    volatile LAS unsigned* st;
};

__device__ __forceinline__ XcdBarrier xcd_barrier_post(unsigned* bar, volatile LAS unsigned* st) {
    XcdBarrier b; b.bar = bar; b.x = xb_xcc_id(); b.st = st; b.wv = __builtin_amdgcn_readfirstlane((int)(threadIdx.x >> 6));
    if (threadIdx.x == 0) (void)xb_add(&bar[XB_XCNT(b.x)], 1u);
    return b;
}
__device__ __forceinline__ void xcd_barrier_complete(unsigned* bar, unsigned x, unsigned& nloc, unsigned& nx) {
    const unsigned G = gridDim.x * gridDim.y * gridDim.z;
    unsigned sum, cnt, mine, sp = 0u;
    for (;;) {
        sum = 0u; cnt = 0u; mine = 0u;
#pragma unroll
        for (unsigned j = 0; j < 16; ++j) { const unsigned c = xb_ld(&bar[XB_XCNT(j)]); sum += c; cnt += (c > 0u) ? 1u : 0u; mine = (j == x) ? c : mine; }
        if (sum == G) break;
        __builtin_amdgcn_s_sleep(1);
        if ((++sp & 255u) == 0u) { if (xb_ld(&bar[XB_TMO])) break; if (sp > XB_SPIN_CAP) { atomicAdd(&bar[XB_TMO], 1u); break; } }
    }
    nloc = mine > 0u ? mine : 1u; nx = cnt > 0u ? cnt : 1u;
}

__device__ __forceinline__ void xcd_barrier(const XcdBarrier& b) {
    asm volatile("s_waitcnt vmcnt(0)" ::: "memory");
    __syncthreads();
    if (b.wv == 0 && pg8::lane_now() == 0) {
        unsigned* bar = b.bar;
        __builtin_amdgcn_s_waitcnt(0);
        unsigned nloc = b.st[0], nx = b.st[1];
        if (nloc == 0u) { xcd_barrier_complete(bar, b.x, nloc, nx); b.st[0] = nloc; b.st[1] = nx; }
        const unsigned old = xb_add(&bar[XB_XSUB(b.x)], 1u);
        const unsigned gen = old / nloc;
        if (old + 1u == (gen + 1u) * nloc) {
            __builtin_amdgcn_fence(__ATOMIC_RELEASE, "agent");
            asm volatile("s_waitcnt vmcnt(0)" ::: "memory");
            const unsigned og = xb_add(&bar[XB_TOP], 1u);
            const unsigned tg = og / nx;
            if (og + 1u == (tg + 1u) * nx) xb_add(&bar[XB_TOPGEN], 1u);
            else XB_SPIN(xb_ld(&bar[XB_TOPGEN]) == tg, bar);
            __builtin_amdgcn_fence(__ATOMIC_ACQUIRE, "agent");
            xb_add(&bar[XB_XGEN(b.x)], 1u);
            asm volatile("s_waitcnt vmcnt(0)" ::: "memory");
        } else {
            XB_SPIN(xb_ld(&bar[XB_XGEN(b.x)]) == gen, bar);
            __builtin_amdgcn_fence(__ATOMIC_ACQUIRE, "agent");
            asm volatile("s_waitcnt vmcnt(0)" ::: "memory");
        }
    }
    __syncthreads();
}
constexpr int BATCH = 4, SEQ = 8192, DM = 2048, M = BATCH * SEQ, BW = 512, INW = 9216, DFF = 5632, NUP = 2 * DFF, DEPTH = 2;
constexpr int NWAVES = 8;
constexpr float EPS = 1e-6f;
constexpr float LOG2E = 1.4426950408889634f;
constexpr float QSCALE = 0.125f * LOG2E;

__device__ __forceinline__ float bf_lo(unsigned w) { return __builtin_bit_cast(float, w << 16); }
__device__ __forceinline__ float bf_hi(unsigned w) { return __builtin_bit_cast(float, w & 0xffff0000u); }
__device__ __forceinline__ float bf2f(unsigned short h) { return __builtin_bit_cast(float, ((unsigned)h) << 16); }
constexpr float W8_SCALE = 32.0f, W8_INV = 1.0f / 32.0f;
__device__ __forceinline__ float sigmoid_f(float v) { return __builtin_amdgcn_rcpf(1.0f + __builtin_amdgcn_exp2f(-LOG2E * v)); }
__device__ __forceinline__ unsigned gate_q4(const pg8::f32x4 x) {
    float t[4];
#pragma unroll
    for (int j = 0; j < 4; ++j) t[j] = fmaxf(__builtin_fmaf(sigmoid_f(x[j]), 255.0f, 12582912.0f), 12582913.0f);
    return __builtin_amdgcn_perm(__builtin_bit_cast(unsigned, t[1]), __builtin_bit_cast(unsigned, t[0]), 0x0c0c0400u) | __builtin_amdgcn_perm(__builtin_bit_cast(unsigned, t[3]), __builtin_bit_cast(unsigned, t[2]), 0x04000c0cu);
}
__device__ __forceinline__ unsigned q8x4(float a, float b, float c, float d, float inv) {
    const float t0 = __builtin_fmaf(a, inv, 12582912.0f), t1 = __builtin_fmaf(b, inv, 12582912.0f), t2 = __builtin_fmaf(c, inv, 12582912.0f), t3 = __builtin_fmaf(d, inv, 12582912.0f);
    return __builtin_amdgcn_perm(__builtin_bit_cast(unsigned, t1), __builtin_bit_cast(unsigned, t0), 0x0c0c0400u) | __builtin_amdgcn_perm(__builtin_bit_cast(unsigned, t3), __builtin_bit_cast(unsigned, t2), 0x04000c0cu);
}
__device__ __forceinline__ float ub0(unsigned q) { float r; asm("v_cvt_f32_ubyte0 %0, %1" : "=v"(r) : "v"(q)); return r; }
__device__ __forceinline__ float ub1(unsigned q) { float r; asm("v_cvt_f32_ubyte1 %0, %1" : "=v"(r) : "v"(q)); return r; }
__device__ __forceinline__ float ub2(unsigned q) { float r; asm("v_cvt_f32_ubyte2 %0, %1" : "=v"(r) : "v"(q)); return r; }
__device__ __forceinline__ float ub3(unsigned q) { float r; asm("v_cvt_f32_ubyte3 %0, %1" : "=v"(r) : "v"(q)); return r; }
__device__ __forceinline__ pg8::f32x4 gate_ratio4(unsigned a, unsigned b) { pg8::f32x4 r; r[0] = ub0(a) * __builtin_amdgcn_rcpf(ub0(b)); r[1] = ub1(a) * __builtin_amdgcn_rcpf(ub1(b)); r[2] = ub2(a) * __builtin_amdgcn_rcpf(ub2(b)); r[3] = ub3(a) * __builtin_amdgcn_rcpf(ub3(b)); return r; }
__device__ __forceinline__ pg8::f32x4 gate_val4(unsigned a) { pg8::f32x4 r; r[0] = ub0(a); r[1] = ub1(a); r[2] = ub2(a); r[3] = ub3(a); return r * (1.0f / 255.0f); }
__device__ __forceinline__ float gelu_tanh(float v) {
    const float u = __builtin_fmaf(v * v, -0.10294324f, -2.3022082f);
    return v * __builtin_amdgcn_rcpf(1.0f + __builtin_amdgcn_exp2f(v * u));
}

#ifndef UPCONV_DPP
#define UPCONV_DPP 1
#endif
#define EPI_ST(p, v) (*(pg8::u32x4*)(p) = (v))
#define EPI_DRY_DECL
#define EPI_DRY_MEMBER
struct EpiPlain {
    static constexpr bool PERM = true, AFTER_DRAIN = false, SEGMENTED = false;
    pg8::bf16_t* O; int ldc; EPI_DRY_MEMBER
    __device__ __forceinline__ void operator()(const pg8::f32x4 (&acc)[2][2][4][2], const pg8::Unit& u, int wr, int wc, int fr, int fq) const {
        EPI_DRY_DECL
        const int row0 = u.pm * 256 + wr * 64 + fr, col0 = u.pn * 256 + wc * 32 + 8 * fq;
#pragma unroll
        for (int ai = 0; ai < 2; ++ai)
#pragma unroll
            for (int m = 0; m < 4; ++m) { pg8::bf16_t* rowp = O + (size_t)(row0 + ai * 128 + m * 16) * ldc + col0;
#pragma unroll
                for (int bj = 0; bj < 2; ++bj) { const pg8::f32x4 v0 = acc[ai][bj][m][0], v1 = acc[ai][bj][m][1];
                    pg8::u32x4 w; w.x = pg8::cvt_pk_bf16(v0[0], v0[1]); w.y = pg8::cvt_pk_bf16(v0[2], v0[3]); w.z = pg8::cvt_pk_bf16(v1[0], v1[1]); w.w = pg8::cvt_pk_bf16(v1[2], v1[3]);
                    EPI_ST(rowp + bj * 128, w); } }
    }
};
struct EpiInProj {
    static constexpr bool PERM = true, AFTER_DRAIN = false, SEGMENTED = false;
    const float* bias; pg8::bf16_t* T6; float* kmean; unsigned* kabs; const float* rs; const unsigned* cm; EPI_DRY_MEMBER
    __device__ __forceinline__ void operator()(pg8::f32x4 (&acc)[2][2][4][2], const pg8::Unit& u, int wr, int wc, int fr, int fq) const {
        EPI_DRY_DECL
        const int pn = u.pn; int mode, ldc, colt; pg8::bf16_t* base;
        {
            pg8::f32x4 cv[2][2];
#pragma unroll
            for (int bj = 0; bj < 2; ++bj)
#pragma unroll
                for (int n = 0; n < 2; ++n) { const pg8::u32x4 cmv = *(const pg8::u32x4*)(cm + pn * 256 + wc * 32 + 8 * fq + bj * 128 + 4 * n); const unsigned c0 = cmv.x, c1 = cmv.y, c2 = cmv.z, c3 = cmv.w;
                    pg8::f32x4 t; t[0] = __builtin_bit_cast(float, c0); t[1] = __builtin_bit_cast(float, c1); t[2] = __builtin_bit_cast(float, c2); t[3] = __builtin_bit_cast(float, c3); cv[bj][n] = t * (1.0f / 127.0f); }
#pragma unroll
            for (int ai = 0; ai < 2; ++ai)
#pragma unroll
                for (int m = 0; m < 4; ++m) { const float rsv = rs[u.pm * 256 + ai * 128 + wr * 64 + m * 16 + fr];
#pragma unroll
                    for (int bj = 0; bj < 2; ++bj)
#pragma unroll
                        for (int n = 0; n < 2; ++n) { pg8::f32x4 t;
#pragma unroll
                            for (int j = 0; j < 4; ++j) { const float af = acc[ai][bj][m][n][j]; t[j] = (float)__builtin_bit_cast(int, af); }
                            acc[ai][bj][m][n] = (t * rsv) * cv[bj][n]; } }
        }
        if (pn < 12) { const int t = pn >> 1, slot = (t == 0) ? 0 : (t == 1) ? 3 : (t == 2) ? 1 : t + 1;
            base = T6 + (size_t)slot * M * BW; ldc = BW; colt = (pn & 1) * 256; mode = t < 2 ? 1 : (t == 2 ? 2 : 0); }
        else { base = T6; ldc = DM; colt = 0; mode = 0; }
        const int row0 = u.pm * 256 + wr * 64 + fr, col0 = colt + wc * 32 + 8 * fq, bcol0 = pn * 256 + wc * 32 + 8 * fq;
        pg8::f32x4 bv[2][2];
#pragma unroll
        for (int bj = 0; bj < 2; ++bj)
#pragma unroll
            for (int n = 0; n < 2; ++n) bv[bj][n] = *(const pg8::f32x4*)(bias + bcol0 + bj * 128 + 4 * n);
        if (pn == 6 || pn == 7) {
            const int lane = fq * 16 + fr; const int b = u.pm >> 5, jblk = u.pm & 31;
#pragma unroll
            for (int bj = 0; bj < 2; ++bj)
#pragma unroll
                for (int n = 0; n < 2; ++n) { pg8::f32x4 s = bv[bj][n] * 8.0f;
#pragma unroll
                    for (int ai = 0; ai < 2; ++ai)
#pragma unroll
                        for (int m = 0; m < 4; ++m) s = s + acc[ai][bj][m][n];
                    pg8::f32x4 mx = {0.f, 0.f, 0.f, 0.f};
#pragma unroll
                    for (int ai = 0; ai < 2; ++ai)
#pragma unroll
                        for (int m = 0; m < 4; ++m) { const pg8::f32x4 kv = acc[ai][bj][m][n] + bv[bj][n];
#pragma unroll
                            for (int j = 0; j < 4; ++j) mx[j] = fmaxf(mx[j], __builtin_fabsf(kv[j])); }
#pragma unroll
                    for (int j = 0; j < 4; ++j) { float v = s[j]; float a = mx[j];
#pragma unroll
                        for (int o = 1; o < 16; o <<= 1) { v += __builtin_bit_cast(float, __builtin_amdgcn_ds_bpermute((lane ^ o) << 2, __builtin_bit_cast(int, v)));
                            a = fmaxf(a, __builtin_bit_cast(float, __builtin_amdgcn_ds_bpermute((lane ^ o) << 2, __builtin_bit_cast(int, a)))); }
                        if (fr == 0) { const int col = (pn & 1) * 256 + bj * 128 + wc * 32 + 8 * fq + 4 * n + j; const size_t ki = ((size_t)(b * 8 + (col >> 6)) * 32 + jblk) * 64 + (col & 63);
                            atomicAdd(kmean + ki, v * (1.0f / 256.0f)); atomicMax(kabs + ki, __builtin_bit_cast(unsigned, a)); } } }
        }
#pragma unroll
        for (int ai = 0; ai < 2; ++ai)
#pragma unroll
            for (int m = 0; m < 4; ++m) { pg8::bf16_t* rowp = base + (size_t)(row0 + ai * 128 + m * 16) * ldc + col0;
#pragma unroll
                for (int bj = 0; bj < 2; ++bj) { pg8::f32x4 v0 = acc[ai][bj][m][0] + bv[bj][0], v1 = acc[ai][bj][m][1] + bv[bj][1];
                    if (mode == 1) {
#pragma unroll
                        for (int j = 0; j < 4; ++j) { v0[j] = gelu_tanh(v0[j]); v1[j] = gelu_tanh(v1[j]); } }
                    else if (mode == 2) { v0 = v0 * QSCALE; v1 = v1 * QSCALE; }
                    pg8::u32x4 w; w.x = pg8::cvt_pk_bf16(v0[0], v0[1]); w.y = pg8::cvt_pk_bf16(v0[2], v0[3]); w.z = pg8::cvt_pk_bf16(v1[0], v1[1]); w.w = pg8::cvt_pk_bf16(v1[2], v1[3]);
                    EPI_ST(rowp + bj * 128, w); } }
    }
};
struct EpiGate8 {
    static constexpr bool PERM = true, AFTER_DRAIN = false, SEGMENTED = false;
    const float* bias; unsigned char* G8; const float* rs; const unsigned* cm; EPI_DRY_MEMBER
    __device__ __forceinline__ void operator()(const pg8::f32x4 (&acc)[2][2][4][2], const pg8::Unit& u, int wr, int wc, int fr_in, int fq_in) const {
        EPI_DRY_DECL
        int fr = fr_in, fq = fq_in; asm volatile("" : "+v"(fr), "+v"(fq));
        const int pn = u.pn, bcol0 = pn * 256 + wc * 32 + 8 * fq;
        pg8::f32x4 bv[2][2];
#pragma unroll
        for (int bj = 0; bj < 2; ++bj)
#pragma unroll
            for (int n = 0; n < 2; ++n) bv[bj][n] = *(const pg8::f32x4*)(bias + bcol0 + bj * 128 + 4 * n);
        pg8::f32x4 cv[2][2];
#pragma unroll
        for (int bj = 0; bj < 2; ++bj)
#pragma unroll
            for (int n = 0; n < 2; ++n) { const pg8::u32x4 cmv = *(const pg8::u32x4*)(cm + bcol0 + bj * 128 + 4 * n); const unsigned c0 = cmv.x, c1 = cmv.y, c2 = cmv.z, c3 = cmv.w;
                pg8::f32x4 t; t[0] = __builtin_bit_cast(float, c0); t[1] = __builtin_bit_cast(float, c1); t[2] = __builtin_bit_cast(float, c2); t[3] = __builtin_bit_cast(float, c3); cv[bj][n] = t * (1.0f / 127.0f); }
        unsigned char* tp = G8 + ((size_t)((pn >> 3) * (M / 256) + u.pm) * 8 + (pn & 7)) * 65536 + (size_t)((((wr * 4 + wc) * 64) + fq * 16 + fr) * 16);
#pragma unroll
        for (int ai = 0; ai < 2; ++ai)
#pragma unroll
            for (int m = 0; m < 4; ++m) { pg8::u32x4 w; const float rsv = rs[u.pm * 256 + ai * 128 + wr * 64 + m * 16 + fr];
                pg8::f32x4 z[2][2];
#pragma unroll
                for (int bj = 0; bj < 2; ++bj)
#pragma unroll
                    for (int n = 0; n < 2; ++n) { pg8::f32x4 t;
#pragma unroll
                        for (int j = 0; j < 4; ++j) { const float af = acc[ai][bj][m][n][j]; t[j] = (float)__builtin_bit_cast(int, af); }
                        z[bj][n] = (t * rsv) * cv[bj][n] + bv[bj][n]; }
                w.x = gate_q4(z[0][0]); w.y = gate_q4(z[0][1]); w.z = gate_q4(z[1][0]); w.w = gate_q4(z[1][1]);
                EPI_ST(tp + (ai * 4 + m) * 8192, w); }
    }
};
struct EpiUpConv {
    static constexpr bool PERM = true, AFTER_DRAIN = false, SEGMENTED = false;
    pg8::bf16_t* A2; const float* wconv; const float* bconv; float* topz; float* botz; PG8_LAS float* xb; const float* rs; const unsigned* cm; EPI_DRY_MEMBER
    __device__ __forceinline__ void operator()(pg8::f32x4 (&acc)[2][2][4][2], const pg8::Unit& u, int wr, int wc, int fr_in, int fq_in) const {
        EPI_DRY_DECL
        int fr = fr_in, fq = fq_in; asm volatile("" : "+v"(fr), "+v"(fq));
        const int lane = fq * 16 + fr, wv = wr * 4 + wc, pm = u.pm, pn = u.pn;
#pragma unroll
        for (int ai = 0; ai < 2; ++ai)
#pragma unroll
            for (int m = 0; m < 4; ++m) { const float rsv = rs[pm * 256 + ai * 128 + wr * 64 + m * 16 + fr];
#pragma unroll
                for (int bj = 0; bj < 2; ++bj)
#pragma unroll
                    for (int n = 0; n < 2; ++n) { pg8::f32x4 t;
#pragma unroll
                        for (int j = 0; j < 4; ++j) { const float af = acc[ai][bj][m][n][j]; t[j] = (float)__builtin_bit_cast(int, af); }
                        acc[ai][bj][m][n] = t * rsv; } }
        if (fr >= 14) {
#pragma unroll
            for (int ai = 0; ai < 2; ++ai)
#pragma unroll
                for (int bj = 0; bj < 2; ++bj) { PG8_LAS pg8::f32x4* p = (PG8_LAS pg8::f32x4*)(xb + ((((wv * 2 + ai) * 2 + (fr - 14)) * 4 + fq) * 2 + bj) * 8); p[0] = acc[ai][bj][3][0]; p[1] = acc[ai][bj][3][1]; }
        }
        const int ecol = pn * 256 + wc * 32 + 8 * fq;
        if (wr == 0 && fr < 2) { float* t = topz + ((size_t)pm * 2 + fr) * NUP + ecol;
#pragma unroll
            for (int bj = 0; bj < 2; ++bj)
#pragma unroll
                for (int n = 0; n < 2; ++n) *(pg8::f32x4*)(t + bj * 128 + 4 * n) = acc[0][bj][0][n]; }
        if (wr == 1 && fr >= 14) { float* t = botz + ((size_t)pm * 2 + (fr - 14)) * NUP + ecol;
#pragma unroll
            for (int bj = 0; bj < 2; ++bj)
#pragma unroll
                for (int n = 0; n < 2; ++n) *(pg8::f32x4*)(t + bj * 128 + 4 * n) = acc[1][bj][3][n]; }
        asm volatile("s_waitcnt lgkmcnt(0)" ::: "memory"); __builtin_amdgcn_s_barrier(); asm volatile("" ::: "memory");
        pg8::f32x4 bnd[2][2][2];
#pragma unroll
        for (int ai = 0; ai < 2; ++ai) { const int sw = (wr == 1) ? wc : 4 + wc, sai = (wr == 1) ? ai : 0; const bool have = (wr == 1) || (ai == 1);
#pragma unroll
            for (int bj = 0; bj < 2; ++bj) { pg8::f32x4 a = {0.f, 0.f, 0.f, 0.f}, b = a;
                if (have && fr >= 14) { const PG8_LAS pg8::f32x4* p = (const PG8_LAS pg8::f32x4*)(xb + ((((sw * 2 + sai) * 2 + (fr - 14)) * 4 + fq) * 2 + bj) * 8); a = p[0]; b = p[1]; }
                bnd[ai][bj][0] = a; bnd[ai][bj][1] = b; } }
        const int s1 = (fr >= 1 ? lane - 1 : lane + 15) << 2, s2 = (fr >= 2 ? lane - 2 : lane + 14) << 2;
#pragma unroll
        for (int bj = 0; bj < 2; ++bj)
#pragma unroll
            for (int n = 0; n < 2; ++n) { const int col = (bj ? DFF : 0) + pn * 128 + wc * 32 + 8 * fq + 4 * n;
                const pg8::u32x4 cmv = *(const pg8::u32x4*)(cm + col); pg8::f32x4 csv;
                { const unsigned c0 = cmv.x, c1 = cmv.y, c2 = cmv.z, c3 = cmv.w; csv[0] = __builtin_bit_cast(float, c0); csv[1] = __builtin_bit_cast(float, c1); csv[2] = __builtin_bit_cast(float, c2); csv[3] = __builtin_bit_cast(float, c3); csv = csv * (1.0f / 127.0f); }
                const pg8::f32x4 w0 = *(const pg8::f32x4*)(wconv + col) * csv, w1 = *(const pg8::f32x4*)(wconv + NUP + col) * csv, w2 = *(const pg8::f32x4*)(wconv + 2 * NUP + col) * csv, bb = *(const pg8::f32x4*)(bconv + col);
#pragma unroll
                for (int ai = 0; ai < 2; ++ai)
#pragma unroll
                    for (int m = 3; m >= 0; --m) { const pg8::f32x4 cur = acc[ai][bj][m][n]; const pg8::f32x4 prv = (m > 0) ? acc[ai][bj][m - 1][n] : bnd[ai][bj][n];
                        pg8::f32x4 z1, z2;
#pragma unroll
                        for (int j = 0; j < 4; ++j) {
#if UPCONV_DPP
                            const float cf = cur[j], pf = prv[j];
                            const int ci = __builtin_bit_cast(int, cf), pi = __builtin_bit_cast(int, pf);
                            const int p1 = __builtin_amdgcn_mov_dpp(pi, 0x121, 0xf, 0xf, false), p2 = __builtin_amdgcn_mov_dpp(pi, 0x122, 0xf, 0xf, false);
                            z1[j] = __builtin_bit_cast(float, __builtin_amdgcn_update_dpp(p1, ci, 0x111, 0xf, 0xf, false));
                            z2[j] = __builtin_bit_cast(float, __builtin_amdgcn_update_dpp(p2, ci, 0x112, 0xf, 0xf, false));
#else
                            const float t1 = (fr == 15) ? prv[j] : cur[j], t2 = (fr >= 14) ? prv[j] : cur[j];
                            z1[j] = __builtin_bit_cast(float, __builtin_amdgcn_ds_bpermute(s1, __builtin_bit_cast(int, t1)));
                            z2[j] = __builtin_bit_cast(float, __builtin_amdgcn_ds_bpermute(s2, __builtin_bit_cast(int, t2)));
#endif
                        }
                        acc[ai][bj][m][n] = w2 * cur + w1 * z1 + w0 * z2 + bb; } }
        const int row0 = pm * 256 + wr * 64 + fr, col0 = pn * 128 + wc * 32 + 8 * fq;
#pragma unroll
        for (int ai = 0; ai < 2; ++ai)
#pragma unroll
            for (int m = 0; m < 4; ++m) { const pg8::f32x4 g0 = acc[ai][0][m][0], g1 = acc[ai][0][m][1], v0 = acc[ai][1][m][0], v1 = acc[ai][1][m][1];
                pg8::u32x4 w; w.x = pg8::cvt_pk_bf16(gelu_tanh(g0[0]) * v0[0], gelu_tanh(g0[1]) * v0[1]); w.y = pg8::cvt_pk_bf16(gelu_tanh(g0[2]) * v0[2], gelu_tanh(g0[3]) * v0[3]);
                w.z = pg8::cvt_pk_bf16(gelu_tanh(g1[0]) * v1[0], gelu_tanh(g1[1]) * v1[1]); w.w = pg8::cvt_pk_bf16(gelu_tanh(g1[2]) * v1[2], gelu_tanh(g1[3]) * v1[3]);
                EPI_ST(A2 + (size_t)(row0 + ai * 128 + m * 16) * DFF + col0, w); }
    }
};
struct EpiBranch {
    static constexpr bool PERM = true, AFTER_DRAIN = false, SEGMENTED = true; static constexpr int SEG_SHIFT = 3;
    const unsigned char* G8; pg8::bf16_t* Mb; EPI_DRY_MEMBER
    __device__ __forceinline__ void seg_hook(pg8::f32x4 (&acc)[2][2][4][2], const pg8::Unit& u, int seg, int wr, int wc, int fr, int fq) const {
        int t16 = (((wr * 4 + wc) * 64) + fq * 16 + fr) * 16;
        asm volatile("" : "+v"(t16));
        const unsigned char* Tp = G8 + ((size_t)((seg - 1) * (M / 256) + u.pm) * 8 + u.pn) * 65536 + t16; const unsigned char* Tn = Tp + (size_t)(M / 256) * 8 * 65536;
        pg8::u32x4 ga[8], gb[8];
#pragma unroll
        for (int c = 0; c < 8; ++c) { ga[c] = *(const pg8::u32x4*)(Tp + c * 8192); gb[c] = *(const pg8::u32x4*)(Tn + c * 8192); }
        asm volatile("" ::: "memory");
#pragma unroll
        for (int ai = 0; ai < 2; ++ai)
#pragma unroll
            for (int m = 0; m < 4; ++m) { const pg8::u32x4 a = ga[ai * 4 + m], b = gb[ai * 4 + m];
                acc[ai][0][m][0] = acc[ai][0][m][0] * gate_ratio4(a.x, b.x); acc[ai][0][m][1] = acc[ai][0][m][1] * gate_ratio4(a.y, b.y);
                acc[ai][1][m][0] = acc[ai][1][m][0] * gate_ratio4(a.z, b.z); acc[ai][1][m][1] = acc[ai][1][m][1] * gate_ratio4(a.w, b.w); }
        asm volatile("" ::: "memory");
    }
    __device__ __forceinline__ void operator()(const pg8::f32x4 (&acc)[2][2][4][2], const pg8::Unit& u, int wr, int wc, int fr, int fq) const {
        const int row0 = u.pm * 256 + wr * 64 + fr, col0 = u.pn * 256 + wc * 32 + 8 * fq;
        EPI_DRY_DECL
        const unsigned char* T2 = G8 + ((size_t)(2 * (M / 256) + u.pm) * 8 + u.pn) * 65536 + (size_t)((((wr * 4 + wc) * 64) + fq * 16 + fr) * 16);
        pg8::u32x4 gv[8];
#pragma unroll
        for (int c = 0; c < 8; ++c) gv[c] = *(const pg8::u32x4*)(T2 + c * 8192);
        asm volatile("" ::: "memory");
#pragma unroll
        for (int ai = 0; ai < 2; ++ai)
#pragma unroll
            for (int m = 0; m < 4; ++m) { const size_t ro = (size_t)(row0 + ai * 128 + m * 16) * DM + col0; const pg8::u32x4 g = gv[ai * 4 + m];
#pragma unroll
                for (int bj = 0; bj < 2; ++bj) { const pg8::f32x4 a0 = acc[ai][bj][m][0] * gate_val4(bj ? g.z : g.x), a1 = acc[ai][bj][m][1] * gate_val4(bj ? g.w : g.y);
                    pg8::u32x4 w; w.x = pg8::cvt_pk_bf16(a0[0], a0[1]); w.y = pg8::cvt_pk_bf16(a0[2], a0[3]); w.z = pg8::cvt_pk_bf16(a1[0], a1[1]); w.w = pg8::cvt_pk_bf16(a1[2], a1[3]);
                    EPI_ST(Mb + ro + bj * 128, w); } }
    }
};
#include <hip/hip_bf16.h>
#include <cmath>
namespace attn_body {
using bf16=__hip_bfloat16;
using bf16x8=__attribute__((ext_vector_type(8)))short;
using s16x4=__attribute__((ext_vector_type(4)))short;
using f32x16=__attribute__((ext_vector_type(16)))float;
using u32x4=__attribute__((ext_vector_type(4)))unsigned;
constexpr int BATCH=4,NHEAD=8,SEQ=8192,D=64,DM=NHEAD*D;
constexpr int NW=8,QBLK=32,QB=QBLK*NW,KVBLK=64,NQB=SEQ/QB;
constexpr int ATTN_PITCH=DM, ATTN_UNIT_ROWS=QB;
__device__ __forceinline__ int crow(int r,int hi){return (r&3)+8*(r>>2)+4*hi;}
#define SBAR() __builtin_amdgcn_sched_barrier(0)
__device__ __forceinline__ void cmask(f32x16&p0,f32x16&p1,int jb,int qrel,int hi){
  const float NEG=-INFINITY; int kb=64*jb+4*hi;
  #pragma unroll
  for(int r=0;r<16;++r){int kv=kb+(r&3)+8*(r>>2); if(kv>qrel)p0[r]=NEG; if(kv+32>qrel)p1[r]=NEG;}
}

constexpr int NSLOT=3, SLOTB=8192;
constexpr int LDS_K=0, LDS_V=NSLOT*SLOTB, LDS_WS=2*NSLOT*SLOTB, LDS_OST=LDS_WS+NW*64*4, LDS_TAB=LDS_OST+NW*4096  , LDS_BYTES=LDS_TAB+16384;
constexpr float C2=0.125f*1.4426950408889634f;
__device__ __forceinline__ void glds16(const void*gsrc,unsigned lds_dst){unsigned keep;
  asm volatile("s_mov_b32 %0, m0\n\ts_mov_b32 m0, %2\n\ts_nop 0\n\tglobal_load_lds_dwordx4 %1, off\n\ts_mov_b32 m0, %0":"=&s"(keep):"v"(gsrc),"s"(lds_dst):"memory");}
__device__ __forceinline__ float max3f(float a,float b,float c){float r;asm("v_max3_f32 %0, %1, %2, %3":"=v"(r):"v"(a),"v"(b),"v"(c));return r;}
__device__ __forceinline__ float max2f(float a,float b){float r;asm("v_max_f32_e32 %0, %1, %2":"=v"(r):"v"(a),"v"(b));return r;}
__device__ __forceinline__ float fadd_s(float a,float b){float r;asm("v_add_f32_e32 %0, %1, %2":"=v"(r):"v"(a),"v"(b));return r;}
__device__ __forceinline__ float fsub_s(float a,float b){float r;asm("v_sub_f32_e32 %0, %1, %2":"=v"(r):"v"(a),"v"(b));return r;}
typedef float f32x2_t __attribute__((ext_vector_type(2))); typedef __bf16 bf16x2_t __attribute__((ext_vector_type(2)));
__device__ __forceinline__ unsigned cvtpk_s(float lo,float hi){f32x2_t v={lo,hi};bf16x2_t b=__builtin_convertvector(v,bf16x2_t);return __builtin_bit_cast(unsigned,b);}
#define WAIT_BAR(N) asm volatile("s_waitcnt vmcnt(" #N ") lgkmcnt(0)\n\ts_barrier":::"memory")

__device__ __forceinline__ void qkt(f32x16&p0,f32x16&p1,const char*Kslot,const bf16x8*qr,const f32x16&negm,int r32,int hi){
  const char*kb=Kslot+hi*1024+r32*16;
  #pragma unroll
  for(int d0=0;d0<4;++d0){
    const bf16x8 b0=*reinterpret_cast<const bf16x8*>(kb+d0*2048);
    const bf16x8 b1=*reinterpret_cast<const bf16x8*>(kb+d0*2048+512);
    if(d0==0){p0=__builtin_amdgcn_mfma_f32_32x32x16_bf16(b0,qr[0],negm,0,0,0);p1=__builtin_amdgcn_mfma_f32_32x32x16_bf16(b1,qr[0],negm,0,0,0);}
    else{p0=__builtin_amdgcn_mfma_f32_32x32x16_bf16(b0,qr[d0],p0,0,0,0);p1=__builtin_amdgcn_mfma_f32_32x32x16_bf16(b1,qr[d0],p1,0,0,0);}}
}
typedef __attribute__((address_space(3))) const char* lds_cptr;
typedef short v4i16_t __attribute__((ext_vector_type(4)));
__device__ __forceinline__ void kload8(bf16x8*kf,lds_cptr kp){
  kf[0]=*(const __attribute__((address_space(3))) bf16x8*)(kp);      kf[1]=*(const __attribute__((address_space(3))) bf16x8*)(kp+512);
  kf[2]=*(const __attribute__((address_space(3))) bf16x8*)(kp+2048); kf[3]=*(const __attribute__((address_space(3))) bf16x8*)(kp+2560);
  kf[4]=*(const __attribute__((address_space(3))) bf16x8*)(kp+4096); kf[5]=*(const __attribute__((address_space(3))) bf16x8*)(kp+4608);
  kf[6]=*(const __attribute__((address_space(3))) bf16x8*)(kp+6144); kf[7]=*(const __attribute__((address_space(3))) bf16x8*)(kp+6656);
}
__device__ __forceinline__ void kload2(bf16x8*kf,lds_cptr kp,int j){ kf[2*j]=*(const __attribute__((address_space(3))) bf16x8*)(kp+j*2048); kf[2*j+1]=*(const __attribute__((address_space(3))) bf16x8*)(kp+j*2048+512); }
__device__ __forceinline__ s16x4 vtr(lds_cptr p){ return __builtin_bit_cast(s16x4,__builtin_amdgcn_ds_read_tr16_b64_v4i16((__attribute__((address_space(3))) v4i16_t*)p)); }
__device__ __forceinline__ float rowmax(const f32x16&p0,const f32x16&p1){
  float a=max3f(p0[0],p0[1],p1[0]),b=max3f(p0[2],p0[3],p1[1]);a=max3f(a,p1[2],p1[3]);
  #pragma unroll
  for(int r=4;r<16;r+=4){a=max3f(a,p0[r],p0[r+1]);b=max3f(b,p0[r+2],p0[r+3]);a=max3f(a,p1[r],p1[r+1]);b=max3f(b,p1[r+2],p1[r+3]);}
  const float m=max2f(a,b);
  auto rr=__builtin_amdgcn_permlane32_swap(__float_as_uint(m),__float_as_uint(m),false,false);
  return max2f(__uint_as_float(rr[0]),__uint_as_float(rr[1]));
}
__device__ __forceinline__ void pv(f32x16*o,int vb,bf16x8 pa0,bf16x8 pa1,bf16x8 pa2,bf16x8 pa3){
  #pragma unroll
  for(int d0=0;d0<2;++d0){s16x4 lo[4],hi[4];
    #pragma unroll
    for(int ks=0;ks<4;++ks){
      asm volatile("ds_read_b64_tr_b16 %0,%1 offset:%c2":"=&v"(lo[ks]):"v"(vb),"i"(d0*4096+ks*1024):"memory");
      asm volatile("ds_read_b64_tr_b16 %0,%1 offset:%c2":"=&v"(hi[ks]):"v"(vb),"i"(d0*4096+ks*1024+512):"memory");}
    asm volatile("s_waitcnt lgkmcnt(0)":::"memory");SBAR();
    #define PK(k) (bf16x8){lo[k][0],lo[k][1],lo[k][2],lo[k][3],hi[k][0],hi[k][1],hi[k][2],hi[k][3]}
    o[d0]=__builtin_amdgcn_mfma_f32_32x32x16_bf16(pa0,PK(0),o[d0],0,0,0);
    o[d0]=__builtin_amdgcn_mfma_f32_32x32x16_bf16(pa1,PK(1),o[d0],0,0,0);
    o[d0]=__builtin_amdgcn_mfma_f32_32x32x16_bf16(pa2,PK(2),o[d0],0,0,0);
    o[d0]=__builtin_amdgcn_mfma_f32_32x32x16_bf16(pa3,PK(3),o[d0],0,0,0);
    #undef PK
  }
}

#ifndef ATTN_STORE16
#define ATTN_STORE16(p,v) (*(u32x4*)(p)=(v))
#endif
template<int THRL> __device__ __forceinline__ void attn_unit(int b,int h,int qb,const bf16*Q,const bf16*__restrict__ K,const bf16*__restrict__ V,const float*__restrict__ KM,const float*__restrict__ KA,bf16*O,char*shm,int wave_s){
  int tid_l=wave_s*64+pg8::lane_now(); asm volatile("":"+v"(tid_l));
  const int tid=tid_l,lane=tid&63,r32=lane&31,hi=lane>>5; const int wid=__builtin_amdgcn_readfirstlane(tid>>6);
  const long rowbase=(long)b*SEQ; const int q0=qb*QB;
  const bf16*Qw=Q+(rowbase+q0+wid*QBLK)*DM+h*D;
  const bf16*Kh=K+rowbase*DM+h*D,*Vh=V+rowbase*DM+h*D;
  const unsigned lds0=(unsigned)(uintptr_t)shm;
  float*wsf=(float*)(shm+LDS_WS)+wid*64;
  const bf16*ksrc_=Kh+(long)lane*DM+wid*8;
  const bf16*vsrc_=Vh+(long)(16*(wid&3)+(lane>>2))*DM+(wid>>2)*32+(lane&3)*8;
  const unsigned kdst=lds0+LDS_K+wid*1024, vdst=lds0+LDS_V+wid*1024;
  const bf16*ksrc=ksrc_,*vsrc=vsrc_;
  #define DMA_K(t,slot) glds16(ksrc+(long)(t)*KVBLK*DM,(unsigned)__builtin_amdgcn_readfirstlane(kdst+(slot)))
  #define DMA_V(t,slot) glds16(vsrc+(long)(t)*KVBLK*DM,(unsigned)__builtin_amdgcn_readfirstlane(vdst+(slot)))
  const int vb0=(int)(lds0+LDS_V)+((lane>>4)&1)*32+(lane&3)*8+(4*hi+((lane&15)>>2))*64;
  const char*Kbase=shm+LDS_K; bf16x8 kf[8];
  const lds_cptr shm3=(lds_cptr)shm; const lds_cptr kp0=shm3+LDS_K+hi*1024+r32*16; const lds_cptr vp0=shm3+LDS_V+((lane>>4)&1)*32+(lane&3)*8+(4*hi+((lane&15)>>2))*64;
  int NT=(q0+QB)/KVBLK;
  { const float4*gm=reinterpret_cast<const float4*>(KM+((long)(b*NHEAD+h)*32)*64), *ga=reinterpret_cast<const float4*>(KA+((long)(b*NHEAD+h)*32)*64);
    float4*lm=reinterpret_cast<float4*>(shm+LDS_TAB), *la=reinterpret_cast<float4*>(shm+LDS_TAB+8192);
    lm[tid]=gm[tid]; la[tid]=ga[tid];
    asm volatile("s_waitcnt vmcnt(0) lgkmcnt(0)\n\ts_barrier":::"memory"); }
  bf16x8 qr[4];
  #pragma unroll
  for(int d0=0;d0<4;++d0)qr[d0]=*reinterpret_cast<const bf16x8*>(&Qw[(long)r32*DM+d0*16+hi*8]);
  float mhat=0.f,l_reg=0.f;f32x16 o[2];o[0]=f32x16{};o[1]=f32x16{};
  const int qrel=wid*QBLK+r32;
  const float sl2=1.4426950408889634f*__builtin_amdgcn_exp2f(-(float)(h+1));
  const float hb4=sl2*(float)(4*hi), sl32=32.f*sl2;
  unsigned selmask=0u;
  { float qf[32];
    #pragma unroll
    for(int d0=0;d0<4;++d0){
      #pragma unroll
      for(int j=0;j<8;++j)qf[d0*8+j]=__builtin_bit_cast(float,((unsigned)(unsigned short)qr[d0][j])<<16);}
    { const bf16*Kd=Kh+(long)(q0+qrel)*DM; float acc=0.f;
      #pragma unroll
      for(int d0=0;d0<4;++d0){ const bf16x8 kq=*reinterpret_cast<const bf16x8*>(&Kd[d0*16+hi*8]);
        #pragma unroll
        for(int j=0;j<8;++j)acc+=qf[d0*8+j]*__builtin_bit_cast(float,((unsigned)(unsigned short)kq[j])<<16);}
      auto rr=__builtin_amdgcn_permlane32_swap(__float_as_uint(acc),__float_as_uint(acc),false,false);
      mhat=(__uint_as_float(rr[0])+__uint_as_float(rr[1]))+sl2*(float)qrel; }
    float v0=-INFINITY,v1=-INFINITY,v2=-INFINITY; int i0=-1,i1=-1,i2=-1; unsigned nearmask=0u;
    const float*KMb=reinterpret_cast<const float*>(shm+LDS_TAB)+hi*8; const float*KAb=reinterpret_cast<const float*>(shm+LDS_TAB+8192)+hi*8;
    for(int j=0;j<qb;++j){ const float*km=KMb+j*64; const float*ka=KAb+j*64; float sp=0.f, up=0.f;
      #pragma unroll
      for(int d0=0;d0<4;++d0){ const float4 a=*reinterpret_cast<const float4*>(km+d0*16), c=*reinterpret_cast<const float4*>(km+d0*16+4);
        sp+=qf[d0*8+0]*a.x+qf[d0*8+1]*a.y+qf[d0*8+2]*a.z+qf[d0*8+3]*a.w+qf[d0*8+4]*c.x+qf[d0*8+5]*c.y+qf[d0*8+6]*c.z+qf[d0*8+7]*c.w;
        const float4 e=*reinterpret_cast<const float4*>(ka+d0*16), f=*reinterpret_cast<const float4*>(ka+d0*16+4);
        up+=__builtin_fabsf(qf[d0*8+0])*e.x+__builtin_fabsf(qf[d0*8+1])*e.y+__builtin_fabsf(qf[d0*8+2])*e.z+__builtin_fabsf(qf[d0*8+3])*e.w+__builtin_fabsf(qf[d0*8+4])*f.x+__builtin_fabsf(qf[d0*8+5])*f.y+__builtin_fabsf(qf[d0*8+6])*f.z+__builtin_fabsf(qf[d0*8+7])*f.w;}
      auto rr=__builtin_amdgcn_permlane32_swap(__float_as_uint(sp),__float_as_uint(sp),false,false);
      const float sc=__uint_as_float(rr[0])+__uint_as_float(rr[1]);
      { auto ru=__builtin_amdgcn_permlane32_swap(__float_as_uint(up),__float_as_uint(up),false,false); const float ub=(__uint_as_float(ru[0])+__uint_as_float(ru[1]))*1.01f;
        if(ub+sl2*(float)(256*j+255-q0)-mhat>-70.f)nearmask|=1u<<j; }
      if(sc>v2){ if(sc>v1){ v2=v1;i2=i1; if(sc>v0){v1=v0;i1=i0;v0=sc;i0=j;} else {v1=sc;i1=j;} } else {v2=sc;i2=j;} } }
    if(i0>=0)selmask|=1u<<i0; if(i1>=0)selmask|=1u<<i1; if(i2>=0)selmask|=1u<<i2;
    unsigned need=selmask&nearmask;
    #pragma unroll
    for(int o_=1;o_<64;o_<<=1)need|=(unsigned)__builtin_amdgcn_ds_bpermute((lane^o_)<<2,(int)need);
    volatile unsigned*xw=(volatile unsigned*)(shm+LDS_OST);
    if(lane==0)xw[wid]=need;
    asm volatile("s_waitcnt lgkmcnt(0)\n\ts_barrier":::"memory");
    unsigned na=xw[0]|xw[1]|xw[2]|xw[3]|xw[4]|xw[5]|xw[6]|xw[7];
    na=(unsigned)__builtin_amdgcn_readfirstlane((int)na)|(1u<<qb);
    const int nskip=__builtin_ctz(na);
    NT-=4*nskip; selmask>>=nskip; ksrc+=(long)nskip*256*DM; vsrc+=(long)nskip*256*DM; }
  f32x16 negm;
  #pragma unroll
  for(int r=0;r<16;++r)negm[r]=sl2*(float)((r&3)+8*(r>>2));
  asm volatile("":"+v"(negm));
  #define ABIAS(P0,P1,t) do{ const int tt_=(t); const bool on_=(tt_>=NT-4)||(((selmask>>(tt_>>2))&1u)!=0u); \
    const float L0_=on_?((sl2*(float)(64*(tt_-(NT-4)))+hb4)-mhat):-INFINITY; const float L1_=L0_+sl32; \
    _Pragma("unroll") for(int r=0;r<16;++r){P0[r]+=L0_;P1[r]+=L1_;} }while(0)
  #define CMASK(P0,P1,t) do{int jb_=(t)-(NT-4); if(jb_>=0)cmask(P0,P1,jb_,qrel,hi);}while(0)
  bool resc=false;
  #define START(P0,P1) do{ const float rm=rowmax(P0,P1); resc=false; \
    if(__any(rm>(float)THRL)){ const float dl=__builtin_fmaxf(rm,0.f); mhat+=dl; \
      _Pragma("unroll") for(int r=0;r<16;++r){P0[r]-=dl;P1[r]-=dl;} } \
    _Pragma("unroll") for(int r=0;r<16;++r)P0[r]=__builtin_amdgcn_exp2f(P0[r]); }while(0)
  #define RESC() do{ if(resc){ asm volatile("s_waitcnt lgkmcnt(0)":::"memory"); \
      _Pragma("unroll") for(int d_=0;d_<2;++d_) _Pragma("unroll") for(int r=0;r<16;++r)o[d_][r]*=wsf[crow(r,hi)]; } }while(0)
  f32x16 pA0,pA1,pB0,pB1;
  int sl_prev=0,sl_cur=0,sl_next=SLOTB;
  #define ROT() do{sl_prev=sl_cur;sl_cur=sl_next;sl_next=(sl_next==(NSLOT-1)*SLOTB)?0:sl_next+SLOTB;}while(0)
  DMA_K(0,0);DMA_V(0,0);DMA_K(1,SLOTB);
  DMA_K(2,2*SLOTB);
  WAIT_BAR(3);
  qkt(pA0,pA1,Kbase,qr,negm,r32,hi);asm volatile("s_nop 15\n\ts_nop 7":"+v"(pA0),"+v"(pA1));ABIAS(pA0,pA1,0);CMASK(pA0,pA1,0);
  START(pA0,pA1);
  _Pragma("unroll") for(int r=0;r<16;++r)pA1[r]=__builtin_amdgcn_exp2f(pA1[r]);
  WAIT_BAR(0);
  DMA_K(3,0);DMA_V(1,SLOTB);
  ROT();
  kload8(kf,kp0+sl_cur);
  WAIT_BAR(2);
  s16x4 vlo[8],vhi[8]; u32x4 pw0,pw1,pw2,pw3;
  #define PKW(P,B) cvtpk_s(P[B],P[B+1])
  #define PAF(k) __builtin_bit_cast(bf16x8,pw##k)
  #define VFR(i) (bf16x8){vlo[i][0],vlo[i][1],vlo[i][2],vlo[i][3],vhi[i][0],vhi[i][1],vhi[i][2],vhi[i][3]}
  #define PIN(x) asm volatile("":"+v"(x))
  #define MX3(a,b,c) __builtin_fmaxf(__builtin_fmaxf((a),(b)),(c))
  #define GAPA(MF,A0,A1,A2,A3,W0,W1,PW) do{ MF; sacc+=A0; sacc+=A1; sacc+=A2; sacc+=A3; PIN(sacc); W0; W1; PIN(PW); SBAR(); }while(0)
  #define EX(v) __builtin_amdgcn_exp2f(v)
  #define GAPB(MF,X,B) do{ MF; X[B]=EX(X[B]); X[B+1]=EX(X[B+1]); X[B+2]=EX(X[B+2]); X[B+3]=EX(X[B+3]); PIN(X); SBAR(); }while(0)
  #define VRD(i) do{ vlo[i]=vtr(vp_+(((i)>>2)*4096+((i)&3)*1024)); vhi[i]=vtr(vp_+(((i)>>2)*4096+((i)&3)*1024+512)); }while(0)
  #define KRD(G,j) do{ if(G){ kload2(kf,kp0+sl_next,j); SBAR(); } }while(0)
  #define STEP(C0,C1,P0,P1,t,GK,GV,GL) do{ SBAR(); \
    const lds_cptr vp_=vp0+sl_prev; \
    VRD(0); SBAR(); float sacc=(P0[0]+P0[1]); \
    GAPA(C0=__builtin_amdgcn_mfma_f32_32x32x16_bf16(kf[0],qr[0],negm,0,0,0), P0[2],P0[3],P0[4],P0[5],     pw0[0]=PKW(P0,0), pw0[1]=PKW(P0,2), pw0); \
    VRD(4); SBAR(); GAPA(C1=__builtin_amdgcn_mfma_f32_32x32x16_bf16(kf[1],qr[0],negm,0,0,0), P0[6],P0[7],P0[8],P0[9],     pw0[2]=PKW(P0,4), pw0[3]=PKW(P0,6), pw0); \
    VRD(1); SBAR(); GAPA(C0=__builtin_amdgcn_mfma_f32_32x32x16_bf16(kf[2],qr[1],C0,0,0,0),   P0[10],P0[11],P0[12],P0[13], pw1[0]=PKW(P0,8), pw1[1]=PKW(P0,10), pw1); \
    VRD(5); SBAR(); GAPA(C1=__builtin_amdgcn_mfma_f32_32x32x16_bf16(kf[3],qr[1],C1,0,0,0),   P0[14],P0[15],P1[0],P1[1],   pw1[2]=PKW(P0,12),pw1[3]=PKW(P0,14), pw1); \
    VRD(2); SBAR(); GAPA(C0=__builtin_amdgcn_mfma_f32_32x32x16_bf16(kf[4],qr[2],C0,0,0,0),   P1[2],P1[3],P1[4],P1[5],     pw2[0]=PKW(P1,0), pw2[1]=PKW(P1,2), pw2); \
    VRD(6); SBAR(); GAPA(C1=__builtin_amdgcn_mfma_f32_32x32x16_bf16(kf[5],qr[2],C1,0,0,0),   P1[6],P1[7],P1[8],P1[9],     pw2[2]=PKW(P1,4), pw2[3]=PKW(P1,6), pw2); \
    VRD(3); SBAR(); GAPA(C0=__builtin_amdgcn_mfma_f32_32x32x16_bf16(kf[6],qr[3],C0,0,0,0),   P1[10],P1[11],P1[12],P1[13], pw3[0]=PKW(P1,8), pw3[1]=PKW(P1,10), pw3); \
    VRD(7); SBAR(); GAPA(C1=__builtin_amdgcn_mfma_f32_32x32x16_bf16(kf[7],qr[3],C1,0,0,0),   P1[14],P1[15],0.f,0.f,       pw3[2]=PKW(P1,12),pw3[3]=PKW(P1,14), pw3); \
    l_reg+=sacc; \
    if(GK){DMA_K((t)+3,sl_cur);} if(GV){DMA_V((t)+1,sl_next);} \
    ABIAS(C0,C1,t); CMASK(C0,C1,t); \
    { float a=MX3(C0[0],C0[1],C1[0]),b=MX3(C0[2],C0[3],C1[1]); a=MX3(a,C1[2],C1[3]); \
      _Pragma("unroll") for(int r=4;r<16;r+=4){a=MX3(a,C0[r],C0[r+1]);b=MX3(b,C0[r+2],C0[r+3]);a=MX3(a,C1[r],C1[r+1]);b=MX3(b,C1[r+2],C1[r+3]);} \
      float rm=__builtin_fmaxf(a,b); { auto rr=__builtin_amdgcn_permlane32_swap(__float_as_uint(rm),__float_as_uint(rm),false,false); rm=__builtin_fmaxf(__uint_as_float(rr[0]),__uint_as_float(rr[1])); } \
      resc=false; \
      if(__builtin_expect(__any(rm>(float)THRL),0)){ const float dl=__builtin_fmaxf(rm,0.f); mhat+=dl; \
        _Pragma("unroll") for(int r=0;r<16;++r){C0[r]-=dl;C1[r]-=dl;} \
        const float f=__builtin_amdgcn_exp2f(-dl); l_reg*=f; if(hi==0)wsf[r32]=f; resc=true; } } \
    SBAR(); \
    GAPB(o[0]=__builtin_amdgcn_mfma_f32_32x32x16_bf16(PAF(0),VFR(0),o[0],0,0,0), C0,0); \
    GAPB(o[1]=__builtin_amdgcn_mfma_f32_32x32x16_bf16(PAF(0),VFR(4),o[1],0,0,0), C0,4); \
    KRD(GL,0); GAPB(o[0]=__builtin_amdgcn_mfma_f32_32x32x16_bf16(PAF(1),VFR(1),o[0],0,0,0), C0,8); \
    KRD(GL,1); GAPB(o[1]=__builtin_amdgcn_mfma_f32_32x32x16_bf16(PAF(1),VFR(5),o[1],0,0,0), C0,12); \
    KRD(GL,2); GAPB(o[0]=__builtin_amdgcn_mfma_f32_32x32x16_bf16(PAF(2),VFR(2),o[0],0,0,0), C1,0); \
    KRD(GL,3); GAPB(o[1]=__builtin_amdgcn_mfma_f32_32x32x16_bf16(PAF(2),VFR(6),o[1],0,0,0), C1,4); \
    GAPB(o[0]=__builtin_amdgcn_mfma_f32_32x32x16_bf16(PAF(3),VFR(3),o[0],0,0,0), C1,8); \
    GAPB(o[1]=__builtin_amdgcn_mfma_f32_32x32x16_bf16(PAF(3),VFR(7),o[1],0,0,0), C1,12); \
    }while(0)
  int t=1;
  #undef CMASK
  #define CMASK(P0,P1,t) do{}while(0)
  for(;t+5<NT;t+=2){
    STEP(pB0,pB1,pA0,pA1,t,true,true,true);     WAIT_BAR(2); RESC(); ROT();
    STEP(pA0,pA1,pB0,pB1,t+1,true,true,true);   WAIT_BAR(2); RESC(); ROT();
  }
  #undef CMASK
  #define CMASK(P0,P1,t) do{int jb_=(t)-(NT-4); if(jb_>=0)cmask(P0,P1,jb_,qrel,hi);}while(0)
  #define ENDW(tt) do{ if((tt)+3<NT){WAIT_BAR(2);} else if((tt)+2<NT){WAIT_BAR(1);} else {WAIT_BAR(0);} }while(0)
  for(;t+1<NT;t+=2){
    STEP(pB0,pB1,pA0,pA1,t,(t+3<NT),(t+1<NT),(t+1<NT));       ENDW(t);   RESC(); ROT();
    STEP(pA0,pA1,pB0,pB1,t+1,(t+4<NT),(t+2<NT),(t+2<NT));     ENDW(t+1); RESC(); ROT();
  }
  STEP(pB0,pB1,pA0,pA1,NT-1,false,false,false); RESC();
  { float sacc=pB0[0]+pB0[1]; _Pragma("unroll") for(int r=2;r<16;++r)sacc+=pB0[r]; _Pragma("unroll") for(int r=0;r<16;++r)sacc+=pB1[r]; l_reg+=sacc;
    pw0=(u32x4){PKW(pB0,0),PKW(pB0,2),PKW(pB0,4),PKW(pB0,6)};pw1=(u32x4){PKW(pB0,8),PKW(pB0,10),PKW(pB0,12),PKW(pB0,14)};pw2=(u32x4){PKW(pB1,0),PKW(pB1,2),PKW(pB1,4),PKW(pB1,6)};pw3=(u32x4){PKW(pB1,8),PKW(pB1,10),PKW(pB1,12),PKW(pB1,14)};
    SBAR(); pv(o,vb0+sl_cur,PAF(0),PAF(1),PAF(2),PAF(3)); }
  #undef PKW
  #undef PAF
  #undef VFR
  #undef PIN
  #undef MX3
  #undef GAPA
  #undef GAPB
  #undef EX
  #undef VRD
  #undef KRD
  #undef STEP
  #undef ENDW
  {auto rr=__builtin_amdgcn_permlane32_swap(__float_as_uint(l_reg),__float_as_uint(l_reg),false,false);l_reg=__uint_as_float(rr[0])+__uint_as_float(rr[1]);}
  if(hi==0)wsf[32+r32]=l_reg;asm volatile("s_waitcnt lgkmcnt(0)":::"memory");
  float rli[16];
  #pragma unroll
  for(int r=0;r<16;++r)rli[r]=__builtin_amdgcn_rcpf(wsf[32+crow(r,hi)]);
  bf16*Ow=O+(rowbase+q0+wid*QBLK)*DM+h*D;
  { bf16*stg=(bf16*)(shm+LDS_OST)+wid*2048;
    #pragma unroll
    for(int r=0;r<16;++r){const int orow=crow(r,hi);
      #pragma unroll
      for(int d0=0;d0<2;++d0)stg[orow*64+d0*32+r32]=__float2bfloat16(o[d0][r]*rli[r]);}
    asm volatile("s_waitcnt lgkmcnt(0)":::"memory");
    #pragma unroll
    for(int i=0;i<4;++i){const int row=i*8+(lane>>3),ch=lane&7; const u32x4 v=*(const u32x4*)(stg+row*64+ch*8); ATTN_STORE16(Ow+(long)row*DM+ch*8,v);} }
  asm volatile("s_waitcnt lgkmcnt(0)\n\ts_barrier":::"memory");
  #undef DMA_K
  #undef DMA_V
  #undef CMASK
  #undef ABIAS
  #undef START
  #undef RESC
  #undef ROT
}
constexpr int ATTN_LDS_BYTES=LDS_BYTES;
struct AttnTensors { const bf16* Q; const bf16* K; const bf16* V; const float* KM; const float* KA; bf16* O; };
struct AttnUnit { int bh; int qb; };
struct StaticOrder {
  int vcu;
  __device__ __forceinline__ explicit StaticOrder(int grid,int block):vcu((block%8)*(grid/8)+block/8){}
  __device__ __forceinline__ bool next(int i,AttnUnit&u)const{ if(i>=4)return false; const int s=vcu&7; u.bh=vcu>>3; u.qb=(i==0)?s:(i==1)?15-s:(i==2)?16+s:31-s; return true; }
  __device__ __forceinline__ void a_ready(const AttnUnit&)const{}
  __device__ __forceinline__ void done(const AttnUnit&)const{}
};
struct QueueOrder {
  unsigned* ctr; volatile unsigned* slot; int wv;
  __device__ __forceinline__ bool next(int,AttnUnit&u)const{
    if(wv==0&&pg8::lane_now()==0)*slot=__hip_atomic_fetch_add(ctr,1u,__ATOMIC_RELAXED,__HIP_MEMORY_SCOPE_AGENT);
    asm volatile("s_waitcnt vmcnt(0) lgkmcnt(0)\n\ts_barrier":::"memory");
    const unsigned idx=(unsigned)__builtin_amdgcn_readfirstlane((int)*slot);
    if(idx>=(unsigned)(BATCH*NHEAD*NQB))return false;
    u.qb=NQB-1-(int)(idx>>5); u.bh=(int)(idx&31u); return true; }
  __device__ __forceinline__ void a_ready(const AttnUnit&)const{}
  __device__ __forceinline__ void done(const AttnUnit&)const{}
};
template<class Sched,int THRL=8> __device__ __forceinline__ void attn_phase(char*lds,const AttnTensors&T,const Sched&S,int wave_s){
  AttnUnit u;
  for(int i=0;S.next(i,u);++i){ S.a_ready(u); attn_unit<THRL>(u.bh/NHEAD,u.bh%NHEAD,u.qb,T.Q,T.K,T.V,T.KM,T.KA,T.O,lds,wave_s); S.done(u); }
}
#undef SBAR
#undef WAIT_BAR
}
constexpr size_t MiB = (size_t)1 << 20;
constexpr size_t WS_CTL = 0, CTL_ZERO_BYTES = 2 * MiB;
constexpr size_t WS_W0 = 2 * MiB;
constexpr size_t WO_IN = 0, WO_SGU = 36 * MiB, WO_MOBA = 38 * MiB, WO_POOL = 40 * MiB, WO_OUT = 42 * MiB, WO_UP = 50 * MiB, WO_DOWN = 94 * MiB;
constexpr size_t WS_SMALL = 118 * MiB;
constexpr size_t WS_MOD = WS_SMALL + 768 * 1024;
constexpr size_t WS_KMEAN = 512 * 1024;
constexpr size_t WS_KABS = 1 * MiB;
constexpr size_t WS_SGUW = WS_SMALL;
constexpr size_t WS_POOLWT = WS_SMALL + 512 * 1024;
constexpr size_t WS_MODP = 120 * MiB;
constexpr size_t WS_TOPZ = 126 * MiB, WS_BOTZ = 137 * MiB;
constexpr size_t WS_H = 148 * MiB;
constexpr size_t WS_T6 = 276 * MiB;
constexpr size_t WS_G3 = 500 * MiB;
constexpr size_t WS_Y = 276 * MiB;
constexpr size_t WS_A2 = 500 * MiB;
constexpr size_t WS_XR = 884 * MiB;
constexpr size_t WS_H8 = WS_G3 + 192 * MiB;
constexpr size_t WO_IN8 = 6 * MiB;
constexpr size_t WS_CMAX = 64 * 1024;
constexpr size_t WS_CMAXG = WS_CMAX + 96 * 1024;
constexpr size_t WS_RS1 = WS_SMALL + 1280 * 1024 + 128 * 1024;
constexpr size_t WS_RS = WS_SMALL + 1280 * 1024;
constexpr size_t WS_END = 1012 * MiB;
constexpr int CW_TMO = 0, CW_CODE = 1, CW_BAR = 4096, CW_ATTNQ = 8192;
constexpr int RING_BYTES = 131072, XB_OFF = RING_BYTES  , LDSCTL_OFF = 139264, MISC_OFF = LDSCTL_OFF + 320, LDS_BYTES = 147456;

__device__ __forceinline__ float lane_xor(float v, int lane, int o) { return __builtin_bit_cast(float, __builtin_amdgcn_ds_bpermute((lane ^ o) << 2, __builtin_bit_cast(int, v))); }
__device__ __forceinline__ float wave_sum(float v, int lane) {
#pragma unroll
    for (int o = 1; o < 64; o <<= 1) v += lane_xor(v, lane, o);
    return v;
}
__device__ __forceinline__ float wave_max(float v, int lane) {
#pragma unroll
    for (int o = 1; o < 64; o <<= 1) v = fmaxf(v, lane_xor(v, lane, o));
    return v;
}
typedef unsigned u32x2v __attribute__((ext_vector_type(2)));
__device__ __forceinline__ void transpose_item(const float* W, int K, int N, bf16* WT, bool upperm, LAS float* scr, int item, int lane, int f8split = 1 << 30, unsigned char* W8 = nullptr, const unsigned* cmax8 = nullptr, const unsigned* cmaxg = nullptr) {
    const int nblk = N / 32, kb = item / nblk, nb = item % nblk, k0 = 64 * kb, n0 = 32 * nb;
    int drow0 = n0;
    if (upperm) drow0 = (n0 < DFF) ? (n0 >> 7) * 256 + (n0 & 127) : ((n0 - DFF) >> 7) * 256 + 128 + ((n0 - DFF) & 127);
    float v[32];
    const float* src = W + (size_t)(k0 + (lane >> 5)) * N + n0 + (lane & 31);
#pragma unroll
    for (int i = 0; i < 32; ++i) v[i] = __builtin_nontemporal_load(src + (size_t)(2 * i) * N);
#pragma unroll
    for (int i = 0; i < 32; ++i) scr[(2 * i + (lane >> 5)) * 33 + (lane & 31)] = v[i];
    LDS_WAIT(); asm volatile("" ::: "memory");
    const int c = lane & 7;
    if (cmax8) {
#pragma unroll
        for (int j = 0; j < 4; ++j) { const int n = (lane >> 3) + 8 * j; const LAS float* s = scr + (8 * c) * 33 + n;
            const unsigned cb = cmax8[n0 + n]; const float cmx = __builtin_bit_cast(float, cb); const float inv = cmx > 0.f ? 127.0f / cmx : 0.f;
            u32x2v o; o.x = q8x4(s[0 * 33], s[1 * 33], s[2 * 33], s[3 * 33], inv); o.y = q8x4(s[4 * 33], s[5 * 33], s[6 * 33], s[7 * 33], inv);
            *(GAS u32x2v*)((unsigned char*)WT + (size_t)(drow0 + n) * K + k0 + 8 * c) = o; }
    } else if (n0 >= f8split) {
#pragma unroll
        for (int j = 0; j < 4; ++j) { const int n = (lane >> 3) + 8 * j; const LAS float* s = scr + (8 * c) * 33 + n;
            const unsigned cb = cmaxg[n0 - f8split + n]; const float cmx = __builtin_bit_cast(float, cb); const float inv = cmx > 0.f ? 127.0f / cmx : 0.f;
            u32x2v o; o.x = q8x4(s[0 * 33], s[1 * 33], s[2 * 33], s[3 * 33], inv); o.y = q8x4(s[4 * 33], s[5 * 33], s[6 * 33], s[7 * 33], inv);
            *(GAS u32x2v*)(W8 + (size_t)(n0 - f8split + n) * K + k0 + 8 * c) = o; }
    } else {
#pragma unroll
    for (int j = 0; j < 4; ++j) { const int n = (lane >> 3) + 8 * j; const LAS float* s = scr + (8 * c) * 33 + n;
        v4u o; o.x = pg8::cvt_pk_bf16(s[0 * 33], s[1 * 33]); o.y = pg8::cvt_pk_bf16(s[2 * 33], s[3 * 33]); o.z = pg8::cvt_pk_bf16(s[4 * 33], s[5 * 33]); o.w = pg8::cvt_pk_bf16(s[6 * 33], s[7 * 33]);
        *(GAS v4u*)(WT + (size_t)(drow0 + n) * K + k0 + 8 * c) = o; }
    }
    LDS_WAIT(); asm volatile("" ::: "memory");
}

__device__ __forceinline__ void strip_quant(const float* W, int N, unsigned char* WT8, bool upperm, unsigned* cmax_out, LAS unsigned char* lds, int strip, int lane, int wave) {
    const int n0 = 32 * strip;
    int drow0 = n0;
    if (upperm) drow0 = (n0 < DFF) ? (n0 >> 7) * 256 + (n0 & 127) : ((n0 - DFF) >> 7) * 256 + 128 + ((n0 - DFF) & 127);
    LAS float* scr = (LAS float*)(lds + wave * 8448);
    LAS float* cmx = (LAS float*)(lds + 8 * 8448);
    float v[4][32];
#pragma unroll
    for (int b = 0; b < 4; ++b) { const float* src = W + (size_t)((4 * wave + b) * 64 + (lane >> 5)) * N + n0 + (lane & 31);
#pragma unroll
        for (int i = 0; i < 32; ++i) v[b][i] = __builtin_nontemporal_load(src + (size_t)(2 * i) * N); }
    float m = 0.f;
#pragma unroll
    for (int b = 0; b < 4; ++b)
#pragma unroll
        for (int i = 0; i < 32; ++i) m = fmaxf(m, __builtin_fabsf(v[b][i]));
    m = fmaxf(m, lane_xor(m, lane, 32));
    if (lane < 32) cmx[wave * 32 + lane] = m;
    __syncthreads();
    const int c = lane & 7;
    float inv[4];
#pragma unroll
    for (int j = 0; j < 4; ++j) { const int n = (lane >> 3) + 8 * j; float mm = 0.f;
#pragma unroll
        for (int w = 0; w < 8; ++w) mm = fmaxf(mm, cmx[w * 32 + n]);
        inv[j] = mm > 0.f ? 127.0f / mm : 0.f;
        if (wave == 0 && c == 0) cmax_out[n0 + n] = __builtin_bit_cast(unsigned, mm); }
#pragma unroll
    for (int b = 0; b < 4; ++b) { const int k0 = (4 * wave + b) * 64;
#pragma unroll
        for (int i = 0; i < 32; ++i) scr[(2 * i + (lane >> 5)) * 33 + (lane & 31)] = v[b][i];
        LDS_WAIT(); asm volatile("" ::: "memory");
#pragma unroll
        for (int j = 0; j < 4; ++j) { const int n = (lane >> 3) + 8 * j; const LAS float* sp = scr + (8 * c) * 33 + n;
            u32x2v o; o.x = q8x4(sp[0 * 33], sp[1 * 33], sp[2 * 33], sp[3 * 33], inv[j]); o.y = q8x4(sp[4 * 33], sp[5 * 33], sp[6 * 33], sp[7 * 33], inv[j]);
            *(GAS u32x2v*)(WT8 + (size_t)(drow0 + n) * DM + k0 + 8 * c) = o; }
        LDS_WAIT(); asm volatile("" ::: "memory"); }
    __syncthreads();
}

template <int MODE, bool XIN_BF16, bool XOUT_BF16, bool H8OUT = false, bool HQOUT = false>
__device__ __forceinline__ void thin_phase(LAS unsigned char* lds, int tid, int lane, int wave, int bx, int G,
        const void* xin_, const bf16* yin, void* xout_, bf16* hout, unsigned char* hout8, float* rsout,
        const float* modA, const float* gA, const float* modS, const float* modT, const float* gS) {
    LAS float* vA = (LAS float*)lds; LAS float* vS = vA + 2048; LAS float* vT = vS + 2048;
    for (int rb = bx; rb < M / 128; rb += G) {
        const int b = rb >> 6;
        __syncthreads();
        for (int c = tid; c < DM; c += 512) {
            if (MODE != 0) vA[c] = modA[(size_t)b * 12288 + c] * gA[c];
            if (MODE != 2) { vS[c] = gS[c] * (1.0f + modS[(size_t)b * 12288 + c]); vT[c] = modT[(size_t)b * 12288 + c]; }
        }
        __syncthreads();
        for (int i = 0; i < 8; ++i) {
            size_t ro[2]; f32x4 x[2][8]; uint2 yr[2][8];
#pragma unroll
            for (int r = 0; r < 2; ++r) { ro[r] = (size_t)(rb * 128 + wave * 16 + i + 8 * r) * DM + 4 * lane;
#pragma unroll
                for (int j = 0; j < 8; ++j) {
                    if (XIN_BF16) { const u32x2v w = __builtin_nontemporal_load((const u32x2v*)((const bf16*)xin_ + ro[r] + 256 * j)); x[r][j] = (f32x4){bf_lo(w.x), bf_hi(w.x), bf_lo(w.y), bf_hi(w.y)}; }
                    else x[r][j] = __builtin_nontemporal_load((const f32x4*)((const float*)xin_ + ro[r] + 256 * j));
                    if (MODE != 0) { const u32x2v w = __builtin_nontemporal_load((const u32x2v*)(yin + ro[r] + 256 * j)); yr[r][j].x = w.x; yr[r][j].y = w.y; } } }
            asm volatile("" ::: "memory");
            if (MODE != 0) {
                float ss[2];
#pragma unroll
                for (int r = 0; r < 2; ++r) { ss[r] = 0.f;
#pragma unroll
                    for (int j = 0; j < 8; ++j) { const float y0 = bf_lo(yr[r][j].x), y1 = bf_hi(yr[r][j].x), y2 = bf_lo(yr[r][j].y), y3 = bf_hi(yr[r][j].y); ss[r] += (y0 * y0 + y1 * y1) + (y2 * y2 + y3 * y3); } }
#pragma unroll
                for (int o = 1; o < 64; o <<= 1) { const float t0 = lane_xor(ss[0], lane, o), t1 = lane_xor(ss[1], lane, o); ss[0] += t0; ss[1] += t1; }
#pragma unroll
                for (int r = 0; r < 2; ++r) { const float rstd = 1.0f / __builtin_sqrtf(ss[r] * (1.0f / DM) + EPS);
#pragma unroll
                    for (int j = 0; j < 8; ++j) { const f32x4 a = *(const LAS f32x4*)(vA + 4 * lane + 256 * j);
                        const f32x4 y = (f32x4){bf_lo(yr[r][j].x), bf_hi(yr[r][j].x), bf_lo(yr[r][j].y), bf_hi(yr[r][j].y)}; x[r][j] = x[r][j] + a * (y * rstd);
                        if (XOUT_BF16) { u32x2v w; w.x = pk2(x[r][j][0], x[r][j][1]); w.y = pk2(x[r][j][2], x[r][j][3]); __builtin_nontemporal_store(w, (u32x2v*)((bf16*)xout_ + ro[r] + 256 * j)); }
                        else __builtin_nontemporal_store(x[r][j], (f32x4*)((float*)xout_ + ro[r] + 256 * j)); } }
            }
            if (MODE != 2) {
                float ss[2];
#pragma unroll
                for (int r = 0; r < 2; ++r) { ss[r] = 0.f;
#pragma unroll
                    for (int j = 0; j < 8; ++j) ss[r] += (x[r][j][0] * x[r][j][0] + x[r][j][1] * x[r][j][1]) + (x[r][j][2] * x[r][j][2] + x[r][j][3] * x[r][j][3]); }
#pragma unroll
                for (int o = 1; o < 64; o <<= 1) { const float t0 = lane_xor(ss[0], lane, o), t1 = lane_xor(ss[1], lane, o); ss[0] += t0; ss[1] += t1; }
                if (HQOUT || H8OUT) {
                    float mx[2];
#pragma unroll
                    for (int r = 0; r < 2; ++r) { const float rstd = 1.0f / __builtin_sqrtf(ss[r] * (1.0f / DM) + EPS); mx[r] = 0.f;
#pragma unroll
                        for (int j = 0; j < 8; ++j) { const f32x4 sv = *(const LAS f32x4*)(vS + 4 * lane + 256 * j), tv = *(const LAS f32x4*)(vT + 4 * lane + 256 * j);
                            const f32x4 h = x[r][j] * rstd * sv + tv; x[r][j] = h;
                            mx[r] = fmaxf(fmaxf(mx[r], fmaxf(__builtin_fabsf(h[0]), __builtin_fabsf(h[1]))), fmaxf(__builtin_fabsf(h[2]), __builtin_fabsf(h[3]))); } }
#pragma unroll
                    for (int o = 1; o < 64; o <<= 1) { const float t0 = lane_xor(mx[0], lane, o), t1 = lane_xor(mx[1], lane, o); mx[0] = fmaxf(mx[0], t0); mx[1] = fmaxf(mx[1], t1); }
#pragma unroll
                    for (int r = 0; r < 2; ++r) { const float inv = mx[r] > 0.f ? 127.0f / mx[r] : 0.f;
                        if (lane == 0) rsout[ro[r] / DM] = mx[r] * (1.0f / 127.0f);
                        unsigned char* qdst = HQOUT ? (unsigned char*)hout : hout8;
#pragma unroll
                        for (int j = 0; j < 8; ++j) { *(unsigned*)(qdst + ro[r] + 256 * j) = q8x4(x[r][j][0], x[r][j][1], x[r][j][2], x[r][j][3], inv);
                            if (!HQOUT) { uint2 w; w.x = pk2(x[r][j][0], x[r][j][1]); w.y = pk2(x[r][j][2], x[r][j][3]); *(uint2*)(hout + ro[r] + 256 * j) = w; } } }
                } else
#pragma unroll
                for (int r = 0; r < 2; ++r) { const float rstd = 1.0f / __builtin_sqrtf(ss[r] * (1.0f / DM) + EPS);
#pragma unroll
                    for (int j = 0; j < 8; ++j) { const f32x4 sv = *(const LAS f32x4*)(vS + 4 * lane + 256 * j), tv = *(const LAS f32x4*)(vT + 4 * lane + 256 * j);
                        const f32x4 h = x[r][j] * rstd * sv + tv; uint2 w; w.x = pk2(h[0], h[1]); w.y = pk2(h[2], h[3]); *(uint2*)(hout + ro[r] + 256 * j) = w; } }
            }
        }
    }
    __syncthreads();
}

typedef float f32x16_t __attribute__((ext_vector_type(16)));
constexpr int VNT_LD = 136;
__device__ __forceinline__ void sgu_mfma_chunk(LAS unsigned char* lds, int chunk, const bf16* Vt, const bf16* Ut, bf16* Uo, const float* norm_g, const bf16* Wm  , const float* sgu_b, int lane, int wave) {
    LAS unsigned short* vnT = (LAS unsigned short*)lds;
    const int t0 = chunk * 128;
    float g8[8];
#pragma unroll
    for (int e = 0; e < 8; ++e) g8[e] = norm_g[lane + 64 * e];
    for (int i4 = 0; i4 < 4; ++i4) {
        float v[4][8];
#pragma unroll
        for (int i = 0; i < 4; ++i) { const bf16* vr = Vt + (size_t)(t0 + wave * 16 + i4 * 4 + i) * BW + lane;
#pragma unroll
            for (int e = 0; e < 8; ++e) v[i][e] = bf2f(vr[64 * e]); }
#pragma unroll
        for (int i = 0; i < 4; ++i) { const int s = wave * 16 + i4 * 4 + i; float sum = 0.f;
#pragma unroll
            for (int e = 0; e < 8; ++e) sum += v[i][e];
            const float mu = wave_sum(sum, lane) * (1.0f / BW); float q = 0.f;
#pragma unroll
            for (int e = 0; e < 8; ++e) { v[i][e] -= mu; q += v[i][e] * v[i][e]; }
            const float rstd = 1.0f / __builtin_sqrtf(wave_sum(q, lane) * (1.0f / BW) + EPS);
#pragma unroll
            for (int e = 0; e < 8; ++e) vnT[(lane + 64 * e) * VNT_LD + s] = (unsigned short)f2bf(v[i][e] * rstd * g8[e]); }
    }
    __syncthreads();
    const int r32 = lane & 31, hi = lane >> 5, g = wave;
    f32x16_t acc[4][2];
#pragma unroll
    for (int ti = 0; ti < 4; ++ti)
#pragma unroll
        for (int dj = 0; dj < 2; ++dj)
#pragma unroll
            for (int r = 0; r < 16; ++r) acc[ti][dj][r] = 0.f;
    const bf16* Wg = Wm + (size_t)g * 16384 + (size_t)r32 * 128 + 8 * hi;
    const LAS unsigned short* vb = vnT + (64 * g + r32) * VNT_LD + 8 * hi;
#pragma unroll
    for (int ks = 0; ks < 8; ++ks) {
        const bf16x8 b0 = *(const LAS bf16x8*)(vb + 16 * ks), b1 = *(const LAS bf16x8*)(vb + 32 * VNT_LD + 16 * ks);
#pragma unroll
        for (int ti = 0; ti < 4; ++ti) if (16 * ks <= 32 * ti + 31) {
            const bf16x8 a = *(const bf16x8*)(Wg + (size_t)ti * 32 * 128 + 16 * ks);
            acc[ti][0] = __builtin_amdgcn_mfma_f32_32x32x16_bf16(b0, a, acc[ti][0], 0, 0, 0);
            acc[ti][1] = __builtin_amdgcn_mfma_f32_32x32x16_bf16(b1, a, acc[ti][1], 0, 0, 0); }
    }
#pragma unroll
    for (int ti = 0; ti < 4; ++ti) { const int t = 32 * ti + r32; const float bs = sgu_b[g * 128 + t];
#pragma unroll
        for (int dj = 0; dj < 2; ++dj)
#pragma unroll
            for (int rg = 0; rg < 4; ++rg) { const size_t o = (size_t)(t0 + t) * BW + 64 * g + 32 * dj + 8 * rg + 4 * hi;
                const uint2 uu = *(const uint2*)(Ut + o); uint2 w;
                w.x = pk2(bf_lo(uu.x) * (acc[ti][dj][4 * rg + 0] + bs), bf_hi(uu.x) * (acc[ti][dj][4 * rg + 1] + bs)); w.y = pk2(bf_lo(uu.y) * (acc[ti][dj][4 * rg + 2] + bs), bf_hi(uu.y) * (acc[ti][dj][4 * rg + 3] + bs));
                *(uint2*)(Uo + o) = w; } }
    __syncthreads();
}

constexpr int PA_LD = 520;
template <int W> __device__ __forceinline__ void pool_window(LAS unsigned short* pa, const bf16* ZP, int t0, int c) {
    float z[64 + W - 1];
    const int pos0 = t0 & (SEQ - 1);
#pragma unroll
    for (int i = 0; i < 64 + W - 1; ++i) { const int dt = i - (W - 1); z[i] = (pos0 + dt >= 0) ? bf2f(ZP[(size_t)(t0 + dt) * BW + c]) : 0.f; }
#pragma unroll
    for (int tl = 0; tl < 64; ++tl) { float s = 0.f;
#pragma unroll
        for (int i = 0; i < W; ++i) s += z[tl + (W - 1) - i];
        const int pos = pos0 + tl; const float cnt = (float)((pos + 1 < W) ? pos + 1 : W);
        pa[tl * PA_LD + c] = (unsigned short)f2bf(s / cnt - z[tl + W - 1]); }
}
__device__ __forceinline__ void pool_mfma_tile(LAS unsigned char* lds, int tile, const bf16* ZP, bf16* YPo, const bf16* PWT  , const float* pool_scale, int tid, int lane, int wave) {
    LAS unsigned short* pa = (LAS unsigned short*)lds;
    const int t0 = tile * 64, c = tid, gsel = wave >> 1;
    if (gsel == 0) pool_window<2>(pa, ZP, t0, c); else if (gsel == 1) pool_window<4>(pa, ZP, t0, c); else if (gsel == 2) pool_window<8>(pa, ZP, t0, c); else pool_window<16>(pa, ZP, t0, c);
    __syncthreads();
    const int r32 = lane & 31, hi = lane >> 5, g = wave >> 1, dh = wave & 1;
    f32x16_t acc[2][2];
#pragma unroll
    for (int ti = 0; ti < 2; ++ti)
#pragma unroll
        for (int dj = 0; dj < 2; ++dj)
#pragma unroll
            for (int r = 0; r < 16; ++r) acc[ti][dj][r] = 0.f;
    const bf16* Bg = PWT + ((size_t)g * 128 + 64 * dh + r32) * 128 + 8 * hi;
    const LAS unsigned short* ab = pa + r32 * PA_LD + 128 * g + 8 * hi;
#pragma unroll
    for (int ks = 0; ks < 8; ++ks) {
        const bf16x8 b0 = *(const bf16x8*)(Bg + 16 * ks), b1 = *(const bf16x8*)(Bg + (size_t)32 * 128 + 16 * ks);
        const bf16x8 a0 = *(const LAS bf16x8*)(ab + 16 * ks), a1 = *(const LAS bf16x8*)(ab + 32 * PA_LD + 16 * ks);
        acc[0][0] = __builtin_amdgcn_mfma_f32_32x32x16_bf16(b0, a0, acc[0][0], 0, 0, 0); acc[0][1] = __builtin_amdgcn_mfma_f32_32x32x16_bf16(b1, a0, acc[0][1], 0, 0, 0);
        acc[1][0] = __builtin_amdgcn_mfma_f32_32x32x16_bf16(b0, a1, acc[1][0], 0, 0, 0); acc[1][1] = __builtin_amdgcn_mfma_f32_32x32x16_bf16(b1, a1, acc[1][1], 0, 0, 0);
    }
#pragma unroll
    for (int dj = 0; dj < 2; ++dj)
#pragma unroll
        for (int rg = 0; rg < 4; ++rg) { const int oc = 128 * g + 64 * dh + 32 * dj + 8 * rg + 4 * hi; const f32x4 sc = *(const f32x4*)(pool_scale + oc);
#pragma unroll
            for (int ti = 0; ti < 2; ++ti) { uint2 w; w.x = pk2(acc[ti][dj][4 * rg + 0] * sc[0], acc[ti][dj][4 * rg + 1] * sc[1]); w.y = pk2(acc[ti][dj][4 * rg + 2] * sc[2], acc[ti][dj][4 * rg + 3] * sc[3]);
                *(uint2*)(YPo + (size_t)(t0 + 32 * ti + r32) * BW + oc) = w; } }
    __syncthreads();
}

#ifndef NREP_GEMM
#define NREP_GEMM 1
#endif
#ifndef WGM_WIDE
#define WGM_WIDE 4
#endif
#ifndef WGM_NARROW
#define WGM_NARROW 4
#endif
#ifndef GP_ALIGN
#define GP_ALIGN true
#endif
#ifndef GP_SP2
#define GP_SP2 true
#endif
#ifndef PROBE_BAR2
#define PROBE_BAR2 0
#endif
#ifndef NREP_P0
#define NREP_P0 1
#endif
#ifndef NREP_ATTN
#define NREP_ATTN 1
#endif
#ifndef NREP_MIX
#define NREP_MIX 1
#endif
#ifndef NREP_THIN
#define NREP_THIN 1
#endif
#define PHASE_IDS() int tid_o = wave_s * 64 + pg8::lane_now(); asm volatile("" : "+v"(tid_o)); const int tid = tid_o, lane = tid & 63, wave = __builtin_amdgcn_readfirstlane(tid >> 6), gw = bx * NWAVES + wave, NGW = G * NWAVES; (void)lane; (void)gw; (void)NGW; (void)wave
struct Args { const float* in[23]; float* out; unsigned char* ws; };
__global__ void __launch_bounds__(NWAVES * 64, 2) fwd_kernel(Args args) {
    extern __shared__ __attribute__((aligned(16))) unsigned char lds_raw[];
    LAS unsigned char* lds = (LAS unsigned char*)lds_raw;
    const int G = gridDim.x, bx = blockIdx.x;
    int wave_s = __builtin_amdgcn_readfirstlane((int)(threadIdx.x >> 6)); asm volatile("" : "+s"(wave_s));
    gu32* ctl = (gu32*)(args.ws + WS_CTL);
    for (int u = threadIdx.x; u < (LDS_BYTES - LDSCTL_OFF) / 4; u += NWAVES * 64) ((LAS unsigned*)(lds + LDSCTL_OFF))[u] = 0u;
    __syncthreads();
    volatile LAS unsigned* MISC = (volatile LAS unsigned*)(lds + MISC_OFF);
    XcdBarrier bar = xcd_barrier_post((unsigned*)(ctl + CW_BAR), MISC + 8);
#define GRID_BAR() do { XcdBarrier b_ = bar; asm volatile("" : "+s"(b_.x), "+s"(b_.bar)); xcd_barrier(b_); if (PROBE_BAR2) xcd_barrier(b_); } while (0)
    const volatile __attribute__((address_space(4))) unsigned long long* kargs = (const volatile __attribute__((address_space(4))) unsigned long long*)__builtin_amdgcn_kernarg_segment_ptr();
#define INP(i) ((const float*)(const GAS float*)kargs[(i)])
#define OUTP ((float*)(GAS float*)kargs[23])
#define WSB ((unsigned char*)(GAS unsigned char*)kargs[24])
#define in_x INP(0)
#define in_c INP(1)
#define g_pre_mix INP(2)
#define g_post_mix INP(3)
#define g_pre_ffn INP(4)
#define g_post_ffn INP(5)
#define w_ada INP(6)
#define b_ada INP(7)
#define w_in INP(8)
#define b_in INP(9)
#define sgu_norm_g INP(10)
#define sgu_w INP(11)
#define sgu_b INP(12)
#define pool_w INP(13)
#define pool_scale INP(14)
#define w_sgu_out INP(15)
#define w_moba_out INP(16)
#define w_pool_out INP(17)
#define w_out INP(18)
#define w_up INP(19)
#define w_conv INP(20)
#define b_conv INP(21)
#define w_down INP(22)
#define out OUTP
#define MOD ((float*)(WSB + WS_MOD))
#define MODP ((float*)(WSB + WS_MODP))
#define KMEAN ((float*)(WSB + WS_KMEAN))
#define H ((bf16*)(WSB + WS_H))
#define T6 ((bf16*)(WSB + WS_T6))
#define G3 ((unsigned char*)(WSB + WS_G3))
#define H8 ((unsigned char*)(WSB + WS_H8))
#define Yb ((bf16*)(WSB + WS_Y))
#define XR ((bf16*)(WSB + WS_XR))
#define A2 ((bf16*)(WSB + WS_A2))
#define Ut T6
#define Qt (T6 + (size_t)1 * M * BW)
#define YP (T6 + (size_t)2 * M * BW)
#define Vt (T6 + (size_t)3 * M * BW)
#define Kt (T6 + (size_t)4 * M * BW)
#define VAt (T6 + (size_t)5 * M * BW)
#define ZPt (T6 + (size_t)6 * M * BW)

    for (int rep0_ = 0; rep0_ < NREP_P0; ++rep0_) {
    {   PHASE_IDS();
        LAS float* cond = (LAS float*)(lds + 69632);
        for (int i = tid; i < BATCH * DM; i += NWAVES * 64) { const float c = in_c[i]; cond[i] = c * sigmoid_f(c); }
        __syncthreads();
        for (int w0 = gw; w0 < 1536 + 64 * NWAVES; w0 += NGW) { const int wt = w0 - 64 * NWAVES; if (wt < 0) continue;
            const int ks = wt / 96, cb = wt % 96, l = cb / 48, n0 = (cb % 48) * 256 + 4 * lane;
            const float* wp = w_ada + ((size_t)l * DM + ks * 128) * 12288 + n0;
            f32x4 a0 = {0.f, 0.f, 0.f, 0.f}, a1 = a0, a2 = a0, a3 = a0;
#pragma unroll 8
            for (int k = 0; k < 128; ++k) { const f32x4 w = __builtin_nontemporal_load((const f32x4*)(wp + (size_t)k * 12288)); const int kk = ks * 128 + k;
                a0 += cond[kk] * w; a1 += cond[DM + kk] * w; a2 += cond[2 * DM + kk] * w; a3 += cond[3 * DM + kk] * w; }
            float* pp = MODP + (size_t)(ks * 8 + l * 4) * 12288 + n0;
            *(f32x4*)(pp) = a0; *(f32x4*)(pp + 12288) = a1; *(f32x4*)(pp + 2 * 12288) = a2; *(f32x4*)(pp + 3 * 12288) = a3;
        }
        LAS float* scr = (LAS float*)(lds + wave * 8448);
#define CONVERT_ITEMS(l, WB, LO, HI, SLOT, NSLOT) \
        for (int it = (LO) + (SLOT) * NWAVES + wave; it < (HI); it += (NSLOT) * NWAVES) { int r = it; \
            bf16* Wc = (bf16*)(WB); \
            if (r < 9216) { transpose_item(w_in + (size_t)(l) * DM * INW, DM, INW, (bf16*)((unsigned char*)Wc + WO_IN), false, scr, r, lane, 0, (unsigned char*)Wc + WO_IN, nullptr, (const unsigned*)(WSB + WS_CMAXG) + (size_t)(l) * 9216); continue; } r -= 9216; \
            if (r < 512) { transpose_item(w_sgu_out + (size_t)(l) * BW * DM, BW, DM, (bf16*)((unsigned char*)Wc + WO_SGU), false, scr, r, lane); continue; } r -= 512; \
            if (r < 512) { transpose_item(w_moba_out + (size_t)(l) * BW * DM, BW, DM, (bf16*)((unsigned char*)Wc + WO_MOBA), false, scr, r, lane); continue; } r -= 512; \
            if (r < 512) { transpose_item(w_pool_out + (size_t)(l) * BW * DM, BW, DM, (bf16*)((unsigned char*)Wc + WO_POOL), false, scr, r, lane); continue; } r -= 512; \
            if (r < 2048) { transpose_item(w_out + (size_t)(l) * DM * DM, DM, DM, (bf16*)((unsigned char*)Wc + WO_OUT), false, scr, r, lane); continue; } r -= 2048; \
            if (r < 11264) { transpose_item(w_up + (size_t)(l) * DM * NUP, DM, NUP, (bf16*)((unsigned char*)Wc + WO_UP), true, scr, r, lane, 1 << 30, nullptr, (const unsigned*)(WSB + WS_CMAX) + (size_t)(l) * NUP); continue; } r -= 11264; \
            transpose_item(w_down + (size_t)(l) * DFF * DM, DFF, DM, (bf16*)((unsigned char*)Wc + WO_DOWN), false, scr, r, lane); \
        }
#define QUANT_STRIPS(l, WB, S0, S1, SLOT, NSLOT) { __syncthreads(); \
          for (int st = (S0) + (SLOT); st < (S1); st += (NSLOT)) { \
              if (st < 288) strip_quant(w_in + (size_t)(l) * DM * INW, INW, (WB) + WO_IN, false, (unsigned*)(WSB + WS_CMAXG) + (size_t)(l) * 9216, lds, st, lane, wave); \
              else strip_quant(w_up + (size_t)(l) * DM * NUP, NUP, (WB) + WO_UP, true, (unsigned*)(WSB + WS_CMAX) + (size_t)(l) * NUP, lds, st - 288, lane, wave); } }
        QUANT_STRIPS(0, WSB + WS_W0, 0, 288, bx, G)
        { bf16* SW = (bf16*)(WSB + WS_SGUW); bf16* PW = (bf16*)(WSB + WS_POOLWT); const float* sw = sgu_w; const float* pw = pool_w;
          for (int i = bx * NWAVES * 64 + tid; i < 2 * 8 * 16384; i += G * NWAVES * 64) { const int t = (i >> 7) & 127, sI = i & 127; SW[i] = (bf16)((sI <= t) ? f2bf(sw[i]) : 0u); }
          for (int i = bx * NWAVES * 64 + tid; i < 2 * 4 * 16384; i += G * NWAVES * 64) { const int lg = i >> 14, d = (i >> 7) & 127, cI = i & 127; PW[i] = (bf16)f2bf(pw[(size_t)lg * 16384 + cI * 128 + d]); } }
        GRID_BAR();
    }
    {   PHASE_IDS();
        for (int v = bx * NWAVES * 64 + tid; v < 2 * BATCH * 12288; v += G * NWAVES * 64) {
            const int lb = v / 12288, n = v % 12288; float s = b_ada[(size_t)(lb >> 2) * 12288 + n];
            for (int ks = 0; ks < 16; ++ks) s += MODP[(size_t)(ks * 8 + lb) * 12288 + n];
            MOD[v] = s; }
        GRID_BAR();
    }
    { PHASE_IDS(); thin_phase<0, false, false, false, true>(lds, tid, lane, wave, bx, G, in_x, nullptr, nullptr, (bf16*)H8, nullptr, (float*)(WSB + WS_RS1), nullptr, nullptr, MOD + 2048, MOD + 0, g_pre_mix); }
    GRID_BAR();
    }

    for (int l = 0; l < DEPTH; ++l) {
#define Wl (l == 0 ? WSB + WS_W0 : (unsigned char*)OUTP)
#define modl (MOD + (size_t)l * BATCH * 12288)
        for (int rep_ = 0; rep_ < NREP_GEMM; ++rep_)
        { { pg8::Gemm g{(const bf16*)H8, (const bf16*)(Wl + WO_IN), M, 3072, DM / 2}; pg8::StaticOrder S; S.init(M, 3072, G, bx, WGM_WIDE);
            EpiInProj E{b_in + (size_t)l * INW, T6, KMEAN + (size_t)l * 65536, (unsigned*)(WSB + WS_KABS) + (size_t)l * 65536, (const float*)(WSB + WS_RS1), (const unsigned*)(WSB + WS_CMAXG) + (size_t)l * 9216};
            pg8::gemm_phase<EpiInProj, pg8::StaticOrder, GP_ALIGN, GP_SP2, false, true>(lds, g, S, E, wave_s); }
          GRID_BAR(); }
        { PHASE_IDS();
          for (int repa_ = NREP_ATTN - 1; repa_ >= 0; --repa_)
          { const attn_body::AttnTensors AT{(const attn_body::bf16*)Qt, (const attn_body::bf16*)Kt, (const attn_body::bf16*)VAt, KMEAN + (size_t)l * 65536, (const float*)(WSB + WS_KABS) + (size_t)l * 65536, repa_ ? (attn_body::bf16*)H : (attn_body::bf16*)Qt};
            const attn_body::QueueOrder AS{(unsigned*)(WSB + WS_CTL) + CW_ATTNQ + 64 * l + 16 * repa_, (volatile unsigned*)((char*)lds_raw + MISC_OFF + 64), wave_s};
            {
              const unsigned nent = (l == 0) ? 1536u : 1024u;
              for (;;) {
                  if (AS.wv == 0 && pg8::lane_now() == 0) *AS.slot = __hip_atomic_fetch_add(AS.ctr, 1u, __ATOMIC_RELAXED, __HIP_MEMORY_SCOPE_AGENT);
                  asm volatile("s_waitcnt vmcnt(0) lgkmcnt(0)\n\ts_barrier" ::: "memory");
                  const unsigned idx = (unsigned)__builtin_amdgcn_readfirstlane((int)*AS.slot);
                  if (idx >= nent) break;
                  unsigned a_ = idx; int bun = -1;
                  if (l == 0) { const unsigned grp = idx / 3u, rr = idx - 3u * grp; if (rr < 2u) a_ = 2u * grp + rr; else bun = (int)grp; }
                  if (bun < 0) { const int qb_ = attn_body::NQB - 1 - (int)(a_ >> 5), bh_ = (int)(a_ & 31u);
                      attn_body::attn_unit<8>(bh_ / attn_body::NHEAD, bh_ % attn_body::NHEAD, qb_, AT.Q, AT.K, AT.V, AT.KM, AT.KA, AT.O, (char*)lds_raw, wave_s); }
                  else { const int lane = pg8::lane_now(); LAS float* scr = (LAS float*)(lds + wave * 8448);
                      if (bun < 256) { const int c_ = bun; CONVERT_ITEMS(0, WSB + WS_W0, 9216, 12800, c_, 256) CONVERT_ITEMS(0, WSB + WS_W0, 24064, 29696, c_, 256) QUANT_STRIPS(0, WSB + WS_W0, 288, 640, c_, 256) }
                      else { const int c_ = bun - 256; CONVERT_ITEMS(1, (unsigned char*)OUTP, 9216, 12800, c_, 256) CONVERT_ITEMS(1, (unsigned char*)OUTP, 24064, 29696, c_, 256) QUANT_STRIPS(1, (unsigned char*)OUTP, 0, 640, c_, 256) }
                      __syncthreads(); }
              } } }
          __syncthreads();
          for (int repm_ = NREP_MIX - 1; repm_ >= 0; --repm_) {
          for (int chunk = bx; chunk < M / 128; chunk += G) sgu_mfma_chunk(lds, chunk, Vt, Ut, repm_ ? H : Ut, sgu_norm_g + (size_t)l * BW, (const bf16*)(WSB + WS_SGUW) + (size_t)l * 8 * 16384, sgu_b + (size_t)l * 8 * 128, lane, wave);
          for (int tile = bx; tile < M / 64; tile += G) pool_mfma_tile(lds, tile, ZPt, YP, (const bf16*)(WSB + WS_POOLWT) + (size_t)l * 4 * 16384, pool_scale + (size_t)l * BW, tid, lane, wave);
          }
          GRID_BAR(); }
        for (int rep_ = 0; rep_ < NREP_GEMM; ++rep_)
        {
          { pg8::Gemm g{(const bf16*)H8, (const bf16*)(Wl + WO_IN + WO_IN8), M, 6144, DM / 2}; pg8::StaticOrder S; S.init(M, 6144, G, bx, WGM_WIDE);
            EpiGate8 E{b_in + (size_t)l * INW + 3072, G3, (const float*)(WSB + WS_RS1), (const unsigned*)(WSB + WS_CMAXG) + (size_t)l * 9216 + 3072};
            pg8::gemm_phase<EpiGate8, pg8::StaticOrder, GP_ALIGN, GP_SP2, false, true>(lds, g, S, E, wave_s); }
          GRID_BAR(); }
        for (int rep_ = 0; rep_ < NREP_GEMM; ++rep_)
        { pg8::Gemm g{Ut, (const bf16*)(Wl + WO_SGU), M, DM, BW, 3, (size_t)M * BW * 2, (size_t)2 * MiB}; pg8::StaticOrder S; S.init(M, DM, G, bx, WGM_NARROW);
          EpiBranch E{G3, H};
          pg8::gemm_phase<EpiBranch, pg8::StaticOrder, GP_ALIGN, GP_SP2>(lds, g, S, E, wave_s);
          GRID_BAR(); }
        for (int rep_ = 0; rep_ < NREP_GEMM; ++rep_)
        { pg8::Gemm g{H, (const bf16*)(Wl + WO_OUT), M, DM, DM}; pg8::StaticOrder S; S.init(M, DM, G, bx, WGM_NARROW);
          EpiPlain E{Yb, DM};
          pg8::gemm_phase<EpiPlain, pg8::StaticOrder, GP_ALIGN, GP_SP2>(lds, g, S, E, wave_s);
          GRID_BAR(); }
        for (int rept_ = 0; rept_ < (l == 0 ? NREP_THIN : 1); ++rept_)
        { PHASE_IDS(); if (l == 0) thin_phase<1, false, true, false, true>(lds, tid, lane, wave, bx, G, in_x, Yb, XR, H, nullptr, (float*)(WSB + WS_RS), modl + 4096, g_post_mix + (size_t)l * DM, modl + 8192, modl + 6144, g_pre_ffn + (size_t)l * DM);
          else thin_phase<1, true, true, false, true>(lds, tid, lane, wave, bx, G, XR, Yb, XR, H, nullptr, (float*)(WSB + WS_RS), modl + 4096, g_post_mix + (size_t)l * DM, modl + 8192, modl + 6144, g_pre_ffn + (size_t)l * DM); }
        GRID_BAR();
        for (int rep_ = 0; rep_ < NREP_GEMM; ++rep_)
        { pg8::Gemm g{H, (const bf16*)(Wl + WO_UP), M, NUP, DM / 2}; pg8::StaticOrder S; S.init(M, NUP, G, bx, WGM_WIDE);
          EpiUpConv E{A2, w_conv + (size_t)l * 3 * NUP, b_conv + (size_t)l * NUP, (float*)(WSB + WS_TOPZ), (float*)(WSB + WS_BOTZ), (LAS float*)(lds + XB_OFF), (const float*)(WSB + WS_RS), (const unsigned*)(WSB + WS_CMAX) + (size_t)l * NUP};
          pg8::gemm_phase<EpiUpConv, pg8::StaticOrder, true, GP_SP2, false, true>(lds, g, S, E, wave_s);
          GRID_BAR(); }
        { PHASE_IDS(); const float* wc = w_conv + (size_t)l * 3 * NUP; const float* bc = b_conv + (size_t)l * NUP;
          const float* TZ = (const float*)(WSB + WS_TOPZ); const float* BZ = (const float*)(WSB + WS_BOTZ); bf16* a2 = A2;
          for (int it = bx * NWAVES * 64 + tid; it < (M / 256) * DFF; it += G * NWAVES * 64) { const int pm = it / DFF, n = it % DFF; if ((pm & 31) == 0) continue;
              const int cg = (n >> 7) * 256 + (n & 127);
              float res[2];
              float zc[2][2];
#pragma unroll
              for (int k = 0; k < 2; ++k) { const int c = cg + 128 * k, pc = n + DFF * k;
                  const float t0 = TZ[((size_t)pm * 2 + 0) * NUP + c], t1 = TZ[((size_t)pm * 2 + 1) * NUP + c], b0 = BZ[((size_t)(pm - 1) * 2 + 0) * NUP + c], b1 = BZ[((size_t)(pm - 1) * 2 + 1) * NUP + c];
                  const unsigned cmb = ((const unsigned*)(WSB + WS_CMAX))[(size_t)l * NUP + pc]; const float csc = __builtin_bit_cast(float, cmb) * (1.0f / 127.0f);
                  const float w0 = wc[pc] * csc, w1 = wc[NUP + pc] * csc, w2 = wc[2 * NUP + pc] * csc, bb = bc[pc];
                  zc[k][0] = w2 * t0 + w1 * b1 + w0 * b0 + bb; zc[k][1] = w2 * t1 + w1 * t0 + w0 * b1 + bb; }
              res[0] = gelu_tanh(zc[0][0]) * zc[1][0]; res[1] = gelu_tanh(zc[0][1]) * zc[1][1];
              a2[(size_t)(pm * 256 + 0) * DFF + n] = (bf16)f2bf(res[0]); a2[(size_t)(pm * 256 + 1) * DFF + n] = (bf16)f2bf(res[1]); }
          GRID_BAR(); }
        for (int rep_ = 0; rep_ < NREP_GEMM; ++rep_)
        { pg8::Gemm g{A2, (const bf16*)(Wl + WO_DOWN), M, DM, DFF}; pg8::StaticOrder S; S.init(M, DM, G, bx, WGM_NARROW);
          EpiPlain E{Yb, DM};
          pg8::gemm_phase<EpiPlain, pg8::StaticOrder, GP_ALIGN, GP_SP2>(lds, g, S, E, wave_s);
          GRID_BAR(); }
        if (l == 0) { PHASE_IDS(); thin_phase<1, true, true, false, true>(lds, tid, lane, wave, bx, G, XR, Yb, XR, (bf16*)H8, nullptr, (float*)(WSB + WS_RS1), modl + 10240, g_post_ffn, MOD + (size_t)BATCH * 12288 + 2048, MOD + (size_t)BATCH * 12288, g_pre_mix + DM);
            GRID_BAR(); }
        else { PHASE_IDS(); thin_phase<2, true, false>(lds, tid, lane, wave, bx, G, XR, Yb, out, nullptr, nullptr, nullptr, modl + 10240, g_post_ffn + (size_t)l * DM, nullptr, nullptr, nullptr); }
    }
#undef GRID_BAR
}
#undef INP
#undef OUTP
#undef WSB
#undef in_x
#undef in_c
#undef g_pre_mix
#undef g_post_mix
#undef g_pre_ffn
#undef g_post_ffn
#undef w_ada
#undef b_ada
#undef w_in
#undef b_in
#undef sgu_norm_g
#undef sgu_w
#undef sgu_b
#undef pool_w
#undef pool_scale
#undef w_sgu_out
#undef w_moba_out
#undef w_pool_out
#undef w_out
#undef w_up
#undef w_conv
#undef b_conv
#undef w_down
#undef out
#undef MOD
#undef MODP
#undef KMEAN
#undef H
#undef T6
#undef G3
#undef H8
#undef YP
#undef Yb
#undef A2
#undef Ut
#undef Vt
#undef Qt
#undef Kt
#undef VAt
#undef ZPt
#undef Wl
#undef XR
#undef CONVERT_ITEMS
#undef QUANT_STRIPS
#undef modl

extern "C" void kernel_launch(void* const* d_in, const int* in_sizes, int n_in, void* d_out, int out_size, void* d_ws, size_t ws_size, hipStream_t stream) {
    static int grid = 0;
    if (grid == 0) {
        if (n_in != 23 || in_sizes[0] != M * DM || out_size != M * DM || ws_size < WS_END) { fprintf(stderr, "kernel_launch: unexpected shapes (n_in %d, in0 %d, out %d, ws %zu); nothing launched\n", n_in, n_in > 0 ? in_sizes[0] : -1, out_size, ws_size); grid = -1; return; }
        int dev = 0, cus = 0;
        if (hipGetDevice(&dev) != hipSuccess || hipDeviceGetAttribute(&cus, hipDeviceAttributeMultiprocessorCount, dev) != hipSuccess) { grid = -1; return; }
        if (hipFuncSetAttribute((const void*)fwd_kernel, hipFuncAttributeMaxDynamicSharedMemorySize, LDS_BYTES) != hipSuccess) { fprintf(stderr, "kernel_launch: hipFuncSetAttribute failed\n"); grid = -1; return; }
        int per_cu = 0;
        if (hipOccupancyMaxActiveBlocksPerMultiprocessor(&per_cu, (const void*)fwd_kernel, NWAVES * 64, LDS_BYTES) != hipSuccess || per_cu < 1) fprintf(stderr, "kernel_launch: occupancy query says %d\n", per_cu);
        (void)hipGetLastError();
        grid = cus;
    }
    if (grid < 0) return;
    if (hipMemsetAsync((char*)d_ws + WS_CTL, 0, CTL_ZERO_BYTES, stream) != hipSuccess) return;
    Args a{};
    for (int i = 0; i < 23; ++i) a.in[i] = (const float*)d_in[i];
    a.out = (float*)d_out; a.ws = (unsigned char*)d_ws;
    hipLaunchKernelGGL(fwd_kernel, dim3(grid), dim3(NWAVES * 64), LDS_BYTES, stream, a);
}
```

```cpp
#include <hip/hip_runtime.h>
#include <cstdio>
#include <cstdint>
namespace pg8 {
#define PG8_LAS __attribute__((address_space(3)))
typedef unsigned short bf16_t;
typedef short bf16x8 __attribute__((ext_vector_type(8)));
typedef float f32x4 __attribute__((ext_vector_type(4)));
typedef unsigned u32x4 __attribute__((ext_vector_type(4)));
__device__ __forceinline__ int lane_now() { int l; asm volatile("v_mbcnt_lo_u32_b32 %0, -1, 0\n\tv_mbcnt_hi_u32_b32 %0, -1, %0" : "=v"(l)); return l; }
typedef int i32x4 __attribute__((ext_vector_type(4)));
typedef int i32x8 __attribute__((ext_vector_type(8)));
constexpr int BM = 256, BK = 64, HALF = 128, HTB = HALF * BK * 2  , STAGE_BYTES = 8 * HTB, NXCD = 8, WGM = 8;

__host__ __device__ __forceinline__ int lds_byte(int r, int c) { const int st = (r >> 4) * 2 + (c >> 5), rr = r & 15, cc = c & 31, ob = rr * 64 + cc * 2; return st * 1024 + (ob ^ (((ob >> 9) & 1) << 5)); }
__host__ __device__ __forceinline__ void stage_rc(int b, int& R, int& C) { const int st = b / 1024, sb = b % 1024, swz = sb ^ (((sb >> 9) & 1) << 5); R = (st >> 1) * 16 + swz / 64; C = (st & 1) * 32 + (swz % 64) / 2; }
__host__ __device__ __forceinline__ int perm32(int rho) { const int n = rho >> 4, i = rho & 15; return 8 * (i >> 2) + 4 * n + (i & 3); }

struct Unit { int pm, pn; };
struct Gemm { const bf16_t* A; const bf16_t* Bt; int M, N, K; int nseg; size_t segA, segB; };

struct StaticOrder {
    int nM, nN, nwg, G, c, wgm;
    __host__ __device__ void init(int M, int N, int G_, int c_, int wgm_ = WGM) { nM = M / BM; nN = N / BM; nwg = nM * nN; G = G_; c = c_; wgm = wgm_; }
    __host__ __device__ bool next(int i, Unit& u) const {
        const long L = (long)i * G + c; if (L >= nwg) return false;
        int wgid = (int)L; { const int q = nwg / NXCD, r = nwg % NXCD, xcd = wgid % NXCD, off = wgid / NXCD; wgid = (xcd < r ? xcd * (q + 1) : r * (q + 1) + (xcd - r) * q) + off; }
        const int nig = wgm * nN, gid = wgid / nig, fm = gid * wgm, gsz = (nM - fm) < wgm ? (nM - fm) : wgm;
        u.pm = fm + ((wgid % nig) % gsz); u.pn = (wgid % nig) / gsz; return true;
    }
    __device__ __forceinline__ void a_ready(const Unit&) const {}
    __device__ __forceinline__ void done(const Unit&) const {}
};

__device__ __forceinline__ unsigned cvt_pk_bf16(float lo, float hi) { unsigned r; asm volatile("v_cvt_pk_bf16_f32 %0, %1, %2" : "=v"(r) : "v"(lo), "v"(hi)); return r; }
typedef float f32x2 __attribute__((ext_vector_type(2)));
template <class Epi, class Sched, bool ALIGN_EPI = false, bool SP2 = false, bool FP8 = false, bool I8 = false>
__device__ __forceinline__ void gemm_phase(PG8_LAS unsigned char* lds, const Gemm g, const Sched& S, const Epi& E, int wave_s) {
    int tid_l = wave_s * 64 + lane_now(); asm volatile("" : "+v"(tid_l));
    const int tid = tid_l, wid = __builtin_amdgcn_readfirstlane(tid >> 6), lane = tid & 63, wr = wid >> 2, wc = wid & 3, fr = lane & 15, fq = lane >> 4;
    const int K = g.K, nt = (K / BK) * (Epi::SEGMENTED ? g.nseg : 1);
    unsigned voffA[2], voffB[2];
#pragma unroll
    for (int i = 0; i < 2; ++i) { int R, C; stage_rc(tid * 16 + i * 8192, R, C); const int Rb = Epi::PERM ? ((R & ~31) + perm32(R & 31)) : R;
        voffA[i] = (unsigned)(R * K + C) * 2u; voffB[i] = (unsigned)(Rb * K + C) * 2u; }
    const size_t kstep = (size_t)(BK * 2);
    const size_t hstep = (size_t)HALF * K * 2;
    const size_t tstep = 2 * hstep;
    const unsigned ldsw = (unsigned)wid * 1024u;
    const int aoff = lds_byte(wr * 64 + fr, fq * 8), boff = lds_byte(wc * 32 + fr, fq * 8);
#define PG8_SA(b, h) (((b) * 2 + (h)) * HTB)
#define PG8_SB(b, h) ((4 + (b) * 2 + (h)) * HTB)
#define PG8_STAGE(bufoff, gbase, voff) do { _Pragma("unroll") for (int _i = 0; _i < 2; ++_i) { unsigned vo_ = (voff)[_i]; if constexpr (FP8 || I8) asm volatile("" : "+v"(vo_));     \
        __builtin_amdgcn_global_load_lds((const unsigned*)((const char*)(gbase) + vo_), (PG8_LAS unsigned*)(lds + (bufoff) + ldsw + _i * 8192), 16, 0, 0); } } while (0)
#define PG8_LDA(dst, b, h) do { _Pragma("unroll") for (int m = 0; m < 4; ++m) _Pragma("unroll") for (int k = 0; k < 2; ++k) dst[m][k] = *(const PG8_LAS bf16x8*)(lds + PG8_SA(b, h) + aoff + m * 2048 + k * 1024); } while (0)
#define PG8_LDB(dst, b, h) do { _Pragma("unroll") for (int n = 0; n < 2; ++n) _Pragma("unroll") for (int k = 0; k < 2; ++k) dst[n][k] = *(const PG8_LAS bf16x8*)(lds + PG8_SB(b, h) + boff + n * 2048 + k * 1024); } while (0)
#define PG8_CAT8(v) __builtin_shufflevector(__builtin_bit_cast(i32x4, (v)[0]), __builtin_bit_cast(i32x4, (v)[1]), 0, 1, 2, 3, 4, 5, 6, 7)
#define PG8_MMA(ai, bj, At, Bt) do { __builtin_amdgcn_s_setprio(1); _Pragma("unroll") for (int m = 0; m < 4; ++m) _Pragma("unroll") for (int n = 0; n < 2; ++n) { \
        if constexpr (FP8) acc[ai][bj][m][n] = __builtin_amdgcn_mfma_scale_f32_16x16x128_f8f6f4(PG8_CAT8(Bt[n]), PG8_CAT8(At[m]), acc[ai][bj][m][n], 0, 0, 0, 0, 0, 0);     \
        else if constexpr (I8) { _Pragma("unroll") for (int k = 0; k < 2; ++k) acc[ai][bj][m][n] = __builtin_bit_cast(f32x4, __builtin_amdgcn_mfma_i32_16x16x64_i8(__builtin_bit_cast(i32x4, Bt[n][k]), __builtin_bit_cast(i32x4, At[m][k]), __builtin_bit_cast(i32x4, acc[ai][bj][m][n]), 0, 0, 0)); } \
        else { _Pragma("unroll") for (int k = 0; k < 2; ++k) acc[ai][bj][m][n] = __builtin_amdgcn_mfma_f32_16x16x32_bf16(Bt[n][k], At[m][k], acc[ai][bj][m][n], 0, 0, 0); } } __builtin_amdgcn_s_setprio(0); } while (0)
#define PG8_WAIT_V(n) asm volatile("s_waitcnt vmcnt(" #n ")" ::: "memory")
#define PG8_WAIT_L(n) asm volatile("s_waitcnt lgkmcnt(" #n ")" ::: "memory")
#define PG8_BAR __builtin_amdgcn_s_barrier()
#define PG8_SCHED __builtin_amdgcn_sched_barrier(0)
    Unit cur, nxt; int ui = 0;
    if (!S.next(0, cur)) return;
    f32x4 acc[2][2][4][2];
#pragma unroll
    for (int a = 0; a < 2; ++a)
#pragma unroll
        for (int b = 0; b < 2; ++b)
#pragma unroll
            for (int m = 0; m < 4; ++m)
#pragma unroll
                for (int n = 0; n < 2; ++n) acc[a][b][m][n] = (f32x4){0.f, 0.f, 0.f, 0.f};
    bf16x8 At[4][2], B0[2][2], B1[2][2];
    const char* cA = (const char*)g.A + (size_t)cur.pm * tstep; const char* cB = (const char*)g.Bt + (size_t)cur.pn * tstep;
    S.a_ready(cur);
    if constexpr (SP2) {
        PG8_STAGE(PG8_SB(0, 0), cB, voffB); PG8_STAGE(PG8_SB(0, 1), cB + hstep, voffB); PG8_STAGE(PG8_SA(0, 0), cA, voffA); PG8_STAGE(PG8_SA(0, 1), cA + hstep, voffA);
        if (wr == 1) PG8_BAR;
        PG8_WAIT_V(2); PG8_BAR;
        PG8_STAGE(PG8_SB(1, 0), cB + kstep, voffB); PG8_STAGE(PG8_SA(1, 0), cA + kstep, voffA); PG8_STAGE(PG8_SB(1, 1), cB + hstep + kstep, voffB);
        PG8_WAIT_V(6); PG8_BAR;
    } else {
        PG8_STAGE(PG8_SB(0, 0), cB, voffB); PG8_STAGE(PG8_SA(0, 0), cA, voffA); PG8_STAGE(PG8_SB(0, 1), cB + hstep, voffB); PG8_STAGE(PG8_SA(0, 1), cA + hstep, voffA);
        if (wr == 1) PG8_BAR;
        PG8_WAIT_V(4); PG8_BAR;
        PG8_STAGE(PG8_SB(1, 0), cB + kstep, voffB); PG8_STAGE(PG8_SA(1, 0), cA + kstep, voffA); PG8_STAGE(PG8_SB(1, 1), cB + hstep + kstep, voffB);
        PG8_WAIT_V(6); PG8_BAR;
    }
    for (;;) {
        const bool has_next = S.next(ui + 1, nxt);
        const char* nA = has_next ? (const char*)g.A + (size_t)nxt.pm * tstep : cA; const char* nB = has_next ? (const char*)g.Bt + (size_t)nxt.pn * tstep : cB;
        for (int t = 0; t < nt; t += 2) {
            const bool last = (t == nt - 2);
            const char* a1; const char* a2; const char* b2;
            if constexpr (Epi::SEGMENTED) {
                constexpr int SH = Epi::SEG_SHIFT, SM = (1 << SH) - 1;
                a1 = cA + (size_t)((t + 1) >> SH) * g.segA + (size_t)((t + 1) & SM) * kstep;
                a2 = last ? nA : cA + (size_t)((t + 2) >> SH) * g.segA + (size_t)((t + 2) & SM) * kstep; b2 = last ? nB : cB + (size_t)((t + 2) >> SH) * g.segB + (size_t)((t + 2) & SM) * kstep;
                if (t != 0 && (t & SM) == 0) E.seg_hook(acc, cur, t >> SH, wr, wc, fr, fq);
            } else {
                a1 = cA + (size_t)(t + 1) * kstep;
                a2 = last ? nA : cA + (size_t)(t + 2) * kstep; b2 = last ? nB : cB + (size_t)(t + 2) * kstep;
            }
            const char* a3 = a2 + kstep; const char* b3 = b2 + kstep;
            if (last && has_next) S.a_ready(nxt);
            if constexpr (SP2) {
            PG8_LDB(B0, 0, 0); PG8_LDB(B1, 0, 1); PG8_SCHED; PG8_LDA(At, 0, 0); PG8_STAGE(PG8_SA(1, 1), a1 + hstep, voffA);
            PG8_WAIT_V(8); PG8_WAIT_L(0); PG8_BAR; PG8_MMA(0, 0, At, B0); PG8_MMA(0, 1, At, B1); PG8_BAR; PG8_SCHED;
            PG8_LDA(At, 0, 1); PG8_STAGE(PG8_SB(0, 0), b2, voffB); PG8_STAGE(PG8_SB(0, 1), b2 + hstep, voffB); PG8_STAGE(PG8_SA(0, 0), a2, voffA);
            PG8_WAIT_V(8); PG8_WAIT_L(0); PG8_BAR; PG8_MMA(1, 0, At, B0); PG8_MMA(1, 1, At, B1); PG8_BAR; PG8_SCHED;
            PG8_LDB(B0, 1, 0); PG8_LDB(B1, 1, 1); PG8_SCHED; PG8_LDA(At, 1, 0); PG8_STAGE(PG8_SA(0, 1), a2 + hstep, voffA);
            PG8_WAIT_V(8); PG8_WAIT_L(0); PG8_BAR; PG8_MMA(0, 0, At, B0); PG8_MMA(0, 1, At, B1); PG8_BAR; PG8_SCHED;
            PG8_LDA(At, 1, 1); PG8_STAGE(PG8_SB(1, 0), b3, voffB); PG8_STAGE(PG8_SB(1, 1), b3 + hstep, voffB); PG8_STAGE(PG8_SA(1, 0), a3, voffA);
            PG8_WAIT_V(8); PG8_WAIT_L(0); PG8_BAR; PG8_MMA(1, 0, At, B0); PG8_MMA(1, 1, At, B1); PG8_BAR; PG8_SCHED;
            } else {
            PG8_LDB(B0, 0, 0); PG8_SCHED; PG8_LDA(At, 0, 0); PG8_STAGE(PG8_SA(1, 1), a1 + hstep, voffA);
            PG8_WAIT_L(8); PG8_BAR; PG8_WAIT_L(0); PG8_MMA(0, 0, At, B0); PG8_BAR; PG8_SCHED;
            PG8_LDB(B1, 0, 1); PG8_STAGE(PG8_SB(0, 0), b2, voffB);
            PG8_BAR; PG8_WAIT_L(0); PG8_MMA(0, 1, At, B1); PG8_BAR;
            PG8_LDA(At, 0, 1); PG8_STAGE(PG8_SA(0, 0), a2, voffA);
            PG8_BAR; PG8_WAIT_L(0); PG8_MMA(1, 0, At, B0); PG8_BAR; PG8_SCHED;
            PG8_STAGE(PG8_SB(0, 1), b2 + hstep, voffB);
            PG8_WAIT_V(6); PG8_BAR; PG8_MMA(1, 1, At, B1); PG8_BAR;
            PG8_LDB(B0, 1, 0); PG8_SCHED; PG8_LDA(At, 1, 0); PG8_STAGE(PG8_SA(0, 1), a2 + hstep, voffA);
            PG8_WAIT_L(8); PG8_BAR; PG8_WAIT_L(0); PG8_MMA(0, 0, At, B0); PG8_BAR; PG8_SCHED;
            PG8_LDB(B1, 1, 1); PG8_STAGE(PG8_SB(1, 0), b3, voffB);
            PG8_BAR; PG8_WAIT_L(0); PG8_MMA(0, 1, At, B1); PG8_BAR;
            PG8_LDA(At, 1, 1); PG8_STAGE(PG8_SA(1, 0), a3, voffA);
            PG8_BAR; PG8_WAIT_L(0); PG8_MMA(1, 0, At, B0); PG8_BAR; PG8_SCHED;
            PG8_STAGE(PG8_SB(1, 1), b3 + hstep, voffB);
            PG8_WAIT_V(6); PG8_BAR; PG8_MMA(1, 1, At, B1); PG8_BAR;
            }
        }
        if constexpr (ALIGN_EPI) { if (wr == 0) PG8_BAR; }
        if constexpr (!Epi::AFTER_DRAIN) { E(acc, cur, wr, wc, fr, fq); S.done(cur); }
        if (!has_next) break;
#pragma unroll
        for (int a = 0; a < 2; ++a)
#pragma unroll
            for (int b = 0; b < 2; ++b)
#pragma unroll
                for (int m = 0; m < 4; ++m)
#pragma unroll
                    for (int n = 0; n < 2; ++n) acc[a][b][m][n] = (f32x4){0.f, 0.f, 0.f, 0.f};
        cur = nxt; cA = nA; cB = nB; ++ui;
        if constexpr (ALIGN_EPI) { if (wr == 1) PG8_BAR; }
    }
    PG8_WAIT_V(0);
    if constexpr (!ALIGN_EPI) { if (wr == 0) PG8_BAR; }
    PG8_BAR;
    if constexpr (Epi::AFTER_DRAIN) { E.fused(acc, cur, wr, wc, fr, fq, lds, wid, lane); S.done(cur); }
#undef PG8_SA
#undef PG8_SB
#undef PG8_STAGE
#undef PG8_LDA
#undef PG8_LDB
#undef PG8_MMA
#undef PG8_CAT8
#undef PG8_WAIT_V
#undef PG8_WAIT_L
#undef PG8_BAR
#undef PG8_SCHED
}
}
#define GAS __attribute__((address_space(1)))
#define LAS __attribute__((address_space(3)))
typedef unsigned short bf16;
typedef unsigned v4u __attribute__((ext_vector_type(4)));
typedef float f32x4 __attribute__((ext_vector_type(4)));
typedef short bf16x8 __attribute__((ext_vector_type(8)));
typedef GAS unsigned gu32;
typedef GAS unsigned long long gu64;
#define RLX_AGENT __ATOMIC_RELAXED, __HIP_MEMORY_SCOPE_AGENT
#define LDS_WAIT() asm volatile("s_waitcnt lgkmcnt(0)" ::: "memory")
#define VM_WAIT() asm volatile("s_waitcnt vmcnt(0)" ::: "memory")
__device__ __forceinline__ unsigned long long rt() { return __builtin_amdgcn_s_memrealtime(); }
__device__ __forceinline__ unsigned f2bf(float f) { unsigned u = __builtin_bit_cast(unsigned, f); return (u + 0x7fffu + ((u >> 16) & 1u)) >> 16; }
__device__ __forceinline__ unsigned pk2(float lo, float hi) { return f2bf(lo) | (f2bf(hi) << 16); }
#define XB_TMO      128
#define XB_XCNT(j)  (256  + 64 * (j))
#define XB_XSUB(j)  (1280 + 64 * (j))
#define XB_XGEN(j)  (2304 + 64 * (j))
#define XB_TOP      3328
#define XB_TOPGEN   3392
#define XCD_BAR_WORDS 3456
#define XB_SPIN_CAP (1u << 18)

__device__ __forceinline__ unsigned xb_ld(unsigned* p)              { return __hip_atomic_load(p, __ATOMIC_RELAXED, __HIP_MEMORY_SCOPE_AGENT); }
__device__ __forceinline__ unsigned xb_add(unsigned* p, unsigned v) { return __hip_atomic_fetch_add(p, v, __ATOMIC_RELAXED, __HIP_MEMORY_SCOPE_AGENT); }
__device__ __forceinline__ unsigned xb_xcc_id() { return (unsigned)__builtin_amdgcn_s_getreg((3 << 11) | 20) & 0xFu; }
#define XB_SPIN(cond, bar) do { unsigned _sp = 0; while (cond) { __builtin_amdgcn_s_sleep(1); \
    if ((++_sp & 255u) == 0u) { if (xb_ld(&(bar)[XB_TMO])) break; if (_sp > XB_SPIN_CAP) { atomicAdd(&(bar)[XB_TMO], 1u); break; } } } } while (0)

struct XcdBarrier {
    unsigned* bar; unsigned x; int wv;
    volatile LAS unsigned* st;
};

__device__ __forceinline__ XcdBarrier xcd_barrier_post(unsigned* bar, volatile LAS unsigned* st) {
    XcdBarrier b; b.bar = bar; b.x = xb_xcc_id(); b.st = st; b.wv = __builtin_amdgcn_readfirstlane((int)(threadIdx.x >> 6));
    if (threadIdx.x == 0) (void)xb_add(&bar[XB_XCNT(b.x)], 1u);
    return b;
}
__device__ __forceinline__ void xcd_barrier_complete(unsigned* bar, unsigned x, unsigned& nloc, unsigned& nx) {
    const unsigned G = gridDim.x * gridDim.y * gridDim.z;
    unsigned sum, cnt, mine, sp = 0u;
    for (;;) {
        sum = 0u; cnt = 0u; mine = 0u;
#pragma unroll
        for (unsigned j = 0; j < 16; ++j) { const unsigned c = xb_ld(&bar[XB_XCNT(j)]); sum += c; cnt += (c > 0u) ? 1u : 0u; mine = (j == x) ? c : mine; }
        if (sum == G) break;
        __builtin_amdgcn_s_sleep(1);
        if ((++sp & 255u) == 0u) { if (xb_ld(&bar[XB_TMO])) break; if (sp > XB_SPIN_CAP) { atomicAdd(&bar[XB_TMO], 1u); break; } }
    }
    nloc = mine > 0u ? mine : 1u; nx = cnt > 0u ? cnt : 1u;
}

__device__ __forceinline__ void xcd_barrier(const XcdBarrier& b) {
    asm volatile("s_waitcnt vmcnt(0)" ::: "memory");
    __syncthreads();
    if (b.wv == 0 && pg8::lane_now() == 0) {
        unsigned* bar = b.bar;
        __builtin_amdgcn_s_waitcnt(0);
        unsigned nloc = b.st[0], nx = b.st[1];
        if (nloc == 0u) { xcd_barrier_complete(bar, b.x, nloc, nx); b.st[0] = nloc; b.st[1] = nx; }
        const unsigned old = xb_add(&bar[XB_XSUB(b.x)], 1u);
        const unsigned gen = old / nloc;
        if (old + 1u == (gen + 1u) * nloc) {
            __builtin_amdgcn_fence(__ATOMIC_RELEASE, "agent");
            asm volatile("s_waitcnt vmcnt(0)" ::: "memory");
            const unsigned og = xb_add(&bar[XB_TOP], 1u);
            const unsigned tg = og / nx;
            if (og + 1u == (tg + 1u) * nx) xb_add(&bar[XB_TOPGEN], 1u);
            else XB_SPIN(xb_ld(&bar[XB_TOPGEN]) == tg, bar);
            __builtin_amdgcn_fence(__ATOMIC_ACQUIRE, "agent");
            xb_add(&bar[XB_XGEN(b.x)], 1u);
            asm volatile("s_waitcnt vmcnt(0)" ::: "memory");
        } else {
            XB_SPIN(xb_ld(&bar[XB_XGEN(b.x)]) == gen, bar);
            __builtin_amdgcn_fence(__ATOMIC_ACQUIRE, "agent");
            asm volatile("s_waitcnt vmcnt(0)" ::: "memory");
        }
    }
    __syncthreads();
}
constexpr int BATCH = 4, SEQ = 8192, DM = 2048, M = BATCH * SEQ, BW = 512, INW = 9216, DFF = 5632, NUP = 2 * DFF, DEPTH = 2;
constexpr int NWAVES = 8;
constexpr float EPS = 1e-6f;
constexpr float LOG2E = 1.4426950408889634f;
constexpr float QSCALE = 0.125f * LOG2E;

__device__ __forceinline__ float bf_lo(unsigned w) { return __builtin_bit_cast(float, w << 16); }
__device__ __forceinline__ float bf_hi(unsigned w) { return __builtin_bit_cast(float, w & 0xffff0000u); }
__device__ __forceinline__ float bf2f(unsigned short h) { return __builtin_bit_cast(float, ((unsigned)h) << 16); }
constexpr float W8_SCALE = 32.0f, W8_INV = 1.0f / 32.0f;
__device__ __forceinline__ float sigmoid_f(float v) { return __builtin_amdgcn_rcpf(1.0f + __builtin_amdgcn_exp2f(-LOG2E * v)); }
__device__ __forceinline__ unsigned gate_q4(const pg8::f32x4 x) {
    float t[4];
#pragma unroll
    for (int j = 0; j < 4; ++j) t[j] = fmaxf(__builtin_fmaf(sigmoid_f(x[j]), 255.0f, 12582912.0f), 12582913.0f);
    return __builtin_amdgcn_perm(__builtin_bit_cast(unsigned, t[1]), __builtin_bit_cast(unsigned, t[0]), 0x0c0c0400u) | __builtin_amdgcn_perm(__builtin_bit_cast(unsigned, t[3]), __builtin_bit_cast(unsigned, t[2]), 0x04000c0cu);
}
__device__ __forceinline__ unsigned q8x4(float a, float b, float c, float d, float inv) {
    const float t0 = __builtin_fmaf(a, inv, 12582912.0f), t1 = __builtin_fmaf(b, inv, 12582912.0f), t2 = __builtin_fmaf(c, inv, 12582912.0f), t3 = __builtin_fmaf(d, inv, 12582912.0f);
    return __builtin_amdgcn_perm(__builtin_bit_cast(unsigned, t1), __builtin_bit_cast(unsigned, t0), 0x0c0c0400u) | __builtin_amdgcn_perm(__builtin_bit_cast(unsigned, t3), __builtin_bit_cast(unsigned, t2), 0x04000c0cu);
}
__device__ __forceinline__ float ub0(unsigned q) { float r; asm("v_cvt_f32_ubyte0 %0, %1" : "=v"(r) : "v"(q)); return r; }
__device__ __forceinline__ float ub1(unsigned q) { float r; asm("v_cvt_f32_ubyte1 %0, %1" : "=v"(r) : "v"(q)); return r; }
__device__ __forceinline__ float ub2(unsigned q) { float r; asm("v_cvt_f32_ubyte2 %0, %1" : "=v"(r) : "v"(q)); return r; }
__device__ __forceinline__ float ub3(unsigned q) { float r; asm("v_cvt_f32_ubyte3 %0, %1" : "=v"(r) : "v"(q)); return r; }
__device__ __forceinline__ pg8::f32x4 gate_ratio4(unsigned a, unsigned b) { pg8::f32x4 r; r[0] = ub0(a) * __builtin_amdgcn_rcpf(ub0(b)); r[1] = ub1(a) * __builtin_amdgcn_rcpf(ub1(b)); r[2] = ub2(a) * __builtin_amdgcn_rcpf(ub2(b)); r[3] = ub3(a) * __builtin_amdgcn_rcpf(ub3(b)); return r; }
__device__ __forceinline__ pg8::f32x4 gate_val4(unsigned a) { pg8::f32x4 r; r[0] = ub0(a); r[1] = ub1(a); r[2] = ub2(a); r[3] = ub3(a); return r * (1.0f / 255.0f); }
__device__ __forceinline__ float gelu_tanh(float v) {
    const float u = __builtin_fmaf(v * v, -0.10294324f, -2.3022082f);
    return v * __builtin_amdgcn_rcpf(1.0f + __builtin_amdgcn_exp2f(v * u));
}

#ifndef UPCONV_DPP
#define UPCONV_DPP 1
#endif
#define EPI_ST(p, v) (*(pg8::u32x4*)(p) = (v))
#define EPI_DRY_DECL
#define EPI_DRY_MEMBER
struct EpiPlain {
    static constexpr bool PERM = true, AFTER_DRAIN = false, SEGMENTED = false;
    pg8::bf16_t* O; int ldc; EPI_DRY_MEMBER
    __device__ __forceinline__ void operator()(const pg8::f32x4 (&acc)[2][2][4][2], const pg8::Unit& u, int wr, int wc, int fr, int fq) const {
        EPI_DRY_DECL
        const int row0 = u.pm * 256 + wr * 64 + fr, col0 = u.pn * 256 + wc * 32 + 8 * fq;
#pragma unroll
        for (int ai = 0; ai < 2; ++ai)
#pragma unroll
            for (int m = 0; m < 4; ++m) { pg8::bf16_t* rowp = O + (size_t)(row0 + ai * 128 + m * 16) * ldc + col0;
#pragma unroll
                for (int bj = 0; bj < 2; ++bj) { const pg8::f32x4 v0 = acc[ai][bj][m][0], v1 = acc[ai][bj][m][1];
                    pg8::u32x4 w; w.x = pg8::cvt_pk_bf16(v0[0], v0[1]); w.y = pg8::cvt_pk_bf16(v0[2], v0[3]); w.z = pg8::cvt_pk_bf16(v1[0], v1[1]); w.w = pg8::cvt_pk_bf16(v1[2], v1[3]);
                    EPI_ST(rowp + bj * 128, w); } }
    }
};
struct EpiInProj {
    static constexpr bool PERM = true, AFTER_DRAIN = false, SEGMENTED = false;
    const float* bias; pg8::bf16_t* T6; float* kmean; unsigned* kabs; const float* rs; const unsigned* cm; EPI_DRY_MEMBER
    __device__ __forceinline__ void operator()(pg8::f32x4 (&acc)[2][2][4][2], const pg8::Unit& u, int wr, int wc, int fr, int fq) const {
        EPI_DRY_DECL
        const int pn = u.pn; int mode, ldc, colt; pg8::bf16_t* base;
        {
            pg8::f32x4 cv[2][2];
#pragma unroll
            for (int bj = 0; bj < 2; ++bj)
#pragma unroll
                for (int n = 0; n < 2; ++n) { const pg8::u32x4 cmv = *(const pg8::u32x4*)(cm + pn * 256 + wc * 32 + 8 * fq + bj * 128 + 4 * n); const unsigned c0 = cmv.x, c1 = cmv.y, c2 = cmv.z, c3 = cmv.w;
                    pg8::f32x4 t; t[0] = __builtin_bit_cast(float, c0); t[1] = __builtin_bit_cast(float, c1); t[2] = __builtin_bit_cast(float, c2); t[3] = __builtin_bit_cast(float, c3); cv[bj][n] = t * (1.0f / 127.0f); }
#pragma unroll
            for (int ai = 0; ai < 2; ++ai)
#pragma unroll
                for (int m = 0; m < 4; ++m) { const float rsv = rs[u.pm * 256 + ai * 128 + wr * 64 + m * 16 + fr];
#pragma unroll
                    for (int bj = 0; bj < 2; ++bj)
#pragma unroll
                        for (int n = 0; n < 2; ++n) { pg8::f32x4 t;
#pragma unroll
                            for (int j = 0; j < 4; ++j) { const float af = acc[ai][bj][m][n][j]; t[j] = (float)__builtin_bit_cast(int, af); }
                            acc[ai][bj][m][n] = (t * rsv) * cv[bj][n]; } }
        }
        if (pn < 12) { const int t = pn >> 1, slot = (t == 0) ? 0 : (t == 1) ? 3 : (t == 2) ? 1 : t + 1;
            base = T6 + (size_t)slot * M * BW; ldc = BW; colt = (pn & 1) * 256; mode = t < 2 ? 1 : (t == 2 ? 2 : 0); }
        else { base = T6; ldc = DM; colt = 0; mode = 0; }
        const int row0 = u.pm * 256 + wr * 64 + fr, col0 = colt + wc * 32 + 8 * fq, bcol0 = pn * 256 + wc * 32 + 8 * fq;
        pg8::f32x4 bv[2][2];
#pragma unroll
        for (int bj = 0; bj < 2; ++bj)
#pragma unroll
            for (int n = 0; n < 2; ++n) bv[bj][n] = *(const pg8::f32x4*)(bias + bcol0 + bj * 128 + 4 * n);
        if (pn == 6 || pn == 7) {
            const int lane = fq * 16 + fr; const int b = u.pm >> 5, jblk = u.pm & 31;
#pragma unroll
            for (int bj = 0; bj < 2; ++bj)
#pragma unroll
                for (int n = 0; n < 2; ++n) { pg8::f32x4 s = bv[bj][n] * 8.0f;
#pragma unroll
                    for (int ai = 0; ai < 2; ++ai)
#pragma unroll
                        for (int m = 0; m < 4; ++m) s = s + acc[ai][bj][m][n];
                    pg8::f32x4 mx = {0.f, 0.f, 0.f, 0.f};
#pragma unroll
                    for (int ai = 0; ai < 2; ++ai)
#pragma unroll
                        for (int m = 0; m < 4; ++m) { const pg8::f32x4 kv = acc[ai][bj][m][n] + bv[bj][n];
#pragma unroll
                            for (int j = 0; j < 4; ++j) mx[j] = fmaxf(mx[j], __builtin_fabsf(kv[j])); }
#pragma unroll
                    for (int j = 0; j < 4; ++j) { float v = s[j]; float a = mx[j];
#pragma unroll
                        for (int o = 1; o < 16; o <<= 1) { v += __builtin_bit_cast(float, __builtin_amdgcn_ds_bpermute((lane ^ o) << 2, __builtin_bit_cast(int, v)));
                            a = fmaxf(a, __builtin_bit_cast(float, __builtin_amdgcn_ds_bpermute((lane ^ o) << 2, __builtin_bit_cast(int, a)))); }
                        if (fr == 0) { const int col = (pn & 1) * 256 + bj * 128 + wc * 32 + 8 * fq + 4 * n + j; const size_t ki = ((size_t)(b * 8 + (col >> 6)) * 32 + jblk) * 64 + (col & 63);
                            atomicAdd(kmean + ki, v * (1.0f / 256.0f)); atomicMax(kabs + ki, __builtin_bit_cast(unsigned, a)); } } }
        }
#pragma unroll
        for (int ai = 0; ai < 2; ++ai)
#pragma unroll
            for (int m = 0; m < 4; ++m) { pg8::bf16_t* rowp = base + (size_t)(row0 + ai * 128 + m * 16) * ldc + col0;
#pragma unroll
                for (int bj = 0; bj < 2; ++bj) { pg8::f32x4 v0 = acc[ai][bj][m][0] + bv[bj][0], v1 = acc[ai][bj][m][1] + bv[bj][1];
                    if (mode == 1) {
#pragma unroll
                        for (int j = 0; j < 4; ++j) { v0[j] = gelu_tanh(v0[j]); v1[j] = gelu_tanh(v1[j]); } }
                    else if (mode == 2) { v0 = v0 * QSCALE; v1 = v1 * QSCALE; }
                    pg8::u32x4 w; w.x = pg8::cvt_pk_bf16(v0[0], v0[1]); w.y = pg8::cvt_pk_bf16(v0[2], v0[3]); w.z = pg8::cvt_pk_bf16(v1[0], v1[1]); w.w = pg8::cvt_pk_bf16(v1[2], v1[3]);
                    EPI_ST(rowp + bj * 128, w); } }
    }
};
struct EpiGate8 {
    static constexpr bool PERM = true, AFTER_DRAIN = false, SEGMENTED = false;
    const float* bias; unsigned char* G8; const float* rs; const unsigned* cm; EPI_DRY_MEMBER
    __device__ __forceinline__ void operator()(const pg8::f32x4 (&acc)[2][2][4][2], const pg8::Unit& u, int wr, int wc, int fr_in, int fq_in) const {
        EPI_DRY_DECL
        int fr = fr_in, fq = fq_in; asm volatile("" : "+v"(fr), "+v"(fq));
        const int pn = u.pn, bcol0 = pn * 256 + wc * 32 + 8 * fq;
        pg8::f32x4 bv[2][2];
#pragma unroll
        for (int bj = 0; bj < 2; ++bj)
#pragma unroll
            for (int n = 0; n < 2; ++n) bv[bj][n] = *(const pg8::f32x4*)(bias + bcol0 + bj * 128 + 4 * n);
        pg8::f32x4 cv[2][2];
#pragma unroll
        for (int bj = 0; bj < 2; ++bj)
#pragma unroll
            for (int n = 0; n < 2; ++n) { const pg8::u32x4 cmv = *(const pg8::u32x4*)(cm + bcol0 + bj * 128 + 4 * n); const unsigned c0 = cmv.x, c1 = cmv.y, c2 = cmv.z, c3 = cmv.w;
                pg8::f32x4 t; t[0] = __builtin_bit_cast(float, c0); t[1] = __builtin_bit_cast(float, c1); t[2] = __builtin_bit_cast(float, c2); t[3] = __builtin_bit_cast(float, c3); cv[bj][n] = t * (1.0f / 127.0f); }
        unsigned char* tp = G8 + ((size_t)((pn >> 3) * (M / 256) + u.pm) * 8 + (pn & 7)) * 65536 + (size_t)((((wr * 4 + wc) * 64) + fq * 16 + fr) * 16);
#pragma unroll
        for (int ai = 0; ai < 2; ++ai)
#pragma unroll
            for (int m = 0; m < 4; ++m) { pg8::u32x4 w; const float rsv = rs[u.pm * 256 + ai * 128 + wr * 64 + m * 16 + fr];
                pg8::f32x4 z[2][2];
#pragma unroll
                for (int bj = 0; bj < 2; ++bj)
#pragma unroll
                    for (int n = 0; n < 2; ++n) { pg8::f32x4 t;
#pragma unroll
                        for (int j = 0; j < 4; ++j) { const float af = acc[ai][bj][m][n][j]; t[j] = (float)__builtin_bit_cast(int, af); }
                        z[bj][n] = (t * rsv) * cv[bj][n] + bv[bj][n]; }
                w.x = gate_q4(z[0][0]); w.y = gate_q4(z[0][1]); w.z = gate_q4(z[1][0]); w.w = gate_q4(z[1][1]);
                EPI_ST(tp + (ai * 4 + m) * 8192, w); }
    }
};
struct EpiUpConv {
    static constexpr bool PERM = true, AFTER_DRAIN = false, SEGMENTED = false;
    pg8::bf16_t* A2; const float* wconv; const float* bconv; float* topz; float* botz; PG8_LAS float* xb; const float* rs; const unsigned* cm; EPI_DRY_MEMBER
    __device__ __forceinline__ void operator()(pg8::f32x4 (&acc)[2][2][4][2], const pg8::Unit& u, int wr, int wc, int fr_in, int fq_in) const {
        EPI_DRY_DECL
        int fr = fr_in, fq = fq_in; asm volatile("" : "+v"(fr), "+v"(fq));
        const int lane = fq * 16 + fr, wv = wr * 4 + wc, pm = u.pm, pn = u.pn;
#pragma unroll
        for (int ai = 0; ai < 2; ++ai)
#pragma unroll
            for (int m = 0; m < 4; ++m) { const float rsv = rs[pm * 256 + ai * 128 + wr * 64 + m * 16 + fr];
#pragma unroll
                for (int bj = 0; bj < 2; ++bj)
#pragma unroll
                    for (int n = 0; n < 2; ++n) { pg8::f32x4 t;
#pragma unroll
                        for (int j = 0; j < 4; ++j) { const float af = acc[ai][bj][m][n][j]; t[j] = (float)__builtin_bit_cast(int, af); }
                        acc[ai][bj][m][n] = t * rsv; } }
        if (fr >= 14) {
#pragma unroll
            for (int ai = 0; ai < 2; ++ai)
#pragma unroll
                for (int bj = 0; bj < 2; ++bj) { PG8_LAS pg8::f32x4* p = (PG8_LAS pg8::f32x4*)(xb + ((((wv * 2 + ai) * 2 + (fr - 14)) * 4 + fq) * 2 + bj) * 8); p[0] = acc[ai][bj][3][0]; p[1] = acc[ai][bj][3][1]; }
        }
        const int ecol = pn * 256 + wc * 32 + 8 * fq;
        if (wr == 0 && fr < 2) { float* t = topz + ((size_t)pm * 2 + fr) * NUP + ecol;
#pragma unroll
            for (int bj = 0; bj < 2; ++bj)
#pragma unroll
                for (int n = 0; n < 2; ++n) *(pg8::f32x4*)(t + bj * 128 + 4 * n) = acc[0][bj][0][n]; }
        if (wr == 1 && fr >= 14) { float* t = botz + ((size_t)pm * 2 + (fr - 14)) * NUP + ecol;
#pragma unroll
            for (int bj = 0; bj < 2; ++bj)
#pragma unroll
                for (int n = 0; n < 2; ++n) *(pg8::f32x4*)(t + bj * 128 + 4 * n) = acc[1][bj][3][n]; }
        asm volatile("s_waitcnt lgkmcnt(0)" ::: "memory"); __builtin_amdgcn_s_barrier(); asm volatile("" ::: "memory");
        pg8::f32x4 bnd[2][2][2];
#pragma unroll
        for (int ai = 0; ai < 2; ++ai) { const int sw = (wr == 1) ? wc : 4 + wc, sai = (wr == 1) ? ai : 0; const bool have = (wr == 1) || (ai == 1);
#pragma unroll
            for (int bj = 0; bj < 2; ++bj) { pg8::f32x4 a = {0.f, 0.f, 0.f, 0.f}, b = a;
                if (have && fr >= 14) { const PG8_LAS pg8::f32x4* p = (const PG8_LAS pg8::f32x4*)(xb + ((((sw * 2 + sai) * 2 + (fr - 14)) * 4 + fq) * 2 + bj) * 8); a = p[0]; b = p[1]; }
                bnd[ai][bj][0] = a; bnd[ai][bj][1] = b; } }
        const int s1 = (fr >= 1 ? lane - 1 : lane + 15) << 2, s2 = (fr >= 2 ? lane - 2 : lane + 14) << 2;
#pragma unroll
        for (int bj = 0; bj < 2; ++bj)
#pragma unroll
            for (int n = 0; n < 2; ++n) { const int col = (bj ? DFF : 0) + pn * 128 + wc * 32 + 8 * fq + 4 * n;
                const pg8::u32x4 cmv = *(const pg8::u32x4*)(cm + col); pg8::f32x4 csv;
                { const unsigned c0 = cmv.x, c1 = cmv.y, c2 = cmv.z, c3 = cmv.w; csv[0] = __builtin_bit_cast(float, c0); csv[1] = __builtin_bit_cast(float, c1); csv[2] = __builtin_bit_cast(float, c2); csv[3] = __builtin_bit_cast(float, c3); csv = csv * (1.0f / 127.0f); }
                const pg8::f32x4 w0 = *(const pg8::f32x4*)(wconv + col) * csv, w1 = *(const pg8::f32x4*)(wconv + NUP + col) * csv, w2 = *(const pg8::f32x4*)(wconv + 2 * NUP + col) * csv, bb = *(const pg8::f32x4*)(bconv + col);
#pragma unroll
                for (int ai = 0; ai < 2; ++ai)
#pragma unroll
                    for (int m = 3; m >= 0; --m) { const pg8::f32x4 cur = acc[ai][bj][m][n]; const pg8::f32x4 prv = (m > 0) ? acc[ai][bj][m - 1][n] : bnd[ai][bj][n];
                        pg8::f32x4 z1, z2;
#pragma unroll
                        for (int j = 0; j < 4; ++j) {
#if UPCONV_DPP
                            const float cf = cur[j], pf = prv[j];
                            const int ci = __builtin_bit_cast(int, cf), pi = __builtin_bit_cast(int, pf);
                            const int p1 = __builtin_amdgcn_mov_dpp(pi, 0x121, 0xf, 0xf, false), p2 = __builtin_amdgcn_mov_dpp(pi, 0x122, 0xf, 0xf, false);
                            z1[j] = __builtin_bit_cast(float, __builtin_amdgcn_update_dpp(p1, ci, 0x111, 0xf, 0xf, false));
                            z2[j] = __builtin_bit_cast(float, __builtin_amdgcn_update_dpp(p2, ci, 0x112, 0xf, 0xf, false));
#else
                            const float t1 = (fr == 15) ? prv[j] : cur[j], t2 = (fr >= 14) ? prv[j] : cur[j];
                            z1[j] = __builtin_bit_cast(float, __builtin_amdgcn_ds_bpermute(s1, __builtin_bit_cast(int, t1)));
                            z2[j] = __builtin_bit_cast(float, __builtin_amdgcn_ds_bpermute(s2, __builtin_bit_cast(int, t2)));
#endif
                        }
                        acc[ai][bj][m][n] = w2 * cur + w1 * z1 + w0 * z2 + bb; } }
        const int row0 = pm * 256 + wr * 64 + fr, col0 = pn * 128 + wc * 32 + 8 * fq;
#pragma unroll
        for (int ai = 0; ai < 2; ++ai)
#pragma unroll
            for (int m = 0; m < 4; ++m) { const pg8::f32x4 g0 = acc[ai][0][m][0], g1 = acc[ai][0][m][1], v0 = acc[ai][1][m][0], v1 = acc[ai][1][m][1];
                pg8::u32x4 w; w.x = pg8::cvt_pk_bf16(gelu_tanh(g0[0]) * v0[0], gelu_tanh(g0[1]) * v0[1]); w.y = pg8::cvt_pk_bf16(gelu_tanh(g0[2]) * v0[2], gelu_tanh(g0[3]) * v0[3]);
                w.z = pg8::cvt_pk_bf16(gelu_tanh(g1[0]) * v1[0], gelu_tanh(g1[1]) * v1[1]); w.w = pg8::cvt_pk_bf16(gelu_tanh(g1[2]) * v1[2], gelu_tanh(g1[3]) * v1[3]);
                EPI_ST(A2 + (size_t)(row0 + ai * 128 + m * 16) * DFF + col0, w); }
    }
};
struct EpiBranch {
    static constexpr bool PERM = true, AFTER_DRAIN = false, SEGMENTED = true; static constexpr int SEG_SHIFT = 3;
    const unsigned char* G8; pg8::bf16_t* Mb; EPI_DRY_MEMBER
    __device__ __forceinline__ void seg_hook(pg8::f32x4 (&acc)[2][2][4][2], const pg8::Unit& u, int seg, int wr, int wc, int fr, int fq) const {
        int t16 = (((wr * 4 + wc) * 64) + fq * 16 + fr) * 16;
        asm volatile("" : "+v"(t16));
        const unsigned char* Tp = G8 + ((size_t)((seg - 1) * (M / 256) + u.pm) * 8 + u.pn) * 65536 + t16; const unsigned char* Tn = Tp + (size_t)(M / 256) * 8 * 65536;
        pg8::u32x4 ga[8], gb[8];
#pragma unroll
        for (int c = 0; c < 8; ++c) { ga[c] = *(const pg8::u32x4*)(Tp + c * 8192); gb[c] = *(const pg8::u32x4*)(Tn + c * 8192); }
        asm volatile("" ::: "memory");
#pragma unroll
        for (int ai = 0; ai < 2; ++ai)
#pragma unroll
            for (int m = 0; m < 4; ++m) { const pg8::u32x4 a = ga[ai * 4 + m], b = gb[ai * 4 + m];
                acc[ai][0][m][0] = acc[ai][0][m][0] * gate_ratio4(a.x, b.x); acc[ai][0][m][1] = acc[ai][0][m][1] * gate_ratio4(a.y, b.y);
                acc[ai][1][m][0] = acc[ai][1][m][0] * gate_ratio4(a.z, b.z); acc[ai][1][m][1] = acc[ai][1][m][1] * gate_ratio4(a.w, b.w); }
        asm volatile("" ::: "memory");
    }
    __device__ __forceinline__ void operator()(const pg8::f32x4 (&acc)[2][2][4][2], const pg8::Unit& u, int wr, int wc, int fr, int fq) const {
        const int row0 = u.pm * 256 + wr * 64 + fr, col0 = u.pn * 256 + wc * 32 + 8 * fq;
        EPI_DRY_DECL
        const unsigned char* T2 = G8 + ((size_t)(2 * (M / 256) + u.pm) * 8 + u.pn) * 65536 + (size_t)((((wr * 4 + wc) * 64) + fq * 16 + fr) * 16);
        pg8::u32x4 gv[8];
#pragma unroll
        for (int c = 0; c < 8; ++c) gv[c] = *(const pg8::u32x4*)(T2 + c * 8192);
        asm volatile("" ::: "memory");
#pragma unroll
        for (int ai = 0; ai < 2; ++ai)
#pragma unroll
            for (int m = 0; m < 4; ++m) { const size_t ro = (size_t)(row0 + ai * 128 + m * 16) * DM + col0; const pg8::u32x4 g = gv[ai * 4 + m];
#pragma unroll
                for (int bj = 0; bj < 2; ++bj) { const pg8::f32x4 a0 = acc[ai][bj][m][0] * gate_val4(bj ? g.z : g.x), a1 = acc[ai][bj][m][1] * gate_val4(bj ? g.w : g.y);
                    pg8::u32x4 w; w.x = pg8::cvt_pk_bf16(a0[0], a0[1]); w.y = pg8::cvt_pk_bf16(a0[2], a0[3]); w.z = pg8::cvt_pk_bf16(a1[0], a1[1]); w.w = pg8::cvt_pk_bf16(a1[2], a1[3]);
                    EPI_ST(Mb + ro + bj * 128, w); } }
    }
};
#include <hip/hip_bf16.h>
#include <cmath>
namespace attn_body {
using bf16=__hip_bfloat16;
using bf16x8=__attribute__((ext_vector_type(8)))short;
using s16x4=__attribute__((ext_vector_type(4)))short;
using f32x16=__attribute__((ext_vector_type(16)))float;
using u32x4=__attribute__((ext_vector_type(4)))unsigned;
constexpr int BATCH=4,NHEAD=8,SEQ=8192,D=64,DM=NHEAD*D;
constexpr int NW=8,QBLK=32,QB=QBLK*NW,KVBLK=64,NQB=SEQ/QB;
constexpr int ATTN_PITCH=DM, ATTN_UNIT_ROWS=QB;
__device__ __forceinline__ int crow(int r,int hi){return (r&3)+8*(r>>2)+4*hi;}
#define SBAR() __builtin_amdgcn_sched_barrier(0)
__device__ __forceinline__ void cmask(f32x16&p0,f32x16&p1,int jb,int qrel,int hi){
  const float NEG=-INFINITY; int kb=64*jb+4*hi;
  #pragma unroll
  for(int r=0;r<16;++r){int kv=kb+(r&3)+8*(r>>2); if(kv>qrel)p0[r]=NEG; if(kv+32>qrel)p1[r]=NEG;}
}

constexpr int NSLOT=3, SLOTB=8192;
constexpr int LDS_K=0, LDS_V=NSLOT*SLOTB, LDS_WS=2*NSLOT*SLOTB, LDS_OST=LDS_WS+NW*64*4, LDS_TAB=LDS_OST+NW*4096  , LDS_BYTES=LDS_TAB+16384;
constexpr float C2=0.125f*1.4426950408889634f;
__device__ __forceinline__ void glds16(const void*gsrc,unsigned lds_dst){unsigned keep;
  asm volatile("s_mov_b32 %0, m0\n\ts_mov_b32 m0, %2\n\ts_nop 0\n\tglobal_load_lds_dwordx4 %1, off\n\ts_mov_b32 m0, %0":"=&s"(keep):"v"(gsrc),"s"(lds_dst):"memory");}
__device__ __forceinline__ float max3f(float a,float b,float c){float r;asm("v_max3_f32 %0, %1, %2, %3":"=v"(r):"v"(a),"v"(b),"v"(c));return r;}
__device__ __forceinline__ float max2f(float a,float b){float r;asm("v_max_f32_e32 %0, %1, %2":"=v"(r):"v"(a),"v"(b));return r;}
__device__ __forceinline__ float fadd_s(float a,float b){float r;asm("v_add_f32_e32 %0, %1, %2":"=v"(r):"v"(a),"v"(b));return r;}
__device__ __forceinline__ float fsub_s(float a,float b){float r;asm("v_sub_f32_e32 %0, %1, %2":"=v"(r):"v"(a),"v"(b));return r;}
typedef float f32x2_t __attribute__((ext_vector_type(2))); typedef __bf16 bf16x2_t __attribute__((ext_vector_type(2)));
__device__ __forceinline__ unsigned cvtpk_s(float lo,float hi){f32x2_t v={lo,hi};bf16x2_t b=__builtin_convertvector(v,bf16x2_t);return __builtin_bit_cast(unsigned,b);}
#define WAIT_BAR(N) asm volatile("s_waitcnt vmcnt(" #N ") lgkmcnt(0)\n\ts_barrier":::"memory")

__device__ __forceinline__ void qkt(f32x16&p0,f32x16&p1,const char*Kslot,const bf16x8*qr,const f32x16&negm,int r32,int hi){
  const char*kb=Kslot+hi*1024+r32*16;
  #pragma unroll
  for(int d0=0;d0<4;++d0){
    const bf16x8 b0=*reinterpret_cast<const bf16x8*>(kb+d0*2048);
    const bf16x8 b1=*reinterpret_cast<const bf16x8*>(kb+d0*2048+512);
    if(d0==0){p0=__builtin_amdgcn_mfma_f32_32x32x16_bf16(b0,qr[0],negm,0,0,0);p1=__builtin_amdgcn_mfma_f32_32x32x16_bf16(b1,qr[0],negm,0,0,0);}
    else{p0=__builtin_amdgcn_mfma_f32_32x32x16_bf16(b0,qr[d0],p0,0,0,0);p1=__builtin_amdgcn_mfma_f32_32x32x16_bf16(b1,qr[d0],p1,0,0,0);}}
}
typedef __attribute__((address_space(3))) const char* lds_cptr;
typedef short v4i16_t __attribute__((ext_vector_type(4)));
__device__ __forceinline__ void kload8(bf16x8*kf,lds_cptr kp){
  kf[0]=*(const __attribute__((address_space(3))) bf16x8*)(kp);      kf[1]=*(const __attribute__((address_space(3))) bf16x8*)(kp+512);
  kf[2]=*(const __attribute__((address_space(3))) bf16x8*)(kp+2048); kf[3]=*(const __attribute__((address_space(3))) bf16x8*)(kp+2560);
  kf[4]=*(const __attribute__((address_space(3))) bf16x8*)(kp+4096); kf[5]=*(const __attribute__((address_space(3))) bf16x8*)(kp+4608);
  kf[6]=*(const __attribute__((address_space(3))) bf16x8*)(kp+6144); kf[7]=*(const __attribute__((address_space(3))) bf16x8*)(kp+6656);
}
__device__ __forceinline__ void kload2(bf16x8*kf,lds_cptr kp,int j){ kf[2*j]=*(const __attribute__((address_space(3))) bf16x8*)(kp+j*2048); kf[2*j+1]=*(const __attribute__((address_space(3))) bf16x8*)(kp+j*2048+512); }
__device__ __forceinline__ s16x4 vtr(lds_cptr p){ return __builtin_bit_cast(s16x4,__builtin_amdgcn_ds_read_tr16_b64_v4i16((__attribute__((address_space(3))) v4i16_t*)p)); }
__device__ __forceinline__ float rowmax(const f32x16&p0,const f32x16&p1){
  float a=max3f(p0[0],p0[1],p1[0]),b=max3f(p0[2],p0[3],p1[1]);a=max3f(a,p1[2],p1[3]);
  #pragma unroll
  for(int r=4;r<16;r+=4){a=max3f(a,p0[r],p0[r+1]);b=max3f(b,p0[r+2],p0[r+3]);a=max3f(a,p1[r],p1[r+1]);b=max3f(b,p1[r+2],p1[r+3]);}
  const float m=max2f(a,b);
  auto rr=__builtin_amdgcn_permlane32_swap(__float_as_uint(m),__float_as_uint(m),false,false);
  return max2f(__uint_as_float(rr[0]),__uint_as_float(rr[1]));
}
__device__ __forceinline__ void pv(f32x16*o,int vb,bf16x8 pa0,bf16x8 pa1,bf16x8 pa2,bf16x8 pa3){
  #pragma unroll
  for(int d0=0;d0<2;++d0){s16x4 lo[4],hi[4];
    #pragma unroll
    for(int ks=0;ks<4;++ks){
      asm volatile("ds_read_b64_tr_b16 %0,%1 offset:%c2":"=&v"(lo[ks]):"v"(vb),"i"(d0*4096+ks*1024):"memory");
      asm volatile("ds_read_b64_tr_b16 %0,%1 offset:%c2":"=&v"(hi[ks]):"v"(vb),"i"(d0*4096+ks*1024+512):"memory");}
    asm volatile("s_waitcnt lgkmcnt(0)":::"memory");SBAR();
    #define PK(k) (bf16x8){lo[k][0],lo[k][1],lo[k][2],lo[k][3],hi[k][0],hi[k][1],hi[k][2],hi[k][3]}
    o[d0]=__builtin_amdgcn_mfma_f32_32x32x16_bf16(pa0,PK(0),o[d0],0,0,0);
    o[d0]=__builtin_amdgcn_mfma_f32_32x32x16_bf16(pa1,PK(1),o[d0],0,0,0);
    o[d0]=__builtin_amdgcn_mfma_f32_32x32x16_bf16(pa2,PK(2),o[d0],0,0,0);
    o[d0]=__builtin_amdgcn_mfma_f32_32x32x16_bf16(pa3,PK(3),o[d0],0,0,0);
    #undef PK
  }
}

#ifndef ATTN_STORE16
#define ATTN_STORE16(p,v) (*(u32x4*)(p)=(v))
#endif
template<int THRL> __device__ __forceinline__ void attn_unit(int b,int h,int qb,const bf16*Q,const bf16*__restrict__ K,const bf16*__restrict__ V,const float*__restrict__ KM,const float*__restrict__ KA,bf16*O,char*shm,int wave_s){
  int tid_l=wave_s*64+pg8::lane_now(); asm volatile("":"+v"(tid_l));
  const int tid=tid_l,lane=tid&63,r32=lane&31,hi=lane>>5; const int wid=__builtin_amdgcn_readfirstlane(tid>>6);
  const long rowbase=(long)b*SEQ; const int q0=qb*QB;
  const bf16*Qw=Q+(rowbase+q0+wid*QBLK)*DM+h*D;
  const bf16*Kh=K+rowbase*DM+h*D,*Vh=V+rowbase*DM+h*D;
  const unsigned lds0=(unsigned)(uintptr_t)shm;
  float*wsf=(float*)(shm+LDS_WS)+wid*64;
  const bf16*ksrc_=Kh+(long)lane*DM+wid*8;
  const bf16*vsrc_=Vh+(long)(16*(wid&3)+(lane>>2))*DM+(wid>>2)*32+(lane&3)*8;
  const unsigned kdst=lds0+LDS_K+wid*1024, vdst=lds0+LDS_V+wid*1024;
  const bf16*ksrc=ksrc_,*vsrc=vsrc_;
  #define DMA_K(t,slot) glds16(ksrc+(long)(t)*KVBLK*DM,(unsigned)__builtin_amdgcn_readfirstlane(kdst+(slot)))
  #define DMA_V(t,slot) glds16(vsrc+(long)(t)*KVBLK*DM,(unsigned)__builtin_amdgcn_readfirstlane(vdst+(slot)))
  const int vb0=(int)(lds0+LDS_V)+((lane>>4)&1)*32+(lane&3)*8+(4*hi+((lane&15)>>2))*64;
  const char*Kbase=shm+LDS_K; bf16x8 kf[8];
  const lds_cptr shm3=(lds_cptr)shm; const lds_cptr kp0=shm3+LDS_K+hi*1024+r32*16; const lds_cptr vp0=shm3+LDS_V+((lane>>4)&1)*32+(lane&3)*8+(4*hi+((lane&15)>>2))*64;
  int NT=(q0+QB)/KVBLK;
  { const float4*gm=reinterpret_cast<const float4*>(KM+((long)(b*NHEAD+h)*32)*64), *ga=reinterpret_cast<const float4*>(KA+((long)(b*NHEAD+h)*32)*64);
    float4*lm=reinterpret_cast<float4*>(shm+LDS_TAB), *la=reinterpret_cast<float4*>(shm+LDS_TAB+8192);
    lm[tid]=gm[tid]; la[tid]=ga[tid];
    asm volatile("s_waitcnt vmcnt(0) lgkmcnt(0)\n\ts_barrier":::"memory"); }
  bf16x8 qr[4];
  #pragma unroll
  for(int d0=0;d0<4;++d0)qr[d0]=*reinterpret_cast<const bf16x8*>(&Qw[(long)r32*DM+d0*16+hi*8]);
  float mhat=0.f,l_reg=0.f;f32x16 o[2];o[0]=f32x16{};o[1]=f32x16{};
  const int qrel=wid*QBLK+r32;
  const float sl2=1.4426950408889634f*__builtin_amdgcn_exp2f(-(float)(h+1));
  const float hb4=sl2*(float)(4*hi), sl32=32.f*sl2;
  unsigned selmask=0u;
  { float qf[32];
    #pragma unroll
    for(int d0=0;d0<4;++d0){
      #pragma unroll
      for(int j=0;j<8;++j)qf[d0*8+j]=__builtin_bit_cast(float,((unsigned)(unsigned short)qr[d0][j])<<16);}
    { const bf16*Kd=Kh+(long)(q0+qrel)*DM; float acc=0.f;
      #pragma unroll
      for(int d0=0;d0<4;++d0){ const bf16x8 kq=*reinterpret_cast<const bf16x8*>(&Kd[d0*16+hi*8]);
        #pragma unroll
        for(int j=0;j<8;++j)acc+=qf[d0*8+j]*__builtin_bit_cast(float,((unsigned)(unsigned short)kq[j])<<16);}
      auto rr=__builtin_amdgcn_permlane32_swap(__float_as_uint(acc),__float_as_uint(acc),false,false);
      mhat=(__uint_as_float(rr[0])+__uint_as_float(rr[1]))+sl2*(float)qrel; }
    float v0=-INFINITY,v1=-INFINITY,v2=-INFINITY; int i0=-1,i1=-1,i2=-1; unsigned nearmask=0u;
    const float*KMb=reinterpret_cast<const float*>(shm+LDS_TAB)+hi*8; const float*KAb=reinterpret_cast<const float*>(shm+LDS_TAB+8192)+hi*8;
    for(int j=0;j<qb;++j){ const float*km=KMb+j*64; const float*ka=KAb+j*64; float sp=0.f, up=0.f;
      #pragma unroll
      for(int d0=0;d0<4;++d0){ const float4 a=*reinterpret_cast<const float4*>(km+d0*16), c=*reinterpret_cast<const float4*>(km+d0*16+4);
        sp+=qf[d0*8+0]*a.x+qf[d0*8+1]*a.y+qf[d0*8+2]*a.z+qf[d0*8+3]*a.w+qf[d0*8+4]*c.x+qf[d0*8+5]*c.y+qf[d0*8+6]*c.z+qf[d0*8+7]*c.w;
        const float4 e=*reinterpret_cast<const float4*>(ka+d0*16), f=*reinterpret_cast<const float4*>(ka+d0*16+4);
        up+=__builtin_fabsf(qf[d0*8+0])*e.x+__builtin_fabsf(qf[d0*8+1])*e.y+__builtin_fabsf(qf[d0*8+2])*e.z+__builtin_fabsf(qf[d0*8+3])*e.w+__builtin_fabsf(qf[d0*8+4])*f.x+__builtin_fabsf(qf[d0*8+5])*f.y+__builtin_fabsf(qf[d0*8+6])*f.z+__builtin_fabsf(qf[d0*8+7])*f.w;}
      auto rr=__builtin_amdgcn_permlane32_swap(__float_as_uint(sp),__float_as_uint(sp),false,false);
      const float sc=__uint_as_float(rr[0])+__uint_as_float(rr[1]);
      { auto ru=__builtin_amdgcn_permlane32_swap(__float_as_uint(up),__float_as_uint(up),false,false); const float ub=(__uint_as_float(ru[0])+__uint_as_float(ru[1]))*1.01f;
        if(ub+sl2*(float)(256*j+255-q0)-mhat>-70.f)nearmask|=1u<<j; }
      if(sc>v2){ if(sc>v1){ v2=v1;i2=i1; if(sc>v0){v1=v0;i1=i0;v0=sc;i0=j;} else {v1=sc;i1=j;} } else {v2=sc;i2=j;} } }
    if(i0>=0)selmask|=1u<<i0; if(i1>=0)selmask|=1u<<i1; if(i2>=0)selmask|=1u<<i2;
    unsigned need=selmask&nearmask;
    #pragma unroll
    for(int o_=1;o_<64;o_<<=1)need|=(unsigned)__builtin_amdgcn_ds_bpermute((lane^o_)<<2,(int)need);
    volatile unsigned*xw=(volatile unsigned*)(shm+LDS_OST);
    if(lane==0)xw[wid]=need;
    asm volatile("s_waitcnt lgkmcnt(0)\n\ts_barrier":::"memory");
    unsigned na=xw[0]|xw[1]|xw[2]|xw[3]|xw[4]|xw[5]|xw[6]|xw[7];
    na=(unsigned)__builtin_amdgcn_readfirstlane((int)na)|(1u<<qb);
    const int nskip=__builtin_ctz(na);
    NT-=4*nskip; selmask>>=nskip; ksrc+=(long)nskip*256*DM; vsrc+=(long)nskip*256*DM; }
  f32x16 negm;
  #pragma unroll
  for(int r=0;r<16;++r)negm[r]=sl2*(float)((r&3)+8*(r>>2));
  asm volatile("":"+v"(negm));
  #define ABIAS(P0,P1,t) do{ const int tt_=(t); const bool on_=(tt_>=NT-4)||(((selmask>>(tt_>>2))&1u)!=0u); \
    const float L0_=on_?((sl2*(float)(64*(tt_-(NT-4)))+hb4)-mhat):-INFINITY; const float L1_=L0_+sl32; \
    _Pragma("unroll") for(int r=0;r<16;++r){P0[r]+=L0_;P1[r]+=L1_;} }while(0)
  #define CMASK(P0,P1,t) do{int jb_=(t)-(NT-4); if(jb_>=0)cmask(P0,P1,jb_,qrel,hi);}while(0)
  bool resc=false;
  #define START(P0,P1) do{ const float rm=rowmax(P0,P1); resc=false; \
    if(__any(rm>(float)THRL)){ const float dl=__builtin_fmaxf(rm,0.f); mhat+=dl; \
      _Pragma("unroll") for(int r=0;r<16;++r){P0[r]-=dl;P1[r]-=dl;} } \
    _Pragma("unroll") for(int r=0;r<16;++r)P0[r]=__builtin_amdgcn_exp2f(P0[r]); }while(0)
  #define RESC() do{ if(resc){ asm volatile("s_waitcnt lgkmcnt(0)":::"memory"); \
      _Pragma("unroll") for(int d_=0;d_<2;++d_) _Pragma("unroll") for(int r=0;r<16;++r)o[d_][r]*=wsf[crow(r,hi)]; } }while(0)
  f32x16 pA0,pA1,pB0,pB1;
  int sl_prev=0,sl_cur=0,sl_next=SLOTB;
  #define ROT() do{sl_prev=sl_cur;sl_cur=sl_next;sl_next=(sl_next==(NSLOT-1)*SLOTB)?0:sl_next+SLOTB;}while(0)
  DMA_K(0,0);DMA_V(0,0);DMA_K(1,SLOTB);
  DMA_K(2,2*SLOTB);
  WAIT_BAR(3);
  qkt(pA0,pA1,Kbase,qr,negm,r32,hi);asm volatile("s_nop 15\n\ts_nop 7":"+v"(pA0),"+v"(pA1));ABIAS(pA0,pA1,0);CMASK(pA0,pA1,0);
  START(pA0,pA1);
  _Pragma("unroll") for(int r=0;r<16;++r)pA1[r]=__builtin_amdgcn_exp2f(pA1[r]);
  WAIT_BAR(0);
  DMA_K(3,0);DMA_V(1,SLOTB);
  ROT();
  kload8(kf,kp0+sl_cur);
  WAIT_BAR(2);
  s16x4 vlo[8],vhi[8]; u32x4 pw0,pw1,pw2,pw3;
  #define PKW(P,B) cvtpk_s(P[B],P[B+1])
  #define PAF(k) __builtin_bit_cast(bf16x8,pw##k)
  #define VFR(i) (bf16x8){vlo[i][0],vlo[i][1],vlo[i][2],vlo[i][3],vhi[i][0],vhi[i][1],vhi[i][2],vhi[i][3]}
  #define PIN(x) asm volatile("":"+v"(x))
  #define MX3(a,b,c) __builtin_fmaxf(__builtin_fmaxf((a),(b)),(c))
  #define GAPA(MF,A0,A1,A2,A3,W0,W1,PW) do{ MF; sacc+=A0; sacc+=A1; sacc+=A2; sacc+=A3; PIN(sacc); W0; W1; PIN(PW); SBAR(); }while(0)
  #define EX(v) __builtin_amdgcn_exp2f(v)
  #define GAPB(MF,X,B) do{ MF; X[B]=EX(X[B]); X[B+1]=EX(X[B+1]); X[B+2]=EX(X[B+2]); X[B+3]=EX(X[B+3]); PIN(X); SBAR(); }while(0)
  #define VRD(i) do{ vlo[i]=vtr(vp_+(((i)>>2)*4096+((i)&3)*1024)); vhi[i]=vtr(vp_+(((i)>>2)*4096+((i)&3)*1024+512)); }while(0)
  #define KRD(G,j) do{ if(G){ kload2(kf,kp0+sl_next,j); SBAR(); } }while(0)
  #define STEP(C0,C1,P0,P1,t,GK,GV,GL) do{ SBAR(); \
    const lds_cptr vp_=vp0+sl_prev; \
    VRD(0); SBAR(); float sacc=(P0[0]+P0[1]); \
    GAPA(C0=__builtin_amdgcn_mfma_f32_32x32x16_bf16(kf[0],qr[0],negm,0,0,0), P0[2],P0[3],P0[4],P0[5],     pw0[0]=PKW(P0,0), pw0[1]=PKW(P0,2), pw0); \
    VRD(4); SBAR(); GAPA(C1=__builtin_amdgcn_mfma_f32_32x32x16_bf16(kf[1],qr[0],negm,0,0,0), P0[6],P0[7],P0[8],P0[9],     pw0[2]=PKW(P0,4), pw0[3]=PKW(P0,6), pw0); \
    VRD(1); SBAR(); GAPA(C0=__builtin_amdgcn_mfma_f32_32x32x16_bf16(kf[2],qr[1],C0,0,0,0),   P0[10],P0[11],P0[12],P0[13], pw1[0]=PKW(P0,8), pw1[1]=PKW(P0,10), pw1); \
    VRD(5); SBAR(); GAPA(C1=__builtin_amdgcn_mfma_f32_32x32x16_bf16(kf[3],qr[1],C1,0,0,0),   P0[14],P0[15],P1[0],P1[1],   pw1[2]=PKW(P0,12),pw1[3]=PKW(P0,14), pw1); \
    VRD(2); SBAR(); GAPA(C0=__builtin_amdgcn_mfma_f32_32x32x16_bf16(kf[4],qr[2],C0,0,0,0),   P1[2],P1[3],P1[4],P1[5],     pw2[0]=PKW(P1,0), pw2[1]=PKW(P1,2), pw2); \
    VRD(6); SBAR(); GAPA(C1=__builtin_amdgcn_mfma_f32_32x32x16_bf16(kf[5],qr[2],C1,0,0,0),   P1[6],P1[7],P1[8],P1[9],     pw2[2]=PKW(P1,4), pw2[3]=PKW(P1,6), pw2); \
    VRD(3); SBAR(); GAPA(C0=__builtin_amdgcn_mfma_f32_32x32x16_bf16(kf[6],qr[3],C0,0,0,0),   P1[10],P1[11],P1[12],P1[13], pw3[0]=PKW(P1,8), pw3[1]=PKW(P1,10), pw3); \
    VRD(7); SBAR(); GAPA(C1=__builtin_amdgcn_mfma_f32_32x32x16_bf16(kf[7],qr[3],C1,0,0,0),   P1[14],P1[15],0.f,0.f,       pw3[2]=PKW(P1,12),pw3[3]=PKW(P1,14), pw3); \
    l_reg+=sacc; \
    if(GK){DMA_K((t)+3,sl_cur);} if(GV){DMA_V((t)+1,sl_next);} \
    ABIAS(C0,C1,t); CMASK(C0,C1,t); \
    { float a=MX3(C0[0],C0[1],C1[0]),b=MX3(C0[2],C0[3],C1[1]); a=MX3(a,C1[2],C1[3]); \
      _Pragma("unroll") for(int r=4;r<16;r+=4){a=MX3(a,C0[r],C0[r+1]);b=MX3(b,C0[r+2],C0[r+3]);a=MX3(a,C1[r],C1[r+1]);b=MX3(b,C1[r+2],C1[r+3]);} \
      float rm=__builtin_fmaxf(a,b); { auto rr=__builtin_amdgcn_permlane32_swap(__float_as_uint(rm),__float_as_uint(rm),false,false); rm=__builtin_fmaxf(__uint_as_float(rr[0]),__uint_as_float(rr[1])); } \
      resc=false; \
      if(__builtin_expect(__any(rm>(float)THRL),0)){ const float dl=__builtin_fmaxf(rm,0.f); mhat+=dl; \
        _Pragma("unroll") for(int r=0;r<16;++r){C0[r]-=dl;C1[r]-=dl;} \
        const float f=__builtin_amdgcn_exp2f(-dl); l_reg*=f; if(hi==0)wsf[r32]=f; resc=true; } } \
    SBAR(); \
    GAPB(o[0]=__builtin_amdgcn_mfma_f32_32x32x16_bf16(PAF(0),VFR(0),o[0],0,0,0), C0,0); \
    GAPB(o[1]=__builtin_amdgcn_mfma_f32_32x32x16_bf16(PAF(0),VFR(4),o[1],0,0,0), C0,4); \
    KRD(GL,0); GAPB(o[0]=__builtin_amdgcn_mfma_f32_32x32x16_bf16(PAF(1),VFR(1),o[0],0,0,0), C0,8); \
    KRD(GL,1); GAPB(o[1]=__builtin_amdgcn_mfma_f32_32x32x16_bf16(PAF(1),VFR(5),o[1],0,0,0), C0,12); \
    KRD(GL,2); GAPB(o[0]=__builtin_amdgcn_mfma_f32_32x32x16_bf16(PAF(2),VFR(2),o[0],0,0,0), C1,0); \
    KRD(GL,3); GAPB(o[1]=__builtin_amdgcn_mfma_f32_32x32x16_bf16(PAF(2),VFR(6),o[1],0,0,0), C1,4); \
    GAPB(o[0]=__builtin_amdgcn_mfma_f32_32x32x16_bf16(PAF(3),VFR(3),o[0],0,0,0), C1,8); \
    GAPB(o[1]=__builtin_amdgcn_mfma_f32_32x32x16_bf16(PAF(3),VFR(7),o[1],0,0,0), C1,12); \
    }while(0)
  int t=1;
  #undef CMASK
  #define CMASK(P0,P1,t) do{}while(0)
  for(;t+5<NT;t+=2){
    STEP(pB0,pB1,pA0,pA1,t,true,true,true);     WAIT_BAR(2); RESC(); ROT();
    STEP(pA0,pA1,pB0,pB1,t+1,true,true,true);   WAIT_BAR(2); RESC(); ROT();
  }
  #undef CMASK
  #define CMASK(P0,P1,t) do{int jb_=(t)-(NT-4); if(jb_>=0)cmask(P0,P1,jb_,qrel,hi);}while(0)
  #define ENDW(tt) do{ if((tt)+3<NT){WAIT_BAR(2);} else if((tt)+2<NT){WAIT_BAR(1);} else {WAIT_BAR(0);} }while(0)
  for(;t+1<NT;t+=2){
    STEP(pB0,pB1,pA0,pA1,t,(t+3<NT),(t+1<NT),(t+1<NT));       ENDW(t);   RESC(); ROT();
    STEP(pA0,pA1,pB0,pB1,t+1,(t+4<NT),(t+2<NT),(t+2<NT));     ENDW(t+1); RESC(); ROT();
  }
  STEP(pB0,pB1,pA0,pA1,NT-1,false,false,false); RESC();
  { float sacc=pB0[0]+pB0[1]; _Pragma("unroll") for(int r=2;r<16;++r)sacc+=pB0[r]; _Pragma("unroll") for(int r=0;r<16;++r)sacc+=pB1[r]; l_reg+=sacc;
    pw0=(u32x4){PKW(pB0,0),PKW(pB0,2),PKW(pB0,4),PKW(pB0,6)};pw1=(u32x4){PKW(pB0,8),PKW(pB0,10),PKW(pB0,12),PKW(pB0,14)};pw2=(u32x4){PKW(pB1,0),PKW(pB1,2),PKW(pB1,4),PKW(pB1,6)};pw3=(u32x4){PKW(pB1,8),PKW(pB1,10),PKW(pB1,12),PKW(pB1,14)};
    SBAR(); pv(o,vb0+sl_cur,PAF(0),PAF(1),PAF(2),PAF(3)); }
  #undef PKW
  #undef PAF
  #undef VFR
  #undef PIN
  #undef MX3
  #undef GAPA
  #undef GAPB
  #undef EX
  #undef VRD
  #undef KRD
  #undef STEP
  #undef ENDW
  {auto rr=__builtin_amdgcn_permlane32_swap(__float_as_uint(l_reg),__float_as_uint(l_reg),false,false);l_reg=__uint_as_float(rr[0])+__uint_as_float(rr[1]);}
  if(hi==0)wsf[32+r32]=l_reg;asm volatile("s_waitcnt lgkmcnt(0)":::"memory");
  float rli[16];
  #pragma unroll
  for(int r=0;r<16;++r)rli[r]=__builtin_amdgcn_rcpf(wsf[32+crow(r,hi)]);
  bf16*Ow=O+(rowbase+q0+wid*QBLK)*DM+h*D;
  { bf16*stg=(bf16*)(shm+LDS_OST)+wid*2048;
    #pragma unroll
    for(int r=0;r<16;++r){const int orow=crow(r,hi);
      #pragma unroll
      for(int d0=0;d0<2;++d0)stg[orow*64+d0*32+r32]=__float2bfloat16(o[d0][r]*rli[r]);}
    asm volatile("s_waitcnt lgkmcnt(0)":::"memory");
    #pragma unroll
    for(int i=0;i<4;++i){const int row=i*8+(lane>>3),ch=lane&7; const u32x4 v=*(const u32x4*)(stg+row*64+ch*8); ATTN_STORE16(Ow+(long)row*DM+ch*8,v);} }
  asm volatile("s_waitcnt lgkmcnt(0)\n\ts_barrier":::"memory");
  #undef DMA_K
  #undef DMA_V
  #undef CMASK
  #undef ABIAS
  #undef START
  #undef RESC
  #undef ROT
}
constexpr int ATTN_LDS_BYTES=LDS_BYTES;
struct AttnTensors { const bf16* Q; const bf16* K; const bf16* V; const float* KM; const float* KA; bf16* O; };
struct AttnUnit { int bh; int qb; };
struct StaticOrder {
  int vcu;
  __device__ __forceinline__ explicit StaticOrder(int grid,int block):vcu((block%8)*(grid/8)+block/8){}
  __device__ __forceinline__ bool next(int i,AttnUnit&u)const{ if(i>=4)return false; const int s=vcu&7; u.bh=vcu>>3; u.qb=(i==0)?s:(i==1)?15-s:(i==2)?16+s:31-s; return true; }
  __device__ __forceinline__ void a_ready(const AttnUnit&)const{}
  __device__ __forceinline__ void done(const AttnUnit&)const{}
};
struct QueueOrder {
  unsigned* ctr; volatile unsigned* slot; int wv;
  __device__ __forceinline__ bool next(int,AttnUnit&u)const{
    if(wv==0&&pg8::lane_now()==0)*slot=__hip_atomic_fetch_add(ctr,1u,__ATOMIC_RELAXED,__HIP_MEMORY_SCOPE_AGENT);
    asm volatile("s_waitcnt vmcnt(0) lgkmcnt(0)\n\ts_barrier":::"memory");
    const unsigned idx=(unsigned)__builtin_amdgcn_readfirstlane((int)*slot);
    if(idx>=(unsigned)(BATCH*NHEAD*NQB))return false;
    u.qb=NQB-1-(int)(idx>>5); u.bh=(int)(idx&31u); return true; }
  __device__ __forceinline__ void a_ready(const AttnUnit&)const{}
  __device__ __forceinline__ void done(const AttnUnit&)const{}
};
template<class Sched,int THRL=8> __device__ __forceinline__ void attn_phase(char*lds,const AttnTensors&T,const Sched&S,int wave_s){
  AttnUnit u;
  for(int i=0;S.next(i,u);++i){ S.a_ready(u); attn_unit<THRL>(u.bh/NHEAD,u.bh%NHEAD,u.qb,T.Q,T.K,T.V,T.KM,T.KA,T.O,lds,wave_s); S.done(u); }
}
#undef SBAR
#undef WAIT_BAR
}
constexpr size_t MiB = (size_t)1 << 20;
constexpr size_t WS_CTL = 0, CTL_ZERO_BYTES = 2 * MiB;
constexpr size_t WS_W0 = 2 * MiB;
constexpr size_t WO_IN = 0, WO_SGU = 36 * MiB, WO_MOBA = 38 * MiB, WO_POOL = 40 * MiB, WO_OUT = 42 * MiB, WO_UP = 50 * MiB, WO_DOWN = 94 * MiB;
constexpr size_t WS_SMALL = 118 * MiB;
constexpr size_t WS_MOD = WS_SMALL + 768 * 1024;
constexpr size_t WS_KMEAN = 512 * 1024;
constexpr size_t WS_KABS = 1 * MiB;
constexpr size_t WS_SGUW = WS_SMALL;
constexpr size_t WS_POOLWT = WS_SMALL + 512 * 1024;
constexpr size_t WS_MODP = 120 * MiB;
constexpr size_t WS_TOPZ = 126 * MiB, WS_BOTZ = 137 * MiB;
constexpr size_t WS_H = 148 * MiB;
constexpr size_t WS_T6 = 276 * MiB;
constexpr size_t WS_G3 = 500 * MiB;
constexpr size_t WS_Y = 276 * MiB;
constexpr size_t WS_A2 = 500 * MiB;
constexpr size_t WS_XR = 884 * MiB;
constexpr size_t WS_H8 = WS_G3 + 192 * MiB;
constexpr size_t WO_IN8 = 6 * MiB;
constexpr size_t WS_CMAX = 64 * 1024;
constexpr size_t WS_CMAXG = WS_CMAX + 96 * 1024;
constexpr size_t WS_RS1 = WS_SMALL + 1280 * 1024 + 128 * 1024;
constexpr size_t WS_RS = WS_SMALL + 1280 * 1024;
constexpr size_t WS_END = 1012 * MiB;
constexpr int CW_TMO = 0, CW_CODE = 1, CW_BAR = 4096, CW_ATTNQ = 8192;
constexpr int RING_BYTES = 131072, XB_OFF = RING_BYTES  , LDSCTL_OFF = 139264, MISC_OFF = LDSCTL_OFF + 320, LDS_BYTES = 147456;

__device__ __forceinline__ float lane_xor(float v, int lane, int o) { return __builtin_bit_cast(float, __builtin_amdgcn_ds_bpermute((lane ^ o) << 2, __builtin_bit_cast(int, v))); }
__device__ __forceinline__ float wave_sum(float v, int lane) {
#pragma unroll
    for (int o = 1; o < 64; o <<= 1) v += lane_xor(v, lane, o);
    return v;
}
__device__ __forceinline__ float wave_max(float v, int lane) {
#pragma unroll
    for (int o = 1; o < 64; o <<= 1) v = fmaxf(v, lane_xor(v, lane, o));
    return v;
}
typedef unsigned u32x2v __attribute__((ext_vector_type(2)));
__device__ __forceinline__ void transpose_item(const float* W, int K, int N, bf16* WT, bool upperm, LAS float* scr, int item, int lane, int f8split = 1 << 30, unsigned char* W8 = nullptr, const unsigned* cmax8 = nullptr, const unsigned* cmaxg = nullptr) {
    const int nblk = N / 32, kb = item / nblk, nb = item % nblk, k0 = 64 * kb, n0 = 32 * nb;
    int drow0 = n0;
    if (upperm) drow0 = (n0 < DFF) ? (n0 >> 7) * 256 + (n0 & 127) : ((n0 - DFF) >> 7) * 256 + 128 + ((n0 - DFF) & 127);
    float v[32];
    const float* src = W + (size_t)(k0 + (lane >> 5)) * N + n0 + (lane & 31);
#pragma unroll
    for (int i = 0; i < 32; ++i) v[i] = __builtin_nontemporal_load(src + (size_t)(2 * i) * N);
#pragma unroll
    for (int i = 0; i < 32; ++i) scr[(2 * i + (lane >> 5)) * 33 + (lane & 31)] = v[i];
    LDS_WAIT(); asm volatile("" ::: "memory");
    const int c = lane & 7;
    if (cmax8) {
#pragma unroll
        for (int j = 0; j < 4; ++j) { const int n = (lane >> 3) + 8 * j; const LAS float* s = scr + (8 * c) * 33 + n;
            const unsigned cb = cmax8[n0 + n]; const float cmx = __builtin_bit_cast(float, cb); const float inv = cmx > 0.f ? 127.0f / cmx : 0.f;
            u32x2v o; o.x = q8x4(s[0 * 33], s[1 * 33], s[2 * 33], s[3 * 33], inv); o.y = q8x4(s[4 * 33], s[5 * 33], s[6 * 33], s[7 * 33], inv);
            *(GAS u32x2v*)((unsigned char*)WT + (size_t)(drow0 + n) * K + k0 + 8 * c) = o; }
    } else if (n0 >= f8split) {
#pragma unroll
        for (int j = 0; j < 4; ++j) { const int n = (lane >> 3) + 8 * j; const LAS float* s = scr + (8 * c) * 33 + n;
            const unsigned cb = cmaxg[n0 - f8split + n]; const float cmx = __builtin_bit_cast(float, cb); const float inv = cmx > 0.f ? 127.0f / cmx : 0.f;
            u32x2v o; o.x = q8x4(s[0 * 33], s[1 * 33], s[2 * 33], s[3 * 33], inv); o.y = q8x4(s[4 * 33], s[5 * 33], s[6 * 33], s[7 * 33], inv);
            *(GAS u32x2v*)(W8 + (size_t)(n0 - f8split + n) * K + k0 + 8 * c) = o; }
    } else {
#pragma unroll
    for (int j = 0; j < 4; ++j) { const int n = (lane >> 3) + 8 * j; const LAS float* s = scr + (8 * c) * 33 + n;
        v4u o; o.x = pg8::cvt_pk_bf16(s[0 * 33], s[1 * 33]); o.y = pg8::cvt_pk_bf16(s[2 * 33], s[3 * 33]); o.z = pg8::cvt_pk_bf16(s[4 * 33], s[5 * 33]); o.w = pg8::cvt_pk_bf16(s[6 * 33], s[7 * 33]);
        *(GAS v4u*)(WT + (size_t)(drow0 + n) * K + k0 + 8 * c) = o; }
    }
    LDS_WAIT(); asm volatile("" ::: "memory");
}

__device__ __forceinline__ void strip_quant(const float* W, int N, unsigned char* WT8, bool upperm, unsigned* cmax_out, LAS unsigned char* lds, int strip, int lane, int wave) {
    const int n0 = 32 * strip;
    int drow0 = n0;
    if (upperm) drow0 = (n0 < DFF) ? (n0 >> 7) * 256 + (n0 & 127) : ((n0 - DFF) >> 7) * 256 + 128 + ((n0 - DFF) & 127);
    LAS float* scr = (LAS float*)(lds + wave * 8448);
    LAS float* cmx = (LAS float*)(lds + 8 * 8448);
    float v[4][32];
#pragma unroll
    for (int b = 0; b < 4; ++b) { const float* src = W + (size_t)((4 * wave + b) * 64 + (lane >> 5)) * N + n0 + (lane & 31);
#pragma unroll
        for (int i = 0; i < 32; ++i) v[b][i] = __builtin_nontemporal_load(src + (size_t)(2 * i) * N); }
    float m = 0.f;
#pragma unroll
    for (int b = 0; b < 4; ++b)
#pragma unroll
        for (int i = 0; i < 32; ++i) m = fmaxf(m, __builtin_fabsf(v[b][i]));
    m = fmaxf(m, lane_xor(m, lane, 32));
    if (lane < 32) cmx[wave * 32 + lane] = m;
    __syncthreads();
    const int c = lane & 7;
    float inv[4];
#pragma unroll
    for (int j = 0; j < 4; ++j) { const int n = (lane >> 3) + 8 * j; float mm = 0.f;
#pragma unroll
        for (int w = 0; w < 8; ++w) mm = fmaxf(mm, cmx[w * 32 + n]);
        inv[j] = mm > 0.f ? 127.0f / mm : 0.f;
        if (wave == 0 && c == 0) cmax_out[n0 + n] = __builtin_bit_cast(unsigned, mm); }
#pragma unroll
    for (int b = 0; b < 4; ++b) { const int k0 = (4 * wave + b) * 64;
#pragma unroll
        for (int i = 0; i < 32; ++i) scr[(2 * i + (lane >> 5)) * 33 + (lane & 31)] = v[b][i];
        LDS_WAIT(); asm volatile("" ::: "memory");
#pragma unroll
        for (int j = 0; j < 4; ++j) { const int n = (lane >> 3) + 8 * j; const LAS float* sp = scr + (8 * c) * 33 + n;
            u32x2v o; o.x = q8x4(sp[0 * 33], sp[1 * 33], sp[2 * 33], sp[3 * 33], inv[j]); o.y = q8x4(sp[4 * 33], sp[5 * 33], sp[6 * 33], sp[7 * 33], inv[j]);
            *(GAS u32x2v*)(WT8 + (size_t)(drow0 + n) * DM + k0 + 8 * c) = o; }
        LDS_WAIT(); asm volatile("" ::: "memory"); }
    __syncthreads();
}

template <int MODE, bool XIN_BF16, bool XOUT_BF16, bool H8OUT = false, bool HQOUT = false>
__device__ __forceinline__ void thin_phase(LAS unsigned char* lds, int tid, int lane, int wave, int bx, int G,
        const void* xin_, const bf16* yin, void* xout_, bf16* hout, unsigned char* hout8, float* rsout,
        const float* modA, const float* gA, const float* modS, const float* modT, const float* gS) {
    LAS float* vA = (LAS float*)lds; LAS float* vS = vA + 2048; LAS float* vT = vS + 2048;
    for (int rb = bx; rb < M / 128; rb += G) {
        const int b = rb >> 6;
        __syncthreads();
        for (int c = tid; c < DM; c += 512) {
            if (MODE != 0) vA[c] = modA[(size_t)b * 12288 + c] * gA[c];
            if (MODE != 2) { vS[c] = gS[c] * (1.0f + modS[(size_t)b * 12288 + c]); vT[c] = modT[(size_t)b * 12288 + c]; }
        }
        __syncthreads();
        for (int i = 0; i < 8; ++i) {
            size_t ro[2]; f32x4 x[2][8]; uint2 yr[2][8];
#pragma unroll
            for (int r = 0; r < 2; ++r) { ro[r] = (size_t)(rb * 128 + wave * 16 + i + 8 * r) * DM + 4 * lane;
#pragma unroll
                for (int j = 0; j < 8; ++j) {
                    if (XIN_BF16) { const u32x2v w = __builtin_nontemporal_load((const u32x2v*)((const bf16*)xin_ + ro[r] + 256 * j)); x[r][j] = (f32x4){bf_lo(w.x), bf_hi(w.x), bf_lo(w.y), bf_hi(w.y)}; }
                    else x[r][j] = __builtin_nontemporal_load((const f32x4*)((const float*)xin_ + ro[r] + 256 * j));
                    if (MODE != 0) { const u32x2v w = __builtin_nontemporal_load((const u32x2v*)(yin + ro[r] + 256 * j)); yr[r][j].x = w.x; yr[r][j].y = w.y; } } }
            asm volatile("" ::: "memory");
            if (MODE != 0) {
                float ss[2];
#pragma unroll
                for (int r = 0; r < 2; ++r) { ss[r] = 0.f;
#pragma unroll
                    for (int j = 0; j < 8; ++j) { const float y0 = bf_lo(yr[r][j].x), y1 = bf_hi(yr[r][j].x), y2 = bf_lo(yr[r][j].y), y3 = bf_hi(yr[r][j].y); ss[r] += (y0 * y0 + y1 * y1) + (y2 * y2 + y3 * y3); } }
#pragma unroll
                for (int o = 1; o < 64; o <<= 1) { const float t0 = lane_xor(ss[0], lane, o), t1 = lane_xor(ss[1], lane, o); ss[0] += t0; ss[1] += t1; }
#pragma unroll
                for (int r = 0; r < 2; ++r) { const float rstd = 1.0f / __builtin_sqrtf(ss[r] * (1.0f / DM) + EPS);
#pragma unroll
                    for (int j = 0; j < 8; ++j) { const f32x4 a = *(const LAS f32x4*)(vA + 4 * lane + 256 * j);
                        const f32x4 y = (f32x4){bf_lo(yr[r][j].x), bf_hi(yr[r][j].x), bf_lo(yr[r][j].y), bf_hi(yr[r][j].y)}; x[r][j] = x[r][j] + a * (y * rstd);
                        if (XOUT_BF16) { u32x2v w; w.x = pk2(x[r][j][0], x[r][j][1]); w.y = pk2(x[r][j][2], x[r][j][3]); __builtin_nontemporal_store(w, (u32x2v*)((bf16*)xout_ + ro[r] + 256 * j)); }
                        else __builtin_nontemporal_store(x[r][j], (f32x4*)((float*)xout_ + ro[r] + 256 * j)); } }
            }
            if (MODE != 2) {
                float ss[2];
#pragma unroll
                for (int r = 0; r < 2; ++r) { ss[r] = 0.f;
#pragma unroll
                    for (int j = 0; j < 8; ++j) ss[r] += (x[r][j][0] * x[r][j][0] + x[r][j][1] * x[r][j][1]) + (x[r][j][2] * x[r][j][2] + x[r][j][3] * x[r][j][3]); }
#pragma unroll
                for (int o = 1; o < 64; o <<= 1) { const float t0 = lane_xor(ss[0], lane, o), t1 = lane_xor(ss[1], lane, o); ss[0] += t0; ss[1] += t1; }
                if (HQOUT || H8OUT) {
                    float mx[2];
#pragma unroll
                    for (int r = 0; r < 2; ++r) { const float rstd = 1.0f / __builtin_sqrtf(ss[r] * (1.0f / DM) + EPS); mx[r] = 0.f;
#pragma unroll
                        for (int j = 0; j < 8; ++j) { const f32x4 sv = *(const LAS f32x4*)(vS + 4 * lane + 256 * j), tv = *(const LAS f32x4*)(vT + 4 * lane + 256 * j);
                            const f32x4 h = x[r][j] * rstd * sv + tv; x[r][j] = h;
                            mx[r] = fmaxf(fmaxf(mx[r], fmaxf(__builtin_fabsf(h[0]), __builtin_fabsf(h[1]))), fmaxf(__builtin_fabsf(h[2]), __builtin_fabsf(h[3]))); } }
#pragma unroll
                    for (int o = 1; o < 64; o <<= 1) { const float t0 = lane_xor(mx[0], lane, o), t1 = lane_xor(mx[1], lane, o); mx[0] = fmaxf(mx[0], t0); mx[1] = fmaxf(mx[1], t1); }
#pragma unroll
                    for (int r = 0; r < 2; ++r) { const float inv = mx[r] > 0.f ? 127.0f / mx[r] : 0.f;
                        if (lane == 0) rsout[ro[r] / DM] = mx[r] * (1.0f / 127.0f);
                        unsigned char* qdst = HQOUT ? (unsigned char*)hout : hout8;
#pragma unroll
                        for (int j = 0; j < 8; ++j) { *(unsigned*)(qdst + ro[r] + 256 * j) = q8x4(x[r][j][0], x[r][j][1], x[r][j][2], x[r][j][3], inv);
                            if (!HQOUT) { uint2 w; w.x = pk2(x[r][j][0], x[r][j][1]); w.y = pk2(x[r][j][2], x[r][j][3]); *(uint2*)(hout + ro[r] + 256 * j) = w; } } }
                } else
#pragma unroll
                for (int r = 0; r < 2; ++r) { const float rstd = 1.0f / __builtin_sqrtf(ss[r] * (1.0f / DM) + EPS);
#pragma unroll
                    for (int j = 0; j < 8; ++j) { const f32x4 sv = *(const LAS f32x4*)(vS + 4 * lane + 256 * j), tv = *(const LAS f32x4*)(vT + 4 * lane + 256 * j);
                        const f32x4 h = x[r][j] * rstd * sv + tv; uint2 w; w.x = pk2(h[0], h[1]); w.y = pk2(h[2], h[3]); *(uint2*)(hout + ro[r] + 256 * j) = w; } }
            }
        }
    }
    __syncthreads();
}

typedef float f32x16_t __attribute__((ext_vector_type(16)));
constexpr int VNT_LD = 136;
__device__ __forceinline__ void sgu_mfma_chunk(LAS unsigned char* lds, int chunk, const bf16* Vt, const bf16* Ut, bf16* Uo, const float* norm_g, const bf16* Wm  , const float* sgu_b, int lane, int wave) {
    LAS unsigned short* vnT = (LAS unsigned short*)lds;
    const int t0 = chunk * 128;
    float g8[8];
#pragma unroll
    for (int e = 0; e < 8; ++e) g8[e] = norm_g[lane + 64 * e];
    for (int i4 = 0; i4 < 4; ++i4) {
        float v[4][8];
#pragma unroll
        for (int i = 0; i < 4; ++i) { const bf16* vr = Vt + (size_t)(t0 + wave * 16 + i4 * 4 + i) * BW + lane;
#pragma unroll
            for (int e = 0; e < 8; ++e) v[i][e] = bf2f(__builtin_nontemporal_load(vr + 64 * e)); }
#pragma unroll
        for (int i = 0; i < 4; ++i) { const int s = wave * 16 + i4 * 4 + i; float sum = 0.f;
#pragma unroll
            for (int e = 0; e < 8; ++e) sum += v[i][e];
            const float mu = wave_sum(sum, lane) * (1.0f / BW); float q = 0.f;
#pragma unroll
            for (int e = 0; e < 8; ++e) { v[i][e] -= mu; q += v[i][e] * v[i][e]; }
            const float rstd = 1.0f / __builtin_sqrtf(wave_sum(q, lane) * (1.0f / BW) + EPS);
#pragma unroll
            for (int e = 0; e < 8; ++e) vnT[(lane + 64 * e) * VNT_LD + s] = (unsigned short)f2bf(v[i][e] * rstd * g8[e]); }
    }
    __syncthreads();
    const int r32 = lane & 31, hi = lane >> 5, g = wave;
    f32x16_t acc[4][2];
#pragma unroll
    for (int ti = 0; ti < 4; ++ti)
#pragma unroll
        for (int dj = 0; dj < 2; ++dj)
#pragma unroll
            for (int r = 0; r < 16; ++r) acc[ti][dj][r] = 0.f;
    const bf16* Wg = Wm + (size_t)g * 16384 + (size_t)r32 * 128 + 8 * hi;
    const LAS unsigned short* vb = vnT + (64 * g + r32) * VNT_LD + 8 * hi;
#pragma unroll
    for (int ks = 0; ks < 8; ++ks) {
        const bf16x8 b0 = *(const LAS bf16x8*)(vb + 16 * ks), b1 = *(const LAS bf16x8*)(vb + 32 * VNT_LD + 16 * ks);
#pragma unroll
        for (int ti = 0; ti < 4; ++ti) if (16 * ks <= 32 * ti + 31) {
            const bf16x8 a = *(const bf16x8*)(Wg + (size_t)ti * 32 * 128 + 16 * ks);
            acc[ti][0] = __builtin_amdgcn_mfma_f32_32x32x16_bf16(b0, a, acc[ti][0], 0, 0, 0);
            acc[ti][1] = __builtin_amdgcn_mfma_f32_32x32x16_bf16(b1, a, acc[ti][1], 0, 0, 0); }
    }
#pragma unroll
    for (int ti = 0; ti < 4; ++ti) { const int t = 32 * ti + r32; const float bs = sgu_b[g * 128 + t];
#pragma unroll
        for (int dj = 0; dj < 2; ++dj)
#pragma unroll
            for (int rg = 0; rg < 4; ++rg) { const size_t o = (size_t)(t0 + t) * BW + 64 * g + 32 * dj + 8 * rg + 4 * hi;
                const u32x2v uu = __builtin_nontemporal_load((const u32x2v*)(Ut + o)); uint2 w;
                w.x = pk2(bf_lo(uu.x) * (acc[ti][dj][4 * rg + 0] + bs), bf_hi(uu.x) * (acc[ti][dj][4 * rg + 1] + bs)); w.y = pk2(bf_lo(uu.y) * (acc[ti][dj][4 * rg + 2] + bs), bf_hi(uu.y) * (acc[ti][dj][4 * rg + 3] + bs));
                *(uint2*)(Uo + o) = w; } }
    __syncthreads();
}

constexpr int PA_LD = 520;
template <int W> __device__ __forceinline__ void pool_window(LAS unsigned short* pa, const bf16* ZP, int t0, int c) {
    float z[64 + W - 1];
    const int pos0 = t0 & (SEQ - 1);
#pragma unroll
    for (int i = 0; i < 64 + W - 1; ++i) { const int dt = i - (W - 1); z[i] = (pos0 + dt >= 0) ? bf2f(__builtin_nontemporal_load(ZP + (size_t)(t0 + dt) * BW + c)) : 0.f; }
#pragma unroll
    for (int tl = 0; tl < 64; ++tl) { float s = 0.f;
#pragma unroll
        for (int i = 0; i < W; ++i) s += z[tl + (W - 1) - i];
        const int pos = pos0 + tl; const float cnt = (float)((pos + 1 < W) ? pos + 1 : W);
        pa[tl * PA_LD + c] = (unsigned short)f2bf(s / cnt - z[tl + W - 1]); }
}
__device__ __forceinline__ void pool_mfma_tile(LAS unsigned char* lds, int tile, const bf16* ZP, bf16* YPo, const bf16* PWT  , const float* pool_scale, int tid, int lane, int wave) {
    LAS unsigned short* pa = (LAS unsigned short*)lds;
    const int t0 = tile * 64, c = tid, gsel = wave >> 1;
    if (gsel == 0) pool_window<2>(pa, ZP, t0, c); else if (gsel == 1) pool_window<4>(pa, ZP, t0, c); else if (gsel == 2) pool_window<8>(pa, ZP, t0, c); else pool_window<16>(pa, ZP, t0, c);
    __syncthreads();
    const int r32 = lane & 31, hi = lane >> 5, g = wave >> 1, dh = wave & 1;
    f32x16_t acc[2][2];
#pragma unroll
    for (int ti = 0; ti < 2; ++ti)
#pragma unroll
        for (int dj = 0; dj < 2; ++dj)
#pragma unroll
            for (int r = 0; r < 16; ++r) acc[ti][dj][r] = 0.f;
    const bf16* Bg = PWT + ((size_t)g * 128 + 64 * dh + r32) * 128 + 8 * hi;
    const LAS unsigned short* ab = pa + r32 * PA_LD + 128 * g + 8 * hi;
#pragma unroll
    for (int ks = 0; ks < 8; ++ks) {
        const bf16x8 b0 = *(const bf16x8*)(Bg + 16 * ks), b1 = *(const bf16x8*)(Bg + (size_t)32 * 128 + 16 * ks);
        const bf16x8 a0 = *(const LAS bf16x8*)(ab + 16 * ks), a1 = *(const LAS bf16x8*)(ab + 32 * PA_LD + 16 * ks);
        acc[0][0] = __builtin_amdgcn_mfma_f32_32x32x16_bf16(b0, a0, acc[0][0], 0, 0, 0); acc[0][1] = __builtin_amdgcn_mfma_f32_32x32x16_bf16(b1, a0, acc[0][1], 0, 0, 0);
        acc[1][0] = __builtin_amdgcn_mfma_f32_32x32x16_bf16(b0, a1, acc[1][0], 0, 0, 0); acc[1][1] = __builtin_amdgcn_mfma_f32_32x32x16_bf16(b1, a1, acc[1][1], 0, 0, 0);
    }
#pragma unroll
    for (int dj = 0; dj < 2; ++dj)
#pragma unroll
        for (int rg = 0; rg < 4; ++rg) { const int oc = 128 * g + 64 * dh + 32 * dj + 8 * rg + 4 * hi; const f32x4 sc = *(const f32x4*)(pool_scale + oc);
#pragma unroll
            for (int ti = 0; ti < 2; ++ti) { uint2 w; w.x = pk2(acc[ti][dj][4 * rg + 0] * sc[0], acc[ti][dj][4 * rg + 1] * sc[1]); w.y = pk2(acc[ti][dj][4 * rg + 2] * sc[2], acc[ti][dj][4 * rg + 3] * sc[3]);
                *(uint2*)(YPo + (size_t)(t0 + 32 * ti + r32) * BW + oc) = w; } }
    __syncthreads();
}

#ifndef NREP_GEMM
#define NREP_GEMM 1
#endif
#ifndef WGM_WIDE
#define WGM_WIDE 4
#endif
#ifndef WGM_NARROW
#define WGM_NARROW 4
#endif
#ifndef GP_ALIGN
#define GP_ALIGN true
#endif
#ifndef GP_SP2
#define GP_SP2 true
#endif
#ifndef PROBE_BAR2
#define PROBE_BAR2 0
#endif
#ifndef NREP_P0
#define NREP_P0 1
#endif
#ifndef NREP_ATTN
#define NREP_ATTN 1
#endif
#ifndef NREP_MIX
#define NREP_MIX 1
#endif
#ifndef NREP_THIN
#define NREP_THIN 1
#endif
#define PHASE_IDS() int tid_o = wave_s * 64 + pg8::lane_now(); asm volatile("" : "+v"(tid_o)); const int tid = tid_o, lane = tid & 63, wave = __builtin_amdgcn_readfirstlane(tid >> 6), gw = bx * NWAVES + wave, NGW = G * NWAVES; (void)lane; (void)gw; (void)NGW; (void)wave
struct Args { const float* in[23]; float* out; unsigned char* ws; };
__global__ void __launch_bounds__(NWAVES * 64, 2) fwd_kernel(Args args) {
    extern __shared__ __attribute__((aligned(16))) unsigned char lds_raw[];
    LAS unsigned char* lds = (LAS unsigned char*)lds_raw;
    const int G = gridDim.x, bx = blockIdx.x;
    int wave_s = __builtin_amdgcn_readfirstlane((int)(threadIdx.x >> 6)); asm volatile("" : "+s"(wave_s));
    gu32* ctl = (gu32*)(args.ws + WS_CTL);
    for (int u = threadIdx.x; u < (LDS_BYTES - LDSCTL_OFF) / 4; u += NWAVES * 64) ((LAS unsigned*)(lds + LDSCTL_OFF))[u] = 0u;
    __syncthreads();
    volatile LAS unsigned* MISC = (volatile LAS unsigned*)(lds + MISC_OFF);
    XcdBarrier bar = xcd_barrier_post((unsigned*)(ctl + CW_BAR), MISC + 8);
#define GRID_BAR() do { XcdBarrier b_ = bar; asm volatile("" : "+s"(b_.x), "+s"(b_.bar)); xcd_barrier(b_); if (PROBE_BAR2) xcd_barrier(b_); } while (0)
    const volatile __attribute__((address_space(4))) unsigned long long* kargs = (const volatile __attribute__((address_space(4))) unsigned long long*)__builtin_amdgcn_kernarg_segment_ptr();
#define INP(i) ((const float*)(const GAS float*)kargs[(i)])
#define OUTP ((float*)(GAS float*)kargs[23])
#define WSB ((unsigned char*)(GAS unsigned char*)kargs[24])
#define in_x INP(0)
#define in_c INP(1)
#define g_pre_mix INP(2)
#define g_post_mix INP(3)
#define g_pre_ffn INP(4)
#define g_post_ffn INP(5)
#define w_ada INP(6)
#define b_ada INP(7)
#define w_in INP(8)
#define b_in INP(9)
#define sgu_norm_g INP(10)
#define sgu_w INP(11)
#define sgu_b INP(12)
#define pool_w INP(13)
#define pool_scale INP(14)
#define w_sgu_out INP(15)
#define w_moba_out INP(16)
#define w_pool_out INP(17)
#define w_out INP(18)
#define w_up INP(19)
#define w_conv INP(20)
#define b_conv INP(21)
#define w_down INP(22)
#define out OUTP
#define MOD ((float*)(WSB + WS_MOD))
#define MODP ((float*)(WSB + WS_MODP))
#define KMEAN ((float*)(WSB + WS_KMEAN))
#define H ((bf16*)(WSB + WS_H))
#define T6 ((bf16*)(WSB + WS_T6))
#define G3 ((unsigned char*)(WSB + WS_G3))
#define H8 ((unsigned char*)(WSB + WS_H8))
#define Yb ((bf16*)(WSB + WS_Y))
#define XR ((bf16*)(WSB + WS_XR))
#define A2 ((bf16*)(WSB + WS_A2))
#define Ut T6
#define Qt (T6 + (size_t)1 * M * BW)
#define YP (T6 + (size_t)2 * M * BW)
#define Vt (T6 + (size_t)3 * M * BW)
#define Kt (T6 + (size_t)4 * M * BW)
#define VAt (T6 + (size_t)5 * M * BW)
#define ZPt (T6 + (size_t)6 * M * BW)

    for (int rep0_ = 0; rep0_ < NREP_P0; ++rep0_) {
    {   PHASE_IDS();
        LAS float* cond = (LAS float*)(lds + 69632);
        for (int i = tid; i < BATCH * DM; i += NWAVES * 64) { const float c = in_c[i]; cond[i] = c * sigmoid_f(c); }
        __syncthreads();
        for (int w0 = gw; w0 < 1536 + 64 * NWAVES; w0 += NGW) { const int wt = w0 - 64 * NWAVES; if (wt < 0) continue;
            const int ks = wt / 96, cb = wt % 96, l = cb / 48, n0 = (cb % 48) * 256 + 4 * lane;
            const float* wp = w_ada + ((size_t)l * DM + ks * 128) * 12288 + n0;
            f32x4 a0 = {0.f, 0.f, 0.f, 0.f}, a1 = a0, a2 = a0, a3 = a0;
#pragma unroll 8
            for (int k = 0; k < 128; ++k) { const f32x4 w = __builtin_nontemporal_load((const f32x4*)(wp + (size_t)k * 12288)); const int kk = ks * 128 + k;
                a0 += cond[kk] * w; a1 += cond[DM + kk] * w; a2 += cond[2 * DM + kk] * w; a3 += cond[3 * DM + kk] * w; }
            float* pp = MODP + (size_t)(ks * 8 + l * 4) * 12288 + n0;
            *(f32x4*)(pp) = a0; *(f32x4*)(pp + 12288) = a1; *(f32x4*)(pp + 2 * 12288) = a2; *(f32x4*)(pp + 3 * 12288) = a3;
        }
        LAS float* scr = (LAS float*)(lds + wave * 8448);
#define CONVERT_ITEMS(l, WB, LO, HI, SLOT, NSLOT) \
        for (int it = (LO) + (SLOT) * NWAVES + wave; it < (HI); it += (NSLOT) * NWAVES) { int r = it; \
            bf16* Wc = (bf16*)(WB); \
            if (r < 9216) { transpose_item(w_in + (size_t)(l) * DM * INW, DM, INW, (bf16*)((unsigned char*)Wc + WO_IN), false, scr, r, lane, 0, (unsigned char*)Wc + WO_IN, nullptr, (const unsigned*)(WSB + WS_CMAXG) + (size_t)(l) * 9216); continue; } r -= 9216; \
            if (r < 512) { transpose_item(w_sgu_out + (size_t)(l) * BW * DM, BW, DM, (bf16*)((unsigned char*)Wc + WO_SGU), false, scr, r, lane); continue; } r -= 512; \
            if (r < 512) { transpose_item(w_moba_out + (size_t)(l) * BW * DM, BW, DM, (bf16*)((unsigned char*)Wc + WO_MOBA), false, scr, r, lane); continue; } r -= 512; \
            if (r < 512) { transpose_item(w_pool_out + (size_t)(l) * BW * DM, BW, DM, (bf16*)((unsigned char*)Wc + WO_POOL), false, scr, r, lane); continue; } r -= 512; \
            if (r < 2048) { transpose_item(w_out + (size_t)(l) * DM * DM, DM, DM, (bf16*)((unsigned char*)Wc + WO_OUT), false, scr, r, lane); continue; } r -= 2048; \
            if (r < 11264) { transpose_item(w_up + (size_t)(l) * DM * NUP, DM, NUP, (bf16*)((unsigned char*)Wc + WO_UP), true, scr, r, lane, 1 << 30, nullptr, (const unsigned*)(WSB + WS_CMAX) + (size_t)(l) * NUP); continue; } r -= 11264; \
            transpose_item(w_down + (size_t)(l) * DFF * DM, DFF, DM, (bf16*)((unsigned char*)Wc + WO_DOWN), false, scr, r, lane); \
        }
#define QUANT_STRIPS(l, WB, S0, S1, SLOT, NSLOT) { __syncthreads(); \
          for (int st = (S0) + (SLOT); st < (S1); st += (NSLOT)) { \
              if (st < 288) strip_quant(w_in + (size_t)(l) * DM * INW, INW, (WB) + WO_IN, false, (unsigned*)(WSB + WS_CMAXG) + (size_t)(l) * 9216, lds, st, lane, wave); \
              else strip_quant(w_up + (size_t)(l) * DM * NUP, NUP, (WB) + WO_UP, true, (unsigned*)(WSB + WS_CMAX) + (size_t)(l) * NUP, lds, st - 288, lane, wave); } }
        QUANT_STRIPS(0, WSB + WS_W0, 0, 288, bx, G)
        { bf16* SW = (bf16*)(WSB + WS_SGUW); bf16* PW = (bf16*)(WSB + WS_POOLWT); const float* sw = sgu_w; const float* pw = pool_w;
          for (int i = bx * NWAVES * 64 + tid; i < 2 * 8 * 16384; i += G * NWAVES * 64) { const int t = (i >> 7) & 127, sI = i & 127; SW[i] = (bf16)((sI <= t) ? f2bf(sw[i]) : 0u); }
          for (int i = bx * NWAVES * 64 + tid; i < 2 * 4 * 16384; i += G * NWAVES * 64) { const int lg = i >> 14, d = (i >> 7) & 127, cI = i & 127; PW[i] = (bf16)f2bf(pw[(size_t)lg * 16384 + cI * 128 + d]); } }
        GRID_BAR();
    }
    {   PHASE_IDS();
        for (int v = bx * NWAVES * 64 + tid; v < 2 * BATCH * 12288; v += G * NWAVES * 64) {
            const int lb = v / 12288, n = v % 12288; float s = b_ada[(size_t)(lb >> 2) * 12288 + n];
            for (int ks = 0; ks < 16; ++ks) s += MODP[(size_t)(ks * 8 + lb) * 12288 + n];
            MOD[v] = s; }
        GRID_BAR();
    }
    { PHASE_IDS(); thin_phase<0, false, false, false, true>(lds, tid, lane, wave, bx, G, in_x, nullptr, nullptr, (bf16*)H8, nullptr, (float*)(WSB + WS_RS1), nullptr, nullptr, MOD + 2048, MOD + 0, g_pre_mix); }
    GRID_BAR();
    }

    for (int l = 0; l < DEPTH; ++l) {
#define Wl (l == 0 ? WSB + WS_W0 : (unsigned char*)OUTP)
#define modl (MOD + (size_t)l * BATCH * 12288)
        for (int rep_ = 0; rep_ < NREP_GEMM; ++rep_)
        { { pg8::Gemm g{(const bf16*)H8, (const bf16*)(Wl + WO_IN), M, 3072, DM / 2}; pg8::StaticOrder S; S.init(M, 3072, G, bx, WGM_WIDE);
            EpiInProj E{b_in + (size_t)l * INW, T6, KMEAN + (size_t)l * 65536, (unsigned*)(WSB + WS_KABS) + (size_t)l * 65536, (const float*)(WSB + WS_RS1), (const unsigned*)(WSB + WS_CMAXG) + (size_t)l * 9216};
            pg8::gemm_phase<EpiInProj, pg8::StaticOrder, GP_ALIGN, GP_SP2, false, true>(lds, g, S, E, wave_s); }
          GRID_BAR(); }
        { PHASE_IDS();
          for (int repa_ = NREP_ATTN - 1; repa_ >= 0; --repa_)
          { const attn_body::AttnTensors AT{(const attn_body::bf16*)Qt, (const attn_body::bf16*)Kt, (const attn_body::bf16*)VAt, KMEAN + (size_t)l * 65536, (const float*)(WSB + WS_KABS) + (size_t)l * 65536, repa_ ? (attn_body::bf16*)H : (attn_body::bf16*)Qt};
            const attn_body::QueueOrder AS{(unsigned*)(WSB + WS_CTL) + CW_ATTNQ + 64 * l + 16 * repa_, (volatile unsigned*)((char*)lds_raw + MISC_OFF + 64), wave_s};
            {
              const unsigned nent = (l == 0) ? 1536u : 1024u;
              for (;;) {
                  if (AS.wv == 0 && pg8::lane_now() == 0) *AS.slot = __hip_atomic_fetch_add(AS.ctr, 1u, __ATOMIC_RELAXED, __HIP_MEMORY_SCOPE_AGENT);
                  asm volatile("s_waitcnt vmcnt(0) lgkmcnt(0)\n\ts_barrier" ::: "memory");
                  const unsigned idx = (unsigned)__builtin_amdgcn_readfirstlane((int)*AS.slot);
                  if (idx >= nent) break;
                  unsigned a_ = idx; int bun = -1;
                  if (l == 0) { const unsigned grp = idx / 3u, rr = idx - 3u * grp; if (rr < 2u) a_ = 2u * grp + rr; else bun = (int)grp; }
                  if (bun < 0) { const int qb_ = attn_body::NQB - 1 - (int)(a_ >> 5), bh_ = (int)(a_ & 31u);
                      attn_body::attn_unit<8>(bh_ / attn_body::NHEAD, bh_ % attn_body::NHEAD, qb_, AT.Q, AT.K, AT.V, AT.KM, AT.KA, AT.O, (char*)lds_raw, wave_s); }
                  else { const int lane = pg8::lane_now(); LAS float* scr = (LAS float*)(lds + wave * 8448);
                      if (bun < 256) { const int c_ = bun; CONVERT_ITEMS(0, WSB + WS_W0, 9216, 12800, c_, 256) CONVERT_ITEMS(0, WSB + WS_W0, 24064, 29696, c_, 256) QUANT_STRIPS(0, WSB + WS_W0, 288, 640, c_, 256) }
                      else { const int c_ = bun - 256; CONVERT_ITEMS(1, (unsigned char*)OUTP, 9216, 12800, c_, 256) CONVERT_ITEMS(1, (unsigned char*)OUTP, 24064, 29696, c_, 256) QUANT_STRIPS(1, (unsigned char*)OUTP, 0, 640, c_, 256) }
                      __syncthreads(); }
              } } }
          __syncthreads();
          for (int repm_ = NREP_MIX - 1; repm_ >= 0; --repm_) {
          for (int chunk = bx; chunk < M / 128; chunk += G) sgu_mfma_chunk(lds, chunk, Vt, Ut, repm_ ? H : Ut, sgu_norm_g + (size_t)l * BW, (const bf16*)(WSB + WS_SGUW) + (size_t)l * 8 * 16384, sgu_b + (size_t)l * 8 * 128, lane, wave);
          for (int tile = bx; tile < M / 64; tile += G) pool_mfma_tile(lds, tile, ZPt, YP, (const bf16*)(WSB + WS_POOLWT) + (size_t)l * 4 * 16384, pool_scale + (size_t)l * BW, tid, lane, wave);
          }
          GRID_BAR(); }
        for (int rep_ = 0; rep_ < NREP_GEMM; ++rep_)
        {
          { pg8::Gemm g{(const bf16*)H8, (const bf16*)(Wl + WO_IN + WO_IN8), M, 6144, DM / 2}; pg8::StaticOrder S; S.init(M, 6144, G, bx, WGM_WIDE);
            EpiGate8 E{b_in + (size_t)l * INW + 3072, G3, (const float*)(WSB + WS_RS1), (const unsigned*)(WSB + WS_CMAXG) + (size_t)l * 9216 + 3072};
            pg8::gemm_phase<EpiGate8, pg8::StaticOrder, GP_ALIGN, GP_SP2, false, true>(lds, g, S, E, wave_s); }
          GRID_BAR(); }
        for (int rep_ = 0; rep_ < NREP_GEMM; ++rep_)
        { pg8::Gemm g{Ut, (const bf16*)(Wl + WO_SGU), M, DM, BW, 3, (size_t)M * BW * 2, (size_t)2 * MiB}; pg8::StaticOrder S; S.init(M, DM, G, bx, WGM_NARROW);
          EpiBranch E{G3, H};
          pg8::gemm_phase<EpiBranch, pg8::StaticOrder, GP_ALIGN, GP_SP2>(lds, g, S, E, wave_s);
          GRID_BAR(); }
        for (int rep_ = 0; rep_ < NREP_GEMM; ++rep_)
        { pg8::Gemm g{H, (const bf16*)(Wl + WO_OUT), M, DM, DM}; pg8::StaticOrder S; S.init(M, DM, G, bx, WGM_NARROW);
          EpiPlain E{Yb, DM};
          pg8::gemm_phase<EpiPlain, pg8::StaticOrder, GP_ALIGN, GP_SP2>(lds, g, S, E, wave_s);
          GRID_BAR(); }
        for (int rept_ = 0; rept_ < (l == 0 ? NREP_THIN : 1); ++rept_)
        { PHASE_IDS(); if (l == 0) thin_phase<1, false, true, false, true>(lds, tid, lane, wave, bx, G, in_x, Yb, XR, H, nullptr, (float*)(WSB + WS_RS), modl + 4096, g_post_mix + (size_t)l * DM, modl + 8192, modl + 6144, g_pre_ffn + (size_t)l * DM);
          else thin_phase<1, true, true, false, true>(lds, tid, lane, wave, bx, G, XR, Yb, XR, H, nullptr, (float*)(WSB + WS_RS), modl + 4096, g_post_mix + (size_t)l * DM, modl + 8192, modl + 6144, g_pre_ffn + (size_t)l * DM); }
        GRID_BAR();
        for (int rep_ = 0; rep_ < NREP_GEMM; ++rep_)
        { pg8::Gemm g{H, (const bf16*)(Wl + WO_UP), M, NUP, DM / 2}; pg8::StaticOrder S; S.init(M, NUP, G, bx, WGM_WIDE);
          EpiUpConv E{A2, w_conv + (size_t)l * 3 * NUP, b_conv + (size_t)l * NUP, (float*)(WSB + WS_TOPZ), (float*)(WSB + WS_BOTZ), (LAS float*)(lds + XB_OFF), (const float*)(WSB + WS_RS), (const unsigned*)(WSB + WS_CMAX) + (size_t)l * NUP};
          pg8::gemm_phase<EpiUpConv, pg8::StaticOrder, true, GP_SP2, false, true>(lds, g, S, E, wave_s);
          GRID_BAR(); }
        { PHASE_IDS(); const float* wc = w_conv + (size_t)l * 3 * NUP; const float* bc = b_conv + (size_t)l * NUP;
          const float* TZ = (const float*)(WSB + WS_TOPZ); const float* BZ = (const float*)(WSB + WS_BOTZ); bf16* a2 = A2;
          for (int it = bx * NWAVES * 64 + tid; it < (M / 256) * DFF; it += G * NWAVES * 64) { const int pm = it / DFF, n = it % DFF; if ((pm & 31) == 0) continue;
              const int cg = (n >> 7) * 256 + (n & 127);
              float res[2];
              float zc[2][2];
#pragma unroll
              for (int k = 0; k < 2; ++k) { const int c = cg + 128 * k, pc = n + DFF * k;
                  const float t0 = TZ[((size_t)pm * 2 + 0) * NUP + c], t1 = TZ[((size_t)pm * 2 + 1) * NUP + c], b0 = BZ[((size_t)(pm - 1) * 2 + 0) * NUP + c], b1 = BZ[((size_t)(pm - 1) * 2 + 1) * NUP + c];
                  const unsigned cmb = ((const unsigned*)(WSB + WS_CMAX))[(size_t)l * NUP + pc]; const float csc = __builtin_bit_cast(float, cmb) * (1.0f / 127.0f);
                  const float w0 = wc[pc] * csc, w1 = wc[NUP + pc] * csc, w2 = wc[2 * NUP + pc] * csc, bb = bc[pc];
                  zc[k][0] = w2 * t0 + w1 * b1 + w0 * b0 + bb; zc[k][1] = w2 * t1 + w1 * t0 + w0 * b1 + bb; }
              res[0] = gelu_tanh(zc[0][0]) * zc[1][0]; res[1] = gelu_tanh(zc[0][1]) * zc[1][1];
              a2[(size_t)(pm * 256 + 0) * DFF + n] = (bf16)f2bf(res[0]); a2[(size_t)(pm * 256 + 1) * DFF + n] = (bf16)f2bf(res[1]); }
          GRID_BAR(); }
        for (int rep_ = 0; rep_ < NREP_GEMM; ++rep_)
        { pg8::Gemm g{A2, (const bf16*)(Wl + WO_DOWN), M, DM, DFF}; pg8::StaticOrder S; S.init(M, DM, G, bx, WGM_NARROW);
          EpiPlain E{Yb, DM};
          pg8::gemm_phase<EpiPlain, pg8::StaticOrder, GP_ALIGN, GP_SP2>(lds, g, S, E, wave_s);
          GRID_BAR(); }
        if (l == 0) { PHASE_IDS(); thin_phase<1, true, true, false, true>(lds, tid, lane, wave, bx, G, XR, Yb, XR, (bf16*)H8, nullptr, (float*)(WSB + WS_RS1), modl + 10240, g_post_ffn, MOD + (size_t)BATCH * 12288 + 2048, MOD + (size_t)BATCH * 12288, g_pre_mix + DM);
            GRID_BAR(); }
        else { PHASE_IDS(); thin_phase<2, true, false>(lds, tid, lane, wave, bx, G, XR, Yb, out, nullptr, nullptr, nullptr, modl + 10240, g_post_ffn + (size_t)l * DM, nullptr, nullptr, nullptr); }
    }
#undef GRID_BAR
}
#undef INP
#undef OUTP
#undef WSB
#undef in_x
#undef in_c
#undef g_pre_mix
#undef g_post_mix
#undef g_pre_ffn
#undef g_post_ffn
#undef w_ada
#undef b_ada
#undef w_in
#undef b_in
#undef sgu_norm_g
#undef sgu_w
#undef sgu_b
#undef pool_w
#undef pool_scale
#undef w_sgu_out
#undef w_moba_out
#undef w_pool_out
#undef w_out
#undef w_up
#undef w_conv
#undef b_conv
#undef w_down
#undef out
#undef MOD
#undef MODP
#undef KMEAN
#undef H
#undef T6
#undef G3
#undef H8
#undef YP
#undef Yb
#undef A2
#undef Ut
#undef Vt
#undef Qt
#undef Kt
#undef VAt
#undef ZPt
#undef Wl
#undef XR
#undef CONVERT_ITEMS
#undef QUANT_STRIPS
#undef modl

extern "C" void kernel_launch(void* const* d_in, const int* in_sizes, int n_in, void* d_out, int out_size, void* d_ws, size_t ws_size, hipStream_t stream) {
    static int grid = 0;
    if (grid == 0) {
        if (n_in != 23 || in_sizes[0] != M * DM || out_size != M * DM || ws_size < WS_END) { fprintf(stderr, "kernel_launch: unexpected shapes (n_in %d, in0 %d, out %d, ws %zu); nothing launched\n", n_in, n_in > 0 ? in_sizes[0] : -1, out_size, ws_size); grid = -1; return; }
        int dev = 0, cus = 0;
        if (hipGetDevice(&dev) != hipSuccess || hipDeviceGetAttribute(&cus, hipDeviceAttributeMultiprocessorCount, dev) != hipSuccess) { grid = -1; return; }
        if (hipFuncSetAttribute((const void*)fwd_kernel, hipFuncAttributeMaxDynamicSharedMemorySize, LDS_BYTES) != hipSuccess) { fprintf(stderr, "kernel_launch: hipFuncSetAttribute failed\n"); grid = -1; return; }
        int per_cu = 0;
        if (hipOccupancyMaxActiveBlocksPerMultiprocessor(&per_cu, (const void*)fwd_kernel, NWAVES * 64, LDS_BYTES) != hipSuccess || per_cu < 1) fprintf(stderr, "kernel_launch: occupancy query says %d\n", per_cu);
        (void)hipGetLastError();
        grid = cus;
    }
    if (grid < 0) return;
    if (hipMemsetAsync((char*)d_ws + WS_CTL, 0, CTL_ZERO_BYTES, stream) != hipSuccess) return;
    Args a{};
    for (int i = 0; i < 23; ++i) a.in[i] = (const float*)d_in[i];
    a.out = (float*)d_out; a.ws = (unsigned char*)d_ws;
    hipLaunchKernelGGL(fwd_kernel, dim3(grid), dim3(NWAVES * 64), LDS_BYTES, stream, a);
}
```

```cpp
#include <hip/hip_runtime.h>
#include <cstdio>
#include <cstdint>
namespace pg8 {
#define PG8_LAS __attribute__((address_space(3)))
typedef unsigned short bf16_t;
typedef short bf16x8 __attribute__((ext_vector_type(8)));
typedef float f32x4 __attribute__((ext_vector_type(4)));
typedef unsigned u32x4 __attribute__((ext_vector_type(4)));
__device__ __forceinline__ int lane_now() { int l; asm volatile("v_mbcnt_lo_u32_b32 %0, -1, 0\n\tv_mbcnt_hi_u32_b32 %0, -1, %0" : "=v"(l)); return l; }
typedef int i32x4 __attribute__((ext_vector_type(4)));
typedef int i32x8 __attribute__((ext_vector_type(8)));
constexpr int BM = 256, BK = 64, HALF = 128, HTB = HALF * BK * 2  , STAGE_BYTES = 8 * HTB, NXCD = 8, WGM = 8;

__host__ __device__ __forceinline__ int lds_byte(int r, int c) { const int st = (r >> 4) * 2 + (c >> 5), rr = r & 15, cc = c & 31, ob = rr * 64 + cc * 2; return st * 1024 + (ob ^ (((ob >> 9) & 1) << 5)); }
__host__ __device__ __forceinline__ void stage_rc(int b, int& R, int& C) { const int st = b / 1024, sb = b % 1024, swz = sb ^ (((sb >> 9) & 1) << 5); R = (st >> 1) * 16 + swz / 64; C = (st & 1) * 32 + (swz % 64) / 2; }
__host__ __device__ __forceinline__ int perm32(int rho) { const int n = rho >> 4, i = rho & 15; return 8 * (i >> 2) + 4 * n + (i & 3); }

struct Unit { int pm, pn; };
struct Gemm { const bf16_t* A; const bf16_t* Bt; int M, N, K; int nseg; size_t segA, segB; };

struct StaticOrder {
    int nM, nN, nwg, G, c, wgm;
    __host__ __device__ void init(int M, int N, int G_, int c_, int wgm_ = WGM) { nM = M / BM; nN = N / BM; nwg = nM * nN; G = G_; c = c_; wgm = wgm_; }
    __host__ __device__ bool next(int i, Unit& u) const {
        const long L = (long)i * G + c; if (L >= nwg) return false;
        int wgid = (int)L; { const int q = nwg / NXCD, r = nwg % NXCD, xcd = wgid % NXCD, off = wgid / NXCD; wgid = (xcd < r ? xcd * (q + 1) : r * (q + 1) + (xcd - r) * q) + off; }
        const int nig = wgm * nN, gid = wgid / nig, fm = gid * wgm, gsz = (nM - fm) < wgm ? (nM - fm) : wgm;
        u.pm = fm + ((wgid % nig) % gsz); u.pn = (wgid % nig) / gsz; return true;
    }
    __device__ __forceinline__ void a_ready(const Unit&) const {}
    __device__ __forceinline__ void done(const Unit&) const {}
};

__device__ __forceinline__ unsigned cvt_pk_bf16(float lo, float hi) { unsigned r; asm volatile("v_cvt_pk_bf16_f32 %0, %1, %2" : "=v"(r) : "v"(lo), "v"(hi)); return r; }
typedef float f32x2 __attribute__((ext_vector_type(2)));
template <class Epi, class Sched, bool ALIGN_EPI = false, bool SP2 = false, bool FP8 = false, bool I8 = false>
__device__ __forceinline__ void gemm_phase(PG8_LAS unsigned char* lds, const Gemm g, const Sched& S, const Epi& E, int wave_s) {
    int tid_l = wave_s * 64 + lane_now(); asm volatile("" : "+v"(tid_l));
    const int tid = tid_l, wid = __builtin_amdgcn_readfirstlane(tid >> 6), lane = tid & 63, wr = wid >> 2, wc = wid & 3, fr = lane & 15, fq = lane >> 4;
    const int K = g.K, nt = (K / BK) * (Epi::SEGMENTED ? g.nseg : 1);
    unsigned voffA[2], voffB[2];
#pragma unroll
    for (int i = 0; i < 2; ++i) { int R, C; stage_rc(tid * 16 + i * 8192, R, C); const int Rb = Epi::PERM ? ((R & ~31) + perm32(R & 31)) : R;
        voffA[i] = (unsigned)(R * K + C) * 2u; voffB[i] = (unsigned)(Rb * K + C) * 2u; }
    const size_t kstep = (size_t)(BK * 2);
    const size_t hstep = (size_t)HALF * K * 2;
    const size_t tstep = 2 * hstep;
    const unsigned ldsw = (unsigned)wid * 1024u;
    const int aoff = lds_byte(wr * 64 + fr, fq * 8), boff = lds_byte(wc * 32 + fr, fq * 8);
#define PG8_SA(b, h) (((b) * 2 + (h)) * HTB)
#define PG8_SB(b, h) ((4 + (b) * 2 + (h)) * HTB)
#define PG8_STAGE(bufoff, gbase, voff) do { _Pragma("unroll") for (int _i = 0; _i < 2; ++_i) { unsigned vo_ = (voff)[_i]; if constexpr (FP8 || I8) asm volatile("" : "+v"(vo_));     \
        __builtin_amdgcn_global_load_lds((const unsigned*)((const char*)(gbase) + vo_), (PG8_LAS unsigned*)(lds + (bufoff) + ldsw + _i * 8192), 16, 0, 0); } } while (0)
#define PG8_LDA(dst, b, h) do { _Pragma("unroll") for (int m = 0; m < 4; ++m) _Pragma("unroll") for (int k = 0; k < 2; ++k) dst[m][k] = *(const PG8_LAS bf16x8*)(lds + PG8_SA(b, h) + aoff + m * 2048 + k * 1024); } while (0)
#define PG8_LDB(dst, b, h) do { _Pragma("unroll") for (int n = 0; n < 2; ++n) _Pragma("unroll") for (int k = 0; k < 2; ++k) dst[n][k] = *(const PG8_LAS bf16x8*)(lds + PG8_SB(b, h) + boff + n * 2048 + k * 1024); } while (0)
#define PG8_CAT8(v) __builtin_shufflevector(__builtin_bit_cast(i32x4, (v)[0]), __builtin_bit_cast(i32x4, (v)[1]), 0, 1, 2, 3, 4, 5, 6, 7)
#define PG8_MMA(ai, bj, At, Bt) do { __builtin_amdgcn_s_setprio(1); _Pragma("unroll") for (int m = 0; m < 4; ++m) _Pragma("unroll") for (int n = 0; n < 2; ++n) { \
        if constexpr (FP8) acc[ai][bj][m][n] = __builtin_amdgcn_mfma_scale_f32_16x16x128_f8f6f4(PG8_CAT8(Bt[n]), PG8_CAT8(At[m]), acc[ai][bj][m][n], 0, 0, 0, 0, 0, 0);     \
        else if constexpr (I8) { _Pragma("unroll") for (int k = 0; k < 2; ++k) acc[ai][bj][m][n] = __builtin_bit_cast(f32x4, __builtin_amdgcn_mfma_i32_16x16x64_i8(__builtin_bit_cast(i32x4, Bt[n][k]), __builtin_bit_cast(i32x4, At[m][k]), __builtin_bit_cast(i32x4, acc[ai][bj][m][n]), 0, 0, 0)); } \
        else { _Pragma("unroll") for (int k = 0; k < 2; ++k) acc[ai][bj][m][n] = __builtin_amdgcn_mfma_f32_16x16x32_bf16(Bt[n][k], At[m][k], acc[ai][bj][m][n], 0, 0, 0); } } __builtin_amdgcn_s_setprio(0); } while (0)
#define PG8_WAIT_V(n) asm volatile("s_waitcnt vmcnt(" #n ")" ::: "memory")
#define PG8_WAIT_L(n) asm volatile("s_waitcnt lgkmcnt(" #n ")" ::: "memory")
#define PG8_BAR __builtin_amdgcn_s_barrier()
#define PG8_SCHED __builtin_amdgcn_sched_barrier(0)
    Unit cur, nxt; int ui = 0;
    if (!S.next(0, cur)) return;
    f32x4 acc[2][2][4][2];
#pragma unroll
    for (int a = 0; a < 2; ++a)
#pragma unroll
        for (int b = 0; b < 2; ++b)
#pragma unroll
            for (int m = 0; m < 4; ++m)
#pragma unroll
                for (int n = 0; n < 2; ++n) acc[a][b][m][n] = (f32x4){0.f, 0.f, 0.f, 0.f};
    bf16x8 At[4][2], B0[2][2], B1[2][2];
    const char* cA = (const char*)g.A + (size_t)cur.pm * tstep; const char* cB = (const char*)g.Bt + (size_t)cur.pn * tstep;
    S.a_ready(cur);
    if constexpr (SP2) {
        PG8_STAGE(PG8_SB(0, 0), cB, voffB); PG8_STAGE(PG8_SB(0, 1), cB + hstep, voffB); PG8_STAGE(PG8_SA(0, 0), cA, voffA); PG8_STAGE(PG8_SA(0, 1), cA + hstep, voffA);
        if (wr == 1) PG8_BAR;
        PG8_WAIT_V(2); PG8_BAR;
        PG8_STAGE(PG8_SB(1, 0), cB + kstep, voffB); PG8_STAGE(PG8_SA(1, 0), cA + kstep, voffA); PG8_STAGE(PG8_SB(1, 1), cB + hstep + kstep, voffB);
        PG8_WAIT_V(6); PG8_BAR;
    } else {
        PG8_STAGE(PG8_SB(0, 0), cB, voffB); PG8_STAGE(PG8_SA(0, 0), cA, voffA); PG8_STAGE(PG8_SB(0, 1), cB + hstep, voffB); PG8_STAGE(PG8_SA(0, 1), cA + hstep, voffA);
        if (wr == 1) PG8_BAR;
        PG8_WAIT_V(4); PG8_BAR;
        PG8_STAGE(PG8_SB(1, 0), cB + kstep, voffB); PG8_STAGE(PG8_SA(1, 0), cA + kstep, voffA); PG8_STAGE(PG8_SB(1, 1), cB + hstep + kstep, voffB);
        PG8_WAIT_V(6); PG8_BAR;
    }
    for (;;) {
        const bool has_next = S.next(ui + 1, nxt);
        const char* nA = has_next ? (const char*)g.A + (size_t)nxt.pm * tstep : cA; const char* nB = has_next ? (const char*)g.Bt + (size_t)nxt.pn * tstep : cB;
        for (int t = 0; t < nt; t += 2) {
            const bool last = (t == nt - 2);
            const char* a1; const char* a2; const char* b2;
            if constexpr (Epi::SEGMENTED) {
                constexpr int SH = Epi::SEG_SHIFT, SM = (1 << SH) - 1;
                a1 = cA + (size_t)((t + 1) >> SH) * g.segA + (size_t)((t + 1) & SM) * kstep;
                a2 = last ? nA : cA + (size_t)((t + 2) >> SH) * g.segA + (size_t)((t + 2) & SM) * kstep; b2 = last ? nB : cB + (size_t)((t + 2) >> SH) * g.segB + (size_t)((t + 2) & SM) * kstep;
                if (t != 0 && (t & SM) == 0) E.seg_hook(acc, cur, t >> SH, wr, wc, fr, fq);
            } else {
                a1 = cA + (size_t)(t + 1) * kstep;
                a2 = last ? nA : cA + (size_t)(t + 2) * kstep; b2 = last ? nB : cB + (size_t)(t + 2) * kstep;
            }
            const char* a3 = a2 + kstep; const char* b3 = b2 + kstep;
            if (last && has_next) S.a_ready(nxt);
            if constexpr (SP2) {
            PG8_LDB(B0, 0, 0); PG8_LDB(B1, 0, 1); PG8_SCHED; PG8_LDA(At, 0, 0); PG8_STAGE(PG8_SA(1, 1), a1 + hstep, voffA);
            PG8_WAIT_V(8); PG8_WAIT_L(0); PG8_BAR; PG8_MMA(0, 0, At, B0); PG8_MMA(0, 1, At, B1); PG8_BAR; PG8_SCHED;
            PG8_LDA(At, 0, 1); PG8_STAGE(PG8_SB(0, 0), b2, voffB); PG8_STAGE(PG8_SB(0, 1), b2 + hstep, voffB); PG8_STAGE(PG8_SA(0, 0), a2, voffA);
            PG8_WAIT_V(8); PG8_WAIT_L(0); PG8_BAR; PG8_MMA(1, 0, At, B0); PG8_MMA(1, 1, At, B1); PG8_BAR; PG8_SCHED;
            PG8_LDB(B0, 1, 0); PG8_LDB(B1, 1, 1); PG8_SCHED; PG8_LDA(At, 1, 0); PG8_STAGE(PG8_SA(0, 1), a2 + hstep, voffA);
            PG8_WAIT_V(8); PG8_WAIT_L(0); PG8_BAR; PG8_MMA(0, 0, At, B0); PG8_MMA(0, 1, At, B1); PG8_BAR; PG8_SCHED;
            PG8_LDA(At, 1, 1); PG8_STAGE(PG8_SB(1, 0), b3, voffB); PG8_STAGE(PG8_SB(1, 1), b3 + hstep, voffB); PG8_STAGE(PG8_SA(1, 0), a3, voffA);
            PG8_WAIT_V(8); PG8_WAIT_L(0); PG8_BAR; PG8_MMA(1, 0, At, B0); PG8_MMA(1, 1, At, B1); PG8_BAR; PG8_SCHED;
            } else {
            PG8_LDB(B0, 0, 0); PG8_SCHED; PG8_LDA(At, 0, 0); PG8_STAGE(PG8_SA(1, 1), a1 + hstep, voffA);
            PG8_WAIT_L(8); PG8_BAR; PG8_WAIT_L(0); PG8_MMA(0, 0, At, B0); PG8_BAR; PG8_SCHED;
            PG8_LDB(B1, 0, 1); PG8_STAGE(PG8_SB(0, 0), b2, voffB);
            PG8_BAR; PG8_WAIT_L(0); PG8_MMA(0, 1, At, B1); PG8_BAR;
            PG8_LDA(At, 0, 1); PG8_STAGE(PG8_SA(0, 0), a2, voffA);
            PG8_BAR; PG8_WAIT_L(0); PG8_MMA(1, 0, At, B0); PG8_BAR; PG8_SCHED;
            PG8_STAGE(PG8_SB(0, 1), b2 + hstep, voffB);
            PG8_WAIT_V(6); PG8_BAR; PG8_MMA(1, 1, At, B1); PG8_BAR;
            PG8_LDB(B0, 1, 0); PG8_SCHED; PG8_LDA(At, 1, 0); PG8_STAGE(PG8_SA(0, 1), a2 + hstep, voffA);
            PG8_WAIT_L(8); PG8_BAR; PG8_WAIT_L(0); PG8_MMA(0, 0, At, B0); PG8_BAR; PG8_SCHED;
            PG8_LDB(B1, 1, 1); PG8_STAGE(PG8_SB(1, 0), b3, voffB);
            PG8_BAR; PG8_WAIT_L(0); PG8_MMA(0, 1, At, B1); PG8_BAR;
            PG8_LDA(At, 1, 1); PG8_STAGE(PG8_SA(1, 0), a3, voffA);
            PG8_BAR; PG8_WAIT_L(0); PG8_MMA(1, 0, At, B0); PG8_BAR; PG8_SCHED;
            PG8_STAGE(PG8_SB(1, 1), b3 + hstep, voffB);
            PG8_WAIT_V(6); PG8_BAR; PG8_MMA(1, 1, At, B1); PG8_BAR;
            }
        }
        if constexpr (ALIGN_EPI) { if (wr == 0) PG8_BAR; }
        if constexpr (!Epi::AFTER_DRAIN) { E(acc, cur, wr, wc, fr, fq); S.done(cur); }
        if (!has_next) break;
#pragma unroll
        for (int a = 0; a < 2; ++a)
#pragma unroll
            for (int b = 0; b < 2; ++b)
#pragma unroll
                for (int m = 0; m < 4; ++m)
#pragma unroll
                    for (int n = 0; n < 2; ++n) acc[a][b][m][n] = (f32x4){0.f, 0.f, 0.f, 0.f};
        cur = nxt; cA = nA; cB = nB; ++ui;
        if constexpr (ALIGN_EPI) { if (wr == 1) PG8_BAR; }
    }
    PG8_WAIT_V(0);
    if constexpr (!ALIGN_EPI) { if (wr == 0) PG8_BAR; }
    PG8_BAR;
    if constexpr (Epi::AFTER_DRAIN) { E.fused(acc, cur, wr, wc, fr, fq, lds, wid, lane); S.done(cur); }
#undef PG8_SA
#undef PG8_SB
#undef PG8_STAGE
#undef PG8_LDA
#undef PG8_LDB
#undef PG8_MMA
#undef PG8_CAT8
#undef PG8_WAIT_V
#undef PG8_WAIT_L
#undef PG8_BAR
#undef PG8_SCHED
}
}
#define GAS __attribute__((address_space(1)))
#define LAS __attribute__((address_space(3)))
typedef unsigned short bf16;
typedef unsigned v4u __attribute__((ext_vector_type(4)));
typedef float f32x4 __attribute__((ext_vector_type(4)));
typedef short bf16x8 __attribute__((ext_vector_type(8)));
typedef GAS unsigned gu32;
typedef GAS unsigned long long gu64;
#define RLX_AGENT __ATOMIC_RELAXED, __HIP_MEMORY_SCOPE_AGENT
#define LDS_WAIT() asm volatile("s_waitcnt lgkmcnt(0)" ::: "memory")
#define VM_WAIT() asm volatile("s_waitcnt vmcnt(0)" ::: "memory")
__device__ __forceinline__ unsigned long long rt() { return __builtin_amdgcn_s_memrealtime(); }
__device__ __forceinline__ unsigned f2bf(float f) { unsigned u = __builtin_bit_cast(unsigned, f); return (u + 0x7fffu + ((u >> 16) & 1u)) >> 16; }
__device__ __forceinline__ unsigned pk2(float lo, float hi) { return f2bf(lo) | (f2bf(hi) << 16); }
#define XB_TMO      128
#define XB_XCNT(j)  (256  + 64 * (j))
#define XB_XSUB(j)  (1280 + 64 * (j))
#define XB_XGEN(j)  (2304 + 64 * (j))
#define XB_TOP      3328
#define XB_TOPGEN   3392
#define XCD_BAR_WORDS 3456
#define XB_SPIN_CAP (1u << 18)

__device__ __forceinline__ unsigned xb_ld(unsigned* p)              { return __hip_atomic_load(p, __ATOMIC_RELAXED, __HIP_MEMORY_SCOPE_AGENT); }
__device__ __forceinline__ unsigned xb_add(unsigned* p, unsigned v) { return __hip_atomic_fetch_add(p, v, __ATOMIC_RELAXED, __HIP_MEMORY_SCOPE_AGENT); }
__device__ __forceinline__ unsigned xb_xcc_id() { return (unsigned)__builtin_amdgcn_s_getreg((3 << 11) | 20) & 0xFu; }
#define XB_SPIN(cond, bar) do { unsigned _sp = 0; while (cond) { __builtin_amdgcn_s_sleep(1); \
    if ((++_sp & 255u) == 0u) { if (xb_ld(&(bar)[XB_TMO])) break; if (_sp > XB_SPIN_CAP) { atomicAdd(&(bar)[XB_TMO], 1u); break; } } } } while (0)

struct XcdBarrier {
    unsigned* bar; unsigned x; int wv;
    volatile LAS unsigned* st;
};

__device__ __forceinline__ XcdBarrier xcd_barrier_post(unsigned* bar, volatile LAS unsigned* st) {
    XcdBarrier b; b.bar = bar; b.x = xb_xcc_id(); b.st = st; b.wv = __builtin_amdgcn_readfirstlane((int)(threadIdx.x >> 6));
    if (threadIdx.x == 0) (void)xb_add(&bar[XB_XCNT(b.x)], 1u);
    return b;
}
__device__ __forceinline__ void xcd_barrier_complete(unsigned* bar, unsigned x, unsigned& nloc, unsigned& nx) {
    const unsigned G = gridDim.x * gridDim.y * gridDim.z;
    unsigned sum, cnt, mine, sp = 0u;
    for (;;) {
        sum = 0u; cnt = 0u; mine = 0u;
#pragma unroll
        for (unsigned j = 0; j < 16; ++j) { const unsigned c = xb_ld(&bar[XB_XCNT(j)]); sum += c; cnt += (c > 0u) ? 1u : 0u; mine = (j == x) ? c : mine; }
        if (sum == G) break;
        __builtin_amdgcn_s_sleep(1);
        if ((++sp & 255u) == 0u) { if (xb_ld(&bar[XB_TMO])) break; if (sp > XB_SPIN_CAP) { atomicAdd(&bar[XB_TMO], 1u); break; } }
    }
    nloc = mine > 0u ? mine : 1u; nx = cnt > 0u ? cnt : 1u;
}

__device__ __forceinline__ void xcd_barrier(const XcdBarrier& b) {
    asm volatile("s_waitcnt vmcnt(0)" ::: "memory");
    __syncthreads();
    if (b.wv == 0 && pg8::lane_now() == 0) {
        unsigned* bar = b.bar;
        __builtin_amdgcn_s_waitcnt(0);
        unsigned nloc = b.st[0], nx = b.st[1];
        if (nloc == 0u) { xcd_barrier_complete(bar, b.x, nloc, nx); b.st[0] = nloc; b.st[1] = nx; }
        const unsigned old = xb_add(&bar[XB_XSUB(b.x)], 1u);
        const unsigned gen = old / nloc;
        if (old + 1u == (gen + 1u) * nloc) {
            __builtin_amdgcn_fence(__ATOMIC_RELEASE, "agent");
            asm volatile("s_waitcnt vmcnt(0)" ::: "memory");
            const unsigned og = xb_add(&bar[XB_TOP], 1u);
            const unsigned tg = og / nx;
            if (og + 1u == (tg + 1u) * nx) xb_add(&bar[XB_TOPGEN], 1u);
            else XB_SPIN(xb_ld(&bar[XB_TOPGEN]) == tg, bar);
            __builtin_amdgcn_fence(__ATOMIC_ACQUIRE, "agent");
            xb_add(&bar[XB_XGEN(b.x)], 1u);
            asm volatile("s_waitcnt vmcnt(0)" ::: "memory");
        } else {
            XB_SPIN(xb_ld(&bar[XB_XGEN(b.x)]) == gen, bar);
            __builtin_amdgcn_fence(__ATOMIC_ACQUIRE, "agent");
            asm volatile("s_waitcnt vmcnt(0)" ::: "memory");
        }
    }
    __syncthreads();
}
constexpr int BATCH = 4, SEQ = 8192, DM = 2048, M = BATCH * SEQ, BW = 512, INW = 9216, DFF = 5632, NUP = 2 * DFF, DEPTH = 2;
constexpr int NWAVES = 8;
constexpr float EPS = 1e-6f;
constexpr float LOG2E = 1.4426950408889634f;
constexpr float QSCALE = 0.125f * LOG2E;

__device__ __forceinline__ float bf_lo(unsigned w) { return __builtin_bit_cast(float, w << 16); }
__device__ __forceinline__ float bf_hi(unsigned w) { return __builtin_bit_cast(float, w & 0xffff0000u); }
__device__ __forceinline__ float bf2f(unsigned short h) { return __builtin_bit_cast(float, ((unsigned)h) << 16); }
constexpr float W8_SCALE = 32.0f, W8_INV = 1.0f / 32.0f;
__device__ __forceinline__ float sigmoid_f(float v) { return __builtin_amdgcn_rcpf(1.0f + __builtin_amdgcn_exp2f(-LOG2E * v)); }
__device__ __forceinline__ unsigned gate_q4(const pg8::f32x4 x) {
    float t[4];
#pragma unroll
    for (int j = 0; j < 4; ++j) t[j] = fmaxf(__builtin_fmaf(sigmoid_f(x[j]), 255.0f, 12582912.0f), 12582913.0f);
    return __builtin_amdgcn_perm(__builtin_bit_cast(unsigned, t[1]), __builtin_bit_cast(unsigned, t[0]), 0x0c0c0400u) | __builtin_amdgcn_perm(__builtin_bit_cast(unsigned, t[3]), __builtin_bit_cast(unsigned, t[2]), 0x04000c0cu);
}
__device__ __forceinline__ unsigned q8x4(float a, float b, float c, float d, float inv) {
    const float t0 = __builtin_fmaf(a, inv, 12582912.0f), t1 = __builtin_fmaf(b, inv, 12582912.0f), t2 = __builtin_fmaf(c, inv, 12582912.0f), t3 = __builtin_fmaf(d, inv, 12582912.0f);
    return __builtin_amdgcn_perm(__builtin_bit_cast(unsigned, t1), __builtin_bit_cast(unsigned, t0), 0x0c0c0400u) | __builtin_amdgcn_perm(__builtin_bit_cast(unsigned, t3), __builtin_bit_cast(unsigned, t2), 0x04000c0cu);
}
__device__ __forceinline__ float ub0(unsigned q) { float r; asm("v_cvt_f32_ubyte0 %0, %1" : "=v"(r) : "v"(q)); return r; }
__device__ __forceinline__ float ub1(unsigned q) { float r; asm("v_cvt_f32_ubyte1 %0, %1" : "=v"(r) : "v"(q)); return r; }
__device__ __forceinline__ float ub2(unsigned q) { float r; asm("v_cvt_f32_ubyte2 %0, %1" : "=v"(r) : "v"(q)); return r; }
__device__ __forceinline__ float ub3(unsigned q) { float r; asm("v_cvt_f32_ubyte3 %0, %1" : "=v"(r) : "v"(q)); return r; }
__device__ __forceinline__ pg8::f32x4 gate_ratio4(unsigned a, unsigned b) { pg8::f32x4 r; r[0] = ub0(a) * __builtin_amdgcn_rcpf(ub0(b)); r[1] = ub1(a) * __builtin_amdgcn_rcpf(ub1(b)); r[2] = ub2(a) * __builtin_amdgcn_rcpf(ub2(b)); r[3] = ub3(a) * __builtin_amdgcn_rcpf(ub3(b)); return r; }
__device__ __forceinline__ pg8::f32x4 gate_val4(unsigned a) { pg8::f32x4 r; r[0] = ub0(a); r[1] = ub1(a); r[2] = ub2(a); r[3] = ub3(a); return r * (1.0f / 255.0f); }
__device__ __forceinline__ float gelu_tanh(float v) {
    const float u = __builtin_fmaf(v * v, -0.10294324f, -2.3022082f);
    return v * __builtin_amdgcn_rcpf(1.0f + __builtin_amdgcn_exp2f(v * u));
}

#ifndef UPCONV_DPP
#define UPCONV_DPP 1
#endif
#define EPI_ST(p, v) (*(pg8::u32x4*)(p) = (v))
#define EPI_DRY_DECL
#define EPI_DRY_MEMBER
struct EpiPlain {
    static constexpr bool PERM = true, AFTER_DRAIN = false, SEGMENTED = false;
    pg8::bf16_t* O; int ldc; EPI_DRY_MEMBER
    __device__ __forceinline__ void operator()(const pg8::f32x4 (&acc)[2][2][4][2], const pg8::Unit& u, int wr, int wc, int fr, int fq) const {
        EPI_DRY_DECL
        const int row0 = u.pm * 256 + wr * 64 + fr, col0 = u.pn * 256 + wc * 32 + 8 * fq;
#pragma unroll
        for (int ai = 0; ai < 2; ++ai)
#pragma unroll
            for (int m = 0; m < 4; ++m) { pg8::bf16_t* rowp = O + (size_t)(row0 + ai * 128 + m * 16) * ldc + col0;
#pragma unroll
                for (int bj = 0; bj < 2; ++bj) { const pg8::f32x4 v0 = acc[ai][bj][m][0], v1 = acc[ai][bj][m][1];
                    pg8::u32x4 w; w.x = pg8::cvt_pk_bf16(v0[0], v0[1]); w.y = pg8::cvt_pk_bf16(v0[2], v0[3]); w.z = pg8::cvt_pk_bf16(v1[0], v1[1]); w.w = pg8::cvt_pk_bf16(v1[2], v1[3]);
                    EPI_ST(rowp + bj * 128, w); } }
    }
};
struct EpiInProj {
    static constexpr bool PERM = true, AFTER_DRAIN = false, SEGMENTED = false;
    const float* bias; pg8::bf16_t* T6; float* kmean; unsigned* kabs; const float* rs; const unsigned* cm; EPI_DRY_MEMBER
    __device__ __forceinline__ void operator()(pg8::f32x4 (&acc)[2][2][4][2], const pg8::Unit& u, int wr, int wc, int fr, int fq) const {
        EPI_DRY_DECL
        const int pn = u.pn; int mode, ldc, colt; pg8::bf16_t* base;
        {
            pg8::f32x4 cv[2][2];
#pragma unroll
            for (int bj = 0; bj < 2; ++bj)
#pragma unroll
                for (int n = 0; n < 2; ++n) { const pg8::u32x4 cmv = *(const pg8::u32x4*)(cm + pn * 256 + wc * 32 + 8 * fq + bj * 128 + 4 * n); const unsigned c0 = cmv.x, c1 = cmv.y, c2 = cmv.z, c3 = cmv.w;
                    pg8::f32x4 t; t[0] = __builtin_bit_cast(float, c0); t[1] = __builtin_bit_cast(float, c1); t[2] = __builtin_bit_cast(float, c2); t[3] = __builtin_bit_cast(float, c3); cv[bj][n] = t * (1.0f / 127.0f); }
#pragma unroll
            for (int ai = 0; ai < 2; ++ai)
#pragma unroll
                for (int m = 0; m < 4; ++m) { const float rsv = rs[u.pm * 256 + ai * 128 + wr * 64 + m * 16 + fr];
#pragma unroll
                    for (int bj = 0; bj < 2; ++bj)
#pragma unroll
                        for (int n = 0; n < 2; ++n) { pg8::f32x4 t;
#pragma unroll
                            for (int j = 0; j < 4; ++j) { const float af = acc[ai][bj][m][n][j]; t[j] = (float)__builtin_bit_cast(int, af); }
                            acc[ai][bj][m][n] = (t * rsv) * cv[bj][n]; } }
        }
        if (pn < 12) { const int t = pn >> 1, slot = (t == 0) ? 0 : (t == 1) ? 3 : (t == 2) ? 1 : t + 1;
            base = T6 + (size_t)slot * M * BW; ldc = BW; colt = (pn & 1) * 256; mode = t < 2 ? 1 : (t == 2 ? 2 : 0); }
        else { base = T6; ldc = DM; colt = 0; mode = 0; }
        const int row0 = u.pm * 256 + wr * 64 + fr, col0 = colt + wc * 32 + 8 * fq, bcol0 = pn * 256 + wc * 32 + 8 * fq;
        pg8::f32x4 bv[2][2];
#pragma unroll
        for (int bj = 0; bj < 2; ++bj)
#pragma unroll
            for (int n = 0; n < 2; ++n) bv[bj][n] = *(const pg8::f32x4*)(bias + bcol0 + bj * 128 + 4 * n);
        if (pn == 6 || pn == 7) {
            const int lane = fq * 16 + fr; const int b = u.pm >> 5, jblk = u.pm & 31;
#pragma unroll
            for (int bj = 0; bj < 2; ++bj)
#pragma unroll
                for (int n = 0; n < 2; ++n) { pg8::f32x4 s = bv[bj][n] * 8.0f;
#pragma unroll
                    for (int ai = 0; ai < 2; ++ai)
#pragma unroll
                        for (int m = 0; m < 4; ++m) s = s + acc[ai][bj][m][n];
                    pg8::f32x4 mx = {0.f, 0.f, 0.f, 0.f};
#pragma unroll
                    for (int ai = 0; ai < 2; ++ai)
#pragma unroll
                        for (int m = 0; m < 4; ++m) { const pg8::f32x4 kv = acc[ai][bj][m][n] + bv[bj][n];
#pragma unroll
                            for (int j = 0; j < 4; ++j) mx[j] = fmaxf(mx[j], __builtin_fabsf(kv[j])); }
#pragma unroll
                    for (int j = 0; j < 4; ++j) { float v = s[j]; float a = mx[j];
#pragma unroll
                        for (int o = 1; o < 16; o <<= 1) { v += __builtin_bit_cast(float, __builtin_amdgcn_ds_bpermute((lane ^ o) << 2, __builtin_bit_cast(int, v)));
                            a = fmaxf(a, __builtin_bit_cast(float, __builtin_amdgcn_ds_bpermute((lane ^ o) << 2, __builtin_bit_cast(int, a)))); }
                        if (fr == 0) { const int col = (pn & 1) * 256 + bj * 128 + wc * 32 + 8 * fq + 4 * n + j; const size_t ki = ((size_t)(b * 8 + (col >> 6)) * 32 + jblk) * 64 + (col & 63);
                            atomicAdd(kmean + ki, v * (1.0f / 256.0f)); atomicMax(kabs + ki, __builtin_bit_cast(unsigned, a)); } } }
        }
#pragma unroll
        for (int ai = 0; ai < 2; ++ai)
#pragma unroll
            for (int m = 0; m < 4; ++m) { pg8::bf16_t* rowp = base + (size_t)(row0 + ai * 128 + m * 16) * ldc + col0;
#pragma unroll
                for (int bj = 0; bj < 2; ++bj) { pg8::f32x4 v0 = acc[ai][bj][m][0] + bv[bj][0], v1 = acc[ai][bj][m][1] + bv[bj][1];
                    if (mode == 1) {
#pragma unroll
                        for (int j = 0; j < 4; ++j) { v0[j] = gelu_tanh(v0[j]); v1[j] = gelu_tanh(v1[j]); } }
                    else if (mode == 2) { v0 = v0 * QSCALE; v1 = v1 * QSCALE; }
                    pg8::u32x4 w; w.x = pg8::cvt_pk_bf16(v0[0], v0[1]); w.y = pg8::cvt_pk_bf16(v0[2], v0[3]); w.z = pg8::cvt_pk_bf16(v1[0], v1[1]); w.w = pg8::cvt_pk_bf16(v1[2], v1[3]);
                    EPI_ST(rowp + bj * 128, w); } }
    }
};
struct EpiGate8 {
    static constexpr bool PERM = true, AFTER_DRAIN = false, SEGMENTED = false;
    const float* bias; unsigned char* G8; const float* rs; const unsigned* cm; EPI_DRY_MEMBER
    __device__ __forceinline__ void operator()(const pg8::f32x4 (&acc)[2][2][4][2], const pg8::Unit& u, int wr, int wc, int fr_in, int fq_in) const {
        EPI_DRY_DECL
        int fr = fr_in, fq = fq_in; asm volatile("" : "+v"(fr), "+v"(fq));
        const int pn = u.pn, bcol0 = pn * 256 + wc * 32 + 8 * fq;
        pg8::f32x4 bv[2][2];
#pragma unroll
        for (int bj = 0; bj < 2; ++bj)
#pragma unroll
            for (int n = 0; n < 2; ++n) bv[bj][n] = *(const pg8::f32x4*)(bias + bcol0 + bj * 128 + 4 * n);
        pg8::f32x4 cv[2][2];
#pragma unroll
        for (int bj = 0; bj < 2; ++bj)
#pragma unroll
            for (int n = 0; n < 2; ++n) { const pg8::u32x4 cmv = *(const pg8::u32x4*)(cm + bcol0 + bj * 128 + 4 * n); const unsigned c0 = cmv.x, c1 = cmv.y, c2 = cmv.z, c3 = cmv.w;
                pg8::f32x4 t; t[0] = __builtin_bit_cast(float, c0); t[1] = __builtin_bit_cast(float, c1); t[2] = __builtin_bit_cast(float, c2); t[3] = __builtin_bit_cast(float, c3); cv[bj][n] = t * (1.0f / 127.0f); }
        unsigned char* tp = G8 + ((size_t)((pn >> 3) * (M / 256) + u.pm) * 8 + (pn & 7)) * 65536 + (size_t)((((wr * 4 + wc) * 64) + fq * 16 + fr) * 16);
#pragma unroll
        for (int ai = 0; ai < 2; ++ai)
#pragma unroll
            for (int m = 0; m < 4; ++m) { pg8::u32x4 w; const float rsv = rs[u.pm * 256 + ai * 128 + wr * 64 + m * 16 + fr];
                pg8::f32x4 z[2][2];
#pragma unroll
                for (int bj = 0; bj < 2; ++bj)
#pragma unroll
                    for (int n = 0; n < 2; ++n) { pg8::f32x4 t;
#pragma unroll
                        for (int j = 0; j < 4; ++j) { const float af = acc[ai][bj][m][n][j]; t[j] = (float)__builtin_bit_cast(int, af); }
                        z[bj][n] = (t * rsv) * cv[bj][n] + bv[bj][n]; }
                w.x = gate_q4(z[0][0]); w.y = gate_q4(z[0][1]); w.z = gate_q4(z[1][0]); w.w = gate_q4(z[1][1]);
                EPI_ST(tp + (ai * 4 + m) * 8192, w); }
    }
};
struct EpiUpConv {
    static constexpr bool PERM = true, AFTER_DRAIN = false, SEGMENTED = false;
    pg8::bf16_t* A2; const float* wconv; const float* bconv; float* topz; float* botz; PG8_LAS float* xb; const float* rs; const unsigned* cm; EPI_DRY_MEMBER
    __device__ __forceinline__ void operator()(pg8::f32x4 (&acc)[2][2][4][2], const pg8::Unit& u, int wr, int wc, int fr_in, int fq_in) const {
        EPI_DRY_DECL
        int fr = fr_in, fq = fq_in; asm volatile("" : "+v"(fr), "+v"(fq));
        const int lane = fq * 16 + fr, wv = wr * 4 + wc, pm = u.pm, pn = u.pn;
#pragma unroll
        for (int ai = 0; ai < 2; ++ai)
#pragma unroll
            for (int m = 0; m < 4; ++m) { const float rsv = rs[pm * 256 + ai * 128 + wr * 64 + m * 16 + fr];
#pragma unroll
                for (int bj = 0; bj < 2; ++bj)
#pragma unroll
                    for (int n = 0; n < 2; ++n) { pg8::f32x4 t;
#pragma unroll
                        for (int j = 0; j < 4; ++j) { const float af = acc[ai][bj][m][n][j]; t[j] = (float)__builtin_bit_cast(int, af); }
                        acc[ai][bj][m][n] = t * rsv; } }
        if (fr >= 14) {
#pragma unroll
            for (int ai = 0; ai < 2; ++ai)
#pragma unroll
                for (int bj = 0; bj < 2; ++bj) { PG8_LAS pg8::f32x4* p = (PG8_LAS pg8::f32x4*)(xb + ((((wv * 2 + ai) * 2 + (fr - 14)) * 4 + fq) * 2 + bj) * 8); p[0] = acc[ai][bj][3][0]; p[1] = acc[ai][bj][3][1]; }
        }
        const int ecol = pn * 256 + wc * 32 + 8 * fq;
        if (wr == 0 && fr < 2) { float* t = topz + ((size_t)pm * 2 + fr) * NUP + ecol;
#pragma unroll
            for (int bj = 0; bj < 2; ++bj)
#pragma unroll
                for (int n = 0; n < 2; ++n) *(pg8::f32x4*)(t + bj * 128 + 4 * n) = acc[0][bj][0][n]; }
        if (wr == 1 && fr >= 14) { float* t = botz + ((size_t)pm * 2 + (fr - 14)) * NUP + ecol;
#pragma unroll
            for (int bj = 0; bj < 2; ++bj)
#pragma unroll
                for (int n = 0; n < 2; ++n) *(pg8::f32x4*)(t + bj * 128 + 4 * n) = acc[1][bj][3][n]; }
        asm volatile("s_waitcnt lgkmcnt(0)" ::: "memory"); __builtin_amdgcn_s_barrier(); asm volatile("" ::: "memory");
        pg8::f32x4 bnd[2][2][2];
#pragma unroll
        for (int ai = 0; ai < 2; ++ai) { const int sw = (wr == 1) ? wc : 4 + wc, sai = (wr == 1) ? ai : 0; const bool have = (wr == 1) || (ai == 1);
#pragma unroll
            for (int bj = 0; bj < 2; ++bj) { pg8::f32x4 a = {0.f, 0.f, 0.f, 0.f}, b = a;
                if (have && fr >= 14) { const PG8_LAS pg8::f32x4* p = (const PG8_LAS pg8::f32x4*)(xb + ((((sw * 2 + sai) * 2 + (fr - 14)) * 4 + fq) * 2 + bj) * 8); a = p[0]; b = p[1]; }
                bnd[ai][bj][0] = a; bnd[ai][bj][1] = b; } }
        const int s1 = (fr >= 1 ? lane - 1 : lane + 15) << 2, s2 = (fr >= 2 ? lane - 2 : lane + 14) << 2;
#pragma unroll
        for (int bj = 0; bj < 2; ++bj)
#pragma unroll
            for (int n = 0; n < 2; ++n) { const int col = (bj ? DFF : 0) + pn * 128 + wc * 32 + 8 * fq + 4 * n;
                const pg8::u32x4 cmv = *(const pg8::u32x4*)(cm + col); pg8::f32x4 csv;
                { const unsigned c0 = cmv.x, c1 = cmv.y, c2 = cmv.z, c3 = cmv.w; csv[0] = __builtin_bit_cast(float, c0); csv[1] = __builtin_bit_cast(float, c1); csv[2] = __builtin_bit_cast(float, c2); csv[3] = __builtin_bit_cast(float, c3); csv = csv * (1.0f / 127.0f); }
                const pg8::f32x4 w0 = *(const pg8::f32x4*)(wconv + col) * csv, w1 = *(const pg8::f32x4*)(wconv + NUP + col) * csv, w2 = *(const pg8::f32x4*)(wconv + 2 * NUP + col) * csv, bb = *(const pg8::f32x4*)(bconv + col);
#pragma unroll
                for (int ai = 0; ai < 2; ++ai)
#pragma unroll
                    for (int m = 3; m >= 0; --m) { const pg8::f32x4 cur = acc[ai][bj][m][n]; const pg8::f32x4 prv = (m > 0) ? acc[ai][bj][m - 1][n] : bnd[ai][bj][n];
                        pg8::f32x4 z1, z2;
#pragma unroll
                        for (int j = 0; j < 4; ++j) {
#if UPCONV_DPP
                            const float cf = cur[j], pf = prv[j];
                            const int ci = __builtin_bit_cast(int, cf), pi = __builtin_bit_cast(int, pf);
                            const int p1 = __builtin_amdgcn_mov_dpp(pi, 0x121, 0xf, 0xf, false), p2 = __builtin_amdgcn_mov_dpp(pi, 0x122, 0xf, 0xf, false);
                            z1[j] = __builtin_bit_cast(float, __builtin_amdgcn_update_dpp(p1, ci, 0x111, 0xf, 0xf, false));
                            z2[j] = __builtin_bit_cast(float, __builtin_amdgcn_update_dpp(p2, ci, 0x112, 0xf, 0xf, false));
#else
                            const float t1 = (fr == 15) ? prv[j] : cur[j], t2 = (fr >= 14) ? prv[j] : cur[j];
                            z1[j] = __builtin_bit_cast(float, __builtin_amdgcn_ds_bpermute(s1, __builtin_bit_cast(int, t1)));
                            z2[j] = __builtin_bit_cast(float, __builtin_amdgcn_ds_bpermute(s2, __builtin_bit_cast(int, t2)));
#endif
                        }
                        acc[ai][bj][m][n] = w2 * cur + w1 * z1 + w0 * z2 + bb; } }
        const int row0 = pm * 256 + wr * 64 + fr, col0 = pn * 128 + wc * 32 + 8 * fq;
#pragma unroll
        for (int ai = 0; ai < 2; ++ai)
#pragma unroll
            for (int m = 0; m < 4; ++m) { const pg8::f32x4 g0 = acc[ai][0][m][0], g1 = acc[ai][0][m][1], v0 = acc[ai][1][m][0], v1 = acc[ai][1][m][1];
                pg8::u32x4 w; w.x = pg8::cvt_pk_bf16(gelu_tanh(g0[0]) * v0[0], gelu_tanh(g0[1]) * v0[1]); w.y = pg8::cvt_pk_bf16(gelu_tanh(g0[2]) * v0[2], gelu_tanh(g0[3]) * v0[3]);
                w.z = pg8::cvt_pk_bf16(gelu_tanh(g1[0]) * v1[0], gelu_tanh(g1[1]) * v1[1]); w.w = pg8::cvt_pk_bf16(gelu_tanh(g1[2]) * v1[2], gelu_tanh(g1[3]) * v1[3]);
                EPI_ST(A2 + (size_t)(row0 + ai * 128 + m * 16) * DFF + col0, w); }
    }
};
struct EpiBranch {
    static constexpr bool PERM = true, AFTER_DRAIN = false, SEGMENTED = true; static constexpr int SEG_SHIFT = 3;
    const unsigned char* G8; pg8::bf16_t* Mb; EPI_DRY_MEMBER
    __device__ __forceinline__ void seg_hook(pg8::f32x4 (&acc)[2][2][4][2], const pg8::Unit& u, int seg, int wr, int wc, int fr, int fq) const {
        int t16 = (((wr * 4 + wc) * 64) + fq * 16 + fr) * 16;
        asm volatile("" : "+v"(t16));
        const unsigned char* Tp = G8 + ((size_t)((seg - 1) * (M / 256) + u.pm) * 8 + u.pn) * 65536 + t16; const unsigned char* Tn = Tp + (size_t)(M / 256) * 8 * 65536;
        pg8::u32x4 ga[8], gb[8];
#pragma unroll
        for (int c = 0; c < 8; ++c) { ga[c] = *(const pg8::u32x4*)(Tp + c * 8192); gb[c] = *(const pg8::u32x4*)(Tn + c * 8192); }
        asm volatile("" ::: "memory");
#pragma unroll
        for (int ai = 0; ai < 2; ++ai)
#pragma unroll
            for (int m = 0; m < 4; ++m) { const pg8::u32x4 a = ga[ai * 4 + m], b = gb[ai * 4 + m];
                acc[ai][0][m][0] = acc[ai][0][m][0] * gate_ratio4(a.x, b.x); acc[ai][0][m][1] = acc[ai][0][m][1] * gate_ratio4(a.y, b.y);
                acc[ai][1][m][0] = acc[ai][1][m][0] * gate_ratio4(a.z, b.z); acc[ai][1][m][1] = acc[ai][1][m][1] * gate_ratio4(a.w, b.w); }
        asm volatile("" ::: "memory");
    }
    __device__ __forceinline__ void operator()(const pg8::f32x4 (&acc)[2][2][4][2], const pg8::Unit& u, int wr, int wc, int fr, int fq) const {
        const int row0 = u.pm * 256 + wr * 64 + fr, col0 = u.pn * 256 + wc * 32 + 8 * fq;
        EPI_DRY_DECL
        const unsigned char* T2 = G8 + ((size_t)(2 * (M / 256) + u.pm) * 8 + u.pn) * 65536 + (size_t)((((wr * 4 + wc) * 64) + fq * 16 + fr) * 16);
        pg8::u32x4 gv[8];
#pragma unroll
        for (int c = 0; c < 8; ++c) gv[c] = *(const pg8::u32x4*)(T2 + c * 8192);
        asm volatile("" ::: "memory");
#pragma unroll
        for (int ai = 0; ai < 2; ++ai)
#pragma unroll
            for (int m = 0; m < 4; ++m) { const size_t ro = (size_t)(row0 + ai * 128 + m * 16) * DM + col0; const pg8::u32x4 g = gv[ai * 4 + m];
#pragma unroll
                for (int bj = 0; bj < 2; ++bj) { const pg8::f32x4 a0 = acc[ai][bj][m][0] * gate_val4(bj ? g.z : g.x), a1 = acc[ai][bj][m][1] * gate_val4(bj ? g.w : g.y);
                    pg8::u32x4 w; w.x = pg8::cvt_pk_bf16(a0[0], a0[1]); w.y = pg8::cvt_pk_bf16(a0[2], a0[3]); w.z = pg8::cvt_pk_bf16(a1[0], a1[1]); w.w = pg8::cvt_pk_bf16(a1[2], a1[3]);
                    EPI_ST(Mb + ro + bj * 128, w); } }
    }
};
#include <hip/hip_bf16.h>
#include <cmath>
namespace attn_body {
using bf16=__hip_bfloat16;
using bf16x8=__attribute__((ext_vector_type(8)))short;
using s16x4=__attribute__((ext_vector_type(4)))short;
using f32x16=__attribute__((ext_vector_type(16)))float;
using u32x4=__attribute__((ext_vector_type(4)))unsigned;
constexpr int BATCH=4,NHEAD=8,SEQ=8192,D=64,DM=NHEAD*D;
constexpr int NW=8,QBLK=32,QB=QBLK*NW,KVBLK=64,NQB=SEQ/QB;
constexpr int ATTN_PITCH=DM, ATTN_UNIT_ROWS=QB;
__device__ __forceinline__ int crow(int r,int hi){return (r&3)+8*(r>>2)+4*hi;}
#define SBAR() __builtin_amdgcn_sched_barrier(0)
__device__ __forceinline__ void cmask(f32x16&p0,f32x16&p1,int jb,int qrel,int hi){
  const float NEG=-INFINITY; int kb=64*jb+4*hi;
  #pragma unroll
  for(int r=0;r<16;++r){int kv=kb+(r&3)+8*(r>>2); if(kv>qrel)p0[r]=NEG; if(kv+32>qrel)p1[r]=NEG;}
}

constexpr int NSLOT=3, SLOTB=8192;
constexpr int LDS_K=0, LDS_V=NSLOT*SLOTB, LDS_WS=2*NSLOT*SLOTB, LDS_OST=LDS_WS+NW*64*4, LDS_TAB=LDS_OST+NW*4096  , LDS_BYTES=LDS_TAB+16384;
constexpr float C2=0.125f*1.4426950408889634f;
__device__ __forceinline__ void glds16(const void*gsrc,unsigned lds_dst){unsigned keep;
  asm volatile("s_mov_b32 %0, m0\n\ts_mov_b32 m0, %2\n\ts_nop 0\n\tglobal_load_lds_dwordx4 %1, off\n\ts_mov_b32 m0, %0":"=&s"(keep):"v"(gsrc),"s"(lds_dst):"memory");}
__device__ __forceinline__ float max3f(float a,float b,float c){float r;asm("v_max3_f32 %0, %1, %2, %3":"=v"(r):"v"(a),"v"(b),"v"(c));return r;}
__device__ __forceinline__ float max2f(float a,float b){float r;asm("v_max_f32_e32 %0, %1, %2":"=v"(r):"v"(a),"v"(b));return r;}
__device__ __forceinline__ float fadd_s(float a,float b){float r;asm("v_add_f32_e32 %0, %1, %2":"=v"(r):"v"(a),"v"(b));return r;}
__device__ __forceinline__ float fsub_s(float a,float b){float r;asm("v_sub_f32_e32 %0, %1, %2":"=v"(r):"v"(a),"v"(b));return r;}
typedef float f32x2_t __attribute__((ext_vector_type(2))); typedef __bf16 bf16x2_t __attribute__((ext_vector_type(2)));
__device__ __forceinline__ unsigned cvtpk_s(float lo,float hi){f32x2_t v={lo,hi};bf16x2_t b=__builtin_convertvector(v,bf16x2_t);return __builtin_bit_cast(unsigned,b);}
#define WAIT_BAR(N) asm volatile("s_waitcnt vmcnt(" #N ") lgkmcnt(0)\n\ts_barrier":::"memory")

__device__ __forceinline__ void qkt(f32x16&p0,f32x16&p1,const char*Kslot,const bf16x8*qr,const f32x16&negm,int r32,int hi){
  const char*kb=Kslot+hi*1024+r32*16;
  #pragma unroll
  for(int d0=0;d0<4;++d0){
    const bf16x8 b0=*reinterpret_cast<const bf16x8*>(kb+d0*2048);
    const bf16x8 b1=*reinterpret_cast<const bf16x8*>(kb+d0*2048+512);
    if(d0==0){p0=__builtin_amdgcn_mfma_f32_32x32x16_bf16(b0,qr[0],negm,0,0,0);p1=__builtin_amdgcn_mfma_f32_32x32x16_bf16(b1,qr[0],negm,0,0,0);}
    else{p0=__builtin_amdgcn_mfma_f32_32x32x16_bf16(b0,qr[d0],p0,0,0,0);p1=__builtin_amdgcn_mfma_f32_32x32x16_bf16(b1,qr[d0],p1,0,0,0);}}
}
typedef __attribute__((address_space(3))) const char* lds_cptr;
typedef short v4i16_t __attribute__((ext_vector_type(4)));
__device__ __forceinline__ void kload8(bf16x8*kf,lds_cptr kp){
  kf[0]=*(const __attribute__((address_space(3))) bf16x8*)(kp);      kf[1]=*(const __attribute__((address_space(3))) bf16x8*)(kp+512);
  kf[2]=*(const __attribute__((address_space(3))) bf16x8*)(kp+2048); kf[3]=*(const __attribute__((address_space(3))) bf16x8*)(kp+2560);
  kf[4]=*(const __attribute__((address_space(3))) bf16x8*)(kp+4096); kf[5]=*(const __attribute__((address_space(3))) bf16x8*)(kp+4608);
  kf[6]=*(const __attribute__((address_space(3))) bf16x8*)(kp+6144); kf[7]=*(const __attribute__((address_space(3))) bf16x8*)(kp+6656);
}
__device__ __forceinline__ void kload2(bf16x8*kf,lds_cptr kp,int j){ kf[2*j]=*(const __attribute__((address_space(3))) bf16x8*)(kp+j*2048); kf[2*j+1]=*(const __attribute__((address_space(3))) bf16x8*)(kp+j*2048+512); }
__device__ __forceinline__ s16x4 vtr(lds_cptr p){ return __builtin_bit_cast(s16x4,__builtin_amdgcn_ds_read_tr16_b64_v4i16((__attribute__((address_space(3))) v4i16_t*)p)); }
__device__ __forceinline__ float rowmax(const f32x16&p0,const f32x16&p1){
  float a=max3f(p0[0],p0[1],p1[0]),b=max3f(p0[2],p0[3],p1[1]);a=max3f(a,p1[2],p1[3]);
  #pragma unroll
  for(int r=4;r<16;r+=4){a=max3f(a,p0[r],p0[r+1]);b=max3f(b,p0[r+2],p0[r+3]);a=max3f(a,p1[r],p1[r+1]);b=max3f(b,p1[r+2],p1[r+3]);}
  const float m=max2f(a,b);
  auto rr=__builtin_amdgcn_permlane32_swap(__float_as_uint(m),__float_as_uint(m),false,false);
  return max2f(__uint_as_float(rr[0]),__uint_as_float(rr[1]));
}
__device__ __forceinline__ void pv(f32x16*o,int vb,bf16x8 pa0,bf16x8 pa1,bf16x8 pa2,bf16x8 pa3){
  #pragma unroll
  for(int d0=0;d0<2;++d0){s16x4 lo[4],hi[4];
    #pragma unroll
    for(int ks=0;ks<4;++ks){
      asm volatile("ds_read_b64_tr_b16 %0,%1 offset:%c2":"=&v"(lo[ks]):"v"(vb),"i"(d0*4096+ks*1024):"memory");
      asm volatile("ds_read_b64_tr_b16 %0,%1 offset:%c2":"=&v"(hi[ks]):"v"(vb),"i"(d0*4096+ks*1024+512):"memory");}
    asm volatile("s_waitcnt lgkmcnt(0)":::"memory");SBAR();
    #define PK(k) (bf16x8){lo[k][0],lo[k][1],lo[k][2],lo[k][3],hi[k][0],hi[k][1],hi[k][2],hi[k][3]}
    o[d0]=__builtin_amdgcn_mfma_f32_32x32x16_bf16(pa0,PK(0),o[d0],0,0,0);
    o[d0]=__builtin_amdgcn_mfma_f32_32x32x16_bf16(pa1,PK(1),o[d0],0,0,0);
    o[d0]=__builtin_amdgcn_mfma_f32_32x32x16_bf16(pa2,PK(2),o[d0],0,0,0);
    o[d0]=__builtin_amdgcn_mfma_f32_32x32x16_bf16(pa3,PK(3),o[d0],0,0,0);
    #undef PK
  }
}

#ifndef ATTN_STORE16
#define ATTN_STORE16(p,v) (*(u32x4*)(p)=(v))
#endif
template<int THRL> __device__ __forceinline__ void attn_unit(int b,int h,int qb,const bf16*Q,const bf16*__restrict__ K,const bf16*__restrict__ V,const float*__restrict__ KM,const float*__restrict__ KA,bf16*O,char*shm,int wave_s){
  int tid_l=wave_s*64+pg8::lane_now(); asm volatile("":"+v"(tid_l));
  const int tid=tid_l,lane=tid&63,r32=lane&31,hi=lane>>5; const int wid=__builtin_amdgcn_readfirstlane(tid>>6);
  const long rowbase=(long)b*SEQ; const int q0=qb*QB;
  const bf16*Qw=Q+(rowbase+q0+wid*QBLK)*DM+h*D;
  const bf16*Kh=K+rowbase*DM+h*D,*Vh=V+rowbase*DM+h*D;
  const unsigned lds0=(unsigned)(uintptr_t)shm;
  float*wsf=(float*)(shm+LDS_WS)+wid*64;
  const bf16*ksrc_=Kh+(long)lane*DM+wid*8;
  const bf16*vsrc_=Vh+(long)(16*(wid&3)+(lane>>2))*DM+(wid>>2)*32+(lane&3)*8;
  const unsigned kdst=lds0+LDS_K+wid*1024, vdst=lds0+LDS_V+wid*1024;
  const bf16*ksrc=ksrc_,*vsrc=vsrc_;
  #define DMA_K(t,slot) glds16(ksrc+(long)(t)*KVBLK*DM,(unsigned)__builtin_amdgcn_readfirstlane(kdst+(slot)))
  #define DMA_V(t,slot) glds16(vsrc+(long)(t)*KVBLK*DM,(unsigned)__builtin_amdgcn_readfirstlane(vdst+(slot)))
  const int vb0=(int)(lds0+LDS_V)+((lane>>4)&1)*32+(lane&3)*8+(4*hi+((lane&15)>>2))*64;
  const char*Kbase=shm+LDS_K; bf16x8 kf[8];
  const lds_cptr shm3=(lds_cptr)shm; const lds_cptr kp0=shm3+LDS_K+hi*1024+r32*16; const lds_cptr vp0=shm3+LDS_V+((lane>>4)&1)*32+(lane&3)*8+(4*hi+((lane&15)>>2))*64;
  int NT=(q0+QB)/KVBLK;
  { const float4*gm=reinterpret_cast<const float4*>(KM+((long)(b*NHEAD+h)*32)*64), *ga=reinterpret_cast<const float4*>(KA+((long)(b*NHEAD+h)*32)*64);
    float4*lm=reinterpret_cast<float4*>(shm+LDS_TAB), *la=reinterpret_cast<float4*>(shm+LDS_TAB+8192);
    lm[tid]=gm[tid]; la[tid]=ga[tid];
    asm volatile("s_waitcnt vmcnt(0) lgkmcnt(0)\n\ts_barrier":::"memory"); }
  bf16x8 qr[4];
  #pragma unroll
  for(int d0=0;d0<4;++d0)qr[d0]=*reinterpret_cast<const bf16x8*>(&Qw[(long)r32*DM+d0*16+hi*8]);
  float mhat=0.f,l_reg=0.f;f32x16 o[2];o[0]=f32x16{};o[1]=f32x16{};
  const int qrel=wid*QBLK+r32;
  const float sl2=1.4426950408889634f*__builtin_amdgcn_exp2f(-(float)(h+1));
  const float hb4=sl2*(float)(4*hi), sl32=32.f*sl2;
  unsigned selmask=0u;
  { float qf[32];
    #pragma unroll
    for(int d0=0;d0<4;++d0){
      #pragma unroll
      for(int j=0;j<8;++j)qf[d0*8+j]=__builtin_bit_cast(float,((unsigned)(unsigned short)qr[d0][j])<<16);}
    { const bf16*Kd=Kh+(long)(q0+qrel)*DM; float acc=0.f;
      #pragma unroll
      for(int d0=0;d0<4;++d0){ const bf16x8 kq=*reinterpret_cast<const bf16x8*>(&Kd[d0*16+hi*8]);
        #pragma unroll
        for(int j=0;j<8;++j)acc+=qf[d0*8+j]*__builtin_bit_cast(float,((unsigned)(unsigned short)kq[j])<<16);}
      auto rr=__builtin_amdgcn_permlane32_swap(__float_as_uint(acc),__float_as_uint(acc),false,false);
      mhat=(__uint_as_float(rr[0])+__uint_as_float(rr[1]))+sl2*(float)qrel; }
    float v0=-INFINITY,v1=-INFINITY,v2=-INFINITY; int i0=-1,i1=-1,i2=-1; unsigned nearmask=0u;
    const float*KMb=reinterpret_cast<const float*>(shm+LDS_TAB)+hi*8; const float*KAb=reinterpret_cast<const float*>(shm+LDS_TAB+8192)+hi*8;
    for(int j=0;j<qb;++j){ const float*km=KMb+j*64; const float*ka=KAb+j*64; float sp=0.f, up=0.f;
      #pragma unroll
      for(int d0=0;d0<4;++d0){ const float4 a=*reinterpret_cast<const float4*>(km+d0*16), c=*reinterpret_cast<const float4*>(km+d0*16+4);
        sp+=qf[d0*8+0]*a.x+qf[d0*8+1]*a.y+qf[d0*8+2]*a.z+qf[d0*8+3]*a.w+qf[d0*8+4]*c.x+qf[d0*8+5]*c.y+qf[d0*8+6]*c.z+qf[d0*8+7]*c.w;
        const float4 e=*reinterpret_cast<const float4*>(ka+d0*16), f=*reinterpret_cast<const float4*>(ka+d0*16+4);
        up+=__builtin_fabsf(qf[d0*8+0])*e.x+__builtin_fabsf(qf[d0*8+1])*e.y+__builtin_fabsf(qf[d0*8+2])*e.z+__builtin_fabsf(qf[d0*8+3])*e.w+__builtin_fabsf(qf[d0*8+4])*f.x+__builtin_fabsf(qf[d0*8+5])*f.y+__builtin_fabsf(qf[d0*8+6])*f.z+__builtin_fabsf(qf[d0*8+7])*f.w;}
      auto rr=__builtin_amdgcn_permlane32_swap(__float_as_uint(sp),__float_as_uint(sp),false,false);
      const float sc=__uint_as_float(rr[0])+__uint_as_float(rr[1]);
      { auto ru=__builtin_amdgcn_permlane32_swap(__float_as_uint(up),__float_as_uint(up),false,false); const float ub=(__uint_as_float(ru[0])+__uint_as_float(ru[1]))*1.01f;
        if(ub+sl2*(float)(256*j+255-q0)-mhat>-70.f)nearmask|=1u<<j; }
      if(sc>v2){ if(sc>v1){ v2=v1;i2=i1; if(sc>v0){v1=v0;i1=i0;v0=sc;i0=j;} else {v1=sc;i1=j;} } else {v2=sc;i2=j;} } }
    if(i0>=0)selmask|=1u<<i0; if(i1>=0)selmask|=1u<<i1; if(i2>=0)selmask|=1u<<i2;
    unsigned need=selmask&nearmask;
    #pragma unroll
    for(int o_=1;o_<64;o_<<=1)need|=(unsigned)__builtin_amdgcn_ds_bpermute((lane^o_)<<2,(int)need);
    volatile unsigned*xw=(volatile unsigned*)(shm+LDS_OST);
    if(lane==0)xw[wid]=need;
    asm volatile("s_waitcnt lgkmcnt(0)\n\ts_barrier":::"memory");
    unsigned na=xw[0]|xw[1]|xw[2]|xw[3]|xw[4]|xw[5]|xw[6]|xw[7];
    na=(unsigned)__builtin_amdgcn_readfirstlane((int)na)|(1u<<qb);
    const int nskip=__builtin_ctz(na);
    NT-=4*nskip; selmask>>=nskip; ksrc+=(long)nskip*256*DM; vsrc+=(long)nskip*256*DM; }
  f32x16 negm;
  #pragma unroll
  for(int r=0;r<16;++r)negm[r]=sl2*(float)((r&3)+8*(r>>2));
  asm volatile("":"+v"(negm));
  #define ABIAS(P0,P1,t) do{ const int tt_=(t); const bool on_=(tt_>=NT-4)||(((selmask>>(tt_>>2))&1u)!=0u); \
    const float L0_=on_?((sl2*(float)(64*(tt_-(NT-4)))+hb4)-mhat):-INFINITY; const float L1_=L0_+sl32; \
    _Pragma("unroll") for(int r=0;r<16;++r){P0[r]+=L0_;P1[r]+=L1_;} }while(0)
  #define CMASK(P0,P1,t) do{int jb_=(t)-(NT-4); if(jb_>=0)cmask(P0,P1,jb_,qrel,hi);}while(0)
  bool resc=false;
  #define START(P0,P1) do{ const float rm=rowmax(P0,P1); resc=false; \
    if(__any(rm>(float)THRL)){ const float dl=__builtin_fmaxf(rm,0.f); mhat+=dl; \
      _Pragma("unroll") for(int r=0;r<16;++r){P0[r]-=dl;P1[r]-=dl;} } \
    _Pragma("unroll") for(int r=0;r<16;++r)P0[r]=__builtin_amdgcn_exp2f(P0[r]); }while(0)
  #define RESC() do{ if(resc){ asm volatile("s_waitcnt lgkmcnt(0)":::"memory"); \
      _Pragma("unroll") for(int d_=0;d_<2;++d_) _Pragma("unroll") for(int r=0;r<16;++r)o[d_][r]*=wsf[crow(r,hi)]; } }while(0)
  f32x16 pA0,pA1,pB0,pB1;
  int sl_prev=0,sl_cur=0,sl_next=SLOTB;
  #define ROT() do{sl_prev=sl_cur;sl_cur=sl_next;sl_next=(sl_next==(NSLOT-1)*SLOTB)?0:sl_next+SLOTB;}while(0)
  DMA_K(0,0);DMA_V(0,0);DMA_K(1,SLOTB);
  DMA_K(2,2*SLOTB);
  WAIT_BAR(3);
  qkt(pA0,pA1,Kbase,qr,negm,r32,hi);asm volatile("s_nop 15\n\ts_nop 7":"+v"(pA0),"+v"(pA1));ABIAS(pA0,pA1,0);CMASK(pA0,pA1,0);
  START(pA0,pA1);
  _Pragma("unroll") for(int r=0;r<16;++r)pA1[r]=__builtin_amdgcn_exp2f(pA1[r]);
  WAIT_BAR(0);
  DMA_K(3,0);DMA_V(1,SLOTB);
  ROT();
  kload8(kf,kp0+sl_cur);
  WAIT_BAR(2);
  s16x4 vlo[8],vhi[8]; u32x4 pw0,pw1,pw2,pw3;
  #define PKW(P,B) cvtpk_s(P[B],P[B+1])
  #define PAF(k) __builtin_bit_cast(bf16x8,pw##k)
  #define VFR(i) (bf16x8){vlo[i][0],vlo[i][1],vlo[i][2],vlo[i][3],vhi[i][0],vhi[i][1],vhi[i][2],vhi[i][3]}
  #define PIN(x) asm volatile("":"+v"(x))
  #define MX3(a,b,c) __builtin_fmaxf(__builtin_fmaxf((a),(b)),(c))
  #define GAPA(MF,A0,A1,A2,A3,W0,W1,PW) do{ MF; sacc+=A0; sacc+=A1; sacc+=A2; sacc+=A3; PIN(sacc); W0; W1; PIN(PW); SBAR(); }while(0)
  #define EX(v) __builtin_amdgcn_exp2f(v)
  #define GAPB(MF,X,B) do{ MF; X[B]=EX(X[B]); X[B+1]=EX(X[B+1]); X[B+2]=EX(X[B+2]); X[B+3]=EX(X[B+3]); PIN(X); SBAR(); }while(0)
  #define VRD(i) do{ vlo[i]=vtr(vp_+(((i)>>2)*4096+((i)&3)*1024)); vhi[i]=vtr(vp_+(((i)>>2)*4096+((i)&3)*1024+512)); }while(0)
  #define KRD(G,j) do{ if(G){ kload2(kf,kp0+sl_next,j); SBAR(); } }while(0)
  #define STEP(C0,C1,P0,P1,t,GK,GV,GL) do{ SBAR(); \
    const lds_cptr vp_=vp0+sl_prev; \
    VRD(0); SBAR(); float sacc=(P0[0]+P0[1]); \
    GAPA(C0=__builtin_amdgcn_mfma_f32_32x32x16_bf16(kf[0],qr[0],negm,0,0,0), P0[2],P0[3],P0[4],P0[5],     pw0[0]=PKW(P0,0), pw0[1]=PKW(P0,2), pw0); \
    VRD(4); SBAR(); GAPA(C1=__builtin_amdgcn_mfma_f32_32x32x16_bf16(kf[1],qr[0],negm,0,0,0), P0[6],P0[7],P0[8],P0[9],     pw0[2]=PKW(P0,4), pw0[3]=PKW(P0,6), pw0); \
    VRD(1); SBAR(); GAPA(C0=__builtin_amdgcn_mfma_f32_32x32x16_bf16(kf[2],qr[1],C0,0,0,0),   P0[10],P0[11],P0[12],P0[13], pw1[0]=PKW(P0,8), pw1[1]=PKW(P0,10), pw1); \
    VRD(5); SBAR(); GAPA(C1=__builtin_amdgcn_mfma_f32_32x32x16_bf16(kf[3],qr[1],C1,0,0,0),   P0[14],P0[15],P1[0],P1[1],   pw1[2]=PKW(P0,12),pw1[3]=PKW(P0,14), pw1); \
    VRD(2); SBAR(); GAPA(C0=__builtin_amdgcn_mfma_f32_32x32x16_bf16(kf[4],qr[2],C0,0,0,0),   P1[2],P1[3],P1[4],P1[5],     pw2[0]=PKW(P1,0), pw2[1]=PKW(P1,2), pw2); \
    VRD(6); SBAR(); GAPA(C1=__builtin_amdgcn_mfma_f32_32x32x16_bf16(kf[5],qr[2],C1,0,0,0),   P1[6],P1[7],P1[8],P1[9],     pw2[2]=PKW(P1,4), pw2[3]=PKW(P1,6), pw2); \
    VRD(3); SBAR(); GAPA(C0=__builtin_amdgcn_mfma_f32_32x32x16_bf16(kf[6],qr[3],C0,0,0,0),   P1[10],P1[11],P1[12],P1[13], pw3[0]=PKW(P1,8), pw3[1]=PKW(P1,10), pw3); \
    VRD(7); SBAR(); GAPA(C1=__builtin_amdgcn_mfma_f32_32x32x16_bf16(kf[7],qr[3],C1,0,0,0),   P1[14],P1[15],0.f,0.f,       pw3[2]=PKW(P1,12),pw3[3]=PKW(P1,14), pw3); \
    l_reg+=sacc; \
    if(GK){DMA_K((t)+3,sl_cur);} if(GV){DMA_V((t)+1,sl_next);} \
    ABIAS(C0,C1,t); CMASK(C0,C1,t); \
    { float a=MX3(C0[0],C0[1],C1[0]),b=MX3(C0[2],C0[3],C1[1]); a=MX3(a,C1[2],C1[3]); \
      _Pragma("unroll") for(int r=4;r<16;r+=4){a=MX3(a,C0[r],C0[r+1]);b=MX3(b,C0[r+2],C0[r+3]);a=MX3(a,C1[r],C1[r+1]);b=MX3(b,C1[r+2],C1[r+3]);} \
      float rm=__builtin_fmaxf(a,b); { auto rr=__builtin_amdgcn_permlane32_swap(__float_as_uint(rm),__float_as_uint(rm),false,false); rm=__builtin_fmaxf(__uint_as_float(rr[0]),__uint_as_float(rr[1])); } \
      resc=false; \
      if(__builtin_expect(__any(rm>(float)THRL),0)){ const float dl=__builtin_fmaxf(rm,0.f); mhat+=dl; \
        _Pragma("unroll") for(int r=0;r<16;++r){C0[r]-=dl;C1[r]-=dl;} \
        const float f=__builtin_amdgcn_exp2f(-dl); l_reg*=f; if(hi==0)wsf[r32]=f; resc=true; } } \
    SBAR(); \
    GAPB(o[0]=__builtin_amdgcn_mfma_f32_32x32x16_bf16(PAF(0),VFR(0),o[0],0,0,0), C0,0); \
    GAPB(o[1]=__builtin_amdgcn_mfma_f32_32x32x16_bf16(PAF(0),VFR(4),o[1],0,0,0), C0,4); \
    KRD(GL,0); GAPB(o[0]=__builtin_amdgcn_mfma_f32_32x32x16_bf16(PAF(1),VFR(1),o[0],0,0,0), C0,8); \
    KRD(GL,1); GAPB(o[1]=__builtin_amdgcn_mfma_f32_32x32x16_bf16(PAF(1),VFR(5),o[1],0,0,0), C0,12); \
    KRD(GL,2); GAPB(o[0]=__builtin_amdgcn_mfma_f32_32x32x16_bf16(PAF(2),VFR(2),o[0],0,0,0), C1,0); \
    KRD(GL,3); GAPB(o[1]=__builtin_amdgcn_mfma_f32_32x32x16_bf16(PAF(2),VFR(6),o[1],0,0,0), C1,4); \
    GAPB(o[0]=__builtin_amdgcn_mfma_f32_32x32x16_bf16(PAF(3),VFR(3),o[0],0,0,0), C1,8); \
    GAPB(o[1]=__builtin_amdgcn_mfma_f32_32x32x16_bf16(PAF(3),VFR(7),o[1],0,0,0), C1,12); \
    }while(0)
  int t=1;
  #undef CMASK
  #define CMASK(P0,P1,t) do{}while(0)
  for(;t+5<NT;t+=2){
    STEP(pB0,pB1,pA0,pA1,t,true,true,true);     WAIT_BAR(2); RESC(); ROT();
    STEP(pA0,pA1,pB0,pB1,t+1,true,true,true);   WAIT_BAR(2); RESC(); ROT();
  }
  #undef CMASK
  #define CMASK(P0,P1,t) do{int jb_=(t)-(NT-4); if(jb_>=0)cmask(P0,P1,jb_,qrel,hi);}while(0)
  #define ENDW(tt) do{ if((tt)+3<NT){WAIT_BAR(2);} else if((tt)+2<NT){WAIT_BAR(1);} else {WAIT_BAR(0);} }while(0)
  for(;t+1<NT;t+=2){
    STEP(pB0,pB1,pA0,pA1,t,(t+3<NT),(t+1<NT),(t+1<NT));       ENDW(t);   RESC(); ROT();
    STEP(pA0,pA1,pB0,pB1,t+1,(t+4<NT),(t+2<NT),(t+2<NT));     ENDW(t+1); RESC(); ROT();
  }
  STEP(pB0,pB1,pA0,pA1,NT-1,false,false,false); RESC();
  { float sacc=pB0[0]+pB0[1]; _Pragma("unroll") for(int r=2;r<16;++r)sacc+=pB0[r]; _Pragma("unroll") for(int r=0;r<16;++r)sacc+=pB1[r]; l_reg+=sacc;
    pw0=(u32x4){PKW(pB0,0),PKW(pB0,2),PKW(pB0,4),PKW(pB0,6)};pw1=(u32x4){PKW(pB0,8),PKW(pB0,10),PKW(pB0,12),PKW(pB0,14)};pw2=(u32x4){PKW(pB1,0),PKW(pB1,2),PKW(pB1,4),PKW(pB1,6)};pw3=(u32x4){PKW(pB1,8),PKW(pB1,10),PKW(pB1,12),PKW(pB1,14)};
    SBAR(); pv(o,vb0+sl_cur,PAF(0),PAF(1),PAF(2),PAF(3)); }
  #undef PKW
  #undef PAF
  #undef VFR
  #undef PIN
  #undef MX3
  #undef GAPA
  #undef GAPB
  #undef EX
  #undef VRD
  #undef KRD
  #undef STEP
  #undef ENDW
  {auto rr=__builtin_amdgcn_permlane32_swap(__float_as_uint(l_reg),__float_as_uint(l_reg),false,false);l_reg=__uint_as_float(rr[0])+__uint_as_float(rr[1]);}
  if(hi==0)wsf[32+r32]=l_reg;asm volatile("s_waitcnt lgkmcnt(0)":::"memory");
  float rli[16];
  #pragma unroll
  for(int r=0;r<16;++r)rli[r]=__builtin_amdgcn_rcpf(wsf[32+crow(r,hi)]);
  bf16*Ow=O+(rowbase+q0+wid*QBLK)*DM+h*D;
  { bf16*stg=(bf16*)(shm+LDS_OST)+wid*2048;
    #pragma unroll
    for(int r=0;r<16;++r){const int orow=crow(r,hi);
      #pragma unroll
      for(int d0=0;d0<2;++d0)stg[orow*64+d0*32+r32]=__float2bfloat16(o[d0][r]*rli[r]);}
    asm volatile("s_waitcnt lgkmcnt(0)":::"memory");
    #pragma unroll
    for(int i=0;i<4;++i){const int row=i*8+(lane>>3),ch=lane&7; const u32x4 v=*(const u32x4*)(stg+row*64+ch*8); ATTN_STORE16(Ow+(long)row*DM+ch*8,v);} }
  asm volatile("s_waitcnt lgkmcnt(0)\n\ts_barrier":::"memory");
  #undef DMA_K
  #undef DMA_V
  #undef CMASK
  #undef ABIAS
  #undef START
  #undef RESC
  #undef ROT
}
constexpr int ATTN_LDS_BYTES=LDS_BYTES;
struct AttnTensors { const bf16* Q; const bf16* K; const bf16* V; const float* KM; const float* KA; bf16* O; };
struct AttnUnit { int bh; int qb; };
struct StaticOrder {
  int vcu;
  __device__ __forceinline__ explicit StaticOrder(int grid,int block):vcu((block%8)*(grid/8)+block/8){}
  __device__ __forceinline__ bool next(int i,AttnUnit&u)const{ if(i>=4)return false; const int s=vcu&7; u.bh=vcu>>3; u.qb=(i==0)?s:(i==1)?15-s:(i==2)?16+s:31-s; return true; }
  __device__ __forceinline__ void a_ready(const AttnUnit&)const{}
  __device__ __forceinline__ void done(const AttnUnit&)const{}
};
struct QueueOrder {
  unsigned* ctr; volatile unsigned* slot; int wv;
  __device__ __forceinline__ bool next(int,AttnUnit&u)const{
    if(wv==0&&pg8::lane_now()==0)*slot=__hip_atomic_fetch_add(ctr,1u,__ATOMIC_RELAXED,__HIP_MEMORY_SCOPE_AGENT);
    asm volatile("s_waitcnt vmcnt(0) lgkmcnt(0)\n\ts_barrier":::"memory");
    const unsigned idx=(unsigned)__builtin_amdgcn_readfirstlane((int)*slot);
    if(idx>=(unsigned)(BATCH*NHEAD*NQB))return false;
    u.qb=NQB-1-(int)(idx>>5); u.bh=(int)(idx&31u); return true; }
  __device__ __forceinline__ void a_ready(const AttnUnit&)const{}
  __device__ __forceinline__ void done(const AttnUnit&)const{}
};
template<class Sched,int THRL=8> __device__ __forceinline__ void attn_phase(char*lds,const AttnTensors&T,const Sched&S,int wave_s){
  AttnUnit u;
  for(int i=0;S.next(i,u);++i){ S.a_ready(u); attn_unit<THRL>(u.bh/NHEAD,u.bh%NHEAD,u.qb,T.Q,T.K,T.V,T.KM,T.KA,T.O,lds,wave_s); S.done(u); }
}
#undef SBAR
#undef WAIT_BAR
}
constexpr size_t MiB = (size_t)1 << 20;
constexpr size_t WS_CTL = 0, CTL_ZERO_BYTES = 2 * MiB;
constexpr size_t WS_W0 = 2 * MiB;
constexpr size_t WO_IN = 0, WO_SGU = 36 * MiB, WO_MOBA = 38 * MiB, WO_POOL = 40 * MiB, WO_OUT = 42 * MiB, WO_UP = 50 * MiB, WO_DOWN = 94 * MiB;
constexpr size_t WS_SMALL = 118 * MiB;
constexpr size_t WS_MOD = WS_SMALL + 768 * 1024;
constexpr size_t WS_KMEAN = 512 * 1024;
constexpr size_t WS_KABS = 1 * MiB;
constexpr size_t WS_SGUW = WS_SMALL;
constexpr size_t WS_POOLWT = WS_SMALL + 512 * 1024;
constexpr size_t WS_MODP = 120 * MiB;
constexpr size_t WS_TOPZ = 126 * MiB, WS_BOTZ = 137 * MiB;
constexpr size_t WS_H = 148 * MiB;
constexpr size_t WS_T6 = 276 * MiB;
constexpr size_t WS_G3 = 500 * MiB;
constexpr size_t WS_Y = 276 * MiB;
constexpr size_t WS_A2 = 500 * MiB;
constexpr size_t WS_XR = 884 * MiB;
constexpr size_t WS_H8 = WS_G3 + 192 * MiB;
constexpr size_t WO_IN8 = 6 * MiB;
constexpr size_t WS_CMAX = 64 * 1024;
constexpr size_t WS_CMAXG = WS_CMAX + 96 * 1024;
constexpr size_t WS_RS1 = WS_SMALL + 1280 * 1024 + 128 * 1024;
constexpr size_t WS_RS = WS_SMALL + 1280 * 1024;
constexpr size_t WS_END = 1012 * MiB;
constexpr int CW_TMO = 0, CW_CODE = 1, CW_BAR = 4096, CW_ATTNQ = 8192;
constexpr int RING_BYTES = 131072, XB_OFF = RING_BYTES  , LDSCTL_OFF = 139264, MISC_OFF = LDSCTL_OFF + 320, LDS_BYTES = 147456;

__device__ __forceinline__ float lane_xor(float v, int lane, int o) { return __builtin_bit_cast(float, __builtin_amdgcn_ds_bpermute((lane ^ o) << 2, __builtin_bit_cast(int, v))); }
__device__ __forceinline__ float wave_sum(float v, int lane) {
#pragma unroll
    for (int o = 1; o < 64; o <<= 1) v += lane_xor(v, lane, o);
    return v;
}
__device__ __forceinline__ float wave_max(float v, int lane) {
#pragma unroll
    for (int o = 1; o < 64; o <<= 1) v = fmaxf(v, lane_xor(v, lane, o));
    return v;
}
typedef unsigned u32x2v __attribute__((ext_vector_type(2)));
__device__ __forceinline__ void transpose_item(const float* W, int K, int N, bf16* WT, bool upperm, LAS float* scr, int item, int lane, int f8split = 1 << 30, unsigned char* W8 = nullptr, const unsigned* cmax8 = nullptr, const unsigned* cmaxg = nullptr) {
    const int nblk = N / 32, kb = item / nblk, nb = item % nblk, k0 = 64 * kb, n0 = 32 * nb;
    int drow0 = n0;
    if (upperm) drow0 = (n0 < DFF) ? (n0 >> 7) * 256 + (n0 & 127) : ((n0 - DFF) >> 7) * 256 + 128 + ((n0 - DFF) & 127);
    float v[32];
    const float* src = W + (size_t)(k0 + (lane >> 5)) * N + n0 + (lane & 31);
#pragma unroll
    for (int i = 0; i < 32; ++i) v[i] = __builtin_nontemporal_load(src + (size_t)(2 * i) * N);
#pragma unroll
    for (int i = 0; i < 32; ++i) scr[(2 * i + (lane >> 5)) * 33 + (lane & 31)] = v[i];
    LDS_WAIT(); asm volatile("" ::: "memory");
    const int c = lane & 7;
    if (cmax8) {
#pragma unroll
        for (int j = 0; j < 4; ++j) { const int n = (lane >> 3) + 8 * j; const LAS float* s = scr + (8 * c) * 33 + n;
            const unsigned cb = cmax8[n0 + n]; const float cmx = __builtin_bit_cast(float, cb); const float inv = cmx > 0.f ? 127.0f / cmx : 0.f;
            u32x2v o; o.x = q8x4(s[0 * 33], s[1 * 33], s[2 * 33], s[3 * 33], inv); o.y = q8x4(s[4 * 33], s[5 * 33], s[6 * 33], s[7 * 33], inv);
            *(GAS u32x2v*)((unsigned char*)WT + (size_t)(drow0 + n) * K + k0 + 8 * c) = o; }
    } else if (n0 >= f8split) {
#pragma unroll
        for (int j = 0; j < 4; ++j) { const int n = (lane >> 3) + 8 * j; const LAS float* s = scr + (8 * c) * 33 + n;
            const unsigned cb = cmaxg[n0 - f8split + n]; const float cmx = __builtin_bit_cast(float, cb); const float inv = cmx > 0.f ? 127.0f / cmx : 0.f;
            u32x2v o; o.x = q8x4(s[0 * 33], s[1 * 33], s[2 * 33], s[3 * 33], inv); o.y = q8x4(s[4 * 33], s[5 * 33], s[6 * 33], s[7 * 33], inv);
            *(GAS u32x2v*)(W8 + (size_t)(n0 - f8split + n) * K + k0 + 8 * c) = o; }
    } else {
#pragma unroll
    for (int j = 0; j < 4; ++j) { const int n = (lane >> 3) + 8 * j; const LAS float* s = scr + (8 * c) * 33 + n;
        v4u o; o.x = pg8::cvt_pk_bf16(s[0 * 33], s[1 * 33]); o.y = pg8::cvt_pk_bf16(s[2 * 33], s[3 * 33]); o.z = pg8::cvt_pk_bf16(s[4 * 33], s[5 * 33]); o.w = pg8::cvt_pk_bf16(s[6 * 33], s[7 * 33]);
        __builtin_nontemporal_store(o, (GAS v4u*)(WT + (size_t)(drow0 + n) * K + k0 + 8 * c)); }
    }
    LDS_WAIT(); asm volatile("" ::: "memory");
}

template <bool NTST> __device__ __forceinline__ void strip_quant(const float* W, int N, unsigned char* WT8, bool upperm, unsigned* cmax_out, LAS unsigned char* lds, int strip, int lane, int wave) {
    const int n0 = 32 * strip;
    int drow0 = n0;
    if (upperm) drow0 = (n0 < DFF) ? (n0 >> 7) * 256 + (n0 & 127) : ((n0 - DFF) >> 7) * 256 + 128 + ((n0 - DFF) & 127);
    LAS float* scr = (LAS float*)(lds + wave * 8448);
    LAS float* cmx = (LAS float*)(lds + 8 * 8448);
    float v[4][32];
#pragma unroll
    for (int b = 0; b < 4; ++b) { const float* src = W + (size_t)((4 * wave + b) * 64 + (lane >> 5)) * N + n0 + (lane & 31);
#pragma unroll
        for (int i = 0; i < 32; ++i) v[b][i] = __builtin_nontemporal_load(src + (size_t)(2 * i) * N); }
    float m = 0.f;
#pragma unroll
    for (int b = 0; b < 4; ++b)
#pragma unroll
        for (int i = 0; i < 32; ++i) m = fmaxf(m, __builtin_fabsf(v[b][i]));
    m = fmaxf(m, lane_xor(m, lane, 32));
    if (lane < 32) cmx[wave * 32 + lane] = m;
    __syncthreads();
    const int c = lane & 7;
    float inv[4];
#pragma unroll
    for (int j = 0; j < 4; ++j) { const int n = (lane >> 3) + 8 * j; float mm = 0.f;
#pragma unroll
        for (int w = 0; w < 8; ++w) mm = fmaxf(mm, cmx[w * 32 + n]);
        inv[j] = mm > 0.f ? 127.0f / mm : 0.f;
        if (wave == 0 && c == 0) cmax_out[n0 + n] = __builtin_bit_cast(unsigned, mm); }
#pragma unroll
    for (int b = 0; b < 4; ++b) { const int k0 = (4 * wave + b) * 64;
#pragma unroll
        for (int i = 0; i < 32; ++i) scr[(2 * i + (lane >> 5)) * 33 + (lane & 31)] = v[b][i];
        LDS_WAIT(); asm volatile("" ::: "memory");
#pragma unroll
        for (int j = 0; j < 4; ++j) { const int n = (lane >> 3) + 8 * j; const LAS float* sp = scr + (8 * c) * 33 + n;
            u32x2v o; o.x = q8x4(sp[0 * 33], sp[1 * 33], sp[2 * 33], sp[3 * 33], inv[j]); o.y = q8x4(sp[4 * 33], sp[5 * 33], sp[6 * 33], sp[7 * 33], inv[j]);
            if (NTST) __builtin_nontemporal_store(o, (GAS u32x2v*)(WT8 + (size_t)(drow0 + n) * DM + k0 + 8 * c)); else *(GAS u32x2v*)(WT8 + (size_t)(drow0 + n) * DM + k0 + 8 * c) = o; }
        LDS_WAIT(); asm volatile("" ::: "memory"); }
    __syncthreads();
}

template <int MODE, bool XIN_BF16, bool XOUT_BF16, bool H8OUT = false, bool HQOUT = false>
__device__ __forceinline__ void thin_phase(LAS unsigned char* lds, int tid, int lane, int wave, int bx, int G,
        const void* xin_, const bf16* yin, void* xout_, bf16* hout, unsigned char* hout8, float* rsout,
        const float* modA, const float* gA, const float* modS, const float* modT, const float* gS) {
    LAS float* vA = (LAS float*)lds; LAS float* vS = vA + 2048; LAS float* vT = vS + 2048;
    for (int rb = bx; rb < M / 128; rb += G) {
        const int b = rb >> 6;
        __syncthreads();
        for (int c = tid; c < DM; c += 512) {
            if (MODE != 0) vA[c] = modA[(size_t)b * 12288 + c] * gA[c];
            if (MODE != 2) { vS[c] = gS[c] * (1.0f + modS[(size_t)b * 12288 + c]); vT[c] = modT[(size_t)b * 12288 + c]; }
        }
        __syncthreads();
        for (int i = 0; i < 8; ++i) {
            size_t ro[2]; f32x4 x[2][8]; uint2 yr[2][8];
#pragma unroll
            for (int r = 0; r < 2; ++r) { ro[r] = (size_t)(rb * 128 + wave * 16 + i + 8 * r) * DM + 4 * lane;
#pragma unroll
                for (int j = 0; j < 8; ++j) {
                    if (XIN_BF16) { const u32x2v w = __builtin_nontemporal_load((const u32x2v*)((const bf16*)xin_ + ro[r] + 256 * j)); x[r][j] = (f32x4){bf_lo(w.x), bf_hi(w.x), bf_lo(w.y), bf_hi(w.y)}; }
                    else x[r][j] = __builtin_nontemporal_load((const f32x4*)((const float*)xin_ + ro[r] + 256 * j));
                    if (MODE != 0) { const u32x2v w = __builtin_nontemporal_load((const u32x2v*)(yin + ro[r] + 256 * j)); yr[r][j].x = w.x; yr[r][j].y = w.y; } } }
            asm volatile("" ::: "memory");
            if (MODE != 0) {
                float ss[2];
#pragma unroll
                for (int r = 0; r < 2; ++r) { ss[r] = 0.f;
#pragma unroll
                    for (int j = 0; j < 8; ++j) { const float y0 = bf_lo(yr[r][j].x), y1 = bf_hi(yr[r][j].x), y2 = bf_lo(yr[r][j].y), y3 = bf_hi(yr[r][j].y); ss[r] += (y0 * y0 + y1 * y1) + (y2 * y2 + y3 * y3); } }
#pragma unroll
                for (int o = 1; o < 64; o <<= 1) { const float t0 = lane_xor(ss[0], lane, o), t1 = lane_xor(ss[1], lane, o); ss[0] += t0; ss[1] += t1; }
#pragma unroll
                for (int r = 0; r < 2; ++r) { const float rstd = 1.0f / __builtin_sqrtf(ss[r] * (1.0f / DM) + EPS);
#pragma unroll
                    for (int j = 0; j < 8; ++j) { const f32x4 a = *(const LAS f32x4*)(vA + 4 * lane + 256 * j);
                        const f32x4 y = (f32x4){bf_lo(yr[r][j].x), bf_hi(yr[r][j].x), bf_lo(yr[r][j].y), bf_hi(yr[r][j].y)}; x[r][j] = x[r][j] + a * (y * rstd);
                        if (XOUT_BF16) { u32x2v w; w.x = pk2(x[r][j][0], x[r][j][1]); w.y = pk2(x[r][j][2], x[r][j][3]); __builtin_nontemporal_store(w, (u32x2v*)((bf16*)xout_ + ro[r] + 256 * j)); }
                        else __builtin_nontemporal_store(x[r][j], (f32x4*)((float*)xout_ + ro[r] + 256 * j)); } }
            }
            if (MODE != 2) {
                float ss[2];
#pragma unroll
                for (int r = 0; r < 2; ++r) { ss[r] = 0.f;
#pragma unroll
                    for (int j = 0; j < 8; ++j) ss[r] += (x[r][j][0] * x[r][j][0] + x[r][j][1] * x[r][j][1]) + (x[r][j][2] * x[r][j][2] + x[r][j][3] * x[r][j][3]); }
#pragma unroll
                for (int o = 1; o < 64; o <<= 1) { const float t0 = lane_xor(ss[0], lane, o), t1 = lane_xor(ss[1], lane, o); ss[0] += t0; ss[1] += t1; }
                if (HQOUT || H8OUT) {
                    float mx[2];
#pragma unroll
                    for (int r = 0; r < 2; ++r) { const float rstd = 1.0f / __builtin_sqrtf(ss[r] * (1.0f / DM) + EPS); mx[r] = 0.f;
#pragma unroll
                        for (int j = 0; j < 8; ++j) { const f32x4 sv = *(const LAS f32x4*)(vS + 4 * lane + 256 * j), tv = *(const LAS f32x4*)(vT + 4 * lane + 256 * j);
                            const f32x4 h = x[r][j] * rstd * sv + tv; x[r][j] = h;
                            mx[r] = fmaxf(fmaxf(mx[r], fmaxf(__builtin_fabsf(h[0]), __builtin_fabsf(h[1]))), fmaxf(__builtin_fabsf(h[2]), __builtin_fabsf(h[3]))); } }
#pragma unroll
                    for (int o = 1; o < 64; o <<= 1) { const float t0 = lane_xor(mx[0], lane, o), t1 = lane_xor(mx[1], lane, o); mx[0] = fmaxf(mx[0], t0); mx[1] = fmaxf(mx[1], t1); }
#pragma unroll
                    for (int r = 0; r < 2; ++r) { const float inv = mx[r] > 0.f ? 127.0f / mx[r] : 0.f;
                        if (lane == 0) rsout[ro[r] / DM] = mx[r] * (1.0f / 127.0f);
                        unsigned char* qdst = HQOUT ? (unsigned char*)hout : hout8;
#pragma unroll
                        for (int j = 0; j < 8; ++j) { *(unsigned*)(qdst + ro[r] + 256 * j) = q8x4(x[r][j][0], x[r][j][1], x[r][j][2], x[r][j][3], inv);
                            if (!HQOUT) { uint2 w; w.x = pk2(x[r][j][0], x[r][j][1]); w.y = pk2(x[r][j][2], x[r][j][3]); *(uint2*)(hout + ro[r] + 256 * j) = w; } } }
                } else
#pragma unroll
                for (int r = 0; r < 2; ++r) { const float rstd = 1.0f / __builtin_sqrtf(ss[r] * (1.0f / DM) + EPS);
#pragma unroll
                    for (int j = 0; j < 8; ++j) { const f32x4 sv = *(const LAS f32x4*)(vS + 4 * lane + 256 * j), tv = *(const LAS f32x4*)(vT + 4 * lane + 256 * j);
                        const f32x4 h = x[r][j] * rstd * sv + tv; uint2 w; w.x = pk2(h[0], h[1]); w.y = pk2(h[2], h[3]); *(uint2*)(hout + ro[r] + 256 * j) = w; } }
            }
        }
    }
    __syncthreads();
}

typedef float f32x16_t __attribute__((ext_vector_type(16)));
constexpr int VNT_LD = 136;
__device__ __forceinline__ void sgu_mfma_chunk(LAS unsigned char* lds, int chunk, const bf16* Vt, const bf16* Ut, bf16* Uo, const float* norm_g, const bf16* Wm  , const float* sgu_b, int lane, int wave) {
    LAS unsigned short* vnT = (LAS unsigned short*)lds;
    const int t0 = chunk * 128;
    float g8[8];
#pragma unroll
    for (int e = 0; e < 8; ++e) g8[e] = norm_g[lane + 64 * e];
    for (int i4 = 0; i4 < 4; ++i4) {
        float v[4][8];
#pragma unroll
        for (int i = 0; i < 4; ++i) { const bf16* vr = Vt + (size_t)(t0 + wave * 16 + i4 * 4 + i) * BW + lane;
#pragma unroll
            for (int e = 0; e < 8; ++e) v[i][e] = bf2f(__builtin_nontemporal_load(vr + 64 * e)); }
#pragma unroll
        for (int i = 0; i < 4; ++i) { const int s = wave * 16 + i4 * 4 + i; float sum = 0.f;
#pragma unroll
            for (int e = 0; e < 8; ++e) sum += v[i][e];
            const float mu = wave_sum(sum, lane) * (1.0f / BW); float q = 0.f;
#pragma unroll
            for (int e = 0; e < 8; ++e) { v[i][e] -= mu; q += v[i][e] * v[i][e]; }
            const float rstd = 1.0f / __builtin_sqrtf(wave_sum(q, lane) * (1.0f / BW) + EPS);
#pragma unroll
            for (int e = 0; e < 8; ++e) vnT[(lane + 64 * e) * VNT_LD + s] = (unsigned short)f2bf(v[i][e] * rstd * g8[e]); }
    }
    __syncthreads();
    const int r32 = lane & 31, hi = lane >> 5, g = wave;
    f32x16_t acc[4][2];
#pragma unroll
    for (int ti = 0; ti < 4; ++ti)
#pragma unroll
        for (int dj = 0; dj < 2; ++dj)
#pragma unroll
            for (int r = 0; r < 16; ++r) acc[ti][dj][r] = 0.f;
    const bf16* Wg = Wm + (size_t)g * 16384 + (size_t)r32 * 128 + 8 * hi;
    const LAS unsigned short* vb = vnT + (64 * g + r32) * VNT_LD + 8 * hi;
#pragma unroll
    for (int ks = 0; ks < 8; ++ks) {
        const bf16x8 b0 = *(const LAS bf16x8*)(vb + 16 * ks), b1 = *(const LAS bf16x8*)(vb + 32 * VNT_LD + 16 * ks);
#pragma unroll
        for (int ti = 0; ti < 4; ++ti) if (16 * ks <= 32 * ti + 31) {
            const bf16x8 a = *(const bf16x8*)(Wg + (size_t)ti * 32 * 128 + 16 * ks);
            acc[ti][0] = __builtin_amdgcn_mfma_f32_32x32x16_bf16(b0, a, acc[ti][0], 0, 0, 0);
            acc[ti][1] = __builtin_amdgcn_mfma_f32_32x32x16_bf16(b1, a, acc[ti][1], 0, 0, 0); }
    }
#pragma unroll
    for (int ti = 0; ti < 4; ++ti) { const int t = 32 * ti + r32; const float bs = sgu_b[g * 128 + t];
#pragma unroll
        for (int dj = 0; dj < 2; ++dj)
#pragma unroll
            for (int rg = 0; rg < 4; ++rg) { const size_t o = (size_t)(t0 + t) * BW + 64 * g + 32 * dj + 8 * rg + 4 * hi;
                const u32x2v uu = __builtin_nontemporal_load((const u32x2v*)(Ut + o)); uint2 w;
                w.x = pk2(bf_lo(uu.x) * (acc[ti][dj][4 * rg + 0] + bs), bf_hi(uu.x) * (acc[ti][dj][4 * rg + 1] + bs)); w.y = pk2(bf_lo(uu.y) * (acc[ti][dj][4 * rg + 2] + bs), bf_hi(uu.y) * (acc[ti][dj][4 * rg + 3] + bs));
                *(uint2*)(Uo + o) = w; } }
    __syncthreads();
}

constexpr int PA_LD = 520;
template <int W> __device__ __forceinline__ void pool_window(LAS unsigned short* pa, const bf16* ZP, int t0, int c) {
    float z[64 + W - 1];
    const int pos0 = t0 & (SEQ - 1);
#pragma unroll
    for (int i = 0; i < 64 + W - 1; ++i) { const int dt = i - (W - 1); z[i] = (pos0 + dt >= 0) ? bf2f(__builtin_nontemporal_load(ZP + (size_t)(t0 + dt) * BW + c)) : 0.f; }
#pragma unroll
    for (int tl = 0; tl < 64; ++tl) { float s = 0.f;
#pragma unroll
        for (int i = 0; i < W; ++i) s += z[tl + (W - 1) - i];
        const int pos = pos0 + tl; const float cnt = (float)((pos + 1 < W) ? pos + 1 : W);
        pa[tl * PA_LD + c] = (unsigned short)f2bf(s / cnt - z[tl + W - 1]); }
}
__device__ __forceinline__ void pool_mfma_tile(LAS unsigned char* lds, int tile, const bf16* ZP, bf16* YPo, const bf16* PWT  , const float* pool_scale, int tid, int lane, int wave) {
    LAS unsigned short* pa = (LAS unsigned short*)lds;
    const int t0 = tile * 64, c = tid, gsel = wave >> 1;
    if (gsel == 0) pool_window<2>(pa, ZP, t0, c); else if (gsel == 1) pool_window<4>(pa, ZP, t0, c); else if (gsel == 2) pool_window<8>(pa, ZP, t0, c); else pool_window<16>(pa, ZP, t0, c);
    __syncthreads();
    const int r32 = lane & 31, hi = lane >> 5, g = wave >> 1, dh = wave & 1;
    f32x16_t acc[2][2];
#pragma unroll
    for (int ti = 0; ti < 2; ++ti)
#pragma unroll
        for (int dj = 0; dj < 2; ++dj)
#pragma unroll
            for (int r = 0; r < 16; ++r) acc[ti][dj][r] = 0.f;
    const bf16* Bg = PWT + ((size_t)g * 128 + 64 * dh + r32) * 128 + 8 * hi;
    const LAS unsigned short* ab = pa + r32 * PA_LD + 128 * g + 8 * hi;
#pragma unroll
    for (int ks = 0; ks < 8; ++ks) {
        const bf16x8 b0 = *(const bf16x8*)(Bg + 16 * ks), b1 = *(const bf16x8*)(Bg + (size_t)32 * 128 + 16 * ks);
        const bf16x8 a0 = *(const LAS bf16x8*)(ab + 16 * ks), a1 = *(const LAS bf16x8*)(ab + 32 * PA_LD + 16 * ks);
        acc[0][0] = __builtin_amdgcn_mfma_f32_32x32x16_bf16(b0, a0, acc[0][0], 0, 0, 0); acc[0][1] = __builtin_amdgcn_mfma_f32_32x32x16_bf16(b1, a0, acc[0][1], 0, 0, 0);
        acc[1][0] = __builtin_amdgcn_mfma_f32_32x32x16_bf16(b0, a1, acc[1][0], 0, 0, 0); acc[1][1] = __builtin_amdgcn_mfma_f32_32x32x16_bf16(b1, a1, acc[1][1], 0, 0, 0);
    }
#pragma unroll
    for (int dj = 0; dj < 2; ++dj)
#pragma unroll
        for (int rg = 0; rg < 4; ++rg) { const int oc = 128 * g + 64 * dh + 32 * dj + 8 * rg + 4 * hi; const f32x4 sc = *(const f32x4*)(pool_scale + oc);
#pragma unroll
            for (int ti = 0; ti < 2; ++ti) { uint2 w; w.x = pk2(acc[ti][dj][4 * rg + 0] * sc[0], acc[ti][dj][4 * rg + 1] * sc[1]); w.y = pk2(acc[ti][dj][4 * rg + 2] * sc[2], acc[ti][dj][4 * rg + 3] * sc[3]);
                *(uint2*)(YPo + (size_t)(t0 + 32 * ti + r32) * BW + oc) = w; } }
    __syncthreads();
}

#ifndef NREP_GEMM
#define NREP_GEMM 1
#endif
#ifndef WGM_WIDE
#define WGM_WIDE 4
#endif
#ifndef WGM_NARROW
#define WGM_NARROW 4
#endif
#ifndef GP_ALIGN
#define GP_ALIGN true
#endif
#ifndef GP_SP2
#define GP_SP2 true
#endif
#ifndef PROBE_BAR2
#define PROBE_BAR2 0
#endif
#ifndef NREP_P0
#define NREP_P0 1
#endif
#ifndef NREP_ATTN
#define NREP_ATTN 1
#endif
#ifndef NREP_MIX
#define NREP_MIX 1
#endif
#ifndef NREP_THIN
#define NREP_THIN 1
#endif
#define PHASE_IDS() int tid_o = wave_s * 64 + pg8::lane_now(); asm volatile("" : "+v"(tid_o)); const int tid = tid_o, lane = tid & 63, wave = __builtin_amdgcn_readfirstlane(tid >> 6), gw = bx * NWAVES + wave, NGW = G * NWAVES; (void)lane; (void)gw; (void)NGW; (void)wave
struct Args { const float* in[23]; float* out; unsigned char* ws; };
__global__ void __launch_bounds__(NWAVES * 64, 2) fwd_kernel(Args args) {
    extern __shared__ __attribute__((aligned(16))) unsigned char lds_raw[];
    LAS unsigned char* lds = (LAS unsigned char*)lds_raw;
    const int G = gridDim.x, bx = blockIdx.x;
    int wave_s = __builtin_amdgcn_readfirstlane((int)(threadIdx.x >> 6)); asm volatile("" : "+s"(wave_s));
    gu32* ctl = (gu32*)(args.ws + WS_CTL);
    for (int u = threadIdx.x; u < (LDS_BYTES - LDSCTL_OFF) / 4; u += NWAVES * 64) ((LAS unsigned*)(lds + LDSCTL_OFF))[u] = 0u;
    __syncthreads();
    volatile LAS unsigned* MISC = (volatile LAS unsigned*)(lds + MISC_OFF);
    XcdBarrier bar = xcd_barrier_post((unsigned*)(ctl + CW_BAR), MISC + 8);
#define GRID_BAR() do { XcdBarrier b_ = bar; asm volatile("" : "+s"(b_.x), "+s"(b_.bar)); xcd_barrier(b_); if (PROBE_BAR2) xcd_barrier(b_); } while (0)
    const volatile __attribute__((address_space(4))) unsigned long long* kargs = (const volatile __attribute__((address_space(4))) unsigned long long*)__builtin_amdgcn_kernarg_segment_ptr();
#define INP(i) ((const float*)(const GAS float*)kargs[(i)])
#define OUTP ((float*)(GAS float*)kargs[23])
#define WSB ((unsigned char*)(GAS unsigned char*)kargs[24])
#define in_x INP(0)
#define in_c INP(1)
#define g_pre_mix INP(2)
#define g_post_mix INP(3)
#define g_pre_ffn INP(4)
#define g_post_ffn INP(5)
#define w_ada INP(6)
#define b_ada INP(7)
#define w_in INP(8)
#define b_in INP(9)
#define sgu_norm_g INP(10)
#define sgu_w INP(11)
#define sgu_b INP(12)
#define pool_w INP(13)
#define pool_scale INP(14)
#define w_sgu_out INP(15)
#define w_moba_out INP(16)
#define w_pool_out INP(17)
#define w_out INP(18)
#define w_up INP(19)
#define w_conv INP(20)
#define b_conv INP(21)
#define w_down INP(22)
#define out OUTP
#define MOD ((float*)(WSB + WS_MOD))
#define MODP ((float*)(WSB + WS_MODP))
#define KMEAN ((float*)(WSB + WS_KMEAN))
#define H ((bf16*)(WSB + WS_H))
#define T6 ((bf16*)(WSB + WS_T6))
#define G3 ((unsigned char*)(WSB + WS_G3))
#define H8 ((unsigned char*)(WSB + WS_H8))
#define Yb ((bf16*)(WSB + WS_Y))
#define XR ((bf16*)(WSB + WS_XR))
#define A2 ((bf16*)(WSB + WS_A2))
#define Ut T6
#define Qt (T6 + (size_t)1 * M * BW)
#define YP (T6 + (size_t)2 * M * BW)
#define Vt (T6 + (size_t)3 * M * BW)
#define Kt (T6 + (size_t)4 * M * BW)
#define VAt (T6 + (size_t)5 * M * BW)
#define ZPt (T6 + (size_t)6 * M * BW)

    for (int rep0_ = 0; rep0_ < NREP_P0; ++rep0_) {
    {   PHASE_IDS();
        LAS float* cond = (LAS float*)(lds + 69632);
        for (int i = tid; i < BATCH * DM; i += NWAVES * 64) { const float c = in_c[i]; cond[i] = c * sigmoid_f(c); }
        __syncthreads();
        for (int w0 = gw; w0 < 1536 + 64 * NWAVES; w0 += NGW) { const int wt = w0 - 64 * NWAVES; if (wt < 0) continue;
            const int ks = wt / 96, cb = wt % 96, l = cb / 48, n0 = (cb % 48) * 256 + 4 * lane;
            const float* wp = w_ada + ((size_t)l * DM + ks * 128) * 12288 + n0;
            f32x4 a0 = {0.f, 0.f, 0.f, 0.f}, a1 = a0, a2 = a0, a3 = a0;
#pragma unroll 8
            for (int k = 0; k < 128; ++k) { const f32x4 w = __builtin_nontemporal_load((const f32x4*)(wp + (size_t)k * 12288)); const int kk = ks * 128 + k;
                a0 += cond[kk] * w; a1 += cond[DM + kk] * w; a2 += cond[2 * DM + kk] * w; a3 += cond[3 * DM + kk] * w; }
            float* pp = MODP + (size_t)(ks * 8 + l * 4) * 12288 + n0;
            *(f32x4*)(pp) = a0; *(f32x4*)(pp + 12288) = a1; *(f32x4*)(pp + 2 * 12288) = a2; *(f32x4*)(pp + 3 * 12288) = a3;
        }
        LAS float* scr = (LAS float*)(lds + wave * 8448);
#define CONVERT_ITEMS(l, WB, LO, HI, SLOT, NSLOT) \
        for (int it = (LO) + (SLOT) * NWAVES + wave; it < (HI); it += (NSLOT) * NWAVES) { int r = it; \
            bf16* Wc = (bf16*)(WB); \
            if (r < 9216) { transpose_item(w_in + (size_t)(l) * DM * INW, DM, INW, (bf16*)((unsigned char*)Wc + WO_IN), false, scr, r, lane, 0, (unsigned char*)Wc + WO_IN, nullptr, (const unsigned*)(WSB + WS_CMAXG) + (size_t)(l) * 9216); continue; } r -= 9216; \
            if (r < 512) { transpose_item(w_sgu_out + (size_t)(l) * BW * DM, BW, DM, (bf16*)((unsigned char*)Wc + WO_SGU), false, scr, r, lane); continue; } r -= 512; \
            if (r < 512) { transpose_item(w_moba_out + (size_t)(l) * BW * DM, BW, DM, (bf16*)((unsigned char*)Wc + WO_MOBA), false, scr, r, lane); continue; } r -= 512; \
            if (r < 512) { transpose_item(w_pool_out + (size_t)(l) * BW * DM, BW, DM, (bf16*)((unsigned char*)Wc + WO_POOL), false, scr, r, lane); continue; } r -= 512; \
            if (r < 2048) { transpose_item(w_out + (size_t)(l) * DM * DM, DM, DM, (bf16*)((unsigned char*)Wc + WO_OUT), false, scr, r, lane); continue; } r -= 2048; \
            if (r < 11264) { transpose_item(w_up + (size_t)(l) * DM * NUP, DM, NUP, (bf16*)((unsigned char*)Wc + WO_UP), true, scr, r, lane, 1 << 30, nullptr, (const unsigned*)(WSB + WS_CMAX) + (size_t)(l) * NUP); continue; } r -= 11264; \
            transpose_item(w_down + (size_t)(l) * DFF * DM, DFF, DM, (bf16*)((unsigned char*)Wc + WO_DOWN), false, scr, r, lane); \
        }
#define QUANT_STRIPS(l, WB, S0, S1, SLOT, NSLOT, NT) { __syncthreads(); \
          for (int st = (S0) + (SLOT); st < (S1); st += (NSLOT)) { \
              if (st < 288) strip_quant<NT>(w_in + (size_t)(l) * DM * INW, INW, (WB) + WO_IN, false, (unsigned*)(WSB + WS_CMAXG) + (size_t)(l) * 9216, lds, st, lane, wave); \
              else strip_quant<NT>(w_up + (size_t)(l) * DM * NUP, NUP, (WB) + WO_UP, true, (unsigned*)(WSB + WS_CMAX) + (size_t)(l) * NUP, lds, st - 288, lane, wave); } }
        QUANT_STRIPS(0, WSB + WS_W0, 0, 288, bx, G, false)
        { bf16* SW = (bf16*)(WSB + WS_SGUW); bf16* PW = (bf16*)(WSB + WS_POOLWT); const float* sw = sgu_w; const float* pw = pool_w;
          for (int i = bx * NWAVES * 64 + tid; i < 2 * 8 * 16384; i += G * NWAVES * 64) { const int t = (i >> 7) & 127, sI = i & 127; SW[i] = (bf16)((sI <= t) ? f2bf(sw[i]) : 0u); }
          for (int i = bx * NWAVES * 64 + tid; i < 2 * 4 * 16384; i += G * NWAVES * 64) { const int lg = i >> 14, d = (i >> 7) & 127, cI = i & 127; PW[i] = (bf16)f2bf(pw[(size_t)lg * 16384 + cI * 128 + d]); } }
        GRID_BAR();
    }
    {   PHASE_IDS();
        for (int v = bx * NWAVES * 64 + tid; v < 2 * BATCH * 12288; v += G * NWAVES * 64) {
            const int lb = v / 12288, n = v % 12288; float s = b_ada[(size_t)(lb >> 2) * 12288 + n];
            for (int ks = 0; ks < 16; ++ks) s += MODP[(size_t)(ks * 8 + lb) * 12288 + n];
            MOD[v] = s; }
        GRID_BAR();
    }
    { PHASE_IDS(); thin_phase<0, false, false, false, true>(lds, tid, lane, wave, bx, G, in_x, nullptr, nullptr, (bf16*)H8, nullptr, (float*)(WSB + WS_RS1), nullptr, nullptr, MOD + 2048, MOD + 0, g_pre_mix); }
    GRID_BAR();
    }

    for (int l = 0; l < DEPTH; ++l) {
#define Wl (l == 0 ? WSB + WS_W0 : (unsigned char*)OUTP)
#define modl (MOD + (size_t)l * BATCH * 12288)
        for (int rep_ = 0; rep_ < NREP_GEMM; ++rep_)
        { { pg8::Gemm g{(const bf16*)H8, (const bf16*)(Wl + WO_IN), M, 3072, DM / 2}; pg8::StaticOrder S; S.init(M, 3072, G, bx, WGM_WIDE);
            EpiInProj E{b_in + (size_t)l * INW, T6, KMEAN + (size_t)l * 65536, (unsigned*)(WSB + WS_KABS) + (size_t)l * 65536, (const float*)(WSB + WS_RS1), (const unsigned*)(WSB + WS_CMAXG) + (size_t)l * 9216};
            pg8::gemm_phase<EpiInProj, pg8::StaticOrder, GP_ALIGN, GP_SP2, false, true>(lds, g, S, E, wave_s); }
          GRID_BAR(); }
        { PHASE_IDS();
          for (int repa_ = NREP_ATTN - 1; repa_ >= 0; --repa_)
          { const attn_body::AttnTensors AT{(const attn_body::bf16*)Qt, (const attn_body::bf16*)Kt, (const attn_body::bf16*)VAt, KMEAN + (size_t)l * 65536, (const float*)(WSB + WS_KABS) + (size_t)l * 65536, repa_ ? (attn_body::bf16*)H : (attn_body::bf16*)Qt};
            const attn_body::QueueOrder AS{(unsigned*)(WSB + WS_CTL) + CW_ATTNQ + 64 * l + 16 * repa_, (volatile unsigned*)((char*)lds_raw + MISC_OFF + 64), wave_s};
            {
              const unsigned nent = (l == 0) ? 1536u : 1024u;
              for (;;) {
                  if (AS.wv == 0 && pg8::lane_now() == 0) *AS.slot = __hip_atomic_fetch_add(AS.ctr, 1u, __ATOMIC_RELAXED, __HIP_MEMORY_SCOPE_AGENT);
                  asm volatile("s_waitcnt vmcnt(0) lgkmcnt(0)\n\ts_barrier" ::: "memory");
                  const unsigned idx = (unsigned)__builtin_amdgcn_readfirstlane((int)*AS.slot);
                  if (idx >= nent) break;
                  unsigned a_ = idx; int bun = -1;
                  if (l == 0) { const unsigned grp = idx / 3u, rr = idx - 3u * grp; if (rr < 2u) a_ = 2u * grp + rr; else bun = (int)grp; }
                  if (bun < 0) { const int qb_ = attn_body::NQB - 1 - (int)(a_ >> 5), bh_ = (int)(a_ & 31u);
                      attn_body::attn_unit<8>(bh_ / attn_body::NHEAD, bh_ % attn_body::NHEAD, qb_, AT.Q, AT.K, AT.V, AT.KM, AT.KA, AT.O, (char*)lds_raw, wave_s); }
                  else { const int lane = pg8::lane_now(); LAS float* scr = (LAS float*)(lds + wave * 8448);
                      if (bun < 256) { const int c_ = bun; CONVERT_ITEMS(0, WSB + WS_W0, 9216, 12800, c_, 256) CONVERT_ITEMS(0, WSB + WS_W0, 24064, 29696, c_, 256) QUANT_STRIPS(0, WSB + WS_W0, 288, 640, c_, 256, true) }
                      else { const int c_ = bun - 256; CONVERT_ITEMS(1, (unsigned char*)OUTP, 9216, 12800, c_, 256) CONVERT_ITEMS(1, (unsigned char*)OUTP, 24064, 29696, c_, 256) QUANT_STRIPS(1, (unsigned char*)OUTP, 0, 640, c_, 256, true) }
                      __syncthreads(); }
              } } }
          __syncthreads();
          for (int repm_ = NREP_MIX - 1; repm_ >= 0; --repm_) {
          for (int chunk = bx; chunk < M / 128; chunk += G) sgu_mfma_chunk(lds, chunk, Vt, Ut, repm_ ? H : Ut, sgu_norm_g + (size_t)l * BW, (const bf16*)(WSB + WS_SGUW) + (size_t)l * 8 * 16384, sgu_b + (size_t)l * 8 * 128, lane, wave);
          for (int tile = bx; tile < M / 64; tile += G) pool_mfma_tile(lds, tile, ZPt, YP, (const bf16*)(WSB + WS_POOLWT) + (size_t)l * 4 * 16384, pool_scale + (size_t)l * BW, tid, lane, wave);
          }
          GRID_BAR(); }
        for (int rep_ = 0; rep_ < NREP_GEMM; ++rep_)
        {
          { pg8::Gemm g{(const bf16*)H8, (const bf16*)(Wl + WO_IN + WO_IN8), M, 6144, DM / 2}; pg8::StaticOrder S; S.init(M, 6144, G, bx, WGM_WIDE);
            EpiGate8 E{b_in + (size_t)l * INW + 3072, G3, (const float*)(WSB + WS_RS1), (const unsigned*)(WSB + WS_CMAXG) + (size_t)l * 9216 + 3072};
            pg8::gemm_phase<EpiGate8, pg8::StaticOrder, GP_ALIGN, GP_SP2, false, true>(lds, g, S, E, wave_s); }
          GRID_BAR(); }
        for (int rep_ = 0; rep_ < NREP_GEMM; ++rep_)
        { pg8::Gemm g{Ut, (const bf16*)(Wl + WO_SGU), M, DM, BW, 3, (size_t)M * BW * 2, (size_t)2 * MiB}; pg8::StaticOrder S; S.init(M, DM, G, bx, WGM_NARROW);
          EpiBranch E{G3, H};
          pg8::gemm_phase<EpiBranch, pg8::StaticOrder, GP_ALIGN, GP_SP2>(lds, g, S, E, wave_s);
          GRID_BAR(); }
        for (int rep_ = 0; rep_ < NREP_GEMM; ++rep_)
        { pg8::Gemm g{H, (const bf16*)(Wl + WO_OUT), M, DM, DM}; pg8::StaticOrder S; S.init(M, DM, G, bx, WGM_NARROW);
          EpiPlain E{Yb, DM};
          pg8::gemm_phase<EpiPlain, pg8::StaticOrder, GP_ALIGN, GP_SP2>(lds, g, S, E, wave_s);
          GRID_BAR(); }
        for (int rept_ = 0; rept_ < (l == 0 ? NREP_THIN : 1); ++rept_)
        { PHASE_IDS(); if (l == 0) thin_phase<1, false, true, false, true>(lds, tid, lane, wave, bx, G, in_x, Yb, XR, H, nullptr, (float*)(WSB + WS_RS), modl + 4096, g_post_mix + (size_t)l * DM, modl + 8192, modl + 6144, g_pre_ffn + (size_t)l * DM);
          else thin_phase<1, true, true, false, true>(lds, tid, lane, wave, bx, G, XR, Yb, XR, H, nullptr, (float*)(WSB + WS_RS), modl + 4096, g_post_mix + (size_t)l * DM, modl + 8192, modl + 6144, g_pre_ffn + (size_t)l * DM); }
        GRID_BAR();
        for (int rep_ = 0; rep_ < NREP_GEMM; ++rep_)
        { pg8::Gemm g{H, (const bf16*)(Wl + WO_UP), M, NUP, DM / 2}; pg8::StaticOrder S; S.init(M, NUP, G, bx, WGM_WIDE);
          EpiUpConv E{A2, w_conv + (size_t)l * 3 * NUP, b_conv + (size_t)l * NUP, (float*)(WSB + WS_TOPZ), (float*)(WSB + WS_BOTZ), (LAS float*)(lds + XB_OFF), (const float*)(WSB + WS_RS), (const unsigned*)(WSB + WS_CMAX) + (size_t)l * NUP};
          pg8::gemm_phase<EpiUpConv, pg8::StaticOrder, true, GP_SP2, false, true>(lds, g, S, E, wave_s);
          GRID_BAR(); }
        { PHASE_IDS(); const float* wc = w_conv + (size_t)l * 3 * NUP; const float* bc = b_conv + (size_t)l * NUP;
          const float* TZ = (const float*)(WSB + WS_TOPZ); const float* BZ = (const float*)(WSB + WS_BOTZ); bf16* a2 = A2;
          for (int it = bx * NWAVES * 64 + tid; it < (M / 256) * DFF; it += G * NWAVES * 64) { const int pm = it / DFF, n = it % DFF; if ((pm & 31) == 0) continue;
              const int cg = (n >> 7) * 256 + (n & 127);
              float res[2];
              float zc[2][2];
#pragma unroll
              for (int k = 0; k < 2; ++k) { const int c = cg + 128 * k, pc = n + DFF * k;
                  const float t0 = TZ[((size_t)pm * 2 + 0) * NUP + c], t1 = TZ[((size_t)pm * 2 + 1) * NUP + c], b0 = BZ[((size_t)(pm - 1) * 2 + 0) * NUP + c], b1 = BZ[((size_t)(pm - 1) * 2 + 1) * NUP + c];
                  const unsigned cmb = ((const unsigned*)(WSB + WS_CMAX))[(size_t)l * NUP + pc]; const float csc = __builtin_bit_cast(float, cmb) * (1.0f / 127.0f);
                  const float w0 = wc[pc] * csc, w1 = wc[NUP + pc] * csc, w2 = wc[2 * NUP + pc] * csc, bb = bc[pc];
                  zc[k][0] = w2 * t0 + w1 * b1 + w0 * b0 + bb; zc[k][1] = w2 * t1 + w1 * t0 + w0 * b1 + bb; }
              res[0] = gelu_tanh(zc[0][0]) * zc[1][0]; res[1] = gelu_tanh(zc[0][1]) * zc[1][1];
              a2[(size_t)(pm * 256 + 0) * DFF + n] = (bf16)f2bf(res[0]); a2[(size_t)(pm * 256 + 1) * DFF + n] = (bf16)f2bf(res[1]); }
          GRID_BAR(); }
        for (int rep_ = 0; rep_ < NREP_GEMM; ++rep_)
        { pg8::Gemm g{A2, (const bf16*)(Wl + WO_DOWN), M, DM, DFF}; pg8::StaticOrder S; S.init(M, DM, G, bx, WGM_NARROW);
          EpiPlain E{Yb, DM};
          pg8::gemm_phase<EpiPlain, pg8::StaticOrder, GP_ALIGN, GP_SP2>(lds, g, S, E, wave_s);
          GRID_BAR(); }
        if (l == 0) { PHASE_IDS(); thin_phase<1, true, true, false, true>(lds, tid, lane, wave, bx, G, XR, Yb, XR, (bf16*)H8, nullptr, (float*)(WSB + WS_RS1), modl + 10240, g_post_ffn, MOD + (size_t)BATCH * 12288 + 2048, MOD + (size_t)BATCH * 12288, g_pre_mix + DM);
            GRID_BAR(); }
        else { PHASE_IDS(); thin_phase<2, true, false>(lds, tid, lane, wave, bx, G, XR, Yb, out, nullptr, nullptr, nullptr, modl + 10240, g_post_ffn + (size_t)l * DM, nullptr, nullptr, nullptr); }
    }
#undef GRID_BAR
}
#undef INP
#undef OUTP
#undef WSB
#undef in_x
#undef in_c
#undef g_pre_mix
#undef g_post_mix
#undef g_pre_ffn
#undef g_post_ffn
#undef w_ada
#undef b_ada
#undef w_in
#undef b_in
#undef sgu_norm_g
#undef sgu_w
#undef sgu_b
#undef pool_w
#undef pool_scale
#undef w_sgu_out
#undef w_moba_out
#undef w_pool_out
#undef w_out
#undef w_up
#undef w_conv
#undef b_conv
#undef w_down
#undef out
#undef MOD
#undef MODP
#undef KMEAN
#undef H
#undef T6
#undef G3
#undef H8
#undef YP
#undef Yb
#undef A2
#undef Ut
#undef Vt
#undef Qt
#undef Kt
#undef VAt
#undef ZPt
#undef Wl
#undef XR
#undef CONVERT_ITEMS
#undef QUANT_STRIPS
#undef modl

extern "C" void kernel_launch(void* const* d_in, const int* in_sizes, int n_in, void* d_out, int out_size, void* d_ws, size_t ws_size, hipStream_t stream) {
    static int grid = 0;
    if (grid == 0) {
        if (n_in != 23 || in_sizes[0] != M * DM || out_size != M * DM || ws_size < WS_END) { fprintf(stderr, "kernel_launch: unexpected shapes (n_in %d, in0 %d, out %d, ws %zu); nothing launched\n", n_in, n_in > 0 ? in_sizes[0] : -1, out_size, ws_size); grid = -1; return; }
        int dev = 0, cus = 0;
        if (hipGetDevice(&dev) != hipSuccess || hipDeviceGetAttribute(&cus, hipDeviceAttributeMultiprocessorCount, dev) != hipSuccess) { grid = -1; return; }
        if (hipFuncSetAttribute((const void*)fwd_kernel, hipFuncAttributeMaxDynamicSharedMemorySize, LDS_BYTES) != hipSuccess) { fprintf(stderr, "kernel_launch: hipFuncSetAttribute failed\n"); grid = -1; return; }
        int per_cu = 0;
        if (hipOccupancyMaxActiveBlocksPerMultiprocessor(&per_cu, (const void*)fwd_kernel, NWAVES * 64, LDS_BYTES) != hipSuccess || per_cu < 1) fprintf(stderr, "kernel_launch: occupancy query says %d\n", per_cu);
        (void)hipGetLastError();
        grid = cus;
    }
    if (grid < 0) return;
    if (hipMemsetAsync((char*)d_ws + WS_CTL, 0, CTL_ZERO_BYTES, stream) != hipSuccess) return;
    Args a{};
    for (int i = 0; i < 23; ++i) a.in[i] = (const float*)d_in[i];
    a.out = (float*)d_out; a.ws = (unsigned char*)d_ws;
    hipLaunchKernelGGL(fwd_kernel, dim3(grid), dim3(NWAVES * 64), LDS_BYTES, stream, a);
}
```

```cpp
#include <hip/hip_runtime.h>
#include <cstdio>
#include <cstdint>
namespace pg8 {
#define PG8_LAS __attribute__((address_space(3)))
typedef unsigned short bf16_t;
typedef short bf16x8 __attribute__((ext_vector_type(8)));
typedef float f32x4 __attribute__((ext_vector_type(4)));
typedef unsigned u32x4 __attribute__((ext_vector_type(4)));
__device__ __forceinline__ int lane_now() { int l; asm volatile("v_mbcnt_lo_u32_b32 %0, -1, 0\n\tv_mbcnt_hi_u32_b32 %0, -1, %0" : "=v"(l)); return l; }
typedef int i32x4 __attribute__((ext_vector_type(4)));
typedef int i32x8 __attribute__((ext_vector_type(8)));
constexpr int BM = 256, BK = 64, HALF = 128, HTB = HALF * BK * 2  , STAGE_BYTES = 8 * HTB, NXCD = 8, WGM = 8;

__host__ __device__ __forceinline__ int lds_byte(int r, int c) { const int st = (r >> 4) * 2 + (c >> 5), rr = r & 15, cc = c & 31, ob = rr * 64 + cc * 2; return st * 1024 + (ob ^ (((ob >> 9) & 1) << 5)); }
__host__ __device__ __forceinline__ void stage_rc(int b, int& R, int& C) { const int st = b / 1024, sb = b % 1024, swz = sb ^ (((sb >> 9) & 1) << 5); R = (st >> 1) * 16 + swz / 64; C = (st & 1) * 32 + (swz % 64) / 2; }
__host__ __device__ __forceinline__ int perm32(int rho) { const int n = rho >> 4, i = rho & 15; return 8 * (i >> 2) + 4 * n + (i & 3); }

struct Unit { int pm, pn; };
struct Gemm { const bf16_t* A; const bf16_t* Bt; int M, N, K; int nseg; size_t segA, segB; };

struct StaticOrder {
    int nM, nN, nwg, G, c, wgm;
    __host__ __device__ void init(int M, int N, int G_, int c_, int wgm_ = WGM) { nM = M / BM; nN = N / BM; nwg = nM * nN; G = G_; c = c_; wgm = wgm_; }
    __host__ __device__ bool next(int i, Unit& u) const {
        const long L = (long)i * G + c; if (L >= nwg) return false;
        int wgid = (int)L; { const int q = nwg / NXCD, r = nwg % NXCD, xcd = wgid % NXCD, off = wgid / NXCD; wgid = (xcd < r ? xcd * (q + 1) : r * (q + 1) + (xcd - r) * q) + off; }
        const int nig = wgm * nN, gid = wgid / nig, fm = gid * wgm, gsz = (nM - fm) < wgm ? (nM - fm) : wgm;
        u.pm = fm + ((wgid % nig) % gsz); u.pn = (wgid % nig) / gsz; return true;
    }
    __device__ __forceinline__ void a_ready(const Unit&) const {}
    __device__ __forceinline__ void done(const Unit&) const {}
};

__device__ __forceinline__ unsigned cvt_pk_bf16(float lo, float hi) { unsigned r; asm volatile("v_cvt_pk_bf16_f32 %0, %1, %2" : "=v"(r) : "v"(lo), "v"(hi)); return r; }
typedef float f32x2 __attribute__((ext_vector_type(2)));
template <class Epi, class Sched, bool ALIGN_EPI = false, bool SP2 = false, bool FP8 = false, bool I8 = false>
__device__ __forceinline__ void gemm_phase(PG8_LAS unsigned char* lds, const Gemm g, const Sched& S, const Epi& E, int wave_s) {
    int tid_l = wave_s * 64 + lane_now(); asm volatile("" : "+v"(tid_l));
    const int tid = tid_l, wid = __builtin_amdgcn_readfirstlane(tid >> 6), lane = tid & 63, wr = wid >> 2, wc = wid & 3, fr = lane & 15, fq = lane >> 4;
    const int K = g.K, nt = (K / BK) * (Epi::SEGMENTED ? g.nseg : 1);
    unsigned voffA[2], voffB[2];
#pragma unroll
    for (int i = 0; i < 2; ++i) { int R, C; stage_rc(tid * 16 + i * 8192, R, C); const int Rb = Epi::PERM ? ((R & ~31) + perm32(R & 31)) : R;
        voffA[i] = (unsigned)(R * K + C) * 2u; voffB[i] = (unsigned)(Rb * K + C) * 2u; }
    const size_t kstep = (size_t)(BK * 2);
    const size_t hstep = (size_t)HALF * K * 2;
    const size_t tstep = 2 * hstep;
    const unsigned ldsw = (unsigned)wid * 1024u;
    const int aoff = lds_byte(wr * 64 + fr, fq * 8), boff = lds_byte(wc * 32 + fr, fq * 8);
#define PG8_SA(b, h) (((b) * 2 + (h)) * HTB)
#define PG8_SB(b, h) ((4 + (b) * 2 + (h)) * HTB)
#define PG8_STAGE(bufoff, gbase, voff) do { _Pragma("unroll") for (int _i = 0; _i < 2; ++_i) { unsigned vo_ = (voff)[_i]; if constexpr (FP8 || I8) asm volatile("" : "+v"(vo_));     \
        __builtin_amdgcn_global_load_lds((const unsigned*)((const char*)(gbase) + vo_), (PG8_LAS unsigned*)(lds + (bufoff) + ldsw + _i * 8192), 16, 0, 0); } } while (0)
#define PG8_LDA(dst, b, h) do { _Pragma("unroll") for (int m = 0; m < 4; ++m) _Pragma("unroll") for (int k = 0; k < 2; ++k) dst[m][k] = *(const PG8_LAS bf16x8*)(lds + PG8_SA(b, h) + aoff + m * 2048 + k * 1024); } while (0)
#define PG8_LDB(dst, b, h) do { _Pragma("unroll") for (int n = 0; n < 2; ++n) _Pragma("unroll") for (int k = 0; k < 2; ++k) dst[n][k] = *(const PG8_LAS bf16x8*)(lds + PG8_SB(b, h) + boff + n * 2048 + k * 1024); } while (0)
#define PG8_CAT8(v) __builtin_shufflevector(__builtin_bit_cast(i32x4, (v)[0]), __builtin_bit_cast(i32x4, (v)[1]), 0, 1, 2, 3, 4, 5, 6, 7)
#define PG8_MMA(ai, bj, At, Bt) do { __builtin_amdgcn_s_setprio(1); _Pragma("unroll") for (int m = 0; m < 4; ++m) _Pragma("unroll") for (int n = 0; n < 2; ++n) { \
        if constexpr (FP8) acc[ai][bj][m][n] = __builtin_amdgcn_mfma_scale_f32_16x16x128_f8f6f4(PG8_CAT8(Bt[n]), PG8_CAT8(At[m]), acc[ai][bj][m][n], 0, 0, 0, 0, 0, 0);     \
        else if constexpr (I8) { _Pragma("unroll") for (int k = 0; k < 2; ++k) acc[ai][bj][m][n] = __builtin_bit_cast(f32x4, __builtin_amdgcn_mfma_i32_16x16x64_i8(__builtin_bit_cast(i32x4, Bt[n][k]), __builtin_bit_cast(i32x4, At[m][k]), __builtin_bit_cast(i32x4, acc[ai][bj][m][n]), 0, 0, 0)); } \
        else { _Pragma("unroll") for (int k = 0; k < 2; ++k) acc[ai][bj][m][n] = __builtin_amdgcn_mfma_f32_16x16x32_bf16(Bt[n][k], At[m][k], acc[ai][bj][m][n], 0, 0, 0); } } __builtin_amdgcn_s_setprio(0); } while (0)
#define PG8_WAIT_V(n) asm volatile("s_waitcnt vmcnt(" #n ")" ::: "memory")
#define PG8_WAIT_L(n) asm volatile("s_waitcnt lgkmcnt(" #n ")" ::: "memory")
#define PG8_BAR __builtin_amdgcn_s_barrier()
#define PG8_SCHED __builtin_amdgcn_sched_barrier(0)
    Unit cur, nxt; int ui = 0;
    if (!S.next(0, cur)) return;
    f32x4 acc[2][2][4][2];
#pragma unroll
    for (int a = 0; a < 2; ++a)
#pragma unroll
        for (int b = 0; b < 2; ++b)
#pragma unroll
            for (int m = 0; m < 4; ++m)
#pragma unroll
                for (int n = 0; n < 2; ++n) acc[a][b][m][n] = (f32x4){0.f, 0.f, 0.f, 0.f};
    bf16x8 At[4][2], B0[2][2], B1[2][2];
    const char* cA = (const char*)g.A + (size_t)cur.pm * tstep; const char* cB = (const char*)g.Bt + (size_t)cur.pn * tstep;
    S.a_ready(cur);
    if constexpr (SP2) {
        PG8_STAGE(PG8_SB(0, 0), cB, voffB); PG8_STAGE(PG8_SB(0, 1), cB + hstep, voffB); PG8_STAGE(PG8_SA(0, 0), cA, voffA); PG8_STAGE(PG8_SA(0, 1), cA + hstep, voffA);
        if (wr == 1) PG8_BAR;
        PG8_WAIT_V(2); PG8_BAR;
        PG8_STAGE(PG8_SB(1, 0), cB + kstep, voffB); PG8_STAGE(PG8_SA(1, 0), cA + kstep, voffA); PG8_STAGE(PG8_SB(1, 1), cB + hstep + kstep, voffB);
        PG8_WAIT_V(6); PG8_BAR;
    } else {
        PG8_STAGE(PG8_SB(0, 0), cB, voffB); PG8_STAGE(PG8_SA(0, 0), cA, voffA); PG8_STAGE(PG8_SB(0, 1), cB + hstep, voffB); PG8_STAGE(PG8_SA(0, 1), cA + hstep, voffA);
        if (wr == 1) PG8_BAR;
        PG8_WAIT_V(4); PG8_BAR;
        PG8_STAGE(PG8_SB(1, 0), cB + kstep, voffB); PG8_STAGE(PG8_SA(1, 0), cA + kstep, voffA); PG8_STAGE(PG8_SB(1, 1), cB + hstep + kstep, voffB);
        PG8_WAIT_V(6); PG8_BAR;
    }
    for (;;) {
        const bool has_next = S.next(ui + 1, nxt);
        const char* nA = has_next ? (const char*)g.A + (size_t)nxt.pm * tstep : cA; const char* nB = has_next ? (const char*)g.Bt + (size_t)nxt.pn * tstep : cB;
        for (int t = 0; t < nt; t += 2) {
            const bool last = (t == nt - 2);
            const char* a1; const char* a2; const char* b2;
            if constexpr (Epi::SEGMENTED) {
                constexpr int SH = Epi::SEG_SHIFT, SM = (1 << SH) - 1;
                a1 = cA + (size_t)((t + 1) >> SH) * g.segA + (size_t)((t + 1) & SM) * kstep;
                a2 = last ? nA : cA + (size_t)((t + 2) >> SH) * g.segA + (size_t)((t + 2) & SM) * kstep; b2 = last ? nB : cB + (size_t)((t + 2) >> SH) * g.segB + (size_t)((t + 2) & SM) * kstep;
                if (t != 0 && (t & SM) == 0) E.seg_hook(acc, cur, t >> SH, wr, wc, fr, fq);
            } else {
                a1 = cA + (size_t)(t + 1) * kstep;
                a2 = last ? nA : cA + (size_t)(t + 2) * kstep; b2 = last ? nB : cB + (size_t)(t + 2) * kstep;
            }
            const char* a3 = a2 + kstep; const char* b3 = b2 + kstep;
            if (last && has_next) S.a_ready(nxt);
            if constexpr (SP2) {
            PG8_LDB(B0, 0, 0); PG8_LDB(B1, 0, 1); PG8_SCHED; PG8_LDA(At, 0, 0); PG8_STAGE(PG8_SA(1, 1), a1 + hstep, voffA);
            PG8_WAIT_V(8); PG8_WAIT_L(0); PG8_BAR; PG8_MMA(0, 0, At, B0); PG8_MMA(0, 1, At, B1); PG8_BAR; PG8_SCHED;
            PG8_LDA(At, 0, 1); PG8_STAGE(PG8_SB(0, 0), b2, voffB); PG8_STAGE(PG8_SB(0, 1), b2 + hstep, voffB); PG8_STAGE(PG8_SA(0, 0), a2, voffA);
            PG8_WAIT_V(8); PG8_WAIT_L(0); PG8_BAR; PG8_MMA(1, 0, At, B0); PG8_MMA(1, 1, At, B1); PG8_BAR; PG8_SCHED;
            PG8_LDB(B0, 1, 0); PG8_LDB(B1, 1, 1); PG8_SCHED; PG8_LDA(At, 1, 0); PG8_STAGE(PG8_SA(0, 1), a2 + hstep, voffA);
            PG8_WAIT_V(8); PG8_WAIT_L(0); PG8_BAR; PG8_MMA(0, 0, At, B0); PG8_MMA(0, 1, At, B1); PG8_BAR; PG8_SCHED;
            PG8_LDA(At, 1, 1); PG8_STAGE(PG8_SB(1, 0), b3, voffB); PG8_STAGE(PG8_SB(1, 1), b3 + hstep, voffB); PG8_STAGE(PG8_SA(1, 0), a3, voffA);
            PG8_WAIT_V(8); PG8_WAIT_L(0); PG8_BAR; PG8_MMA(1, 0, At, B0); PG8_MMA(1, 1, At, B1); PG8_BAR; PG8_SCHED;
            } else {
            PG8_LDB(B0, 0, 0); PG8_SCHED; PG8_LDA(At, 0, 0); PG8_STAGE(PG8_SA(1, 1), a1 + hstep, voffA);
            PG8_WAIT_L(8); PG8_BAR; PG8_WAIT_L(0); PG8_MMA(0, 0, At, B0); PG8_BAR; PG8_SCHED;
            PG8_LDB(B1, 0, 1); PG8_STAGE(PG8_SB(0, 0), b2, voffB);
            PG8_BAR; PG8_WAIT_L(0); PG8_MMA(0, 1, At, B1); PG8_BAR;
            PG8_LDA(At, 0, 1); PG8_STAGE(PG8_SA(0, 0), a2, voffA);
            PG8_BAR; PG8_WAIT_L(0); PG8_MMA(1, 0, At, B0); PG8_BAR; PG8_SCHED;
            PG8_STAGE(PG8_SB(0, 1), b2 + hstep, voffB);
            PG8_WAIT_V(6); PG8_BAR; PG8_MMA(1, 1, At, B1); PG8_BAR;
            PG8_LDB(B0, 1, 0); PG8_SCHED; PG8_LDA(At, 1, 0); PG8_STAGE(PG8_SA(0, 1), a2 + hstep, voffA);
            PG8_WAIT_L(8); PG8_BAR; PG8_WAIT_L(0); PG8_MMA(0, 0, At, B0); PG8_BAR; PG8_SCHED;
            PG8_LDB(B1, 1, 1); PG8_STAGE(PG8_SB(1, 0), b3, voffB);
            PG8_BAR; PG8_WAIT_L(0); PG8_MMA(0, 1, At, B1); PG8_BAR;
            PG8_LDA(At, 1, 1); PG8_STAGE(PG8_SA(1, 0), a3, voffA);
            PG8_BAR; PG8_WAIT_L(0); PG8_MMA(1, 0, At, B0); PG8_BAR; PG8_SCHED;
            PG8_STAGE(PG8_SB(1, 1), b3 + hstep, voffB);
            PG8_WAIT_V(6); PG8_BAR; PG8_MMA(1, 1, At, B1); PG8_BAR;
            }
        }
        if constexpr (ALIGN_EPI) { if (wr == 0) PG8_BAR; }
        if constexpr (!Epi::AFTER_DRAIN) { E(acc, cur, wr, wc, fr, fq); S.done(cur); }
        if (!has_next) break;
#pragma unroll
        for (int a = 0; a < 2; ++a)
#pragma unroll
            for (int b = 0; b < 2; ++b)
#pragma unroll
                for (int m = 0; m < 4; ++m)
#pragma unroll
                    for (int n = 0; n < 2; ++n) acc[a][b][m][n] = (f32x4){0.f, 0.f, 0.f, 0.f};
        cur = nxt; cA = nA; cB = nB; ++ui;
        if constexpr (ALIGN_EPI) { if (wr == 1) PG8_BAR; }
    }
    PG8_WAIT_V(0);
    if constexpr (!ALIGN_EPI) { if (wr == 0) PG8_BAR; }
    PG8_BAR;
    if constexpr (Epi::AFTER_DRAIN) { E.fused(acc, cur, wr, wc, fr, fq, lds, wid, lane); S.done(cur); }
#undef PG8_SA
#undef PG8_SB
#undef PG8_STAGE
#undef PG8_LDA
#undef PG8_LDB
#undef PG8_MMA
#undef PG8_CAT8
#undef PG8_WAIT_V
#undef PG8_WAIT_L
#undef PG8_BAR
#undef PG8_SCHED
}
}
#define GAS __attribute__((address_space(1)))
#define LAS __attribute__((address_space(3)))
typedef unsigned short bf16;
typedef unsigned v4u __attribute__((ext_vector_type(4)));
typedef float f32x4 __attribute__((ext_vector_type(4)));
typedef short bf16x8 __attribute__((ext_vector_type(8)));
typedef GAS unsigned gu32;
typedef GAS unsigned long long gu64;
#define RLX_AGENT __ATOMIC_RELAXED, __HIP_MEMORY_SCOPE_AGENT
#define LDS_WAIT() asm volatile("s_waitcnt lgkmcnt(0)" ::: "memory")
#define VM_WAIT() asm volatile("s_waitcnt vmcnt(0)" ::: "memory")
__device__ __forceinline__ unsigned long long rt() { return __builtin_amdgcn_s_memrealtime(); }
__device__ __forceinline__ unsigned f2bf(float f) { unsigned u = __builtin_bit_cast(unsigned, f); return (u + 0x7fffu + ((u >> 16) & 1u)) >> 16; }
__device__ __forceinline__ unsigned pk2(float lo, float hi) { return f2bf(lo) | (f2bf(hi) << 16); }
#define XB_TMO      128
#define XB_XCNT(j)  (256  + 64 * (j))
#define XB_XSUB(j)  (1280 + 64 * (j))
#define XB_XGEN(j)  (2304 + 64 * (j))
#define XB_TOP      3328
#define XB_TOPGEN   3392
#define XCD_BAR_WORDS 3456
#define XB_SPIN_CAP (1u << 18)

__device__ __forceinline__ unsigned xb_ld(unsigned* p)              { return __hip_atomic_load(p, __ATOMIC_RELAXED, __HIP_MEMORY_SCOPE_AGENT); }
__device__ __forceinline__ unsigned xb_add(unsigned* p, unsigned v) { return __hip_atomic_fetch_add(p, v, __ATOMIC_RELAXED, __HIP_MEMORY_SCOPE_AGENT); }
__device__ __forceinline__ unsigned xb_xcc_id() { return (unsigned)__builtin_amdgcn_s_getreg((3 << 11) | 20) & 0xFu; }
#define XB_SPIN(cond, bar) do { unsigned _sp = 0; while (cond) { __builtin_amdgcn_s_sleep(1); \
    if ((++_sp & 255u) == 0u) { if (xb_ld(&(bar)[XB_TMO])) break; if (_sp > XB_SPIN_CAP) { atomicAdd(&(bar)[XB_TMO], 1u); break; } } } } while (0)

struct XcdBarrier {
    unsigned* bar; unsigned x; int wv;
    volatile LAS unsigned* st;
};

__device__ __forceinline__ XcdBarrier xcd_barrier_post(unsigned* bar, volatile LAS unsigned* st) {
    XcdBarrier b; b.bar = bar; b.x = xb_xcc_id(); b.st = st; b.wv = __builtin_amdgcn_readfirstlane((int)(threadIdx.x >> 6));
    if (threadIdx.x == 0) (void)xb_add(&bar[XB_XCNT(b.x)], 1u);
    return b;
}
__device__ __forceinline__ void xcd_barrier_complete(unsigned* bar, unsigned x, unsigned& nloc, unsigned& nx) {
    const unsigned G = gridDim.x * gridDim.y * gridDim.z;
    unsigned sum, cnt, mine, sp = 0u;
    for (;;) {
        sum = 0u; cnt = 0u; mine = 0u;
#pragma unroll
        for (unsigned j = 0; j < 16; ++j) { const unsigned c = xb_ld(&bar[XB_XCNT(j)]); sum += c; cnt += (c > 0u) ? 1u : 0u; mine = (j == x) ? c : mine; }
        if (sum == G) break;
        __builtin_amdgcn_s_sleep(1);
        if ((++sp & 255u) == 0u) { if (xb_ld(&bar[XB_TMO])) break; if (sp > XB_SPIN_CAP) { atomicAdd(&bar[XB_TMO], 1u); break; } }
    }
    nloc = mine > 0u ? mine : 1u; nx = cnt > 0u ? cnt : 1u;
}

__device__ __forceinline__ void xcd_barrier(const XcdBarrier& b) {
    asm volatile("s_waitcnt vmcnt(0)" ::: "memory");
    __syncthreads();
    if (b.wv == 0 && pg8::lane_now() == 0) {
        unsigned* bar = b.bar;
        __builtin_amdgcn_s_waitcnt(0);
        unsigned nloc = b.st[0], nx = b.st[1];
        if (nloc == 0u) { xcd_barrier_complete(bar, b.x, nloc, nx); b.st[0] = nloc; b.st[1] = nx; }
        const unsigned old = xb_add(&bar[XB_XSUB(b.x)], 1u);
        const unsigned gen = old / nloc;
        if (old + 1u == (gen + 1u) * nloc) {
            __builtin_amdgcn_fence(__ATOMIC_RELEASE, "agent");
            asm volatile("s_waitcnt vmcnt(0)" ::: "memory");
            const unsigned og = xb_add(&bar[XB_TOP], 1u);
            const unsigned tg = og / nx;
            if (og + 1u == (tg + 1u) * nx) xb_add(&bar[XB_TOPGEN], 1u);
            else XB_SPIN(xb_ld(&bar[XB_TOPGEN]) == tg, bar);
            __builtin_amdgcn_fence(__ATOMIC_ACQUIRE, "agent");
            xb_add(&bar[XB_XGEN(b.x)], 1u);
            asm volatile("s_waitcnt vmcnt(0)" ::: "memory");
        } else {
            XB_SPIN(xb_ld(&bar[XB_XGEN(b.x)]) == gen, bar);
            __builtin_amdgcn_fence(__ATOMIC_ACQUIRE, "agent");
            asm volatile("s_waitcnt vmcnt(0)" ::: "memory");
        }
    }
    __syncthreads();
}
constexpr int BATCH = 4, SEQ = 8192, DM = 2048, M = BATCH * SEQ, BW = 512, INW = 9216, DFF = 5632, NUP = 2 * DFF, DEPTH = 2;
constexpr int NWAVES = 8;
constexpr float EPS = 1e-6f;
constexpr float LOG2E = 1.4426950408889634f;
constexpr float QSCALE = 0.125f * LOG2E;

__device__ __forceinline__ float bf_lo(unsigned w) { return __builtin_bit_cast(float, w << 16); }
__device__ __forceinline__ float bf_hi(unsigned w) { return __builtin_bit_cast(float, w & 0xffff0000u); }
__device__ __forceinline__ float bf2f(unsigned short h) { return __builtin_bit_cast(float, ((unsigned)h) << 16); }
constexpr float W8_SCALE = 32.0f, W8_INV = 1.0f / 32.0f;
__device__ __forceinline__ float sigmoid_f(float v) { return __builtin_amdgcn_rcpf(1.0f + __builtin_amdgcn_exp2f(-LOG2E * v)); }
__device__ __forceinline__ unsigned gate_q4(const pg8::f32x4 x) {
    float t[4];
#pragma unroll
    for (int j = 0; j < 4; ++j) t[j] = fmaxf(__builtin_fmaf(sigmoid_f(x[j]), 255.0f, 12582912.0f), 12582913.0f);
    return __builtin_amdgcn_perm(__builtin_bit_cast(unsigned, t[1]), __builtin_bit_cast(unsigned, t[0]), 0x0c0c0400u) | __builtin_amdgcn_perm(__builtin_bit_cast(unsigned, t[3]), __builtin_bit_cast(unsigned, t[2]), 0x04000c0cu);
}
__device__ __forceinline__ unsigned q8x4(float a, float b, float c, float d, float inv) {
    const float t0 = __builtin_fmaf(a, inv, 12582912.0f), t1 = __builtin_fmaf(b, inv, 12582912.0f), t2 = __builtin_fmaf(c, inv, 12582912.0f), t3 = __builtin_fmaf(d, inv, 12582912.0f);
    return __builtin_amdgcn_perm(__builtin_bit_cast(unsigned, t1), __builtin_bit_cast(unsigned, t0), 0x0c0c0400u) | __builtin_amdgcn_perm(__builtin_bit_cast(unsigned, t3), __builtin_bit_cast(unsigned, t2), 0x04000c0cu);
}
__device__ __forceinline__ float ub0(unsigned q) { float r; asm("v_cvt_f32_ubyte0 %0, %1" : "=v"(r) : "v"(q)); return r; }
__device__ __forceinline__ float ub1(unsigned q) { float r; asm("v_cvt_f32_ubyte1 %0, %1" : "=v"(r) : "v"(q)); return r; }
__device__ __forceinline__ float ub2(unsigned q) { float r; asm("v_cvt_f32_ubyte2 %0, %1" : "=v"(r) : "v"(q)); return r; }
__device__ __forceinline__ float ub3(unsigned q) { float r; asm("v_cvt_f32_ubyte3 %0, %1" : "=v"(r) : "v"(q)); return r; }
__device__ __forceinline__ pg8::f32x4 gate_ratio4(unsigned a, unsigned b) { pg8::f32x4 r; r[0] = ub0(a) * __builtin_amdgcn_rcpf(ub0(b)); r[1] = ub1(a) * __builtin_amdgcn_rcpf(ub1(b)); r[2] = ub2(a) * __builtin_amdgcn_rcpf(ub2(b)); r[3] = ub3(a) * __builtin_amdgcn_rcpf(ub3(b)); return r; }
__device__ __forceinline__ pg8::f32x4 gate_val4(unsigned a) { pg8::f32x4 r; r[0] = ub0(a); r[1] = ub1(a); r[2] = ub2(a); r[3] = ub3(a); return r * (1.0f / 255.0f); }
__device__ __forceinline__ float gelu_tanh(float v) {
    const float u = __builtin_fmaf(v * v, -0.10294324f, -2.3022082f);
    return v * __builtin_amdgcn_rcpf(1.0f + __builtin_amdgcn_exp2f(v * u));
}

#ifndef UPCONV_DPP
#define UPCONV_DPP 1
#endif
#define EPI_ST(p, v) (*(pg8::u32x4*)(p) = (v))
#define EPI_DRY_DECL
#define EPI_DRY_MEMBER
struct EpiPlain {
    static constexpr bool PERM = true, AFTER_DRAIN = false, SEGMENTED = false;
    pg8::bf16_t* O; int ldc; EPI_DRY_MEMBER
    __device__ __forceinline__ void operator()(const pg8::f32x4 (&acc)[2][2][4][2], const pg8::Unit& u, int wr, int wc, int fr, int fq) const {
        EPI_DRY_DECL
        const int row0 = u.pm * 256 + wr * 64 + fr, col0 = u.pn * 256 + wc * 32 + 8 * fq;
#pragma unroll
        for (int ai = 0; ai < 2; ++ai)
#pragma unroll
            for (int m = 0; m < 4; ++m) { pg8::bf16_t* rowp = O + (size_t)(row0 + ai * 128 + m * 16) * ldc + col0;
#pragma unroll
                for (int bj = 0; bj < 2; ++bj) { const pg8::f32x4 v0 = acc[ai][bj][m][0], v1 = acc[ai][bj][m][1];
                    pg8::u32x4 w; w.x = pg8::cvt_pk_bf16(v0[0], v0[1]); w.y = pg8::cvt_pk_bf16(v0[2], v0[3]); w.z = pg8::cvt_pk_bf16(v1[0], v1[1]); w.w = pg8::cvt_pk_bf16(v1[2], v1[3]);
                    EPI_ST(rowp + bj * 128, w); } }
    }
};
struct EpiInProj {
    static constexpr bool PERM = true, AFTER_DRAIN = false, SEGMENTED = false;
    const float* bias; pg8::bf16_t* T6; float* kmean; unsigned* kabs; const float* rs; const unsigned* cm; EPI_DRY_MEMBER
    __device__ __forceinline__ void operator()(pg8::f32x4 (&acc)[2][2][4][2], const pg8::Unit& u, int wr, int wc, int fr, int fq) const {
        EPI_DRY_DECL
        const int pn = u.pn; int mode, ldc, colt; pg8::bf16_t* base;
        {
            pg8::f32x4 cv[2][2];
#pragma unroll
            for (int bj = 0; bj < 2; ++bj)
#pragma unroll
                for (int n = 0; n < 2; ++n) { const pg8::u32x4 cmv = *(const pg8::u32x4*)(cm + pn * 256 + wc * 32 + 8 * fq + bj * 128 + 4 * n); const unsigned c0 = cmv.x, c1 = cmv.y, c2 = cmv.z, c3 = cmv.w;
                    pg8::f32x4 t; t[0] = __builtin_bit_cast(float, c0); t[1] = __builtin_bit_cast(float, c1); t[2] = __builtin_bit_cast(float, c2); t[3] = __builtin_bit_cast(float, c3); cv[bj][n] = t * (1.0f / 127.0f); }
#pragma unroll
            for (int ai = 0; ai < 2; ++ai)
#pragma unroll
                for (int m = 0; m < 4; ++m) { const float rsv = rs[u.pm * 256 + ai * 128 + wr * 64 + m * 16 + fr];
#pragma unroll
                    for (int bj = 0; bj < 2; ++bj)
#pragma unroll
                        for (int n = 0; n < 2; ++n) { pg8::f32x4 t;
#pragma unroll
                            for (int j = 0; j < 4; ++j) { const float af = acc[ai][bj][m][n][j]; t[j] = (float)__builtin_bit_cast(int, af); }
                            acc[ai][bj][m][n] = (t * rsv) * cv[bj][n]; } }
        }
        if (pn < 12) { const int t = pn >> 1, slot = (t == 0) ? 0 : (t == 1) ? 3 : (t == 2) ? 1 : t + 1;
            base = T6 + (size_t)slot * M * BW; ldc = BW; colt = (pn & 1) * 256; mode = t < 2 ? 1 : (t == 2 ? 2 : 0); }
        else { base = T6; ldc = DM; colt = 0; mode = 0; }
        const int row0 = u.pm * 256 + wr * 64 + fr, col0 = colt + wc * 32 + 8 * fq, bcol0 = pn * 256 + wc * 32 + 8 * fq;
        pg8::f32x4 bv[2][2];
#pragma unroll
        for (int bj = 0; bj < 2; ++bj)
#pragma unroll
            for (int n = 0; n < 2; ++n) bv[bj][n] = *(const pg8::f32x4*)(bias + bcol0 + bj * 128 + 4 * n);
        if (pn == 6 || pn == 7) {
            const int lane = fq * 16 + fr; const int b = u.pm >> 5, jblk = u.pm & 31;
#pragma unroll
            for (int bj = 0; bj < 2; ++bj)
#pragma unroll
                for (int n = 0; n < 2; ++n) { pg8::f32x4 s = bv[bj][n] * 8.0f;
#pragma unroll
                    for (int ai = 0; ai < 2; ++ai)
#pragma unroll
                        for (int m = 0; m < 4; ++m) s = s + acc[ai][bj][m][n];
                    pg8::f32x4 mx = {0.f, 0.f, 0.f, 0.f};
#pragma unroll
                    for (int ai = 0; ai < 2; ++ai)
#pragma unroll
                        for (int m = 0; m < 4; ++m) { const pg8::f32x4 kv = acc[ai][bj][m][n] + bv[bj][n];
#pragma unroll
                            for (int j = 0; j < 4; ++j) mx[j] = fmaxf(mx[j], __builtin_fabsf(kv[j])); }
#pragma unroll
                    for (int j = 0; j < 4; ++j) { float v = s[j]; float a = mx[j];
#pragma unroll
                        for (int o = 1; o < 16; o <<= 1) { v += __builtin_bit_cast(float, __builtin_amdgcn_ds_bpermute((lane ^ o) << 2, __builtin_bit_cast(int, v)));
                            a = fmaxf(a, __builtin_bit_cast(float, __builtin_amdgcn_ds_bpermute((lane ^ o) << 2, __builtin_bit_cast(int, a)))); }
                        if (fr == 0) { const int col = (pn & 1) * 256 + bj * 128 + wc * 32 + 8 * fq + 4 * n + j; const size_t ki = ((size_t)(b * 8 + (col >> 6)) * 32 + jblk) * 64 + (col & 63);
                            atomicAdd(kmean + ki, v * (1.0f / 256.0f)); atomicMax(kabs + ki, __builtin_bit_cast(unsigned, a)); } } }
        }
#pragma unroll
        for (int ai = 0; ai < 2; ++ai)
#pragma unroll
            for (int m = 0; m < 4; ++m) { pg8::bf16_t* rowp = base + (size_t)(row0 + ai * 128 + m * 16) * ldc + col0;
#pragma unroll
                for (int bj = 0; bj < 2; ++bj) { pg8::f32x4 v0 = acc[ai][bj][m][0] + bv[bj][0], v1 = acc[ai][bj][m][1] + bv[bj][1];
                    if (mode == 1) {
#pragma unroll
                        for (int j = 0; j < 4; ++j) { v0[j] = gelu_tanh(v0[j]); v1[j] = gelu_tanh(v1[j]); } }
                    else if (mode == 2) { v0 = v0 * QSCALE; v1 = v1 * QSCALE; }
                    pg8::u32x4 w; w.x = pg8::cvt_pk_bf16(v0[0], v0[1]); w.y = pg8::cvt_pk_bf16(v0[2], v0[3]); w.z = pg8::cvt_pk_bf16(v1[0], v1[1]); w.w = pg8::cvt_pk_bf16(v1[2], v1[3]);
                    EPI_ST(rowp + bj * 128, w); } }
    }
};
struct EpiGate8 {
    static constexpr bool PERM = true, AFTER_DRAIN = false, SEGMENTED = false;
    const float* bias; unsigned char* G8; const float* rs; const unsigned* cm; EPI_DRY_MEMBER
    __device__ __forceinline__ void operator()(const pg8::f32x4 (&acc)[2][2][4][2], const pg8::Unit& u, int wr, int wc, int fr_in, int fq_in) const {
        EPI_DRY_DECL
        int fr = fr_in, fq = fq_in; asm volatile("" : "+v"(fr), "+v"(fq));
        const int pn = u.pn, bcol0 = pn * 256 + wc * 32 + 8 * fq;
        pg8::f32x4 bv[2][2];
#pragma unroll
        for (int bj = 0; bj < 2; ++bj)
#pragma unroll
            for (int n = 0; n < 2; ++n) bv[bj][n] = *(const pg8::f32x4*)(bias + bcol0 + bj * 128 + 4 * n);
        pg8::f32x4 cv[2][2];
#pragma unroll
        for (int bj = 0; bj < 2; ++bj)
#pragma unroll
            for (int n = 0; n < 2; ++n) { const pg8::u32x4 cmv = *(const pg8::u32x4*)(cm + bcol0 + bj * 128 + 4 * n); const unsigned c0 = cmv.x, c1 = cmv.y, c2 = cmv.z, c3 = cmv.w;
                pg8::f32x4 t; t[0] = __builtin_bit_cast(float, c0); t[1] = __builtin_bit_cast(float, c1); t[2] = __builtin_bit_cast(float, c2); t[3] = __builtin_bit_cast(float, c3); cv[bj][n] = t * (1.0f / 127.0f); }
        unsigned char* tp = G8 + ((size_t)((pn >> 3) * (M / 256) + u.pm) * 8 + (pn & 7)) * 65536 + (size_t)((((wr * 4 + wc) * 64) + fq * 16 + fr) * 16);
#pragma unroll
        for (int ai = 0; ai < 2; ++ai)
#pragma unroll
            for (int m = 0; m < 4; ++m) { pg8::u32x4 w; const float rsv = rs[u.pm * 256 + ai * 128 + wr * 64 + m * 16 + fr];
                pg8::f32x4 z[2][2];
#pragma unroll
                for (int bj = 0; bj < 2; ++bj)
#pragma unroll
                    for (int n = 0; n < 2; ++n) { pg8::f32x4 t;
#pragma unroll
                        for (int j = 0; j < 4; ++j) { const float af = acc[ai][bj][m][n][j]; t[j] = (float)__builtin_bit_cast(int, af); }
                        z[bj][n] = (t * rsv) * cv[bj][n] + bv[bj][n]; }
                w.x = gate_q4(z[0][0]); w.y = gate_q4(z[0][1]); w.z = gate_q4(z[1][0]); w.w = gate_q4(z[1][1]);
                EPI_ST(tp + (ai * 4 + m) * 8192, w); }
    }
};
struct EpiUpConv {
    static constexpr bool PERM = true, AFTER_DRAIN = false, SEGMENTED = false;
    pg8::bf16_t* A2; const float* wconv; const float* bconv; float* topz; float* botz; PG8_LAS float* xb; const float* rs; const unsigned* cm; EPI_DRY_MEMBER
    __device__ __forceinline__ void operator()(pg8::f32x4 (&acc)[2][2][4][2], const pg8::Unit& u, int wr, int wc, int fr_in, int fq_in) const {
        EPI_DRY_DECL
        int fr = fr_in, fq = fq_in; asm volatile("" : "+v"(fr), "+v"(fq));
        const int lane = fq * 16 + fr, wv = wr * 4 + wc, pm = u.pm, pn = u.pn;
#pragma unroll
        for (int ai = 0; ai < 2; ++ai)
#pragma unroll
            for (int m = 0; m < 4; ++m) { const float rsv = rs[pm * 256 + ai * 128 + wr * 64 + m * 16 + fr];
#pragma unroll
                for (int bj = 0; bj < 2; ++bj)
#pragma unroll
                    for (int n = 0; n < 2; ++n) { pg8::f32x4 t;
#pragma unroll
                        for (int j = 0; j < 4; ++j) { const float af = acc[ai][bj][m][n][j]; t[j] = (float)__builtin_bit_cast(int, af); }
                        acc[ai][bj][m][n] = t * rsv; } }
        if (fr >= 14) {
#pragma unroll
            for (int ai = 0; ai < 2; ++ai)
#pragma unroll
                for (int bj = 0; bj < 2; ++bj) { PG8_LAS pg8::f32x4* p = (PG8_LAS pg8::f32x4*)(xb + ((((wv * 2 + ai) * 2 + (fr - 14)) * 4 + fq) * 2 + bj) * 8); p[0] = acc[ai][bj][3][0]; p[1] = acc[ai][bj][3][1]; }
        }
        const int ecol = pn * 256 + wc * 32 + 8 * fq;
        if (wr == 0 && fr < 2) { float* t = topz + ((size_t)pm * 2 + fr) * NUP + ecol;
#pragma unroll
            for (int bj = 0; bj < 2; ++bj)
#pragma unroll
                for (int n = 0; n < 2; ++n) *(pg8::f32x4*)(t + bj * 128 + 4 * n) = acc[0][bj][0][n]; }
        if (wr == 1 && fr >= 14) { float* t = botz + ((size_t)pm * 2 + (fr - 14)) * NUP + ecol;
#pragma unroll
            for (int bj = 0; bj < 2; ++bj)
#pragma unroll
                for (int n = 0; n < 2; ++n) *(pg8::f32x4*)(t + bj * 128 + 4 * n) = acc[1][bj][3][n]; }
        asm volatile("s_waitcnt lgkmcnt(0)" ::: "memory"); __builtin_amdgcn_s_barrier(); asm volatile("" ::: "memory");
        pg8::f32x4 bnd[2][2][2];
#pragma unroll
        for (int ai = 0; ai < 2; ++ai) { const int sw = (wr == 1) ? wc : 4 + wc, sai = (wr == 1) ? ai : 0; const bool have = (wr == 1) || (ai == 1);
#pragma unroll
            for (int bj = 0; bj < 2; ++bj) { pg8::f32x4 a = {0.f, 0.f, 0.f, 0.f}, b = a;
                if (have && fr >= 14) { const PG8_LAS pg8::f32x4* p = (const PG8_LAS pg8::f32x4*)(xb + ((((sw * 2 + sai) * 2 + (fr - 14)) * 4 + fq) * 2 + bj) * 8); a = p[0]; b = p[1]; }
                bnd[ai][bj][0] = a; bnd[ai][bj][1] = b; } }
        const int s1 = (fr >= 1 ? lane - 1 : lane + 15) << 2, s2 = (fr >= 2 ? lane - 2 : lane + 14) << 2;
#pragma unroll
        for (int bj = 0; bj < 2; ++bj)
#pragma unroll
            for (int n = 0; n < 2; ++n) { const int col = (bj ? DFF : 0) + pn * 128 + wc * 32 + 8 * fq + 4 * n;
                const pg8::u32x4 cmv = *(const pg8::u32x4*)(cm + col); pg8::f32x4 csv;
                { const unsigned c0 = cmv.x, c1 = cmv.y, c2 = cmv.z, c3 = cmv.w; csv[0] = __builtin_bit_cast(float, c0); csv[1] = __builtin_bit_cast(float, c1); csv[2] = __builtin_bit_cast(float, c2); csv[3] = __builtin_bit_cast(float, c3); csv = csv * (1.0f / 127.0f); }
                const pg8::f32x4 w0 = *(const pg8::f32x4*)(wconv + col) * csv, w1 = *(const pg8::f32x4*)(wconv + NUP + col) * csv, w2 = *(const pg8::f32x4*)(wconv + 2 * NUP + col) * csv, bb = *(const pg8::f32x4*)(bconv + col);
#pragma unroll
                for (int ai = 0; ai < 2; ++ai)
#pragma unroll
                    for (int m = 3; m >= 0; --m) { const pg8::f32x4 cur = acc[ai][bj][m][n]; const pg8::f32x4 prv = (m > 0) ? acc[ai][bj][m - 1][n] : bnd[ai][bj][n];
                        pg8::f32x4 z1, z2;
#pragma unroll
                        for (int j = 0; j < 4; ++j) {
#if UPCONV_DPP
                            const float cf = cur[j], pf = prv[j];
                            const int ci = __builtin_bit_cast(int, cf), pi = __builtin_bit_cast(int, pf);
                            const int p1 = __builtin_amdgcn_mov_dpp(pi, 0x121, 0xf, 0xf, false), p2 = __builtin_amdgcn_mov_dpp(pi, 0x122, 0xf, 0xf, false);
                            z1[j] = __builtin_bit_cast(float, __builtin_amdgcn_update_dpp(p1, ci, 0x111, 0xf, 0xf, false));
                            z2[j] = __builtin_bit_cast(float, __builtin_amdgcn_update_dpp(p2, ci, 0x112, 0xf, 0xf, false));
#else
                            const float t1 = (fr == 15) ? prv[j] : cur[j], t2 = (fr >= 14) ? prv[j] : cur[j];
                            z1[j] = __builtin_bit_cast(float, __builtin_amdgcn_ds_bpermute(s1, __builtin_bit_cast(int, t1)));
                            z2[j] = __builtin_bit_cast(float, __builtin_amdgcn_ds_bpermute(s2, __builtin_bit_cast(int, t2)));
#endif
                        }
                        acc[ai][bj][m][n] = w2 * cur + w1 * z1 + w0 * z2 + bb; } }
        const int row0 = pm * 256 + wr * 64 + fr, col0 = pn * 128 + wc * 32 + 8 * fq;
#pragma unroll
        for (int ai = 0; ai < 2; ++ai)
#pragma unroll
            for (int m = 0; m < 4; ++m) { const pg8::f32x4 g0 = acc[ai][0][m][0], g1 = acc[ai][0][m][1], v0 = acc[ai][1][m][0], v1 = acc[ai][1][m][1];
                pg8::u32x4 w; w.x = pg8::cvt_pk_bf16(gelu_tanh(g0[0]) * v0[0], gelu_tanh(g0[1]) * v0[1]); w.y = pg8::cvt_pk_bf16(gelu_tanh(g0[2]) * v0[2], gelu_tanh(g0[3]) * v0[3]);
                w.z = pg8::cvt_pk_bf16(gelu_tanh(g1[0]) * v1[0], gelu_tanh(g1[1]) * v1[1]); w.w = pg8::cvt_pk_bf16(gelu_tanh(g1[2]) * v1[2], gelu_tanh(g1[3]) * v1[3]);
                EPI_ST(A2 + (size_t)(row0 + ai * 128 + m * 16) * DFF + col0, w); }
    }
};
struct EpiBranch {
    static constexpr bool PERM = true, AFTER_DRAIN = false, SEGMENTED = true; static constexpr int SEG_SHIFT = 3;
    const unsigned char* G8; pg8::bf16_t* Mb; EPI_DRY_MEMBER
    __device__ __forceinline__ void seg_hook(pg8::f32x4 (&acc)[2][2][4][2], const pg8::Unit& u, int seg, int wr, int wc, int fr, int fq) const {
        int t16 = (((wr * 4 + wc) * 64) + fq * 16 + fr) * 16;
        asm volatile("" : "+v"(t16));
        const unsigned char* Tp = G8 + ((size_t)((seg - 1) * (M / 256) + u.pm) * 8 + u.pn) * 65536 + t16; const unsigned char* Tn = Tp + (size_t)(M / 256) * 8 * 65536;
        pg8::u32x4 ga[8], gb[8];
#pragma unroll
        for (int c = 0; c < 8; ++c) { ga[c] = *(const pg8::u32x4*)(Tp + c * 8192); gb[c] = *(const pg8::u32x4*)(Tn + c * 8192); }
        asm volatile("" ::: "memory");
#pragma unroll
        for (int ai = 0; ai < 2; ++ai)
#pragma unroll
            for (int m = 0; m < 4; ++m) { const pg8::u32x4 a = ga[ai * 4 + m], b = gb[ai * 4 + m];
                acc[ai][0][m][0] = acc[ai][0][m][0] * gate_ratio4(a.x, b.x); acc[ai][0][m][1] = acc[ai][0][m][1] * gate_ratio4(a.y, b.y);
                acc[ai][1][m][0] = acc[ai][1][m][0] * gate_ratio4(a.z, b.z); acc[ai][1][m][1] = acc[ai][1][m][1] * gate_ratio4(a.w, b.w); }
        asm volatile("" ::: "memory");
    }
    __device__ __forceinline__ void operator()(const pg8::f32x4 (&acc)[2][2][4][2], const pg8::Unit& u, int wr, int wc, int fr, int fq) const {
        const int row0 = u.pm * 256 + wr * 64 + fr, col0 = u.pn * 256 + wc * 32 + 8 * fq;
        EPI_DRY_DECL
        const unsigned char* T2 = G8 + ((size_t)(2 * (M / 256) + u.pm) * 8 + u.pn) * 65536 + (size_t)((((wr * 4 + wc) * 64) + fq * 16 + fr) * 16);
        pg8::u32x4 gv[8];
#pragma unroll
        for (int c = 0; c < 8; ++c) gv[c] = *(const pg8::u32x4*)(T2 + c * 8192);
        asm volatile("" ::: "memory");
#pragma unroll
        for (int ai = 0; ai < 2; ++ai)
#pragma unroll
            for (int m = 0; m < 4; ++m) { const size_t ro = (size_t)(row0 + ai * 128 + m * 16) * DM + col0; const pg8::u32x4 g = gv[ai * 4 + m];
#pragma unroll
                for (int bj = 0; bj < 2; ++bj) { const pg8::f32x4 a0 = acc[ai][bj][m][0] * gate_val4(bj ? g.z : g.x), a1 = acc[ai][bj][m][1] * gate_val4(bj ? g.w : g.y);
                    pg8::u32x4 w; w.x = pg8::cvt_pk_bf16(a0[0], a0[1]); w.y = pg8::cvt_pk_bf16(a0[2], a0[3]); w.z = pg8::cvt_pk_bf16(a1[0], a1[1]); w.w = pg8::cvt_pk_bf16(a1[2], a1[3]);
                    EPI_ST(Mb + ro + bj * 128, w); } }
    }
};
#include <hip/hip_bf16.h>
#include <cmath>
namespace attn_body {
using bf16=__hip_bfloat16;
using bf16x8=__attribute__((ext_vector_type(8)))short;
using s16x4=__attribute__((ext_vector_type(4)))short;
using f32x16=__attribute__((ext_vector_type(16)))float;
using u32x4=__attribute__((ext_vector_type(4)))unsigned;
constexpr int BATCH=4,NHEAD=8,SEQ=8192,D=64,DM=NHEAD*D;
constexpr int NW=8,QBLK=32,QB=QBLK*NW,KVBLK=64,NQB=SEQ/QB;
constexpr int ATTN_PITCH=DM, ATTN_UNIT_ROWS=QB;
__device__ __forceinline__ int crow(int r,int hi){return (r&3)+8*(r>>2)+4*hi;}
#define SBAR() __builtin_amdgcn_sched_barrier(0)
__device__ __forceinline__ void cmask(f32x16&p0,f32x16&p1,int jb,int qrel,int hi){
  const float NEG=-INFINITY; int kb=64*jb+4*hi;
  #pragma unroll
  for(int r=0;r<16;++r){int kv=kb+(r&3)+8*(r>>2); if(kv>qrel)p0[r]=NEG; if(kv+32>qrel)p1[r]=NEG;}
}

constexpr int NSLOT=3, SLOTB=8192;
constexpr int LDS_K=0, LDS_V=NSLOT*SLOTB, LDS_WS=2*NSLOT*SLOTB, LDS_OST=LDS_WS+NW*64*4, LDS_TAB=LDS_OST+NW*4096  , LDS_BYTES=LDS_TAB+16384;
constexpr float C2=0.125f*1.4426950408889634f;
__device__ __forceinline__ void glds16(const void*gsrc,unsigned lds_dst){unsigned keep;
  asm volatile("s_mov_b32 %0, m0\n\ts_mov_b32 m0, %2\n\ts_nop 0\n\tglobal_load_lds_dwordx4 %1, off\n\ts_mov_b32 m0, %0":"=&s"(keep):"v"(gsrc),"s"(lds_dst):"memory");}
__device__ __forceinline__ float max3f(float a,float b,float c){float r;asm("v_max3_f32 %0, %1, %2, %3":"=v"(r):"v"(a),"v"(b),"v"(c));return r;}
__device__ __forceinline__ float max2f(float a,float b){float r;asm("v_max_f32_e32 %0, %1, %2":"=v"(r):"v"(a),"v"(b));return r;}
__device__ __forceinline__ float fadd_s(float a,float b){float r;asm("v_add_f32_e32 %0, %1, %2":"=v"(r):"v"(a),"v"(b));return r;}
__device__ __forceinline__ float fsub_s(float a,float b){float r;asm("v_sub_f32_e32 %0, %1, %2":"=v"(r):"v"(a),"v"(b));return r;}
typedef float f32x2_t __attribute__((ext_vector_type(2))); typedef __bf16 bf16x2_t __attribute__((ext_vector_type(2)));
__device__ __forceinline__ unsigned cvtpk_s(float lo,float hi){f32x2_t v={lo,hi};bf16x2_t b=__builtin_convertvector(v,bf16x2_t);return __builtin_bit_cast(unsigned,b);}
#define WAIT_BAR(N) asm volatile("s_waitcnt vmcnt(" #N ") lgkmcnt(0)\n\ts_barrier":::"memory")

__device__ __forceinline__ void qkt(f32x16&p0,f32x16&p1,const char*Kslot,const bf16x8*qr,const f32x16&negm,int r32,int hi){
  const char*kb=Kslot+hi*1024+r32*16;
  #pragma unroll
  for(int d0=0;d0<4;++d0){
    const bf16x8 b0=*reinterpret_cast<const bf16x8*>(kb+d0*2048);
    const bf16x8 b1=*reinterpret_cast<const bf16x8*>(kb+d0*2048+512);
    if(d0==0){p0=__builtin_amdgcn_mfma_f32_32x32x16_bf16(b0,qr[0],negm,0,0,0);p1=__builtin_amdgcn_mfma_f32_32x32x16_bf16(b1,qr[0],negm,0,0,0);}
    else{p0=__builtin_amdgcn_mfma_f32_32x32x16_bf16(b0,qr[d0],p0,0,0,0);p1=__builtin_amdgcn_mfma_f32_32x32x16_bf16(b1,qr[d0],p1,0,0,0);}}
}
typedef __attribute__((address_space(3))) const char* lds_cptr;
typedef short v4i16_t __attribute__((ext_vector_type(4)));
__device__ __forceinline__ void kload8(bf16x8*kf,lds_cptr kp){
  kf[0]=*(const __attribute__((address_space(3))) bf16x8*)(kp);      kf[1]=*(const __attribute__((address_space(3))) bf16x8*)(kp+512);
  kf[2]=*(const __attribute__((address_space(3))) bf16x8*)(kp+2048); kf[3]=*(const __attribute__((address_space(3))) bf16x8*)(kp+2560);
  kf[4]=*(const __attribute__((address_space(3))) bf16x8*)(kp+4096); kf[5]=*(const __attribute__((address_space(3))) bf16x8*)(kp+4608);
  kf[6]=*(const __attribute__((address_space(3))) bf16x8*)(kp+6144); kf[7]=*(const __attribute__((address_space(3))) bf16x8*)(kp+6656);
}
__device__ __forceinline__ void kload2(bf16x8*kf,lds_cptr kp,int j){ kf[2*j]=*(const __attribute__((address_space(3))) bf16x8*)(kp+j*2048); kf[2*j+1]=*(const __attribute__((address_space(3))) bf16x8*)(kp+j*2048+512); }
__device__ __forceinline__ s16x4 vtr(lds_cptr p){ return __builtin_bit_cast(s16x4,__builtin_amdgcn_ds_read_tr16_b64_v4i16((__attribute__((address_space(3))) v4i16_t*)p)); }
__device__ __forceinline__ float rowmax(const f32x16&p0,const f32x16&p1){
  float a=max3f(p0[0],p0[1],p1[0]),b=max3f(p0[2],p0[3],p1[1]);a=max3f(a,p1[2],p1[3]);
  #pragma unroll
  for(int r=4;r<16;r+=4){a=max3f(a,p0[r],p0[r+1]);b=max3f(b,p0[r+2],p0[r+3]);a=max3f(a,p1[r],p1[r+1]);b=max3f(b,p1[r+2],p1[r+3]);}
  const float m=max2f(a,b);
  auto rr=__builtin_amdgcn_permlane32_swap(__float_as_uint(m),__float_as_uint(m),false,false);
  return max2f(__uint_as_float(rr[0]),__uint_as_float(rr[1]));
}
__device__ __forceinline__ void pv(f32x16*o,int vb,bf16x8 pa0,bf16x8 pa1,bf16x8 pa2,bf16x8 pa3){
  #pragma unroll
  for(int d0=0;d0<2;++d0){s16x4 lo[4],hi[4];
    #pragma unroll
    for(int ks=0;ks<4;++ks){
      asm volatile("ds_read_b64_tr_b16 %0,%1 offset:%c2":"=&v"(lo[ks]):"v"(vb),"i"(d0*4096+ks*1024):"memory");
      asm volatile("ds_read_b64_tr_b16 %0,%1 offset:%c2":"=&v"(hi[ks]):"v"(vb),"i"(d0*4096+ks*1024+512):"memory");}
    asm volatile("s_waitcnt lgkmcnt(0)":::"memory");SBAR();
    #define PK(k) (bf16x8){lo[k][0],lo[k][1],lo[k][2],lo[k][3],hi[k][0],hi[k][1],hi[k][2],hi[k][3]}
    o[d0]=__builtin_amdgcn_mfma_f32_32x32x16_bf16(pa0,PK(0),o[d0],0,0,0);
    o[d0]=__builtin_amdgcn_mfma_f32_32x32x16_bf16(pa1,PK(1),o[d0],0,0,0);
    o[d0]=__builtin_amdgcn_mfma_f32_32x32x16_bf16(pa2,PK(2),o[d0],0,0,0);
    o[d0]=__builtin_amdgcn_mfma_f32_32x32x16_bf16(pa3,PK(3),o[d0],0,0,0);
    #undef PK
  }
}

#ifndef ATTN_STORE16
#define ATTN_STORE16(p,v) (*(u32x4*)(p)=(v))
#endif
template<int THRL> __device__ __forceinline__ void attn_unit(int b,int h,int qb,const bf16*Q,const bf16*__restrict__ K,const bf16*__restrict__ V,const float*__restrict__ KM,const float*__restrict__ KA,bf16*O,char*shm,int wave_s){
  int tid_l=wave_s*64+pg8::lane_now(); asm volatile("":"+v"(tid_l));
  const int tid=tid_l,lane=tid&63,r32=lane&31,hi=lane>>5; const int wid=__builtin_amdgcn_readfirstlane(tid>>6);
  const long rowbase=(long)b*SEQ; const int q0=qb*QB;
  const bf16*Qw=Q+(rowbase+q0+wid*QBLK)*DM+h*D;
  const bf16*Kh=K+rowbase*DM+h*D,*Vh=V+rowbase*DM+h*D;
  const unsigned lds0=(unsigned)(uintptr_t)shm;
  float*wsf=(float*)(shm+LDS_WS)+wid*64;
  const bf16*ksrc_=Kh+(long)lane*DM+wid*8;
  const bf16*vsrc_=Vh+(long)(16*(wid&3)+(lane>>2))*DM+(wid>>2)*32+(lane&3)*8;
  const unsigned kdst=lds0+LDS_K+wid*1024, vdst=lds0+LDS_V+wid*1024;
  const bf16*ksrc=ksrc_,*vsrc=vsrc_;
  #define DMA_K(t,slot) glds16(ksrc+(long)(t)*KVBLK*DM,(unsigned)__builtin_amdgcn_readfirstlane(kdst+(slot)))
  #define DMA_V(t,slot) glds16(vsrc+(long)(t)*KVBLK*DM,(unsigned)__builtin_amdgcn_readfirstlane(vdst+(slot)))
  const int vb0=(int)(lds0+LDS_V)+((lane>>4)&1)*32+(lane&3)*8+(4*hi+((lane&15)>>2))*64;
  const char*Kbase=shm+LDS_K; bf16x8 kf[8];
  const lds_cptr shm3=(lds_cptr)shm; const lds_cptr kp0=shm3+LDS_K+hi*1024+r32*16; const lds_cptr vp0=shm3+LDS_V+((lane>>4)&1)*32+(lane&3)*8+(4*hi+((lane&15)>>2))*64;
  int NT=(q0+QB)/KVBLK;
  { const float4*gm=reinterpret_cast<const float4*>(KM+((long)(b*NHEAD+h)*32)*64), *ga=reinterpret_cast<const float4*>(KA+((long)(b*NHEAD+h)*32)*64);
    float4*lm=reinterpret_cast<float4*>(shm+LDS_TAB), *la=reinterpret_cast<float4*>(shm+LDS_TAB+8192);
    lm[tid]=gm[tid]; la[tid]=ga[tid];
    asm volatile("s_waitcnt vmcnt(0) lgkmcnt(0)\n\ts_barrier":::"memory"); }
  bf16x8 qr[4];
  #pragma unroll
  for(int d0=0;d0<4;++d0)qr[d0]=*reinterpret_cast<const bf16x8*>(&Qw[(long)r32*DM+d0*16+hi*8]);
  float mhat=0.f,l_reg=0.f;f32x16 o[2];o[0]=f32x16{};o[1]=f32x16{};
  const int qrel=wid*QBLK+r32;
  const float sl2=1.4426950408889634f*__builtin_amdgcn_exp2f(-(float)(h+1));
  const float hb4=sl2*(float)(4*hi), sl32=32.f*sl2;
  unsigned selmask=0u;
  { float qf[32];
    #pragma unroll
    for(int d0=0;d0<4;++d0){
      #pragma unroll
      for(int j=0;j<8;++j)qf[d0*8+j]=__builtin_bit_cast(float,((unsigned)(unsigned short)qr[d0][j])<<16);}
    { const bf16*Kd=Kh+(long)(q0+qrel)*DM; float acc=0.f;
      #pragma unroll
      for(int d0=0;d0<4;++d0){ const bf16x8 kq=*reinterpret_cast<const bf16x8*>(&Kd[d0*16+hi*8]);
        #pragma unroll
        for(int j=0;j<8;++j)acc+=qf[d0*8+j]*__builtin_bit_cast(float,((unsigned)(unsigned short)kq[j])<<16);}
      auto rr=__builtin_amdgcn_permlane32_swap(__float_as_uint(acc),__float_as_uint(acc),false,false);
      mhat=(__uint_as_float(rr[0])+__uint_as_float(rr[1]))+sl2*(float)qrel; }
    float v0=-INFINITY,v1=-INFINITY,v2=-INFINITY; int i0=-1,i1=-1,i2=-1; unsigned nearmask=0u;
    const float*KMb=reinterpret_cast<const float*>(shm+LDS_TAB)+hi*8; const float*KAb=reinterpret_cast<const float*>(shm+LDS_TAB+8192)+hi*8;
    for(int j=0;j<qb;++j){ const float*km=KMb+j*64; const float*ka=KAb+j*64; float sp=0.f, up=0.f;
      #pragma unroll
      for(int d0=0;d0<4;++d0){ const float4 a=*reinterpret_cast<const float4*>(km+d0*16), c=*reinterpret_cast<const float4*>(km+d0*16+4);
        sp+=qf[d0*8+0]*a.x+qf[d0*8+1]*a.y+qf[d0*8+2]*a.z+qf[d0*8+3]*a.w+qf[d0*8+4]*c.x+qf[d0*8+5]*c.y+qf[d0*8+6]*c.z+qf[d0*8+7]*c.w;
        const float4 e=*reinterpret_cast<const float4*>(ka+d0*16), f=*reinterpret_cast<const float4*>(ka+d0*16+4);
        up+=__builtin_fabsf(qf[d0*8+0])*e.x+__builtin_fabsf(qf[d0*8+1])*e.y+__builtin_fabsf(qf[d0*8+2])*e.z+__builtin_fabsf(qf[d0*8+3])*e.w+__builtin_fabsf(qf[d0*8+4])*f.x+__builtin_fabsf(qf[d0*8+5])*f.y+__builtin_fabsf(qf[d0*8+6])*f.z+__builtin_fabsf(qf[d0*8+7])*f.w;}
      auto rr=__builtin_amdgcn_permlane32_swap(__float_as_uint(sp),__float_as_uint(sp),false,false);
      const float sc=__uint_as_float(rr[0])+__uint_as_float(rr[1]);
      { auto ru=__builtin_amdgcn_permlane32_swap(__float_as_uint(up),__float_as_uint(up),false,false); const float ub=(__uint_as_float(ru[0])+__uint_as_float(ru[1]))*1.01f;
        if(ub+sl2*(float)(256*j+255-q0)-mhat>-70.f)nearmask|=1u<<j; }
      if(sc>v2){ if(sc>v1){ v2=v1;i2=i1; if(sc>v0){v1=v0;i1=i0;v0=sc;i0=j;} else {v1=sc;i1=j;} } else {v2=sc;i2=j;} } }
    if(i0>=0)selmask|=1u<<i0; if(i1>=0)selmask|=1u<<i1; if(i2>=0)selmask|=1u<<i2;
    unsigned need=selmask&nearmask;
    #pragma unroll
    for(int o_=1;o_<64;o_<<=1)need|=(unsigned)__builtin_amdgcn_ds_bpermute((lane^o_)<<2,(int)need);
    volatile unsigned*xw=(volatile unsigned*)(shm+LDS_OST);
    if(lane==0)xw[wid]=need;
    asm volatile("s_waitcnt lgkmcnt(0)\n\ts_barrier":::"memory");
    unsigned na=xw[0]|xw[1]|xw[2]|xw[3]|xw[4]|xw[5]|xw[6]|xw[7];
    na=(unsigned)__builtin_amdgcn_readfirstlane((int)na)|(1u<<qb);
    const int nskip=__builtin_ctz(na);
    NT-=4*nskip; selmask>>=nskip; ksrc+=(long)nskip*256*DM; vsrc+=(long)nskip*256*DM; }
  f32x16 negm;
  #pragma unroll
  for(int r=0;r<16;++r)negm[r]=sl2*(float)((r&3)+8*(r>>2));
  asm volatile("":"+v"(negm));
  #define ABIAS(P0,P1,t) do{ const int tt_=(t); const bool on_=(tt_>=NT-4)||(((selmask>>(tt_>>2))&1u)!=0u); \
    const float L0_=on_?((sl2*(float)(64*(tt_-(NT-4)))+hb4)-mhat):-INFINITY; const float L1_=L0_+sl32; \
    _Pragma("unroll") for(int r=0;r<16;++r){P0[r]+=L0_;P1[r]+=L1_;} }while(0)
  #define CMASK(P0,P1,t) do{int jb_=(t)-(NT-4); if(jb_>=0)cmask(P0,P1,jb_,qrel,hi);}while(0)
  bool resc=false;
  #define START(P0,P1) do{ const float rm=rowmax(P0,P1); resc=false; \
    if(__any(rm>(float)THRL)){ const float dl=__builtin_fmaxf(rm,0.f); mhat+=dl; \
      _Pragma("unroll") for(int r=0;r<16;++r){P0[r]-=dl;P1[r]-=dl;} } \
    _Pragma("unroll") for(int r=0;r<16;++r)P0[r]=__builtin_amdgcn_exp2f(P0[r]); }while(0)
  #define RESC() do{ if(resc){ asm volatile("s_waitcnt lgkmcnt(0)":::"memory"); \
      _Pragma("unroll") for(int d_=0;d_<2;++d_) _Pragma("unroll") for(int r=0;r<16;++r)o[d_][r]*=wsf[crow(r,hi)]; } }while(0)
  f32x16 pA0,pA1,pB0,pB1;
  int sl_prev=0,sl_cur=0,sl_next=SLOTB;
  #define ROT() do{sl_prev=sl_cur;sl_cur=sl_next;sl_next=(sl_next==(NSLOT-1)*SLOTB)?0:sl_next+SLOTB;}while(0)
  DMA_K(0,0);DMA_V(0,0);DMA_K(1,SLOTB);
  DMA_K(2,2*SLOTB);
  WAIT_BAR(3);
  qkt(pA0,pA1,Kbase,qr,negm,r32,hi);asm volatile("s_nop 15\n\ts_nop 7":"+v"(pA0),"+v"(pA1));ABIAS(pA0,pA1,0);CMASK(pA0,pA1,0);
  START(pA0,pA1);
  _Pragma("unroll") for(int r=0;r<16;++r)pA1[r]=__builtin_amdgcn_exp2f(pA1[r]);
  WAIT_BAR(0);
  DMA_K(3,0);DMA_V(1,SLOTB);
  ROT();
  kload8(kf,kp0+sl_cur);
  WAIT_BAR(2);
  s16x4 vlo[8],vhi[8]; u32x4 pw0,pw1,pw2,pw3;
  #define PKW(P,B) cvtpk_s(P[B],P[B+1])
  #define PAF(k) __builtin_bit_cast(bf16x8,pw##k)
  #define VFR(i) (bf16x8){vlo[i][0],vlo[i][1],vlo[i][2],vlo[i][3],vhi[i][0],vhi[i][1],vhi[i][2],vhi[i][3]}
  #define PIN(x) asm volatile("":"+v"(x))
  #define MX3(a,b,c) __builtin_fmaxf(__builtin_fmaxf((a),(b)),(c))
  #define GAPA(MF,A0,A1,A2,A3,W0,W1,PW) do{ MF; sacc+=A0; sacc+=A1; sacc+=A2; sacc+=A3; PIN(sacc); W0; W1; PIN(PW); SBAR(); }while(0)
  #define EX(v) __builtin_amdgcn_exp2f(v)
  #define GAPB(MF,X,B) do{ MF; X[B]=EX(X[B]); X[B+1]=EX(X[B+1]); X[B+2]=EX(X[B+2]); X[B+3]=EX(X[B+3]); PIN(X); SBAR(); }while(0)
  #define VRD(i) do{ vlo[i]=vtr(vp_+(((i)>>2)*4096+((i)&3)*1024)); vhi[i]=vtr(vp_+(((i)>>2)*4096+((i)&3)*1024+512)); }while(0)
  #define KRD(G,j) do{ if(G){ kload2(kf,kp0+sl_next,j); SBAR(); } }while(0)
  #define STEP(C0,C1,P0,P1,t,GK,GV,GL) do{ SBAR(); \
    const lds_cptr vp_=vp0+sl_prev; \
    VRD(0); SBAR(); float sacc=(P0[0]+P0[1]); \
    GAPA(C0=__builtin_amdgcn_mfma_f32_32x32x16_bf16(kf[0],qr[0],negm,0,0,0), P0[2],P0[3],P0[4],P0[5],     pw0[0]=PKW(P0,0), pw0[1]=PKW(P0,2), pw0); \
    VRD(4); SBAR(); GAPA(C1=__builtin_amdgcn_mfma_f32_32x32x16_bf16(kf[1],qr[0],negm,0,0,0), P0[6],P0[7],P0[8],P0[9],     pw0[2]=PKW(P0,4), pw0[3]=PKW(P0,6), pw0); \
    VRD(1); SBAR(); GAPA(C0=__builtin_amdgcn_mfma_f32_32x32x16_bf16(kf[2],qr[1],C0,0,0,0),   P0[10],P0[11],P0[12],P0[13], pw1[0]=PKW(P0,8), pw1[1]=PKW(P0,10), pw1); \
    VRD(5); SBAR(); GAPA(C1=__builtin_amdgcn_mfma_f32_32x32x16_bf16(kf[3],qr[1],C1,0,0,0),   P0[14],P0[15],P1[0],P1[1],   pw1[2]=PKW(P0,12),pw1[3]=PKW(P0,14), pw1); \
    VRD(2); SBAR(); GAPA(C0=__builtin_amdgcn_mfma_f32_32x32x16_bf16(kf[4],qr[2],C0,0,0,0),   P1[2],P1[3],P1[4],P1[5],     pw2[0]=PKW(P1,0), pw2[1]=PKW(P1,2), pw2); \
    VRD(6); SBAR(); GAPA(C1=__builtin_amdgcn_mfma_f32_32x32x16_bf16(kf[5],qr[2],C1,0,0,0),   P1[6],P1[7],P1[8],P1[9],     pw2[2]=PKW(P1,4), pw2[3]=PKW(P1,6), pw2); \
    VRD(3); SBAR(); GAPA(C0=__builtin_amdgcn_mfma_f32_32x32x16_bf16(kf[6],qr[3],C0,0,0,0),   P1[10],P1[11],P1[12],P1[13], pw3[0]=PKW(P1,8), pw3[1]=PKW(P1,10), pw3); \
    VRD(7); SBAR(); GAPA(C1=__builtin_amdgcn_mfma_f32_32x32x16_bf16(kf[7],qr[3],C1,0,0,0),   P1[14],P1[15],0.f,0.f,       pw3[2]=PKW(P1,12),pw3[3]=PKW(P1,14), pw3); \
    l_reg+=sacc; \
    if(GK){DMA_K((t)+3,sl_cur);} if(GV){DMA_V((t)+1,sl_next);} \
    ABIAS(C0,C1,t); CMASK(C0,C1,t); \
    { float a=MX3(C0[0],C0[1],C1[0]),b=MX3(C0[2],C0[3],C1[1]); a=MX3(a,C1[2],C1[3]); \
      _Pragma("unroll") for(int r=4;r<16;r+=4){a=MX3(a,C0[r],C0[r+1]);b=MX3(b,C0[r+2],C0[r+3]);a=MX3(a,C1[r],C1[r+1]);b=MX3(b,C1[r+2],C1[r+3]);} \
      float rm=__builtin_fmaxf(a,b); { auto rr=__builtin_amdgcn_permlane32_swap(__float_as_uint(rm),__float_as_uint(rm),false,false); rm=__builtin_fmaxf(__uint_as_float(rr[0]),__uint_as_float(rr[1])); } \
      resc=false; \
      if(__builtin_expect(__any(rm>(float)THRL),0)){ const float dl=__builtin_fmaxf(rm,0.f); mhat+=dl; \
        _Pragma("unroll") for(int r=0;r<16;++r){C0[r]-=dl;C1[r]-=dl;} \
        const float f=__builtin_amdgcn_exp2f(-dl); l_reg*=f; if(hi==0)wsf[r32]=f; resc=true; } } \
    SBAR(); \
    GAPB(o[0]=__builtin_amdgcn_mfma_f32_32x32x16_bf16(PAF(0),VFR(0),o[0],0,0,0), C0,0); \
    GAPB(o[1]=__builtin_amdgcn_mfma_f32_32x32x16_bf16(PAF(0),VFR(4),o[1],0,0,0), C0,4); \
    KRD(GL,0); GAPB(o[0]=__builtin_amdgcn_mfma_f32_32x32x16_bf16(PAF(1),VFR(1),o[0],0,0,0), C0,8); \
    KRD(GL,1); GAPB(o[1]=__builtin_amdgcn_mfma_f32_32x32x16_bf16(PAF(1),VFR(5),o[1],0,0,0), C0,12); \
    KRD(GL,2); GAPB(o[0]=__builtin_amdgcn_mfma_f32_32x32x16_bf16(PAF(2),VFR(2),o[0],0,0,0), C1,0); \
    KRD(GL,3); GAPB(o[1]=__builtin_amdgcn_mfma_f32_32x32x16_bf16(PAF(2),VFR(6),o[1],0,0,0), C1,4); \
    GAPB(o[0]=__builtin_amdgcn_mfma_f32_32x32x16_bf16(PAF(3),VFR(3),o[0],0,0,0), C1,8); \
    GAPB(o[1]=__builtin_amdgcn_mfma_f32_32x32x16_bf16(PAF(3),VFR(7),o[1],0,0,0), C1,12); \
    }while(0)
  int t=1;
  #undef CMASK
  #define CMASK(P0,P1,t) do{}while(0)
  for(;t+5<NT;t+=2){
    STEP(pB0,pB1,pA0,pA1,t,true,true,true);     WAIT_BAR(2); RESC(); ROT();
    STEP(pA0,pA1,pB0,pB1,t+1,true,true,true);   WAIT_BAR(2); RESC(); ROT();
  }
  #undef CMASK
  #define CMASK(P0,P1,t) do{int jb_=(t)-(NT-4); if(jb_>=0)cmask(P0,P1,jb_,qrel,hi);}while(0)
  #define ENDW(tt) do{ if((tt)+3<NT){WAIT_BAR(2);} else if((tt)+2<NT){WAIT_BAR(1);} else {WAIT_BAR(0);} }while(0)
  for(;t+1<NT;t+=2){
    STEP(pB0,pB1,pA0,pA1,t,(t+3<NT),(t+1<NT),(t+1<NT));       ENDW(t);   RESC(); ROT();
    STEP(pA0,pA1,pB0,pB1,t+1,(t+4<NT),(t+2<NT),(t+2<NT));     ENDW(t+1); RESC(); ROT();
  }
  STEP(pB0,pB1,pA0,pA1,NT-1,false,false,false); RESC();
  { float sacc=pB0[0]+pB0[1]; _Pragma("unroll") for(int r=2;r<16;++r)sacc+=pB0[r]; _Pragma("unroll") for(int r=0;r<16;++r)sacc+=pB1[r]; l_reg+=sacc;
    pw0=(u32x4){PKW(pB0,0),PKW(pB0,2),PKW(pB0,4),PKW(pB0,6)};pw1=(u32x4){PKW(pB0,8),PKW(pB0,10),PKW(pB0,12),PKW(pB0,14)};pw2=(u32x4){PKW(pB1,0),PKW(pB1,2),PKW(pB1,4),PKW(pB1,6)};pw3=(u32x4){PKW(pB1,8),PKW(pB1,10),PKW(pB1,12),PKW(pB1,14)};
    SBAR(); pv(o,vb0+sl_cur,PAF(0),PAF(1),PAF(2),PAF(3)); }
  #undef PKW
  #undef PAF
  #undef VFR
  #undef PIN
  #undef MX3
  #undef GAPA
  #undef GAPB
  #undef EX
  #undef VRD
  #undef KRD
  #undef STEP
  #undef ENDW
  {auto rr=__builtin_amdgcn_permlane32_swap(__float_as_uint(l_reg),__float_as_uint(l_reg),false,false);l_reg=__uint_as_float(rr[0])+__uint_as_float(rr[1]);}
  if(hi==0)wsf[32+r32]=l_reg;asm volatile("s_waitcnt lgkmcnt(0)":::"memory");
  float rli[16];
  #pragma unroll
  for(int r=0;r<16;++r)rli[r]=__builtin_amdgcn_rcpf(wsf[32+crow(r,hi)]);
  bf16*Ow=O+(rowbase+q0+wid*QBLK)*DM+h*D;
  { bf16*stg=(bf16*)(shm+LDS_OST)+wid*2048;
    #pragma unroll
    for(int r=0;r<16;++r){const int orow=crow(r,hi);
      #pragma unroll
      for(int d0=0;d0<2;++d0)stg[orow*64+d0*32+r32]=__float2bfloat16(o[d0][r]*rli[r]);}
    asm volatile("s_waitcnt lgkmcnt(0)":::"memory");
    #pragma unroll
    for(int i=0;i<4;++i){const int row=i*8+(lane>>3),ch=lane&7; const u32x4 v=*(const u32x4*)(stg+row*64+ch*8); ATTN_STORE16(Ow+(long)row*DM+ch*8,v);} }
  asm volatile("s_waitcnt lgkmcnt(0)\n\ts_barrier":::"memory");
  #undef DMA_K
  #undef DMA_V
  #undef CMASK
  #undef ABIAS
  #undef START
  #undef RESC
  #undef ROT
}
constexpr int ATTN_LDS_BYTES=LDS_BYTES;
struct AttnTensors { const bf16* Q; const bf16* K; const bf16* V; const float* KM; const float* KA; bf16* O; };
struct AttnUnit { int bh; int qb; };
struct StaticOrder {
  int vcu;
  __device__ __forceinline__ explicit StaticOrder(int grid,int block):vcu((block%8)*(grid/8)+block/8){}
  __device__ __forceinline__ bool next(int i,AttnUnit&u)const{ if(i>=4)return false; const int s=vcu&7; u.bh=vcu>>3; u.qb=(i==0)?s:(i==1)?15-s:(i==2)?16+s:31-s; return true; }
  __device__ __forceinline__ void a_ready(const AttnUnit&)const{}
  __device__ __forceinline__ void done(const AttnUnit&)const{}
};
struct QueueOrder {
  unsigned* ctr; volatile unsigned* slot; int wv;
  __device__ __forceinline__ bool next(int,AttnUnit&u)const{
    if(wv==0&&pg8::lane_now()==0)*slot=__hip_atomic_fetch_add(ctr,1u,__ATOMIC_RELAXED,__HIP_MEMORY_SCOPE_AGENT);
    asm volatile("s_waitcnt vmcnt(0) lgkmcnt(0)\n\ts_barrier":::"memory");
    const unsigned idx=(unsigned)__builtin_amdgcn_readfirstlane((int)*slot);
    if(idx>=(unsigned)(BATCH*NHEAD*NQB))return false;
    u.qb=NQB-1-(int)(idx>>5); u.bh=(int)(idx&31u); return true; }
  __device__ __forceinline__ void a_ready(const AttnUnit&)const{}
  __device__ __forceinline__ void done(const AttnUnit&)const{}
};
template<class Sched,int THRL=8> __device__ __forceinline__ void attn_phase(char*lds,const AttnTensors&T,const Sched&S,int wave_s){
  AttnUnit u;
  for(int i=0;S.next(i,u);++i){ S.a_ready(u); attn_unit<THRL>(u.bh/NHEAD,u.bh%NHEAD,u.qb,T.Q,T.K,T.V,T.KM,T.KA,T.O,lds,wave_s); S.done(u); }
}
#undef SBAR
#undef WAIT_BAR
}
constexpr size_t MiB = (size_t)1 << 20;
constexpr size_t WS_CTL = 0, CTL_ZERO_BYTES = 2 * MiB;
constexpr size_t WS_W0 = 2 * MiB;
constexpr size_t WO_IN = 0, WO_SGU = 36 * MiB, WO_MOBA = 38 * MiB, WO_POOL = 40 * MiB, WO_OUT = 42 * MiB, WO_UP = 50 * MiB, WO_DOWN = 94 * MiB;
constexpr size_t WS_SMALL = 118 * MiB;
constexpr size_t WS_MOD = WS_SMALL + 768 * 1024;
constexpr size_t WS_KMEAN = 512 * 1024;
constexpr size_t WS_KABS = 1 * MiB;
constexpr size_t WS_SGUW = WS_SMALL;
constexpr size_t WS_POOLWT = WS_SMALL + 512 * 1024;
constexpr size_t WS_MODP = 120 * MiB;
constexpr size_t WS_TOPZ = 126 * MiB, WS_BOTZ = 137 * MiB;
constexpr size_t WS_H = 148 * MiB;
constexpr size_t WS_T6 = 276 * MiB;
constexpr size_t WS_G3 = 500 * MiB;
constexpr size_t WS_Y = 276 * MiB;
constexpr size_t WS_A2 = 500 * MiB;
constexpr size_t WS_XR = 884 * MiB;
constexpr size_t WS_H8 = WS_G3 + 192 * MiB;
constexpr size_t WO_IN8 = 6 * MiB;
constexpr size_t WS_CMAX = 64 * 1024;
constexpr size_t WS_CMAXG = WS_CMAX + 96 * 1024;
constexpr size_t WS_RS1 = WS_SMALL + 1280 * 1024 + 128 * 1024;
constexpr size_t WS_RS = WS_SMALL + 1280 * 1024;
constexpr size_t WS_END = 1012 * MiB;
constexpr int CW_TMO = 0, CW_CODE = 1, CW_BAR = 4096, CW_ATTNQ = 8192;
constexpr int RING_BYTES = 131072, XB_OFF = RING_BYTES  , LDSCTL_OFF = 139264, MISC_OFF = LDSCTL_OFF + 320, LDS_BYTES = 147456;

__device__ __forceinline__ float lane_xor(float v, int lane, int o) { return __builtin_bit_cast(float, __builtin_amdgcn_ds_bpermute((lane ^ o) << 2, __builtin_bit_cast(int, v))); }
__device__ __forceinline__ float wave_sum(float v, int lane) {
#pragma unroll
    for (int o = 1; o < 64; o <<= 1) v += lane_xor(v, lane, o);
    return v;
}
__device__ __forceinline__ float wave_max(float v, int lane) {
#pragma unroll
    for (int o = 1; o < 64; o <<= 1) v = fmaxf(v, lane_xor(v, lane, o));
    return v;
}
typedef unsigned u32x2v __attribute__((ext_vector_type(2)));
__device__ __forceinline__ void transpose_item(const float* W, int K, int N, bf16* WT, bool upperm, LAS float* scr, int item, int lane, int f8split = 1 << 30, unsigned char* W8 = nullptr, const unsigned* cmax8 = nullptr, const unsigned* cmaxg = nullptr) {
    const int nblk = N / 32, kb = item / nblk, nb = item % nblk, k0 = 64 * kb, n0 = 32 * nb;
    int drow0 = n0;
    if (upperm) drow0 = (n0 < DFF) ? (n0 >> 7) * 256 + (n0 & 127) : ((n0 - DFF) >> 7) * 256 + 128 + ((n0 - DFF) & 127);
    float v[32];
    const float* src = W + (size_t)(k0 + (lane >> 5)) * N + n0 + (lane & 31);
#pragma unroll
    for (int i = 0; i < 32; ++i) v[i] = __builtin_nontemporal_load(src + (size_t)(2 * i) * N);
#pragma unroll
    for (int i = 0; i < 32; ++i) scr[(2 * i + (lane >> 5)) * 33 + (lane & 31)] = v[i];
    LDS_WAIT(); asm volatile("" ::: "memory");
    const int c = lane & 7;
    if (cmax8) {
#pragma unroll
        for (int j = 0; j < 4; ++j) { const int n = (lane >> 3) + 8 * j; const LAS float* s = scr + (8 * c) * 33 + n;
            const unsigned cb = cmax8[n0 + n]; const float cmx = __builtin_bit_cast(float, cb); const float inv = cmx > 0.f ? 127.0f / cmx : 0.f;
            u32x2v o; o.x = q8x4(s[0 * 33], s[1 * 33], s[2 * 33], s[3 * 33], inv); o.y = q8x4(s[4 * 33], s[5 * 33], s[6 * 33], s[7 * 33], inv);
            *(GAS u32x2v*)((unsigned char*)WT + (size_t)(drow0 + n) * K + k0 + 8 * c) = o; }
    } else if (n0 >= f8split) {
#pragma unroll
        for (int j = 0; j < 4; ++j) { const int n = (lane >> 3) + 8 * j; const LAS float* s = scr + (8 * c) * 33 + n;
            const unsigned cb = cmaxg[n0 - f8split + n]; const float cmx = __builtin_bit_cast(float, cb); const float inv = cmx > 0.f ? 127.0f / cmx : 0.f;
            u32x2v o; o.x = q8x4(s[0 * 33], s[1 * 33], s[2 * 33], s[3 * 33], inv); o.y = q8x4(s[4 * 33], s[5 * 33], s[6 * 33], s[7 * 33], inv);
            *(GAS u32x2v*)(W8 + (size_t)(n0 - f8split + n) * K + k0 + 8 * c) = o; }
    } else {
#pragma unroll
    for (int j = 0; j < 4; ++j) { const int n = (lane >> 3) + 8 * j; const LAS float* s = scr + (8 * c) * 33 + n;
        v4u o; o.x = pg8::cvt_pk_bf16(s[0 * 33], s[1 * 33]); o.y = pg8::cvt_pk_bf16(s[2 * 33], s[3 * 33]); o.z = pg8::cvt_pk_bf16(s[4 * 33], s[5 * 33]); o.w = pg8::cvt_pk_bf16(s[6 * 33], s[7 * 33]);
        __builtin_nontemporal_store(o, (GAS v4u*)(WT + (size_t)(drow0 + n) * K + k0 + 8 * c)); }
    }
    LDS_WAIT(); asm volatile("" ::: "memory");
}

template <bool NTST> __device__ __forceinline__ void strip_quant(const float* W, int N, unsigned char* WT8, bool upperm, unsigned* cmax_out, LAS unsigned char* lds, int strip, int lane, int wave) {
    const int n0 = 32 * strip;
    int drow0 = n0;
    if (upperm) drow0 = (n0 < DFF) ? (n0 >> 7) * 256 + (n0 & 127) : ((n0 - DFF) >> 7) * 256 + 128 + ((n0 - DFF) & 127);
    LAS float* scr = (LAS float*)(lds + wave * 8448);
    LAS float* cmx = (LAS float*)(lds + 8 * 8448);
    float v[4][32];
#pragma unroll
    for (int b = 0; b < 4; ++b) { const float* src = W + (size_t)((4 * wave + b) * 64 + (lane >> 5)) * N + n0 + (lane & 31);
#pragma unroll
        for (int i = 0; i < 32; ++i) v[b][i] = __builtin_nontemporal_load(src + (size_t)(2 * i) * N); }
    float m = 0.f;
#pragma unroll
    for (int b = 0; b < 4; ++b)
#pragma unroll
        for (int i = 0; i < 32; ++i) m = fmaxf(m, __builtin_fabsf(v[b][i]));
    m = fmaxf(m, lane_xor(m, lane, 32));
    if (lane < 32) cmx[wave * 32 + lane] = m;
    __syncthreads();
    const int c = lane & 7;
    float inv[4];
#pragma unroll
    for (int j = 0; j < 4; ++j) { const int n = (lane >> 3) + 8 * j; float mm = 0.f;
#pragma unroll
        for (int w = 0; w < 8; ++w) mm = fmaxf(mm, cmx[w * 32 + n]);
        inv[j] = mm > 0.f ? 127.0f / mm : 0.f;
        if (wave == 0 && c == 0) cmax_out[n0 + n] = __builtin_bit_cast(unsigned, mm); }
#pragma unroll
    for (int b = 0; b < 4; ++b) { const int k0 = (4 * wave + b) * 64;
#pragma unroll
        for (int i = 0; i < 32; ++i) scr[(2 * i + (lane >> 5)) * 33 + (lane & 31)] = v[b][i];
        LDS_WAIT(); asm volatile("" ::: "memory");
#pragma unroll
        for (int j = 0; j < 4; ++j) { const int n = (lane >> 3) + 8 * j; const LAS float* sp = scr + (8 * c) * 33 + n;
            u32x2v o; o.x = q8x4(sp[0 * 33], sp[1 * 33], sp[2 * 33], sp[3 * 33], inv[j]); o.y = q8x4(sp[4 * 33], sp[5 * 33], sp[6 * 33], sp[7 * 33], inv[j]);
            if (NTST) __builtin_nontemporal_store(o, (GAS u32x2v*)(WT8 + (size_t)(drow0 + n) * DM + k0 + 8 * c)); else *(GAS u32x2v*)(WT8 + (size_t)(drow0 + n) * DM + k0 + 8 * c) = o; }
        LDS_WAIT(); asm volatile("" ::: "memory"); }
    __syncthreads();
}

template <int MODE, bool XIN_BF16, bool XOUT_BF16, bool H8OUT = false, bool HQOUT = false>
__device__ __forceinline__ void thin_phase(LAS unsigned char* lds, int tid, int lane, int wave, int bx, int G,
        const void* xin_, const bf16* yin, void* xout_, bf16* hout, unsigned char* hout8, float* rsout,
        const float* modA, const float* gA, const float* modS, const float* modT, const float* gS) {
    LAS float* vA = (LAS float*)lds; LAS float* vS = vA + 2048; LAS float* vT = vS + 2048;
    for (int rb = bx; rb < M / 128; rb += G) {
        const int b = rb >> 6;
        __syncthreads();
        for (int c = tid; c < DM; c += 512) {
            if (MODE != 0) vA[c] = modA[(size_t)b * 12288 + c] * gA[c];
            if (MODE != 2) { vS[c] = gS[c] * (1.0f + modS[(size_t)b * 12288 + c]); vT[c] = modT[(size_t)b * 12288 + c]; }
        }
        __syncthreads();
        for (int i = 0; i < 8; ++i) {
            size_t ro[2]; f32x4 x[2][8]; uint2 yr[2][8];
#pragma unroll
            for (int r = 0; r < 2; ++r) { ro[r] = (size_t)(rb * 128 + wave * 16 + i + 8 * r) * DM + 4 * lane;
#pragma unroll
                for (int j = 0; j < 8; ++j) {
                    if (XIN_BF16) { const u32x2v w = __builtin_nontemporal_load((const u32x2v*)((const bf16*)xin_ + ro[r] + 256 * j)); x[r][j] = (f32x4){bf_lo(w.x), bf_hi(w.x), bf_lo(w.y), bf_hi(w.y)}; }
                    else x[r][j] = __builtin_nontemporal_load((const f32x4*)((const float*)xin_ + ro[r] + 256 * j));
                    if (MODE != 0) { const u32x2v w = __builtin_nontemporal_load((const u32x2v*)(yin + ro[r] + 256 * j)); yr[r][j].x = w.x; yr[r][j].y = w.y; } } }
            asm volatile("" ::: "memory");
            if (MODE != 0) {
                float ss[2];
#pragma unroll
                for (int r = 0; r < 2; ++r) { ss[r] = 0.f;
#pragma unroll
                    for (int j = 0; j < 8; ++j) { const float y0 = bf_lo(yr[r][j].x), y1 = bf_hi(yr[r][j].x), y2 = bf_lo(yr[r][j].y), y3 = bf_hi(yr[r][j].y); ss[r] += (y0 * y0 + y1 * y1) + (y2 * y2 + y3 * y3); } }
#pragma unroll
                for (int o = 1; o < 64; o <<= 1) { const float t0 = lane_xor(ss[0], lane, o), t1 = lane_xor(ss[1], lane, o); ss[0] += t0; ss[1] += t1; }
#pragma unroll
                for (int r = 0; r < 2; ++r) { const float rstd = 1.0f / __builtin_sqrtf(ss[r] * (1.0f / DM) + EPS);
#pragma unroll
                    for (int j = 0; j < 8; ++j) { const f32x4 a = *(const LAS f32x4*)(vA + 4 * lane + 256 * j);
                        const f32x4 y = (f32x4){bf_lo(yr[r][j].x), bf_hi(yr[r][j].x), bf_lo(yr[r][j].y), bf_hi(yr[r][j].y)}; x[r][j] = x[r][j] + a * (y * rstd);
                        if (XOUT_BF16) { u32x2v w; w.x = pk2(x[r][j][0], x[r][j][1]); w.y = pk2(x[r][j][2], x[r][j][3]); __builtin_nontemporal_store(w, (u32x2v*)((bf16*)xout_ + ro[r] + 256 * j)); }
                        else __builtin_nontemporal_store(x[r][j], (f32x4*)((float*)xout_ + ro[r] + 256 * j)); } }
            }
            if (MODE != 2) {
                float ss[2];
#pragma unroll
                for (int r = 0; r < 2; ++r) { ss[r] = 0.f;
#pragma unroll
                    for (int j = 0; j < 8; ++j) ss[r] += (x[r][j][0] * x[r][j][0] + x[r][j][1] * x[r][j][1]) + (x[r][j][2] * x[r][j][2] + x[r][j][3] * x[r][j][3]); }
#pragma unroll
                for (int o = 1; o < 64; o <<= 1) { const float t0 = lane_xor(ss[0], lane, o), t1 = lane_xor(ss[1], lane, o); ss[0] += t0; ss[1] += t1; }
                if (HQOUT || H8OUT) {
                    float mx[2];
#pragma unroll
                    for (int r = 0; r < 2; ++r) { const float rstd = 1.0f / __builtin_sqrtf(ss[r] * (1.0f / DM) + EPS); mx[r] = 0.f;
#pragma unroll
                        for (int j = 0; j < 8; ++j) { const f32x4 sv = *(const LAS f32x4*)(vS + 4 * lane + 256 * j), tv = *(const LAS f32x4*)(vT + 4 * lane + 256 * j);
                            const f32x4 h = x[r][j] * rstd * sv + tv; x[r][j] = h;
                            mx[r] = fmaxf(fmaxf(mx[r], fmaxf(__builtin_fabsf(h[0]), __builtin_fabsf(h[1]))), fmaxf(__builtin_fabsf(h[2]), __builtin_fabsf(h[3]))); } }
#pragma unroll
                    for (int o = 1; o < 64; o <<= 1) { const float t0 = lane_xor(mx[0], lane, o), t1 = lane_xor(mx[1], lane, o); mx[0] = fmaxf(mx[0], t0); mx[1] = fmaxf(mx[1], t1); }
#pragma unroll
                    for (int r = 0; r < 2; ++r) { const float inv = mx[r] > 0.f ? 127.0f / mx[r] : 0.f;
                        if (lane == 0) rsout[ro[r] / DM] = mx[r] * (1.0f / 127.0f);
                        unsigned char* qdst = HQOUT ? (unsigned char*)hout : hout8;
#pragma unroll
                        for (int j = 0; j < 8; ++j) { *(unsigned*)(qdst + ro[r] + 256 * j) = q8x4(x[r][j][0], x[r][j][1], x[r][j][2], x[r][j][3], inv);
                            if (!HQOUT) { uint2 w; w.x = pk2(x[r][j][0], x[r][j][1]); w.y = pk2(x[r][j][2], x[r][j][3]); *(uint2*)(hout + ro[r] + 256 * j) = w; } } }
                } else
#pragma unroll
                for (int r = 0; r < 2; ++r) { const float rstd = 1.0f / __builtin_sqrtf(ss[r] * (1.0f / DM) + EPS);
#pragma unroll
                    for (int j = 0; j < 8; ++j) { const f32x4 sv = *(const LAS f32x4*)(vS + 4 * lane + 256 * j), tv = *(const LAS f32x4*)(vT + 4 * lane + 256 * j);
                        const f32x4 h = x[r][j] * rstd * sv + tv; uint2 w; w.x = pk2(h[0], h[1]); w.y = pk2(h[2], h[3]); *(uint2*)(hout + ro[r] + 256 * j) = w; } }
            }
        }
    }
    __syncthreads();
}

typedef float f32x16_t __attribute__((ext_vector_type(16)));
constexpr int VNT_LD = 136;
__device__ __forceinline__ void sgu_mfma_chunk(LAS unsigned char* lds, int chunk, const bf16* Vt, const bf16* Ut, bf16* Uo, const float* norm_g, const bf16* Wm  , const float* sgu_b, int lane, int wave) {
    LAS unsigned short* vnT = (LAS unsigned short*)lds;
    const int t0 = chunk * 128;
    float g8[8];
#pragma unroll
    for (int e = 0; e < 8; ++e) g8[e] = norm_g[lane + 64 * e];
    for (int i4 = 0; i4 < 4; ++i4) {
        float v[4][8];
#pragma unroll
        for (int i = 0; i < 4; ++i) { const bf16* vr = Vt + (size_t)(t0 + wave * 16 + i4 * 4 + i) * BW + lane;
#pragma unroll
            for (int e = 0; e < 8; ++e) v[i][e] = bf2f(__builtin_nontemporal_load(vr + 64 * e)); }
#pragma unroll
        for (int i = 0; i < 4; ++i) { const int s = wave * 16 + i4 * 4 + i; float sum = 0.f;
#pragma unroll
            for (int e = 0; e < 8; ++e) sum += v[i][e];
            const float mu = wave_sum(sum, lane) * (1.0f / BW); float q = 0.f;
#pragma unroll
            for (int e = 0; e < 8; ++e) { v[i][e] -= mu; q += v[i][e] * v[i][e]; }
            const float rstd = 1.0f / __builtin_sqrtf(wave_sum(q, lane) * (1.0f / BW) + EPS);
#pragma unroll
            for (int e = 0; e < 8; ++e) vnT[(lane + 64 * e) * VNT_LD + s] = (unsigned short)f2bf(v[i][e] * rstd * g8[e]); }
    }
    __syncthreads();
    const int r32 = lane & 31, hi = lane >> 5, g = wave;
    f32x16_t acc[4][2];
#pragma unroll
    for (int ti = 0; ti < 4; ++ti)
#pragma unroll
        for (int dj = 0; dj < 2; ++dj)
#pragma unroll
            for (int r = 0; r < 16; ++r) acc[ti][dj][r] = 0.f;
    const bf16* Wg = Wm + (size_t)g * 16384 + (size_t)r32 * 128 + 8 * hi;
    const LAS unsigned short* vb = vnT + (64 * g + r32) * VNT_LD + 8 * hi;
#pragma unroll
    for (int ks = 0; ks < 8; ++ks) {
        const bf16x8 b0 = *(const LAS bf16x8*)(vb + 16 * ks), b1 = *(const LAS bf16x8*)(vb + 32 * VNT_LD + 16 * ks);
#pragma unroll
        for (int ti = 0; ti < 4; ++ti) if (16 * ks <= 32 * ti + 31) {
            const bf16x8 a = *(const bf16x8*)(Wg + (size_t)ti * 32 * 128 + 16 * ks);
            acc[ti][0] = __builtin_amdgcn_mfma_f32_32x32x16_bf16(b0, a, acc[ti][0], 0, 0, 0);
            acc[ti][1] = __builtin_amdgcn_mfma_f32_32x32x16_bf16(b1, a, acc[ti][1], 0, 0, 0); }
    }
#pragma unroll
    for (int ti = 0; ti < 4; ++ti) { const int t = 32 * ti + r32; const float bs = sgu_b[g * 128 + t];
#pragma unroll
        for (int dj = 0; dj < 2; ++dj)
#pragma unroll
            for (int rg = 0; rg < 4; ++rg) { const size_t o = (size_t)(t0 + t) * BW + 64 * g + 32 * dj + 8 * rg + 4 * hi;
                const u32x2v uu = __builtin_nontemporal_load((const u32x2v*)(Ut + o)); uint2 w;
                w.x = pk2(bf_lo(uu.x) * (acc[ti][dj][4 * rg + 0] + bs), bf_hi(uu.x) * (acc[ti][dj][4 * rg + 1] + bs)); w.y = pk2(bf_lo(uu.y) * (acc[ti][dj][4 * rg + 2] + bs), bf_hi(uu.y) * (acc[ti][dj][4 * rg + 3] + bs));
                *(uint2*)(Uo + o) = w; } }
    __syncthreads();
}

constexpr int PA_LD = 520;
template <int W> __device__ __forceinline__ void pool_window(LAS unsigned short* pa, const bf16* ZP, int t0, int c) {
    float z[64 + W - 1];
    const int pos0 = t0 & (SEQ - 1);
#pragma unroll
    for (int i = 0; i < 64 + W - 1; ++i) { const int dt = i - (W - 1); z[i] = (pos0 + dt >= 0) ? bf2f(__builtin_nontemporal_load(ZP + (size_t)(t0 + dt) * BW + c)) : 0.f; }
#pragma unroll
    for (int tl = 0; tl < 64; ++tl) { float s = 0.f;
#pragma unroll
        for (int i = 0; i < W; ++i) s += z[tl + (W - 1) - i];
        const int pos = pos0 + tl; const float cnt = (float)((pos + 1 < W) ? pos + 1 : W);
        pa[tl * PA_LD + c] = (unsigned short)f2bf(s / cnt - z[tl + W - 1]); }
}
__device__ __forceinline__ void pool_mfma_tile(LAS unsigned char* lds, int tile, const bf16* ZP, bf16* YPo, const bf16* PWT  , const float* pool_scale, int tid, int lane, int wave) {
    LAS unsigned short* pa = (LAS unsigned short*)lds;
    const int t0 = tile * 64, c = tid, gsel = wave >> 1;
    if (gsel == 0) pool_window<2>(pa, ZP, t0, c); else if (gsel == 1) pool_window<4>(pa, ZP, t0, c); else if (gsel == 2) pool_window<8>(pa, ZP, t0, c); else pool_window<16>(pa, ZP, t0, c);
    __syncthreads();
    const int r32 = lane & 31, hi = lane >> 5, g = wave >> 1, dh = wave & 1;
    f32x16_t acc[2][2];
#pragma unroll
    for (int ti = 0; ti < 2; ++ti)
#pragma unroll
        for (int dj = 0; dj < 2; ++dj)
#pragma unroll
            for (int r = 0; r < 16; ++r) acc[ti][dj][r] = 0.f;
    const bf16* Bg = PWT + ((size_t)g * 128 + 64 * dh + r32) * 128 + 8 * hi;
    const LAS unsigned short* ab = pa + r32 * PA_LD + 128 * g + 8 * hi;
#pragma unroll
    for (int ks = 0; ks < 8; ++ks) {
        const bf16x8 b0 = *(const bf16x8*)(Bg + 16 * ks), b1 = *(const bf16x8*)(Bg + (size_t)32 * 128 + 16 * ks);
        const bf16x8 a0 = *(const LAS bf16x8*)(ab + 16 * ks), a1 = *(const LAS bf16x8*)(ab + 32 * PA_LD + 16 * ks);
        acc[0][0] = __builtin_amdgcn_mfma_f32_32x32x16_bf16(b0, a0, acc[0][0], 0, 0, 0); acc[0][1] = __builtin_amdgcn_mfma_f32_32x32x16_bf16(b1, a0, acc[0][1], 0, 0, 0);
        acc[1][0] = __builtin_amdgcn_mfma_f32_32x32x16_bf16(b0, a1, acc[1][0], 0, 0, 0); acc[1][1] = __builtin_amdgcn_mfma_f32_32x32x16_bf16(b1, a1, acc[1][1], 0, 0, 0);
    }
#pragma unroll
    for (int dj = 0; dj < 2; ++dj)
#pragma unroll
        for (int rg = 0; rg < 4; ++rg) { const int oc = 128 * g + 64 * dh + 32 * dj + 8 * rg + 4 * hi; const f32x4 sc = *(const f32x4*)(pool_scale + oc);
#pragma unroll
            for (int ti = 0; ti < 2; ++ti) { uint2 w; w.x = pk2(acc[ti][dj][4 * rg + 0] * sc[0], acc[ti][dj][4 * rg + 1] * sc[1]); w.y = pk2(acc[ti][dj][4 * rg + 2] * sc[2], acc[ti][dj][4 * rg + 3] * sc[3]);
                *(uint2*)(YPo + (size_t)(t0 + 32 * ti + r32) * BW + oc) = w; } }
    __syncthreads();
}

#ifndef NREP_GEMM
#define NREP_GEMM 1
#endif
#ifndef WGM_WIDE
#define WGM_WIDE 4
#endif
#ifndef WGM_NARROW
#define WGM_NARROW 4
#endif
#ifndef GP_ALIGN
#define GP_ALIGN true
#endif
#ifndef GP_SP2
#define GP_SP2 true
#endif
#ifndef PROBE_BAR2
#define PROBE_BAR2 0
#endif
#ifndef NREP_P0
#define NREP_P0 1
#endif
#ifndef NREP_ATTN
#define NREP_ATTN 1
#endif
#ifndef NREP_MIX
#define NREP_MIX 1
#endif
#ifndef NREP_THIN
#define NREP_THIN 1
#endif
#define PHASE_IDS() int tid_o = wave_s * 64 + pg8::lane_now(); asm volatile("" : "+v"(tid_o)); const int tid = tid_o, lane = tid & 63, wave = __builtin_amdgcn_readfirstlane(tid >> 6), gw = bx * NWAVES + wave, NGW = G * NWAVES; (void)lane; (void)gw; (void)NGW; (void)wave
struct Args { const float* in[23]; float* out; unsigned char* ws; };
__global__ void __launch_bounds__(NWAVES * 64, 2) fwd_kernel(Args args) {
    extern __shared__ __attribute__((aligned(16))) unsigned char lds_raw[];
    LAS unsigned char* lds = (LAS unsigned char*)lds_raw;
    const int G = gridDim.x, bx = blockIdx.x;
    int wave_s = __builtin_amdgcn_readfirstlane((int)(threadIdx.x >> 6)); asm volatile("" : "+s"(wave_s));
    gu32* ctl = (gu32*)(args.ws + WS_CTL);
    for (int u = threadIdx.x; u < (LDS_BYTES - LDSCTL_OFF) / 4; u += NWAVES * 64) ((LAS unsigned*)(lds + LDSCTL_OFF))[u] = 0u;
    __syncthreads();
    volatile LAS unsigned* MISC = (volatile LAS unsigned*)(lds + MISC_OFF);
    XcdBarrier bar = xcd_barrier_post((unsigned*)(ctl + CW_BAR), MISC + 8);
#define GRID_BAR() do { XcdBarrier b_ = bar; asm volatile("" : "+s"(b_.x), "+s"(b_.bar)); xcd_barrier(b_); if (PROBE_BAR2) xcd_barrier(b_); } while (0)
    const volatile __attribute__((address_space(4))) unsigned long long* kargs = (const volatile __attribute__((address_space(4))) unsigned long long*)__builtin_amdgcn_kernarg_segment_ptr();
#define INP(i) ((const float*)(const GAS float*)kargs[(i)])
#define OUTP ((float*)(GAS float*)kargs[23])
#define WSB ((unsigned char*)(GAS unsigned char*)kargs[24])
#define in_x INP(0)
#define in_c INP(1)
#define g_pre_mix INP(2)
#define g_post_mix INP(3)
#define g_pre_ffn INP(4)
#define g_post_ffn INP(5)
#define w_ada INP(6)
#define b_ada INP(7)
#define w_in INP(8)
#define b_in INP(9)
#define sgu_norm_g INP(10)
#define sgu_w INP(11)
#define sgu_b INP(12)
#define pool_w INP(13)
#define pool_scale INP(14)
#define w_sgu_out INP(15)
#define w_moba_out INP(16)
#define w_pool_out INP(17)
#define w_out INP(18)
#define w_up INP(19)
#define w_conv INP(20)
#define b_conv INP(21)
#define w_down INP(22)
#define out OUTP
#define MOD ((float*)(WSB + WS_MOD))
#define MODP ((float*)(WSB + WS_MODP))
#define KMEAN ((float*)(WSB + WS_KMEAN))
#define H ((bf16*)(WSB + WS_H))
#define T6 ((bf16*)(WSB + WS_T6))
#define G3 ((unsigned char*)(WSB + WS_G3))
#define H8 ((unsigned char*)(WSB + WS_H8))
#define Yb ((bf16*)(WSB + WS_Y))
#define XR ((bf16*)(WSB + WS_XR))
#define A2 ((bf16*)(WSB + WS_A2))
#define Ut T6
#define Qt (T6 + (size_t)1 * M * BW)
#define YP (T6 + (size_t)2 * M * BW)
#define Vt (T6 + (size_t)3 * M * BW)
#define Kt (T6 + (size_t)4 * M * BW)
#define VAt (T6 + (size_t)5 * M * BW)
#define ZPt (T6 + (size_t)6 * M * BW)

    for (int rep0_ = 0; rep0_ < NREP_P0; ++rep0_) {
    {   PHASE_IDS();
        LAS float* cond = (LAS float*)(lds + 69632);
        for (int i = tid; i < BATCH * DM; i += NWAVES * 64) { const float c = in_c[i]; cond[i] = c * sigmoid_f(c); }
        __syncthreads();
        for (int w0 = gw; w0 < 1536 + 64 * NWAVES; w0 += NGW) { const int wt = w0 - 64 * NWAVES; if (wt < 0) continue;
            const int ks = wt / 96, cb = wt % 96, l = cb / 48, n0 = (cb % 48) * 256 + 4 * lane;
            const float* wp = w_ada + ((size_t)l * DM + ks * 128) * 12288 + n0;
            f32x4 a0 = {0.f, 0.f, 0.f, 0.f}, a1 = a0, a2 = a0, a3 = a0;
#pragma unroll 8
            for (int k = 0; k < 128; ++k) { const f32x4 w = __builtin_nontemporal_load((const f32x4*)(wp + (size_t)k * 12288)); const int kk = ks * 128 + k;
                a0 += cond[kk] * w; a1 += cond[DM + kk] * w; a2 += cond[2 * DM + kk] * w; a3 += cond[3 * DM + kk] * w; }
            float* pp = MODP + (size_t)(ks * 8 + l * 4) * 12288 + n0;
            *(f32x4*)(pp) = a0; *(f32x4*)(pp + 12288) = a1; *(f32x4*)(pp + 2 * 12288) = a2; *(f32x4*)(pp + 3 * 12288) = a3;
        }
        LAS float* scr = (LAS float*)(lds + wave * 8448);
#define CONVERT_ITEMS(l, WB, LO, HI, SLOT, NSLOT) \
        for (int it = (LO) + (SLOT) * NWAVES + wave; it < (HI); it += (NSLOT) * NWAVES) { int r = it; \
            bf16* Wc = (bf16*)(WB); \
            if (r < 9216) { transpose_item(w_in + (size_t)(l) * DM * INW, DM, INW, (bf16*)((unsigned char*)Wc + WO_IN), false, scr, r, lane, 0, (unsigned char*)Wc + WO_IN, nullptr, (const unsigned*)(WSB + WS_CMAXG) + (size_t)(l) * 9216); continue; } r -= 9216; \
            if (r < 512) { transpose_item(w_sgu_out + (size_t)(l) * BW * DM, BW, DM, (bf16*)((unsigned char*)Wc + WO_SGU), false, scr, r, lane); continue; } r -= 512; \
            if (r < 512) { transpose_item(w_moba_out + (size_t)(l) * BW * DM, BW, DM, (bf16*)((unsigned char*)Wc + WO_MOBA), false, scr, r, lane); continue; } r -= 512; \
            if (r < 512) { transpose_item(w_pool_out + (size_t)(l) * BW * DM, BW, DM, (bf16*)((unsigned char*)Wc + WO_POOL), false, scr, r, lane); continue; } r -= 512; \
            if (r < 2048) { transpose_item(w_out + (size_t)(l) * DM * DM, DM, DM, (bf16*)((unsigned char*)Wc + WO_OUT), false, scr, r, lane); continue; } r -= 2048; \
            if (r < 11264) { transpose_item(w_up + (size_t)(l) * DM * NUP, DM, NUP, (bf16*)((unsigned char*)Wc + WO_UP), true, scr, r, lane, 1 << 30, nullptr, (const unsigned*)(WSB + WS_CMAX) + (size_t)(l) * NUP); continue; } r -= 11264; \
            transpose_item(w_down + (size_t)(l) * DFF * DM, DFF, DM, (bf16*)((unsigned char*)Wc + WO_DOWN), false, scr, r, lane); \
        }
#define QUANT_STRIPS(l, WB, S0, S1, SLOT, NSLOT, NT) { __syncthreads(); \
          for (int st = (S0) + (SLOT); st < (S1); st += (NSLOT)) { \
              if (st < 288) strip_quant<NT>(w_in + (size_t)(l) * DM * INW, INW, (WB) + WO_IN, false, (unsigned*)(WSB + WS_CMAXG) + (size_t)(l) * 9216, lds, st, lane, wave); \
              else strip_quant<NT>(w_up + (size_t)(l) * DM * NUP, NUP, (WB) + WO_UP, true, (unsigned*)(WSB + WS_CMAX) + (size_t)(l) * NUP, lds, st - 288, lane, wave); } }
        QUANT_STRIPS(0, WSB + WS_W0, 0, 288, bx, G, false)
        { bf16* SW = (bf16*)(WSB + WS_SGUW); bf16* PW = (bf16*)(WSB + WS_POOLWT); const float* sw = sgu_w; const float* pw = pool_w;
          for (int i = bx * NWAVES * 64 + tid; i < 2 * 8 * 16384; i += G * NWAVES * 64) { const int t = (i >> 7) & 127, sI = i & 127; SW[i] = (bf16)((sI <= t) ? f2bf(sw[i]) : 0u); }
          for (int i = bx * NWAVES * 64 + tid; i < 2 * 4 * 16384; i += G * NWAVES * 64) { const int lg = i >> 14, d = (i >> 7) & 127, cI = i & 127; PW[i] = (bf16)f2bf(pw[(size_t)lg * 16384 + cI * 128 + d]); } }
        GRID_BAR();
    }
    {   PHASE_IDS();
        for (int v = bx * NWAVES * 64 + tid; v < 2 * BATCH * 12288; v += G * NWAVES * 64) {
            const int lb = v / 12288, n = v % 12288; float s = b_ada[(size_t)(lb >> 2) * 12288 + n];
            for (int ks = 0; ks < 16; ++ks) s += MODP[(size_t)(ks * 8 + lb) * 12288 + n];
            MOD[v] = s; }
        GRID_BAR();
    }
    { PHASE_IDS(); thin_phase<0, false, false, false, true>(lds, tid, lane, wave, bx, G, in_x, nullptr, nullptr, (bf16*)H8, nullptr, (float*)(WSB + WS_RS1), nullptr, nullptr, MOD + 2048, MOD + 0, g_pre_mix); }
    GRID_BAR();
    }

    for (int l = 0; l < DEPTH; ++l) {
#define Wl (l == 0 ? WSB + WS_W0 : (unsigned char*)OUTP)
#define modl (MOD + (size_t)l * BATCH * 12288)
        for (int rep_ = 0; rep_ < NREP_GEMM; ++rep_)
        { { pg8::Gemm g{(const bf16*)H8, (const bf16*)(Wl + WO_IN), M, 3072, DM / 2}; pg8::StaticOrder S; S.init(M, 3072, G, bx, WGM_WIDE);
            EpiInProj E{b_in + (size_t)l * INW, T6, KMEAN + (size_t)l * 65536, (unsigned*)(WSB + WS_KABS) + (size_t)l * 65536, (const float*)(WSB + WS_RS1), (const unsigned*)(WSB + WS_CMAXG) + (size_t)l * 9216};
            pg8::gemm_phase<EpiInProj, pg8::StaticOrder, GP_ALIGN, GP_SP2, false, true>(lds, g, S, E, wave_s); }
          GRID_BAR(); }
        for (int rep_ = 0; rep_ < NREP_GEMM; ++rep_)
        {
          { pg8::Gemm g{(const bf16*)H8, (const bf16*)(Wl + WO_IN + WO_IN8), M, 6144, DM / 2}; pg8::StaticOrder S; S.init(M, 6144, G, bx, WGM_WIDE);
            EpiGate8 E{b_in + (size_t)l * INW + 3072, G3, (const float*)(WSB + WS_RS1), (const unsigned*)(WSB + WS_CMAXG) + (size_t)l * 9216 + 3072};
            pg8::gemm_phase<EpiGate8, pg8::StaticOrder, GP_ALIGN, GP_SP2, false, true>(lds, g, S, E, wave_s); }
          GRID_BAR(); }
        { PHASE_IDS();
          for (int repa_ = NREP_ATTN - 1; repa_ >= 0; --repa_)
          { const attn_body::AttnTensors AT{(const attn_body::bf16*)Qt, (const attn_body::bf16*)Kt, (const attn_body::bf16*)VAt, KMEAN + (size_t)l * 65536, (const float*)(WSB + WS_KABS) + (size_t)l * 65536, repa_ ? (attn_body::bf16*)H : (attn_body::bf16*)Qt};
            const attn_body::QueueOrder AS{(unsigned*)(WSB + WS_CTL) + CW_ATTNQ + 64 * l + 16 * repa_, (volatile unsigned*)((char*)lds_raw + MISC_OFF + 64), wave_s};
            {
              const unsigned nent = (l == 0) ? 1536u : 1024u;
              for (;;) {
                  if (AS.wv == 0 && pg8::lane_now() == 0) *AS.slot = __hip_atomic_fetch_add(AS.ctr, 1u, __ATOMIC_RELAXED, __HIP_MEMORY_SCOPE_AGENT);
                  asm volatile("s_waitcnt vmcnt(0) lgkmcnt(0)\n\ts_barrier" ::: "memory");
                  const unsigned idx = (unsigned)__builtin_amdgcn_readfirstlane((int)*AS.slot);
                  if (idx >= nent) break;
                  unsigned a_ = idx; int bun = -1;
                  if (l == 0) { const unsigned grp = idx / 3u, rr = idx - 3u * grp; if (rr < 2u) a_ = 2u * grp + rr; else bun = (int)grp; }
                  if (bun < 0) { const int qb_ = attn_body::NQB - 1 - (int)(a_ >> 5), bh_ = (int)(a_ & 31u);
                      attn_body::attn_unit<8>(bh_ / attn_body::NHEAD, bh_ % attn_body::NHEAD, qb_, AT.Q, AT.K, AT.V, AT.KM, AT.KA, AT.O, (char*)lds_raw, wave_s); }
                  else { const int lane = pg8::lane_now(); LAS float* scr = (LAS float*)(lds + wave * 8448);
                      if (bun < 256) { const int c_ = bun; CONVERT_ITEMS(0, WSB + WS_W0, 9216, 12800, c_, 256) CONVERT_ITEMS(0, WSB + WS_W0, 24064, 29696, c_, 256) QUANT_STRIPS(0, WSB + WS_W0, 288, 640, c_, 256, true) }
                      else { const int c_ = bun - 256; CONVERT_ITEMS(1, (unsigned char*)OUTP, 9216, 12800, c_, 256) CONVERT_ITEMS(1, (unsigned char*)OUTP, 24064, 29696, c_, 256) QUANT_STRIPS(1, (unsigned char*)OUTP, 0, 640, c_, 256, true) }
                      __syncthreads(); }
              } } }
          __syncthreads();
          for (int repm_ = NREP_MIX - 1; repm_ >= 0; --repm_) {
          for (int chunk = bx; chunk < M / 128; chunk += G) sgu_mfma_chunk(lds, chunk, Vt, Ut, repm_ ? H : Ut, sgu_norm_g + (size_t)l * BW, (const bf16*)(WSB + WS_SGUW) + (size_t)l * 8 * 16384, sgu_b + (size_t)l * 8 * 128, lane, wave);
          for (int tile = bx; tile < M / 64; tile += G) pool_mfma_tile(lds, tile, ZPt, YP, (const bf16*)(WSB + WS_POOLWT) + (size_t)l * 4 * 16384, pool_scale + (size_t)l * BW, tid, lane, wave);
          }
          GRID_BAR(); }
        for (int rep_ = 0; rep_ < NREP_GEMM; ++rep_)
        { pg8::Gemm g{Ut, (const bf16*)(Wl + WO_SGU), M, DM, BW, 3, (size_t)M * BW * 2, (size_t)2 * MiB}; pg8::StaticOrder S; S.init(M, DM, G, bx, WGM_NARROW);
          EpiBranch E{G3, H};
          pg8::gemm_phase<EpiBranch, pg8::StaticOrder, GP_ALIGN, GP_SP2>(lds, g, S, E, wave_s);
          GRID_BAR(); }
        for (int rep_ = 0; rep_ < NREP_GEMM; ++rep_)
        { pg8::Gemm g{H, (const bf16*)(Wl + WO_OUT), M, DM, DM}; pg8::StaticOrder S; S.init(M, DM, G, bx, WGM_NARROW);
          EpiPlain E{Yb, DM};
          pg8::gemm_phase<EpiPlain, pg8::StaticOrder, GP_ALIGN, GP_SP2>(lds, g, S, E, wave_s);
          GRID_BAR(); }
        for (int rept_ = 0; rept_ < (l == 0 ? NREP_THIN : 1); ++rept_)
        { PHASE_IDS(); if (l == 0) thin_phase<1, false, true, false, true>(lds, tid, lane, wave, bx, G, in_x, Yb, XR, H, nullptr, (float*)(WSB + WS_RS), modl + 4096, g_post_mix + (size_t)l * DM, modl + 8192, modl + 6144, g_pre_ffn + (size_t)l * DM);
          else thin_phase<1, true, true, false, true>(lds, tid, lane, wave, bx, G, XR, Yb, XR, H, nullptr, (float*)(WSB + WS_RS), modl + 4096, g_post_mix + (size_t)l * DM, modl + 8192, modl + 6144, g_pre_ffn + (size_t)l * DM); }
        GRID_BAR();
        for (int rep_ = 0; rep_ < NREP_GEMM; ++rep_)
        { pg8::Gemm g{H, (const bf16*)(Wl + WO_UP), M, NUP, DM / 2}; pg8::StaticOrder S; S.init(M, NUP, G, bx, WGM_WIDE);
          EpiUpConv E{A2, w_conv + (size_t)l * 3 * NUP, b_conv + (size_t)l * NUP, (float*)(WSB + WS_TOPZ), (float*)(WSB + WS_BOTZ), (LAS float*)(lds + XB_OFF), (const float*)(WSB + WS_RS), (const unsigned*)(WSB + WS_CMAX) + (size_t)l * NUP};
          pg8::gemm_phase<EpiUpConv, pg8::StaticOrder, true, GP_SP2, false, true>(lds, g, S, E, wave_s);
          GRID_BAR(); }
        { PHASE_IDS(); const float* wc = w_conv + (size_t)l * 3 * NUP; const float* bc = b_conv + (size_t)l * NUP;
          const float* TZ = (const float*)(WSB + WS_TOPZ); const float* BZ = (const float*)(WSB + WS_BOTZ); bf16* a2 = A2;
          for (int it = bx * NWAVES * 64 + tid; it < (M / 256) * DFF; it += G * NWAVES * 64) { const int pm = it / DFF, n = it % DFF; if ((pm & 31) == 0) continue;
              const int cg = (n >> 7) * 256 + (n & 127);
              float res[2];
              float zc[2][2];
#pragma unroll
              for (int k = 0; k < 2; ++k) { const int c = cg + 128 * k, pc = n + DFF * k;
                  const float t0 = TZ[((size_t)pm * 2 + 0) * NUP + c], t1 = TZ[((size_t)pm * 2 + 1) * NUP + c], b0 = BZ[((size_t)(pm - 1) * 2 + 0) * NUP + c], b1 = BZ[((size_t)(pm - 1) * 2 + 1) * NUP + c];
                  const unsigned cmb = ((const unsigned*)(WSB + WS_CMAX))[(size_t)l * NUP + pc]; const float csc = __builtin_bit_cast(float, cmb) * (1.0f / 127.0f);
                  const float w0 = wc[pc] * csc, w1 = wc[NUP + pc] * csc, w2 = wc[2 * NUP + pc] * csc, bb = bc[pc];
                  zc[k][0] = w2 * t0 + w1 * b1 + w0 * b0 + bb; zc[k][1] = w2 * t1 + w1 * t0 + w0 * b1 + bb; }
              res[0] = gelu_tanh(zc[0][0]) * zc[1][0]; res[1] = gelu_tanh(zc[0][1]) * zc[1][1];
              a2[(size_t)(pm * 256 + 0) * DFF + n] = (bf16)f2bf(res[0]); a2[(size_t)(pm * 256 + 1) * DFF + n] = (bf16)f2bf(res[1]); }
          GRID_BAR(); }
        for (int rep_ = 0; rep_ < NREP_GEMM; ++rep_)
        { pg8::Gemm g{A2, (const bf16*)(Wl + WO_DOWN), M, DM, DFF}; pg8::StaticOrder S; S.init(M, DM, G, bx, WGM_NARROW);
          EpiPlain E{Yb, DM};
          pg8::gemm_phase<EpiPlain, pg8::StaticOrder, GP_ALIGN, GP_SP2>(lds, g, S, E, wave_s);
          GRID_BAR(); }
        if (l == 0) { PHASE_IDS(); thin_phase<1, true, true, false, true>(lds, tid, lane, wave, bx, G, XR, Yb, XR, (bf16*)H8, nullptr, (float*)(WSB + WS_RS1), modl + 10240, g_post_ffn, MOD + (size_t)BATCH * 12288 + 2048, MOD + (size_t)BATCH * 12288, g_pre_mix + DM);
            GRID_BAR(); }
        else { PHASE_IDS(); thin_phase<2, true, false>(lds, tid, lane, wave, bx, G, XR, Yb, out, nullptr, nullptr, nullptr, modl + 10240, g_post_ffn + (size_t)l * DM, nullptr, nullptr, nullptr); }
    }
#undef GRID_BAR
}
#undef INP
#undef OUTP
#undef WSB
#undef in_x
#undef in_c
#undef g_pre_mix
#undef g_post_mix
#undef g_pre_ffn
#undef g_post_ffn
#undef w_ada
#undef b_ada
#undef w_in
#undef b_in
#undef sgu_norm_g
#undef sgu_w
#undef sgu_b
#undef pool_w
#undef pool_scale
#undef w_sgu_out
#undef w_moba_out
#undef w_pool_out
#undef w_out
#undef w_up
#undef w_conv
#undef b_conv
#undef w_down
#undef out
#undef MOD
#undef MODP
#undef KMEAN
#undef H
#undef T6
#undef G3
#undef H8
#undef YP
#undef Yb
#undef A2
#undef Ut
#undef Vt
#undef Qt
#undef Kt
#undef VAt
#undef ZPt
#undef Wl
#undef XR
#undef CONVERT_ITEMS
#undef QUANT_STRIPS
#undef modl

extern "C" void kernel_launch(void* const* d_in, const int* in_sizes, int n_in, void* d_out, int out_size, void* d_ws, size_t ws_size, hipStream_t stream) {
    static int grid = 0;
    if (grid == 0) {
        if (n_in != 23 || in_sizes[0] != M * DM || out_size != M * DM || ws_size < WS_END) { fprintf(stderr, "kernel_launch: unexpected shapes (n_in %d, in0 %d, out %d, ws %zu); nothing launched\n", n_in, n_in > 0 ? in_sizes[0] : -1, out_size, ws_size); grid = -1; return; }
        int dev = 0, cus = 0;
        if (hipGetDevice(&dev) != hipSuccess || hipDeviceGetAttribute(&cus, hipDeviceAttributeMultiprocessorCount, dev) != hipSuccess) { grid = -1; return; }
        if (hipFuncSetAttribute((const void*)fwd_kernel, hipFuncAttributeMaxDynamicSharedMemorySize, LDS_BYTES) != hipSuccess) { fprintf(stderr, "kernel_launch: hipFuncSetAttribute failed\n"); grid = -1; return; }
        int per_cu = 0;
        if (hipOccupancyMaxActiveBlocksPerMultiprocessor(&per_cu, (const void*)fwd_kernel, NWAVES * 64, LDS_BYTES) != hipSuccess || per_cu < 1) fprintf(stderr, "kernel_launch: occupancy query says %d\n", per_cu);
        (void)hipGetLastError();
        grid = cus;
    }
    if (grid < 0) return;
    if (hipMemsetAsync((char*)d_ws + WS_CTL, 0, CTL_ZERO_BYTES, stream) != hipSuccess) return;
    Args a{};
    for (int i = 0; i < 23; ++i) a.in[i] = (const float*)d_in[i];
    a.out = (float*)d_out; a.ws = (unsigned char*)d_ws;
    hipLaunchKernelGGL(fwd_kernel, dim3(grid), dim3(NWAVES * 64), LDS_BYTES, stream, a);
}
```
